# Optimizing an MI355X kernel written in HIP

```python
import math
import jax
import jax.numpy as jnp
from jax import lax
import numpy as np

D_MODEL = 1024
BATCH = 32
SEQ = 256
DEPTH = 2
DEC_BATCH = 8
DEC_SEQ = 4096
PAST_LEN = 512

GRID_W = 64
HEAD_DIM = 64
D_MIX = D_MODEL
GROUP_W = D_MIX // 4
NORM_EPS = 1e-6
NEG_INF = -1e30
GQA_HEADS = GROUP_W // HEAD_DIM
GQA_KV_HEADS = GQA_HEADS // 2
GQA_GROUP = GQA_HEADS // GQA_KV_HEADS
ROPE_THETA = 10000.0
Q_BLOCK = 128
RW_HEADS = GROUP_W // HEAD_DIM
RW_DECAY_RANK = 32
RW_AAA_RANK = 32
RW_GATE_RANK = 64
RW_LN_EPS = 64e-5
NA_HEADS = GROUP_W // HEAD_DIM
NA_ROWS = 8
NA_COLS = 16
NA_QCOLS = 16
NA_SPAN = NA_QCOLS + NA_COLS
DN_HEADS = GROUP_W // HEAD_DIM
DN_CONV = 5
DN_CHUNK = 64
PEER_HEADS = 8
PEER_NKEYS = 128
PEER_EXPERTS = PEER_NKEYS * PEER_NKEYS
PEER_DQ = 256
PEER_TOPK = 16
PEER_BLOCK = 128
GQA_PROJ = GROUP_W + 2 * GQA_KV_HEADS * HEAD_DIM
RW_SHIFT_COLS = 3 * GROUP_W + RW_DECAY_RANK + RW_AAA_RANK
RW_PROJ = 3 * GROUP_W + 2 * RW_DECAY_RANK + 2 * RW_AAA_RANK + RW_GATE_RANK
NA_PROJ = 3 * GROUP_W
DN_PROJ = 3 * GROUP_W + 4 * DN_HEADS + GROUP_W
IN_COLS = GQA_PROJ + RW_PROJ + NA_PROJ + DN_PROJ

kernel_name = "hybrid_diffusion_prefix_trunk_step"


def rms_norm(x, g):
    xf = x.astype(jnp.float32)
    y = xf * lax.rsqrt(jnp.mean(xf * xf, axis=-1, keepdims=True) + NORM_EPS)
    return (y * g.astype(jnp.float32)).astype(x.dtype)


def l2_norm(x):
    return x * lax.rsqrt(jnp.sum(x * x, axis=-1, keepdims=True) + NORM_EPS)


def axial_rope_tables(T):
    t = np.arange(T)
    row, col = t // GRID_W, t % GRID_W
    n_freq = HEAD_DIM // 4
    inv = ROPE_THETA ** (-2.0 * np.arange(n_freq) / (HEAD_DIM // 2))
    ang = np.concatenate([row[:, None] * inv[None], col[:, None] * inv[None]], axis=1)
    return jnp.asarray(np.cos(ang), jnp.float32), jnp.asarray(np.sin(ang), jnp.float32)


def apply_rope(x, cos, sin):
    xf = x.astype(jnp.float32)
    half = HEAD_DIM // 2
    x1, x2 = xf[..., :half], xf[..., half:]
    c, s = cos[None, :, None, :], sin[None, :, None, :]
    return jnp.concatenate([x1 * c - x2 * s, x2 * c + x1 * s], axis=-1).astype(x.dtype)


def blocked_attention(q, k, v):
    B, KVH, G, T, dh = q.shape
    nb = T // Q_BLOCK
    qb = jnp.moveaxis(q.reshape(B, KVH, G, nb, Q_BLOCK, dh), 3, 0)
    scale = HEAD_DIM ** -0.5

    def one_block(qblk):
        s = jnp.einsum("bkgqd,bkld->bkgql", qblk, k).astype(jnp.float32) * scale
        p = jax.nn.softmax(s, axis=-1).astype(v.dtype)
        return jnp.einsum("bkgql,bkld->bkgqd", p, v)

    o = lax.map(one_block, qb)
    return jnp.moveaxis(o, 0, 3).reshape(B, KVH, G, T, dh)


def neighbourhood_attention(q, k, v, bias, k_ctx, v_ctx):
    B, H, T, dh = q.shape
    rows = T // GRID_W
    wr = min(NA_ROWS, rows)
    r = np.arange(rows)
    row_idx = np.clip(r - wr // 2, 0, rows - wr)[:, None] + np.arange(wr)[None, :]
    dr_idx = row_idx - r[:, None] + (NA_ROWS - 1)
    qg = q.reshape(B, H, rows, GRID_W, dh)
    kg = k.reshape(B, H, rows, GRID_W, dh)[:, :, row_idx]
    vg = v.reshape(B, H, rows, GRID_W, dh)[:, :, row_idx]
    k_ctx = k_ctx.astype(q.dtype)
    v_ctx = v_ctx.astype(v.dtype)
    scale = HEAD_DIM ** -0.5
    n_loc = wr * NA_SPAN
    outs = []
    for qc0 in range(0, GRID_W, NA_QCOLS):
        kc0 = min(max(qc0 - NA_COLS // 2, 0), GRID_W - NA_SPAN)
        qcols = np.arange(qc0, qc0 + NA_QCOLS)
        kcols = np.arange(kc0, kc0 + NA_SPAN)
        cstart = np.clip(qcols - NA_COLS // 2, 0, GRID_W - NA_COLS)
        valid = (kcols[None, :] >= cstart[:, None]) & (kcols[None, :] < cstart[:, None] + NA_COLS)
        dc_idx = np.clip(kcols[None, :] - qcols[:, None], -(NA_COLS - 1), NA_COLS - 1) + (NA_COLS - 1)
        rel = bias[:, dr_idx[:, None, :, None], dc_idx[None, :, None, :]].astype(jnp.float32)
        qj = qg[:, :, :, qc0:qc0 + NA_QCOLS]
        kj = kg[:, :, :, :, kc0:kc0 + NA_SPAN]
        vj = vg[:, :, :, :, kc0:kc0 + NA_SPAN]
        s_loc = jnp.einsum("bhrqd,bhrwcd->bhrqwc", qj, kj).astype(jnp.float32) * scale + rel[None]
        s_loc = jnp.where(valid[:, None, :], s_loc, NEG_INF)
        s_ctx = jnp.einsum("bhrqd,bhpd->bhrqp", qj, k_ctx).astype(jnp.float32) * scale
        s_all = jnp.concatenate([s_loc.reshape(B, H, rows, NA_QCOLS, n_loc), s_ctx], axis=-1)
        prob = jax.nn.softmax(s_all, axis=-1).astype(v.dtype)
        p_loc = prob[..., :n_loc].reshape(B, H, rows, NA_QCOLS, wr, NA_SPAN)
        o = jnp.einsum("bhrqwc,bhrwcd->bhrqd", p_loc, vj) + jnp.einsum("bhrqp,bhpd->bhrqd", prob[..., n_loc:], v_ctx)
        outs.append(o)
    return jnp.concatenate(outs, axis=3).reshape(B, H, T, dh)


def gqa_mixer(p, lp, ctx_kv):
    B, T, _ = p.shape
    kvw = GQA_KV_HEADS * HEAD_DIM
    q = rms_norm(p[..., :GROUP_W].reshape(B, T, GQA_HEADS, HEAD_DIM), lp["gqa_q_norm"])
    k = rms_norm(p[..., GROUP_W:GROUP_W + kvw].reshape(B, T, GQA_KV_HEADS, HEAD_DIM), lp["gqa_k_norm"])
    v = p[..., GROUP_W + kvw:].reshape(B, T, GQA_KV_HEADS, HEAD_DIM)
    if ctx_kv is not None:
        cos, sin = axial_rope_tables(T)
        q = apply_rope(q, cos, sin)
        k = apply_rope(k, cos, sin)
    qh = q.reshape(B, T, GQA_KV_HEADS, GQA_GROUP, HEAD_DIM).transpose(0, 2, 3, 1, 4)
    kh = k.transpose(0, 2, 1, 3)
    vh = v.transpose(0, 2, 1, 3)
    if ctx_kv is None:
        o = blocked_attention(qh, kh, vh)
    else:
        k_ctx, v_ctx = ctx_kv
        o = blocked_attention(qh, jnp.concatenate([kh, k_ctx.astype(kh.dtype)], axis=2),
                              jnp.concatenate([vh, v_ctx.astype(vh.dtype)], axis=2))
    return o.transpose(0, 3, 1, 2, 4).reshape(B, T, GROUP_W), (kh, vh)


def rwkv_scan(r, w, k, v, a, b, S0, reverse):
    def step(S, inp):
        r_t, w_t, k_t, v_t, a_t, b_t = inp
        sa = jnp.einsum("bhvk,bhk->bhv", S, a_t)
        S = S * w_t[:, :, None, :] + sa[..., None] * b_t[:, :, None, :] + v_t[..., None] * k_t[:, :, None, :]
        return S, jnp.einsum("bhvk,bhk->bhv", S, r_t)

    S, o = lax.scan(step, S0, (r, w, k, v, a, b), reverse=reverse)
    return o, S


def rwkv_mixer(p, lp, S0):
    B, T, _ = p.shape
    f32 = jnp.float32
    W, H = GROUP_W, RW_HEADS
    o0 = 3 * W
    o1 = o0 + 2 * RW_DECAY_RANK
    o2 = o1 + 2 * RW_AAA_RANK
    rkv = p[..., :o0]
    wd = p[..., o0:o1].reshape(B, T, 2, RW_DECAY_RANK)
    ad = p[..., o1:o2].reshape(B, T, 2, RW_AAA_RANK)
    gate = jax.nn.sigmoid(p[..., o2:]) @ lp["rw_g2"]
    heads = lambda a: a.astype(f32).reshape(B, T, H, HEAD_DIM)
    tm = lambda a: jnp.swapaxes(a, 0, 1)
    S0 = S0.astype(f32)
    outs, bonuses, finals = [], [], []
    for d in range(2):
        base = jnp.concatenate([rkv, wd[:, :, d], ad[:, :, d]], axis=-1)
        if d == 0:
            shifted = jnp.pad(base[:, :-1], ((0, 0), (1, 0), (0, 0)))
        else:
            shifted = jnp.pad(base[:, 1:], ((0, 0), (0, 1), (0, 0)))
        xd = base + (shifted - base) * lp["rw_mu"][d]
        r, k, v = xd[..., :W], xd[..., W:2 * W], xd[..., 2 * W:3 * W]
        wl, al = xd[..., 3 * W:3 * W + RW_DECAY_RANK], xd[..., 3 * W + RW_DECAY_RANK:]
        w = -jax.nn.softplus(-(lp["rw_w0"][d] + jnp.tanh(wl) @ lp["rw_w2"][d])) - 0.5
        decay = jnp.exp(-jnp.exp(w.astype(f32)))
        a = jax.nn.sigmoid((lp["rw_a0"][d] + al @ lp["rw_a2"][d]).astype(f32))
        kf = k.astype(f32)
        kk = l2_norm(heads(kf * lp["rw_k_k"].astype(f32)))
        k_eff = heads(kf * (1.0 + (a - 1.0) * lp["rw_k_a"].astype(f32)))
        rh, vh, ah = heads(r), heads(v), heads(a)
        o, S = rwkv_scan(tm(rh), tm(heads(decay)), tm(k_eff), tm(vh), tm(-kk), tm(kk * ah), S0[:, d], d == 1)
        outs.append(tm(o))
        bonuses.append(jnp.sum(rh * k_eff * lp["rw_r_k"].astype(f32), axis=-1, keepdims=True) * vh)
        finals.append(S)
    o = outs[0] + outs[1]
    mu = jnp.mean(o, axis=-1, keepdims=True)
    var = jnp.mean(jnp.square(o - mu), axis=-1, keepdims=True)
    y = ((o - mu) * lax.rsqrt(var + RW_LN_EPS)).reshape(B, T, W) * lp["rw_ln_g"].astype(f32) + lp["rw_ln_b"].astype(f32)
    y = y + (bonuses[0] + bonuses[1]).reshape(B, T, W)
    return y.astype(p.dtype) * gate, jnp.stack(finals, axis=1)


def na_mixer(p, lp, ctx_kv):
    B, T, _ = p.shape
    q, k, v = [p[..., i * GROUP_W:(i + 1) * GROUP_W].reshape(B, T, NA_HEADS, HEAD_DIM).transpose(0, 2, 1, 3) for i in range(3)]
    if ctx_kv is None:
        o = blocked_attention(q[:, :, None], k, v)[:, :, 0]
    else:
        o = neighbourhood_attention(q, k, v, lp["na_bias"], ctx_kv[0], ctx_kv[1])
    return o.transpose(0, 2, 1, 3).reshape(B, T, GROUP_W), (k, v)


def gated_delta_chunked(q, k, v, g, beta, S0):
    B, T, H, dk = q.shape
    dv = v.shape[-1]
    n = T // DN_CHUNK

    def to_chunks(a):
        a = a.reshape((B, n, DN_CHUNK, H) + a.shape[3:])
        return jnp.moveaxis(a, (1, 3), (0, 2))

    qc, kc, vc, bc = to_chunks(q), to_chunks(k), to_chunks(v), to_chunks(beta)
    gc = jnp.cumsum(to_chunks(g), axis=-1)
    idx = np.arange(DN_CHUNK)
    incl = idx[:, None] >= idx[None, :]
    strict = idx[:, None] > idx[None, :]
    diff = gc[..., :, None] - gc[..., None, :]
    dmat = jnp.where(incl, jnp.exp(jnp.where(incl, diff, 0.0)), 0.0)
    kb = kc * bc[..., None]
    A = jnp.where(strict, jnp.einsum("...id,...jd->...ij", kb, kc) * dmat, 0.0)
    eye = jnp.eye(DN_CHUNK, dtype=A.dtype)
    Tm = lax.linalg.triangular_solve(A + eye, jnp.broadcast_to(eye, A.shape), left_side=True, lower=True, unit_diagonal=True)
    u = Tm @ (vc * bc[..., None])
    w = Tm @ (kb * jnp.exp(gc)[..., None])
    qk = jnp.where(incl, jnp.einsum("...id,...jd->...ij", qc, kc) * dmat, 0.0)

    def step(S, inp):
        q_i, k_i, u_i, w_i, g_i, qk_i = inp
        v_new = u_i - jnp.einsum("bhck,bhkv->bhcv", w_i, S)
        o = jnp.einsum("bhck,bhkv->bhcv", q_i * jnp.exp(g_i)[..., None], S) + jnp.einsum("bhij,bhjv->bhiv", qk_i, v_new)
        g_last = g_i[..., -1]
        S = S * jnp.exp(g_last)[..., None, None] + jnp.einsum(
            "bhck,bhcv->bhkv", k_i * jnp.exp(g_last[..., None] - g_i)[..., None], v_new)
        return S, o

    S, o = lax.scan(step, S0, (qc, kc, u, w, gc, qk))
    return jnp.moveaxis(o, (0, 2), (1, 3)).reshape(B, T, H, dv), S


def deltanet_mixer(p, lp, S0):
    B, T, _ = p.shape
    f32 = jnp.float32
    W, H = GROUP_W, DN_HEADS
    qkv = lax.conv_general_dilated(p[..., :3 * W], lp["dn_conv"][:, None, :], window_strides=(1,),
                                   padding=[(DN_CONV // 2, DN_CONV // 2)],
                                   dimension_numbers=("NWC", "WIO", "NWC"), feature_group_count=3 * W)
    qkv = jax.nn.silu(qkv)
    heads = lambda a: a.astype(f32).reshape(B, T, H, HEAD_DIM)
    q = l2_norm(heads(qkv[..., :W])) * (HEAD_DIM ** -0.5)
    k = l2_norm(heads(qkv[..., W:2 * W]))
    v = heads(qkv[..., 2 * W:])
    beta = jax.nn.sigmoid(p[..., 3 * W:3 * W + 2 * H].astype(f32)).reshape(B, T, 2, H)
    alpha = p[..., 3 * W + 2 * H:3 * W + 4 * H].astype(f32).reshape(B, T, 2, H)
    g = -jnp.exp(lp["dn_a_log"].astype(f32)) * jax.nn.softplus(alpha + lp["dn_dt_bias"].astype(f32))
    z = heads(p[..., 3 * W + 4 * H:])
    S0 = S0.astype(f32)
    o_f, s_f = gated_delta_chunked(q, k, v, g[:, :, 0], beta[:, :, 0], S0[:, 0])
    rev = lambda a: jnp.flip(a, axis=1)
    o_b, s_b = gated_delta_chunked(rev(q), rev(k), rev(v), rev(g[:, :, 1]), rev(beta[:, :, 1]), S0[:, 1])
    o = rms_norm(o_f + rev(o_b), lp["dn_norm_g"]) * jax.nn.silu(z)
    return o.reshape(B, T, W).astype(p.dtype), jnp.stack([s_f, s_b], axis=1)


def peer_ffn(h, lp):
    B, T, D = h.shape
    nb = (B * T) // PEER_BLOCK
    wq, keys, u, v = lp["peer_wq"], lp["peer_keys"], lp["peer_u"], lp["peer_v"]

    def block(xb):
        q = (xb @ wq).reshape(PEER_BLOCK, PEER_HEADS, 2, PEER_DQ // 2)
        s = jnp.einsum("nhpd,hpkd->nhpk", q, keys).astype(jnp.float32)
        s1, i1 = lax.top_k(s[:, :, 0], PEER_TOPK)
        s2, i2 = lax.top_k(s[:, :, 1], PEER_TOPK)
        cand = (s1[..., :, None] + s2[..., None, :]).reshape(PEER_BLOCK, PEER_HEADS, PEER_TOPK * PEER_TOPK)
        cidx = (i1[..., :, None] * PEER_NKEYS + i2[..., None, :]).reshape(PEER_BLOCK, PEER_HEADS, PEER_TOPK * PEER_TOPK)
        top_s, pos = lax.top_k(cand, PEER_TOPK)
        idx = jnp.take_along_axis(cidx, pos, axis=-1).reshape(PEER_BLOCK, PEER_HEADS * PEER_TOPK)
        gate = jax.nn.softmax(top_s, axis=-1).reshape(PEER_BLOCK, PEER_HEADS * PEER_TOPK).astype(xb.dtype)
        act = jax.nn.gelu(jnp.einsum("nd,ned->ne", xb, u[idx]), approximate=False)
        return jnp.einsum("ne,ned->nd", gate * act, v[idx])

    return lax.map(block, h.reshape(nb, PEER_BLOCK, D)).reshape(B, T, D)


def trunk_layer(x, cond, lp, ctx):
    B, T, _ = x.shape
    mod = jax.nn.silu(cond) @ lp["w_mod"] + lp["b_mod"]
    sh1, sc1, g1, sh2, sc2, g2 = [m[:, None, :] for m in jnp.split(mod, 6, axis=-1)]
    h = rms_norm(x, lp["norm1_g"]) * (1 + sc1) + sh1
    proj = h @ lp["w_in"]
    pa, pb, pc, pd = jnp.split(proj, [GQA_PROJ, GQA_PROJ + RW_PROJ, GQA_PROJ + RW_PROJ + NA_PROJ], axis=-1)
    if ctx is None:
        ctx_a = None
        ctx_c = None
        s_rw0 = jnp.zeros((B, 2, RW_HEADS, HEAD_DIM, HEAD_DIM), jnp.float32)
        s_dn0 = jnp.zeros((B, 2, DN_HEADS, HEAD_DIM, HEAD_DIM), jnp.float32)
    else:
        ka_c, va_c, kc_c, vc_c, s_rw0, s_dn0 = ctx
        ctx_a = (ka_c, va_c)
        ctx_c = (kc_c, vc_c)
    oa, (ka, va) = gqa_mixer(pa, lp, ctx_a)
    ob, s_rw = rwkv_mixer(pb, lp, s_rw0)
    oc, (kc, vc) = na_mixer(pc, lp, ctx_c)
    od, s_dn = deltanet_mixer(pd, lp, s_dn0)
    mix = jnp.concatenate([oa, ob, oc, od], axis=-1) @ lp["w_out"]
    x = x + g1 * mix
    h2 = rms_norm(x, lp["norm2_g"]) * (1 + sc2) + sh2
    x = x + g2 * peer_ffn(h2, lp)
    return x, (ka, va, kc, vc, s_rw, s_dn)


def setup_inputs(seed: int = 0) -> dict:
    key = jax.random.key(seed)
    keys = iter(jax.random.split(key, 64))
    f32 = jnp.float32

    def nrm(shape, scale):
        return jax.random.normal(next(keys), shape, f32) * scale

    def gain(shape):
        return 1.0 + 0.02 * jax.random.normal(next(keys), shape, f32)

    def unif(shape, lo, hi):
        return jax.random.uniform(next(keys), shape, f32, lo, hi)

    W = GROUP_W
    dt = jnp.exp(unif((DEPTH, 2, DN_HEADS), math.log(1e-3), math.log(1e-1)))
    return {
        "x_prompt": nrm((BATCH, SEQ, D_MODEL), 1.0),
        "x_sample": nrm((DEC_BATCH, DEC_SEQ, D_MODEL), 1.0),
        "c": nrm((DEC_BATCH, D_MODEL), 1.0),
        "cache_gqa_k": nrm((DEC_BATCH, DEPTH, GQA_KV_HEADS, PAST_LEN, HEAD_DIM), 1.0),
        "cache_gqa_v": nrm((DEC_BATCH, DEPTH, GQA_KV_HEADS, PAST_LEN, HEAD_DIM), 1.0),
        "cache_na_k": nrm((DEC_BATCH, DEPTH, NA_HEADS, PAST_LEN, HEAD_DIM), 1.0),
        "cache_na_v": nrm((DEC_BATCH, DEPTH, NA_HEADS, PAST_LEN, HEAD_DIM), 1.0),
        "state_rwkv": nrm((DEC_BATCH, DEPTH, 2, RW_HEADS, HEAD_DIM, HEAD_DIM), 0.1),
        "state_delta": nrm((DEC_BATCH, DEPTH, 2, DN_HEADS, HEAD_DIM, HEAD_DIM), 0.1),
        "c_ctx": nrm((D_MODEL,), 1.0),
        "norm1_g": gain((DEPTH, D_MODEL)),
        "norm2_g": gain((DEPTH, D_MODEL)),
        "w_mod": nrm((DEPTH, D_MODEL, 6 * D_MODEL), 0.5 * D_MODEL ** -0.5),
        "b_mod": nrm((DEPTH, 6 * D_MODEL), 0.02),
        "w_in": nrm((DEPTH, D_MODEL, IN_COLS), D_MODEL ** -0.5),
        "w_out": nrm((DEPTH, D_MIX, D_MODEL), D_MIX ** -0.5),
        "gqa_q_norm": gain((DEPTH, HEAD_DIM)),
        "gqa_k_norm": gain((DEPTH, HEAD_DIM)),
        "rw_mu": unif((DEPTH, 2, RW_SHIFT_COLS), 0.0, 1.0),
        "rw_w0": unif((DEPTH, 2, W), -5.0, -0.5),
        "rw_w2": nrm((DEPTH, 2, RW_DECAY_RANK, W), 0.1),
        "rw_a0": nrm((DEPTH, 2, W), 0.1),
        "rw_a2": nrm((DEPTH, 2, RW_AAA_RANK, W), RW_AAA_RANK ** -0.5),
        "rw_g2": nrm((DEPTH, RW_GATE_RANK, W), RW_GATE_RANK ** -0.5),
        "rw_k_k": 0.85 * gain((DEPTH, W)),
        "rw_k_a": gain((DEPTH, W)),
        "rw_r_k": nrm((DEPTH, RW_HEADS, HEAD_DIM), 0.1),
        "rw_ln_g": gain((DEPTH, W)),
        "rw_ln_b": nrm((DEPTH, W), 0.02),
        "na_bias": nrm((DEPTH, NA_HEADS, 2 * NA_ROWS - 1, 2 * NA_COLS - 1), 0.1),
        "dn_conv": nrm((DEPTH, DN_CONV, 3 * W), DN_CONV ** -0.5),
        "dn_a_log": jnp.log(unif((DEPTH, 2, DN_HEADS), 1.0, 16.0)),
        "dn_dt_bias": dt + jnp.log(-jnp.expm1(-dt)),
        "dn_norm_g": gain((DEPTH, HEAD_DIM)),
        "peer_wq": nrm((DEPTH, D_MODEL, PEER_HEADS * PEER_DQ), D_MODEL ** -0.5),
        "peer_keys": nrm((DEPTH, PEER_HEADS, 2, PEER_NKEYS, PEER_DQ // 2), (PEER_DQ // 2) ** -0.5),
        "peer_u": nrm((DEPTH, PEER_EXPERTS, D_MODEL), D_MODEL ** -0.5),
        "peer_v": nrm((DEPTH, PEER_EXPERTS, D_MODEL), (PEER_HEADS * PEER_TOPK) ** -0.5),
        "final_norm_g": gain((D_MODEL,)),
    }


def reference(x_prompt, x_sample, c, cache_gqa_k, cache_gqa_v, cache_na_k, cache_na_v, state_rwkv, state_delta,
              c_ctx, norm1_g, norm2_g, w_mod, b_mod, w_in, w_out, gqa_q_norm, gqa_k_norm,
              rw_mu, rw_w0, rw_w2, rw_a0, rw_a2, rw_g2, rw_k_k, rw_k_a, rw_r_k, rw_ln_g, rw_ln_b,
              na_bias, dn_conv, dn_a_log, dn_dt_bias, dn_norm_g,
              peer_wq, peer_keys, peer_u, peer_v, final_norm_g):
    def layer_params(l):
        return {
            "norm1_g": norm1_g[l], "norm2_g": norm2_g[l], "w_mod": w_mod[l], "b_mod": b_mod[l],
            "w_in": w_in[l], "w_out": w_out[l], "gqa_q_norm": gqa_q_norm[l], "gqa_k_norm": gqa_k_norm[l],
            "rw_mu": rw_mu[l], "rw_w0": rw_w0[l], "rw_w2": rw_w2[l], "rw_a0": rw_a0[l], "rw_a2": rw_a2[l],
            "rw_g2": rw_g2[l], "rw_k_k": rw_k_k[l], "rw_k_a": rw_k_a[l], "rw_r_k": rw_r_k[l],
            "rw_ln_g": rw_ln_g[l], "rw_ln_b": rw_ln_b[l], "na_bias": na_bias[l],
            "dn_conv": dn_conv[l], "dn_a_log": dn_a_log[l], "dn_dt_bias": dn_dt_bias[l], "dn_norm_g": dn_norm_g[l],
            "peer_wq": peer_wq[l], "peer_keys": peer_keys[l], "peer_u": peer_u[l], "peer_v": peer_v[l],
        }

    xp = x_prompt
    cond_ctx = c_ctx[None, :]
    per_layer = []
    for l in range(DEPTH):
        xp, st = trunk_layer(xp, cond_ctx, layer_params(l), None)
        per_layer.append(st)
    y_prompt = rms_norm(xp, final_norm_g)

    xs = x_sample
    for l in range(DEPTH):
        ctx = (cache_gqa_k[:, l], cache_gqa_v[:, l], cache_na_k[:, l], cache_na_v[:, l], state_rwkv[:, l], state_delta[:, l])
        xs, _ = trunk_layer(xs, c, layer_params(l), ctx)
    y_sample = rms_norm(xs, final_norm_g)

    dt = x_prompt.dtype
    new_gqa_k = jnp.stack([st[0] for st in per_layer], axis=1).astype(dt)
    new_gqa_v = jnp.stack([st[1] for st in per_layer], axis=1).astype(dt)
    new_na_k = jnp.stack([st[2] for st in per_layer], axis=1).astype(dt)
    new_na_v = jnp.stack([st[3] for st in per_layer], axis=1).astype(dt)
    new_state_rwkv = jnp.stack([st[4] for st in per_layer], axis=1).astype(dt)
    new_state_delta = jnp.stack([st[5] for st in per_layer], axis=1).astype(dt)
    return (y_prompt, y_sample, new_gqa_k, new_gqa_v, new_na_k, new_na_v, new_state_rwkv, new_state_delta)
```

```cpp
#ifndef HOST_EMU
#include <hip/hip_runtime.h>
#include <hip/hip_cooperative_groups.h>
namespace cg = cooperative_groups;
#define HD __device__ __forceinline__
#define HDN __device__ __noinline__
typedef _Float16 h16;
#define CBAR asm volatile("" ::: "memory")
#define SMEM_BYTES 73728
__shared__ __attribute__((aligned(16))) char g_smem[SMEM_BYTES];
__device__ __forceinline__ int otid() { int t = threadIdx.x; asm volatile("" : "+v"(t)); return t; }
#define FSIN(x) __sinf(x)
#define FCOS(x) __cosf(x)
#else
#include <cmath>
#include <cstring>
#define HD static inline
#define HDN static
typedef float h16;
#define CBAR
#define FSIN(x) sinf(x)
#define FCOS(x) cosf(x)
#endif
#include <cstdio>
#include <cstring>

#ifndef CFG_BATCH
#define CFG_BATCH 32
#define CFG_SEQ 256
#define CFG_DB 8
#define CFG_DS 4096
#define CFG_PAST 512
#define CFG_NKEYS 128
#endif

#define NTC (CFG_BATCH * CFG_SEQ)
#define NTL (CFG_DB * CFG_DS)
#define NT (NTC + NTL)
#define NCOND (1 + CFG_DB)
#define GROWS (CFG_DS / 64)
#define WR (GROWS < 8 ? GROWS : 8)
#define NEXP (CFG_NKEYS * CFG_NKEYS)
#define INC 3280
#define RW_OFF 512
#define NA_OFF 1472
#define DN_OFF 2240

struct P {
  const float *xp, *xs, *c, *cgk, *cgv, *cnk, *cnv, *srw, *sdn, *cctx, *n1g, *n2g, *wmod, *bmod, *win, *wout,
      *gqn, *gkn, *rwmu, *rww0, *rww2, *rwa0, *rwa2, *rwg2, *rwkk, *rwka, *rwrk, *rwlng, *rwlnb, *nabias,
      *dnconv, *dnalog, *dndt, *dnng, *pwq, *pkeys, *pu, *pv, *fng;
  float *X, *ogk, *ogv, *onk, *onv, *orw, *odn;
  float* mod;
  h16* act;
  h16* proj;
  h16* rwaux;
  h16* dnp;
  h16* pq;
  float* tks;
  int* tki;
  int* pidx;
  float* pact;
  unsigned* counters;
  unsigned* xbar;
  unsigned* cucnt;
  h16 *keys16, *u16, *v16;
  float *rwsc, *dnsc;
  h16 *wtin, *wtout, *wtq;
};

HD float sigmoidf_(float x) { return 1.0f / (1.0f + expf(-x)); }
HD float siluf_(float x) { return x * sigmoidf_(x); }
HD float softplusf_(float x) { return fmaxf(x, 0.0f) + log1pf(expf(-fabsf(x))); }
HD int condrow(long token) { return token < NTC ? 0 : 1 + (int)((token - NTC) / CFG_DS); }
HD void seqinfo(long token, int& t, int& T, long& base) {
  if (token < NTC) { T = CFG_SEQ; t = (int)(token % CFG_SEQ); base = token - t; }
  else { long u = token - NTC; T = CFG_DS; t = (int)(u % CFG_DS); base = token - t; }
}

HD void b_init(long i, const P& p, int l) {
  p.X[i] = (i < (long)NTC * 1024) ? p.xp[i] : p.xs[i - (long)NTC * 1024];
}
HD void b_mod(long i, const P& p, int) {
  int col = (int)(i % 6144); int r = (int)((i / 6144) % NCOND); int l = (int)(i / (6144L * NCOND));
  const float* cond = r == 0 ? p.cctx : p.c + (long)(r - 1) * 1024;
  float acc = p.bmod[l * 6144 + col];
  for (int k = 0; k < 1024; ++k) acc += siluf_(cond[k]) * p.wmod[((long)l * 1024 + k) * 6144 + col];
  p.mod[i] = acc;
}
template <int WHICH>
HD void b_norm(long i, const P& p, int l) {
  const float* x = p.X + i * 1024;
  float ss = 0.f;
  for (int k = 0; k < 1024; ++k) ss += x[k] * x[k];
  float rstd = 1.0f / sqrtf(ss * (1.0f / 1024) + 1e-6f);
  const float* m = p.mod + ((long)l * NCOND + condrow(i)) * 6144 + (WHICH ? 3072 : 0);
  const float* g = (WHICH ? p.n2g : p.n1g) + l * 1024;
  for (int k = 0; k < 1024; ++k) p.act[i * 1024 + k] = (h16)((x[k] * rstd * g[k]) * (1.0f + m[1024 + k]) + m[k]);
}
HD void b_prep_gqa(long i, const P& p, int l) {
  long token = i / 6; int slot = (int)(i % 6);
  h16* x = p.proj + token * INC + slot * 64;
  float y[64]; float ss = 0.f;
#pragma unroll
  for (int d = 0; d < 64; ++d) { y[d] = (float)x[d]; ss += y[d] * y[d]; }
  float rstd = 1.0f / sqrtf(ss * (1.0f / 64) + 1e-6f);
  const float* g = (slot < 4 ? p.gqn : p.gkn) + l * 64;
#pragma unroll
  for (int d = 0; d < 64; ++d) y[d] = y[d] * rstd * g[d];
  if (token >= NTC) {
    int t = (int)((token - NTC) % CFG_DS); int row = t / 64, colp = t % 64;
#pragma unroll
    for (int j = 0; j < 32; ++j) {
      float inv = exp2f(-(float)(j % 16) * 0.83048202372184059f);
      float ang = (float)(j < 16 ? row : colp) * inv;
      float cs = FCOS(ang), sn = FSIN(ang);
      float a = y[j], b = y[j + 32];
      y[j] = a * cs - b * sn; y[j + 32] = b * cs + a * sn;
    }
  } else if (slot >= 4) {
    int b = (int)(token / CFG_SEQ), t = (int)(token % CFG_SEQ);
    float* o = p.ogk + ((((long)b * 2 + l) * 2 + (slot - 4)) * CFG_SEQ + t) * 64;
#pragma unroll
    for (int d = 0; d < 64; ++d) o[d] = y[d];
  }
  float sc = slot < 4 ? 0.125f : 1.0f;
#pragma unroll
  for (int d = 0; d < 64; ++d) x[d] = (h16)(y[d] * sc);
}
HD void b_prep_cache(long i, const P& p, int l) {
  long token = i / 640; int e = (int)(i % 640);
  int b = (int)(token / CFG_SEQ), t = (int)(token % CFG_SEQ);
  const h16* pr = p.proj + token * INC;
  if (e < 128) { int kvh = e / 64, d = e % 64; p.ogv[((((long)b * 2 + l) * 2 + kvh) * CFG_SEQ + t) * 64 + d] = (float)pr[384 + e]; }
  else if (e < 384) { int c = e - 128; int h = c / 64, d = c % 64; p.onk[((((long)b * 2 + l) * 4 + h) * CFG_SEQ + t) * 64 + d] = (float)pr[NA_OFF + 256 + c]; }
  else { int c = e - 384; int h = c / 64, d = c % 64; p.onv[((((long)b * 2 + l) * 4 + h) * CFG_SEQ + t) * 64 + d] = (float)pr[NA_OFF + 512 + c]; }
}
HD void b_rwaux(long i, const P& p, int l) {
  int col = (int)(i % 256); int d = (int)((i / 256) % 2); long token = i / 512;
  int t, T; long base; seqinfo(token, t, T, base);
  bool sv = d == 0 ? (t > 0) : (t < T - 1);
  const h16* pb = p.proj + token * INC + RW_OFF;
  const h16* ps = p.proj + (token + (d == 0 ? -1 : 1)) * INC + RW_OFF;
  const float* mu = p.rwmu + ((long)l * 2 + d) * 832;
  float accw = p.rww0[(l * 2 + d) * 256 + col], acca = p.rwa0[(l * 2 + d) * 256 + col];
  for (int j = 0; j < 32; ++j) {
    float bw = (float)pb[768 + d * 32 + j], sw = sv ? (float)ps[768 + d * 32 + j] : 0.f;
    float wl = bw + (sw - bw) * mu[768 + j];
    float ba = (float)pb[832 + d * 32 + j], sa = sv ? (float)ps[832 + d * 32 + j] : 0.f;
    float al = ba + (sa - ba) * mu[800 + j];
    accw += tanhf(wl) * p.rww2[(((long)l * 2 + d) * 32 + j) * 256 + col];
    acca += al * p.rwa2[(((long)l * 2 + d) * 32 + j) * 256 + col];
  }
  float w = -softplusf_(-accw) - 0.5f;
  p.rwaux[((token * 2 + d) * 2 + 0) * 256 + col] = (h16)expf(w);
  p.rwaux[((token * 2 + d) * 2 + 1) * 256 + col] = (h16)sigmoidf_(acca);
}
HD void b_dnconv(long i, const P& p, int l) {
  int c = (int)(i % 768); long token = i / 768;
  int t, T; long base; seqinfo(token, t, T, base);
  float acc = 0.f;
#pragma unroll
  for (int j = 0; j < 5; ++j) {
    int tt = t + j - 2;
    if (tt >= 0 && tt < T) acc += (float)p.proj[(base + tt) * INC + DN_OFF + c] * p.dnconv[((long)l * 5 + j) * 768 + c];
  }
  p.dnp[token * 768 + c] = (h16)siluf_(acc);
}
HD void b_dnnorm(long i, const P& p, int) {
  long token = i / 8; int slot = (int)(i % 8);
  h16* x = p.dnp + token * 768 + slot * 64;
  float ss = 0.f;
  for (int d = 0; d < 64; ++d) { float v = (float)x[d]; ss += v * v; }
  float rs = 1.0f / sqrtf(ss + 1e-6f) * (slot < 4 ? 0.125f : 1.0f);
  for (int d = 0; d < 64; ++d) x[d] = (h16)((float)x[d] * rs);
}

struct Softmax64 {
  float m, lsum, acc[64];
};
template <typename TK>
HD void attend_key(Softmax64& st, const float* q, const TK* k, const TK* v, float scale, float bias) {
  float s = 0.f;
#pragma unroll
  for (int d = 0; d < 64; ++d) s += q[d] * (float)k[d];
  s = s * scale + bias;
  if (s > st.m) {
    float f = expf(st.m - s);
    st.lsum *= f;
#pragma unroll
    for (int d = 0; d < 64; ++d) st.acc[d] *= f;
    st.m = s;
  }
  float pw = expf(s - st.m);
  st.lsum += pw;
#pragma unroll
  for (int d = 0; d < 64; ++d) st.acc[d] += pw * (float)v[d];
}
HD void b_attn_gqa(long i, const P& p, int l) {
  int h = (int)(i / NT); long token = i % NT; int kvh = h / 2;
  float q[64];
  const h16* qp = p.proj + token * INC + h * 64;
#pragma unroll
  for (int d = 0; d < 64; ++d) q[d] = (float)qp[d];
  Softmax64 st; st.m = -1e30f; st.lsum = 0.f;
#pragma unroll
  for (int d = 0; d < 64; ++d) st.acc[d] = 0.f;
  int t, T; long base; seqinfo(token, t, T, base);
  for (int tk = 0; tk < T; ++tk) {
    const h16* kp = p.proj + (base + tk) * INC + 256 + kvh * 64;
    attend_key<h16>(st, q, kp, kp + 128, 1.0f, 0.f);
  }
  if (token >= NTC) {
    int b = (int)((token - NTC) / CFG_DS);
    const float* ck = p.cgk + (((long)b * 2 + l) * 2 + kvh) * CFG_PAST * 64;
    const float* cv = p.cgv + (((long)b * 2 + l) * 2 + kvh) * CFG_PAST * 64;
    for (int pp = 0; pp < CFG_PAST; ++pp) attend_key<float>(st, q, ck + pp * 64, cv + pp * 64, 1.0f, 0.f);
  }
  float inv = 1.0f / st.lsum;
  h16* o = p.act + token * 1024 + h * 64;
#pragma unroll
  for (int d = 0; d < 64; ++d) o[d] = (h16)(st.acc[d] * inv);
}
HD void b_attn_na(long i, const P& p, int l) {
  int h = (int)(i / NT); long token = i % NT;
  float q[64];
  const h16* qp = p.proj + token * INC + NA_OFF + h * 64;
#pragma unroll
  for (int d = 0; d < 64; ++d) q[d] = (float)qp[d];
  Softmax64 st; st.m = -1e30f; st.lsum = 0.f;
#pragma unroll
  for (int d = 0; d < 64; ++d) st.acc[d] = 0.f;
  int t, T; long base; seqinfo(token, t, T, base);
  if (token < NTC) {
    for (int tk = 0; tk < T; ++tk) {
      const h16* kp = p.proj + (base + tk) * INC + NA_OFF + 256 + h * 64;
      attend_key<h16>(st, q, kp, kp + 256, 0.125f, 0.f);
    }
  } else {
    int r = t / 64, cq = t % 64;
    int r0 = r - WR / 2; r0 = r0 < 0 ? 0 : (r0 > GROWS - WR ? GROWS - WR : r0);
    int cs = cq - 8; cs = cs < 0 ? 0 : (cs > 48 ? 48 : cs);
    const float* bias = p.nabias + ((long)l * 4 + h) * 15 * 31;
    for (int w = 0; w < WR; ++w) {
      int kr = r0 + w;
      for (int cc = 0; cc < 16; ++cc) {
        int kc = cs + cc;
        const h16* kp = p.proj + (base + kr * 64 + kc) * INC + NA_OFF + 256 + h * 64;
        attend_key<h16>(st, q, kp, kp + 256, 0.125f, bias[(kr - r + 7) * 31 + (kc - cq + 15)]);
      }
    }
    int b = (int)((token - NTC) / CFG_DS);
    const float* ck = p.cnk + (((long)b * 2 + l) * 4 + h) * CFG_PAST * 64;
    const float* cv = p.cnv + (((long)b * 2 + l) * 4 + h) * CFG_PAST * 64;
    for (int pp = 0; pp < CFG_PAST; ++pp) attend_key<float>(st, q, ck + pp * 64, cv + pp * 64, 0.125f, 0.f);
  }
  float inv = 1.0f / st.lsum;
  h16* o = p.act + token * 1024 + 512 + h * 64;
#pragma unroll
  for (int d = 0; d < 64; ++d) o[d] = (h16)(st.acc[d] * inv);
}

HD float rw_lerp(const P& p, int l, long token, bool sv, int d, int c) {
  float b = (float)p.proj[token * INC + RW_OFF + c];
  float s = sv ? (float)p.proj[(token + (d == 0 ? -1 : 1)) * INC + RW_OFF + c] : 0.f;
  return b + (s - b) * p.rwmu[((long)l * 2 + d) * 832 + c];
}
HD void b_rwscan(long i, const P& p, int l) {
  int v = (int)(i % 64); int sb = (int)(i / 64); int h = sb % 4; int bi = sb / 4;
  bool ctx = bi < CFG_BATCH;
  int T = ctx ? CFG_SEQ : CFG_DS;
  long base = ctx ? (long)bi * CFG_SEQ : (long)NTC + (long)(bi - CFG_BATCH) * CFG_DS;
#ifndef HOST_EMU
  float* S = (float*)g_smem + threadIdx.x * 65;
#else
  float S[64];
#endif
  for (int d = 0; d < 2; ++d) {
    if (ctx) {
      for (int k = 0; k < 64; ++k) S[k] = 0.f;
    } else {
      const float* s0 = p.srw + (((((long)(bi - CFG_BATCH)) * 2 + l) * 2 + d) * 4 + h) * 4096 + v * 64;
      for (int k = 0; k < 64; ++k) S[k] = s0[k];
    }
    for (int step = 0; step < T; ++step) {
      int t = d == 0 ? step : T - 1 - step;
      long token = base + t;
      bool sv = d == 0 ? (t > 0) : (t < T - 1);
      const h16* aux = p.rwaux + (token * 2 + d) * 512;
      float ss = 0.f;
      for (int k = 0; k < 64; ++k) {
        float kv = rw_lerp(p, l, token, sv, d, 256 + h * 64 + k) * p.rwkk[l * 256 + h * 64 + k];
        ss += kv * kv;
      }
      float rs = 1.0f / sqrtf(ss + 1e-6f);
      float sa = 0.f;
      for (int k = 0; k < 64; ++k) {
        float kk = rw_lerp(p, l, token, sv, d, 256 + h * 64 + k) * p.rwkk[l * 256 + h * 64 + k] * rs;
        sa -= S[k] * kk;
      }
      float vv = rw_lerp(p, l, token, sv, d, 512 + h * 64 + v);
      float o = 0.f;
      for (int k = 0; k < 64; ++k) {
        int c = h * 64 + k;
        float kr = rw_lerp(p, l, token, sv, d, 256 + c);
        float kk = kr * p.rwkk[l * 256 + c] * rs;
        float a = (float)aux[256 + c];
        float dec = expf(-(float)aux[c]);
        float keff = kr * (1.0f + (a - 1.0f) * p.rwka[l * 256 + c]);
        float r = rw_lerp(p, l, token, sv, d, c);
        S[k] = S[k] * dec + sa * (kk * a) + vv * keff;
        o += S[k] * r;
      }
      h16* op = p.act + token * 1024 + 256 + h * 64 + v;
      if (d == 0) *op = (h16)o; else *op = (h16)((float)*op + o);
    }
    if (ctx) {
      float* so = p.orw + (((((long)bi) * 2 + l) * 2 + d) * 4 + h) * 4096 + v * 64;
      for (int k = 0; k < 64; ++k) so[k] = S[k];
    }
  }
}
HD void b_rwfin(long i, const P& p, int l) {
  long token = i / 4; int h = (int)(i % 4);
  int t, T; long base; seqinfo(token, t, T, base);
  h16* op = p.act + token * 1024 + 256 + h * 64;
  float mu = 0.f;
  for (int k = 0; k < 64; ++k) mu += (float)op[k];
  mu *= (1.0f / 64);
  float var = 0.f;
  for (int k = 0; k < 64; ++k) { float dlt = (float)op[k] - mu; var += dlt * dlt; }
  var *= (1.0f / 64);
  float rs = 1.0f / sqrtf(var + 64e-5f);
  float bon0 = 0.f, bon1 = 0.f;
  for (int d = 0; d < 2; ++d) {
    bool sv = d == 0 ? (t > 0) : (t < T - 1);
    const h16* aux = p.rwaux + (token * 2 + d) * 512;
    float s = 0.f;
    for (int k = 0; k < 64; ++k) {
      int c = h * 64 + k;
      float kr = rw_lerp(p, l, token, sv, d, 256 + c);
      float a = (float)aux[256 + c];
      float keff = kr * (1.0f + (a - 1.0f) * p.rwka[l * 256 + c]);
      s += rw_lerp(p, l, token, sv, d, c) * keff * p.rwrk[l * 256 + c];
    }
    if (d == 0) bon0 = s; else bon1 = s;
  }
  bool sv0 = t > 0, sv1 = t < T - 1;
  for (int k = 0; k < 64; ++k) {
    int c = h * 64 + k;
    float y = ((float)op[k] - mu) * rs * p.rwlng[l * 256 + c] + p.rwlnb[l * 256 + c];
    y += bon0 * rw_lerp(p, l, token, sv0, 0, 512 + c) + bon1 * rw_lerp(p, l, token, sv1, 1, 512 + c);
    float gate = 0.f;
    for (int j = 0; j < 64; ++j) gate += sigmoidf_((float)p.proj[token * INC + RW_OFF + 896 + j]) * p.rwg2[((long)l * 64 + j) * 256 + c];
    op[k] = (h16)(y * gate);
  }
}
HD void b_dnscan(long i, const P& p, int l) {
  int v = (int)(i % 64); int sb = (int)(i / 64); int h = sb % 4; int bi = sb / 4;
  bool ctx = bi < CFG_BATCH;
  int T = ctx ? CFG_SEQ : CFG_DS;
  long base = ctx ? (long)bi * CFG_SEQ : (long)NTC + (long)(bi - CFG_BATCH) * CFG_DS;
#ifndef HOST_EMU
  float* S = (float*)g_smem + threadIdx.x * 65;
#else
  float S[64];
#endif
  for (int d = 0; d < 2; ++d) {
    if (ctx) {
      for (int k = 0; k < 64; ++k) S[k] = 0.f;
    } else {
      const float* s0 = p.sdn + (((((long)(bi - CFG_BATCH)) * 2 + l) * 2 + d) * 4 + h) * 4096 + v;
      for (int k = 0; k < 64; ++k) S[k] = s0[k * 64];
    }
    float nalog = -expf(p.dnalog[(l * 2 + d) * 4 + h]);
    float dtb = p.dndt[(l * 2 + d) * 4 + h];
    for (int step = 0; step < T; ++step) {
      int t = d == 0 ? step : T - 1 - step;
      long token = base + t;
      const h16* dp = p.dnp + token * 768;
      const h16* pr = p.proj + token * INC + DN_OFF;
      float beta = sigmoidf_((float)pr[768 + d * 4 + h]);
      float g = nalog * softplusf_((float)pr[776 + d * 4 + h] + dtb);
      float a = expf(g);
      float sk = 0.f;
      for (int k = 0; k < 64; ++k) sk += (float)dp[256 + h * 64 + k] * S[k];
      float coef = beta * ((float)dp[512 + h * 64 + v] - a * sk);
      float o = 0.f;
      for (int k = 0; k < 64; ++k) {
        S[k] = a * S[k] + coef * (float)dp[256 + h * 64 + k];
        o += (float)dp[h * 64 + k] * S[k];
      }
      h16* op = p.act + token * 1024 + 768 + h * 64 + v;
      if (d == 0) *op = (h16)o; else *op = (h16)((float)*op + o);
    }
    if (ctx) {
      float* so = p.odn + (((((long)bi) * 2 + l) * 2 + d) * 4 + h) * 4096 + v;
      for (int k = 0; k < 64; ++k) so[k * 64] = S[k];
    }
  }
}
HD void b_dnfin(long i, const P& p, int l) {
  long token = i / 4; int h = (int)(i % 4);
  h16* op = p.act + token * 1024 + 768 + h * 64;
  float ss = 0.f;
  for (int k = 0; k < 64; ++k) { float o = (float)op[k]; ss += o * o; }
  float rs = 1.0f / sqrtf(ss * (1.0f / 64) + 1e-6f);
  for (int k = 0; k < 64; ++k) {
    float z = (float)p.proj[token * INC + DN_OFF + 784 + h * 64 + k];
    op[k] = (h16)((float)op[k] * rs * p.dnng[l * 64 + k] * siluf_(z));
  }
}
HD void top16_insert(float (&ts)[16], int (&ti)[16], float s, int id) {
#pragma unroll
  for (int j = 0; j < 16; ++j) {
    if (s > ts[j]) { float a = ts[j]; ts[j] = s; s = a; int b = ti[j]; ti[j] = id; id = b; }
  }
}
HD void b_topk1(long i, const P& p, int l) {
  long token = i / 16; int hp = (int)(i % 16);
  const h16* q = p.pq + token * 2048 + hp * 128;
  const float* keys = p.pkeys + ((long)l * 16 + hp) * CFG_NKEYS * 128;
  float ts[16]; int ti[16];
#pragma unroll
  for (int j = 0; j < 16; ++j) { ts[j] = -3.0e38f; ti[j] = 0; }
  for (int k = 0; k < CFG_NKEYS; ++k) {
    float s = 0.f;
    for (int d = 0; d < 128; ++d) s += (float)q[d] * keys[k * 128 + d];
    top16_insert(ts, ti, s, k);
  }
#pragma unroll
  for (int j = 0; j < 16; ++j) { p.tks[token * 256 + hp * 16 + j] = ts[j]; p.tki[token * 256 + hp * 16 + j] = ti[j]; }
}
HD void b_topk2(long i, const P& p, int l) {
  long token = i / 8; int hd = (int)(i % 8);
  const float* s1 = p.tks + token * 256 + hd * 32; const int* i1 = p.tki + token * 256 + hd * 32;
  float ts[16]; int ti[16];
#pragma unroll
  for (int j = 0; j < 16; ++j) { ts[j] = -3.0e38f; ti[j] = 0; }
  for (int a = 0; a < 16; ++a)
    for (int b = 0; b < 16; ++b) top16_insert(ts, ti, s1[a] + s1[16 + b], i1[a] * CFG_NKEYS + i1[16 + b]);
  float sum = 0.f;
#pragma unroll
  for (int j = 0; j < 16; ++j) sum += expf(ts[j] - ts[0]);
  float inv = 1.0f / sum;
#pragma unroll
  for (int j = 0; j < 16; ++j) { p.pidx[token * 128 + hd * 16 + j] = ti[j]; p.pact[token * 128 + hd * 16 + j] = expf(ts[j] - ts[0]) * inv; }
}
HD void b_peer_act(long i, const P& p, int l) {
  long token = i / 128;
  const float* u = p.pu + ((long)l * NEXP + p.pidx[i]) * 1024;
  const h16* x = p.act + token * 1024;
  float dot = 0.f;
  for (int k = 0; k < 1024; ++k) dot += (float)x[k] * u[k];
  float ge = 0.5f * dot * (1.0f + erff(dot * 0.70710678118654752f));
  p.pact[i] = p.pact[i] * ge;
}
HD void b_peer_out(long i, const P& p, int l) {
  long token = i / 1024; int col = (int)(i % 1024);
  float acc = 0.f;
  for (int e = 0; e < 128; ++e) acc += p.pact[token * 128 + e] * p.pv[((long)l * NEXP + p.pidx[token * 128 + e]) * 1024 + col];
  p.X[i] += p.mod[((long)l * NCOND + condrow(token)) * 6144 + 5120 + col] * acc;
}
HD void b_final(long i, const P& p, int) {
  float* x = p.X + i * 1024;
  float ss = 0.f;
  for (int k = 0; k < 1024; ++k) ss += x[k] * x[k];
  float rstd = 1.0f / sqrtf(ss * (1.0f / 1024) + 1e-6f);
  for (int k = 0; k < 1024; ++k) x[k] = x[k] * rstd * p.fng[k];
}
HD float gemm_elem(const h16* A, const float* B, int N, long token, int col) {
  float acc = 0.f;
  for (int k = 0; k < 1024; ++k) acc += (float)A[token * 1024 + k] * B[(long)k * N + col];
  return acc;
}
HD void b_inproj(long i, const P& p, int l) {
  long token = i / INC; int col = (int)(i % INC);
  p.proj[i] = (h16)gemm_elem(p.act, p.win + (long)l * 1024 * INC, INC, token, col);
}
HD void b_outproj(long i, const P& p, int l) {
  long token = i / 1024; int col = (int)(i % 1024);
  float acc = gemm_elem(p.act, p.wout + (long)l * 1024 * 1024, 1024, token, col);
  p.X[i] += p.mod[((long)l * NCOND + condrow(token)) * 6144 + 2048 + col] * acc;
}
HD void b_peerq(long i, const P& p, int l) {
  long token = i / 2048; int col = (int)(i % 2048);
  p.pq[i] = (h16)gemm_elem(p.act, p.pwq + (long)l * 1024 * 2048, 2048, token, col);
}

#ifndef PROBE_KMAX
#define PROBE_KMAX 16
#endif
#ifndef REP_S0
#define REP_S0 1
#endif
#ifndef REP_MISC
#define REP_MISC 1
#endif
#ifndef REP_G0
#define REP_G0 1
#endif
#ifndef REP_G2
#define REP_G2 1
#endif
#ifndef REP_SP
#define REP_SP 1
#endif
#define NSCAN ((long)(CFG_BATCH + CFG_DB) * 4 * 64)
#define NPAD_IN 3328

#ifndef HOST_EMU
typedef _Float16 half8 __attribute__((ext_vector_type(8)));
typedef _Float16 half4 __attribute__((ext_vector_type(4)));
typedef _Float16 half2v __attribute__((ext_vector_type(2)));
typedef float f32x2 __attribute__((ext_vector_type(2)));
typedef float f32x16 __attribute__((ext_vector_type(16)));
typedef float f32x4 __attribute__((ext_vector_type(4)));
typedef unsigned u32x4 __attribute__((ext_vector_type(4)));
typedef short s16x4v __attribute__((__vector_size__(4 * sizeof(short))));

template <int CTRL> __device__ __forceinline__ float dppf(float x) {
  return __builtin_bit_cast(float, __builtin_amdgcn_update_dpp(0, __builtin_bit_cast(int, x), CTRL, 0xF, 0xF, true));
}
__device__ __forceinline__ float sum16(float x) { x += dppf<0x128>(x); x += dppf<0x124>(x); x += dppf<0xB1>(x); x += dppf<0x4E>(x); return x; }
__device__ __forceinline__ float sum8(float x) { x += dppf<0xB1>(x); x += dppf<0x4E>(x); x += dppf<0x141>(x); return x; }
__device__ __forceinline__ float sum64(float x) { x = sum16(x); x += __shfl_xor(x, 16); x += __shfl_xor(x, 32); return x; }

#define CSWAP_DESC(S, ID, i, j) { const bool c_ = S[j] > S[i]; const float a_ = c_ ? S[j] : S[i]; const float b_ = c_ ? S[i] : S[j]; \
    const int ia_ = c_ ? ID[j] : ID[i]; const int ib_ = c_ ? ID[i] : ID[j]; S[i] = a_; S[j] = b_; ID[i] = ia_; ID[j] = ib_; }
__device__ __forceinline__ void bitonic_sort16_desc(float (&s)[16], int (&id)[16]) {
#pragma unroll
  for (int k = 2; k <= 16; k <<= 1) {
#pragma unroll
    for (int j = k >> 1; j > 0; j >>= 1) {
#pragma unroll
      for (int i = 0; i < 16; ++i) {
        const int l = i ^ j;
        if (l > i) {
          if ((i & k) == 0) CSWAP_DESC(s, id, i, l) else CSWAP_DESC(s, id, l, i)
        }
      }
    }
  }
}
__device__ __forceinline__ void merge_top16(float (&ts)[16], int (&ti)[16], const float (&gs)[16], const int (&gi)[16]) {
#pragma unroll
  for (int i = 0; i < 16; ++i) { if (gs[15 - i] > ts[i]) { ts[i] = gs[15 - i]; ti[i] = gi[15 - i]; } }
#pragma unroll
  for (int j = 8; j > 0; j >>= 1) {
#pragma unroll
    for (int i = 0; i < 16; ++i) { if ((i & j) == 0) CSWAP_DESC(ts, ti, i, i + j) }
  }
}
__device__ void blk_convert(long w, const P& p) {
  int l = (int)(w / 1600); int r = (int)(w % 1600);
  const float* src; h16* dst; int N, ntile;
  if (r < 832) { src = p.win + (long)l * 1024 * INC; dst = p.wtin + (long)l * NPAD_IN * 1024; N = INC; ntile = 52; }
  else if (r < 1088) { r -= 832; src = p.wout + (long)l * 1024 * 1024; dst = p.wtout + (long)l * 1024 * 1024; N = 1024; ntile = 16; }
  else { r -= 1088; src = p.pwq + (long)l * 1024 * 2048; dst = p.wtq + (long)l * 2048 * 1024; N = 2048; ntile = 32; }
  int kt = r / ntile, nt = r % ntile;
  int k0 = kt * 64, n0 = nt * 64;
  h16* tile = (h16*)g_smem;
  const int tid_ = otid(); int c = tid_ & 63, r4 = tid_ >> 6;
  __syncthreads();
#pragma unroll
  for (int j = 0; j < 16; ++j) {
    int rr = r4 + 4 * j;
    float v = (n0 + c < N) ? src[(long)(k0 + rr) * N + n0 + c] : 0.f;
    tile[rr * 66 + c] = (h16)v;
  }
  __syncthreads();
#pragma unroll
  for (int j = 0; j < 16; ++j) {
    int rr = r4 + 4 * j;
    dst[(long)(n0 + rr) * 1024 + k0 + c] = tile[c * 66 + rr];
  }
}

template <int EPI>
__device__ void gemm_phase(const P& p, int l, int kmax = 16) {
  constexpr int NTILES = EPI == 0 ? (NPAD_IN / 128) : (EPI == 1 ? 8 : 16);
  constexpr int NT8 = (NTILES + 7) / 8;
  const long nw = EPI == 0 ? (long)(NT / 128) * NTILES : (long)(NT / 128) * 8 * NT8;
#define TILE_OF(W, MT, NTV) { const int x_ = (int)((W) & 7); const int j_ = (int)((W) >> 3);                        \
    if (EPI == 0) { if (j_ < 960) { MT = j_ / 3; NTV = x_ + 8 * (j_ - 3 * MT); } else { NTV = 24 + (x_ >> 2); MT = 80 * (x_ & 3) + j_ - 960; } } \
    else { NTV = x_ + 8 * (j_ % NT8); MT = j_ / NT8; } }
  const h16* A = p.act;
  const h16* Bt = EPI == 0 ? p.wtin + (long)l * NPAD_IN * 1024 : (EPI == 1 ? p.wtout + (long)l * 1024 * 1024 : p.wtq + (long)l * 2048 * 1024);
  const int tid = otid(), lane = tid & 63, wv = tid >> 6, wm = wv >> 1, wn = wv & 1;
  h16* As = (h16*)g_smem;
  h16* Bs = As + 2 * 128 * 72;
  const int lrow = tid >> 3, lch = tid & 7;
  long w = blockIdx.x; int mt = 0, nt = 0;
  for (;;) { if (w >= nw) return; TILE_OF(w, mt, nt) if (nt < NTILES) break; w += gridDim.x; }
  int m0 = mt * 128, n0 = nt * 128;
  const h16* Ag = A + (long)(m0 + lrow) * 1024 + lch * 8;
  const h16* Bg = Bt + (long)(n0 + lrow) * 1024 + lch * 8;
  u32x4 ra0, ra1, ra2, ra3, rb0, rb1, rb2, rb3;
  u32x4 sa0, sa1, sa2, sa3, sb0, sb1, sb2, sb3;
  const f32x16 zero16 = {0.f, 0.f, 0.f, 0.f, 0.f, 0.f, 0.f, 0.f, 0.f, 0.f, 0.f, 0.f, 0.f, 0.f, 0.f, 0.f};
  f32x16 acc00, acc01, acc10, acc11;
#define GLD0(K0) \
  ra0 = *(const u32x4*)(Ag + (K0)); ra1 = *(const u32x4*)(Ag + 32 * 1024 + (K0)); ra2 = *(const u32x4*)(Ag + 64 * 1024 + (K0)); ra3 = *(const u32x4*)(Ag + 96 * 1024 + (K0)); \
  rb0 = *(const u32x4*)(Bg + (K0)); rb1 = *(const u32x4*)(Bg + 32 * 1024 + (K0)); rb2 = *(const u32x4*)(Bg + 64 * 1024 + (K0)); rb3 = *(const u32x4*)(Bg + 96 * 1024 + (K0));
#define GLD1(K0) \
  sa0 = *(const u32x4*)(Ag + (K0)); sa1 = *(const u32x4*)(Ag + 32 * 1024 + (K0)); sa2 = *(const u32x4*)(Ag + 64 * 1024 + (K0)); sa3 = *(const u32x4*)(Ag + 96 * 1024 + (K0)); \
  sb0 = *(const u32x4*)(Bg + (K0)); sb1 = *(const u32x4*)(Bg + 32 * 1024 + (K0)); sb2 = *(const u32x4*)(Bg + 64 * 1024 + (K0)); sb3 = *(const u32x4*)(Bg + 96 * 1024 + (K0));
#define LST0(AW, BW) \
  *(u32x4*)((AW) + (lrow) * 72 + lch * 8) = ra0; *(u32x4*)((AW) + (lrow + 32) * 72 + lch * 8) = ra1; *(u32x4*)((AW) + (lrow + 64) * 72 + lch * 8) = ra2; *(u32x4*)((AW) + (lrow + 96) * 72 + lch * 8) = ra3; \
  *(u32x4*)((BW) + (lrow) * 72 + lch * 8) = rb0; *(u32x4*)((BW) + (lrow + 32) * 72 + lch * 8) = rb1; *(u32x4*)((BW) + (lrow + 64) * 72 + lch * 8) = rb2; *(u32x4*)((BW) + (lrow + 96) * 72 + lch * 8) = rb3;
#define LST1(AW, BW) \
  *(u32x4*)((AW) + (lrow) * 72 + lch * 8) = sa0; *(u32x4*)((AW) + (lrow + 32) * 72 + lch * 8) = sa1; *(u32x4*)((AW) + (lrow + 64) * 72 + lch * 8) = sa2; *(u32x4*)((AW) + (lrow + 96) * 72 + lch * 8) = sa3; \
  *(u32x4*)((BW) + (lrow) * 72 + lch * 8) = sb0; *(u32x4*)((BW) + (lrow + 32) * 72 + lch * 8) = sb1; *(u32x4*)((BW) + (lrow + 64) * 72 + lch * 8) = sb2; *(u32x4*)((BW) + (lrow + 96) * 72 + lch * 8) = sb3;
#define GCOMP(BUF)                                                                                   \
  {                                                                                                  \
    const h16* Ab = As + (BUF) * 128 * 72 + (wm * 64 + (lane & 31)) * 72 + (lane >> 5) * 8;          \
    const h16* Bb = Bs + (BUF) * 128 * 72 + (wn * 64 + (lane & 31)) * 72 + (lane >> 5) * 8;          \
    _Pragma("unroll") for (int s = 0; s < 4; ++s) {                                                  \
      half8 a0 = *(const half8*)(Ab + s * 16), a1 = *(const half8*)(Ab + 32 * 72 + s * 16);          \
      half8 b0 = *(const half8*)(Bb + s * 16), b1 = *(const half8*)(Bb + 32 * 72 + s * 16);          \
      acc00 = __builtin_amdgcn_mfma_f32_32x32x16_f16(a0, b0, acc00, 0, 0, 0);                        \
      acc01 = __builtin_amdgcn_mfma_f32_32x32x16_f16(a0, b1, acc01, 0, 0, 0);                        \
      acc10 = __builtin_amdgcn_mfma_f32_32x32x16_f16(a1, b0, acc10, 0, 0, 0);                        \
      acc11 = __builtin_amdgcn_mfma_f32_32x32x16_f16(a1, b1, acc11, 0, 0, 0);                        \
    }                                                                                                \
  }
  GLD0(0)
  GLD1(64)
  for (;;) {
  acc00 = zero16; acc01 = zero16; acc10 = zero16; acc11 = zero16;
  __builtin_amdgcn_sched_barrier(0);
  __syncthreads();
  LST0(As, Bs)
  GLD0(128)
  __builtin_amdgcn_sched_barrier(0);
  __syncthreads();
  for (int kt = 0; kt < kmax; kt += 2) {
    GCOMP(0)
    __builtin_amdgcn_sched_barrier(0);
    LST1(As + 128 * 72, Bs + 128 * 72)
    if (kt + 3 < 16) { GLD1((kt + 3) * 64) }
    __builtin_amdgcn_sched_barrier(0);
    __syncthreads();
    GCOMP(1)
    __builtin_amdgcn_sched_barrier(0);
    if (kt + 2 < 16) { LST0(As, Bs) }
    if (kt + 4 < 16) { GLD0((kt + 4) * 64) }
    __builtin_amdgcn_sched_barrier(0);
    __syncthreads();
  }
  const int cm0 = m0, cn0 = n0, cnt = nt;
  long w2 = w + gridDim.x; int mt2 = 0, nt2 = 0; bool has_next = false;
  for (;;) { if (w2 >= nw) break; TILE_OF(w2, mt2, nt2) if (nt2 < NTILES) { has_next = true; break; } w2 += gridDim.x; }
  if (has_next) {
    m0 = mt2 * 128; n0 = nt2 * 128; nt = nt2;
    Ag = A + (long)(m0 + lrow) * 1024 + lch * 8; Bg = Bt + (long)(n0 + lrow) * 1024 + lch * 8;
  }
  __builtin_amdgcn_sched_barrier(0);
#define GEMM_EPI(ACC, I, J)                                                                         \
  _Pragma("unroll") for (int r = 0; r < 16; ++r) {                                                   \
    const long row = cm0 + wm * 64 + (I) * 32 + (r & 3) + 8 * (r >> 2) + 4 * (lane >> 5);             \
    const int col = cn0 + wn * 64 + (J) * 32 + (lane & 31);                                            \
    const float v = ACC[r];                                                                          \
    if (EPI == 0) { if (col < INC) p.proj[row * INC + col] = (h16)v; }                                \
    else if (EPI == 1) { p.X[row * 1024 + col] += p.mod[((long)l * NCOND + condrow(row)) * 6144 + 2048 + col] * v; } \
    else { p.pq[row * 2048 + col] = (h16)v; }                                                         \
  }
  if (EPI == 0) {
    h16* Ct = (h16*)g_smem;
#define CST(ACC, I, J) _Pragma("unroll") for (int r = 0; r < 16; ++r) Ct[(wm * 64 + (I) * 32 + (r & 3) + 8 * (r >> 2) + 4 * (lane >> 5)) * 136 + wn * 64 + (J) * 32 + (lane & 31)] = (h16)ACC[r];
    CST(acc00, 0, 0) CST(acc01, 0, 1) CST(acc10, 1, 0) CST(acc11, 1, 1)
#undef CST
    __syncthreads();
#pragma unroll
    for (int j = 0; j < 8; ++j) {
      const int idx = tid + 256 * j; const int rr = idx >> 4, cc = idx & 15;
      if (cn0 + cc * 8 < INC) *(u32x4*)(p.proj + (long)(cm0 + rr) * INC + cn0 + cc * 8) = *(const u32x4*)(Ct + rr * 136 + cc * 8);
    }
  } else if (EPI == 1) {
#define EPI1(ACC, I, J)                                                                              \
    {                                                                                                \
      float xv_[16], mv_[16];                                                                        \
      const int col = cn0 + wn * 64 + (J) * 32 + (lane & 31);                                         \
      _Pragma("unroll") for (int r = 0; r < 16; ++r) {                                               \
        const long row = cm0 + wm * 64 + (I) * 32 + (r & 3) + 8 * (r >> 2) + 4 * (lane >> 5);         \
        xv_[r] = p.X[row * 1024 + col]; mv_[r] = p.mod[((long)l * NCOND + condrow(row)) * 6144 + 2048 + col]; \
      }                                                                                              \
      _Pragma("unroll") for (int r = 0; r < 16; ++r) {                                               \
        const long row = cm0 + wm * 64 + (I) * 32 + (r & 3) + 8 * (r >> 2) + 4 * (lane >> 5);         \
        p.X[row * 1024 + col] = xv_[r] + mv_[r] * ACC[r];                                            \
      }                                                                                              \
    }
    EPI1(acc00, 0, 0) EPI1(acc01, 0, 1) EPI1(acc10, 1, 0) EPI1(acc11, 1, 1)
#undef EPI1
  } else {
    h16* Q = (h16*)g_smem;
    h16* Kk = Q + 128 * 136;
    const h16* kg = p.keys16 + ((long)l * 16 + cnt) * CFG_NKEYS * 128;
#define QST(ACC, I, J) _Pragma("unroll") for (int r = 0; r < 16; ++r) Q[(wm * 64 + (I) * 32 + (r & 3) + 8 * (r >> 2) + 4 * (lane >> 5)) * 136 + wn * 64 + (J) * 32 + (lane & 31)] = (h16)ACC[r];
    QST(acc00, 0, 0) QST(acc01, 0, 1) QST(acc10, 1, 0) QST(acc11, 1, 1)
#undef QST
#pragma unroll
    for (int j = 0; j < 8; ++j) {
      const int idx = tid + 256 * j; const int kr = idx >> 4, kc = idx & 15;
      *(u32x4*)(Kk + kr * 136 + kc * 8) = *(const u32x4*)(kg + kr * 128 + kc * 8);
    }
    __syncthreads();
    f32x16 z = {0.f, 0.f, 0.f, 0.f, 0.f, 0.f, 0.f, 0.f, 0.f, 0.f, 0.f, 0.f, 0.f, 0.f, 0.f, 0.f};
    f32x16 s00 = z, s01 = z, s10 = z, s11 = z;
    const h16* Qb = Q + (wm * 64 + (lane & 31)) * 136 + (lane >> 5) * 8;
    const h16* Kb = Kk + (wn * 64 + (lane & 31)) * 136 + (lane >> 5) * 8;
#pragma unroll
    for (int sidx = 0; sidx < 8; ++sidx) {
      half8 a0 = *(const half8*)(Qb + sidx * 16), a1 = *(const half8*)(Qb + 32 * 136 + sidx * 16);
      half8 b0 = *(const half8*)(Kb + sidx * 16), b1 = *(const half8*)(Kb + 32 * 136 + sidx * 16);
      s00 = __builtin_amdgcn_mfma_f32_32x32x16_f16(a0, b0, s00, 0, 0, 0);
      s01 = __builtin_amdgcn_mfma_f32_32x32x16_f16(a0, b1, s01, 0, 0, 0);
      s10 = __builtin_amdgcn_mfma_f32_32x32x16_f16(a1, b0, s10, 0, 0, 0);
      s11 = __builtin_amdgcn_mfma_f32_32x32x16_f16(a1, b1, s11, 0, 0, 0);
    }
    __syncthreads();
    float* SC = (float*)g_smem;
#define SST(ACC, I, J) _Pragma("unroll") for (int r = 0; r < 16; ++r) SC[(wm * 64 + (I) * 32 + (r & 3) + 8 * (r >> 2) + 4 * (lane >> 5)) * 129 + wn * 64 + (J) * 32 + (lane & 31)] = ACC[r];
    SST(s00, 0, 0) SST(s01, 0, 1) SST(s10, 1, 0) SST(s11, 1, 1)
#undef SST
    __syncthreads();
    const int row = tid >> 1, half = tid & 1;
    float ts[16]; int ti[16];
#pragma unroll
    for (int j = 0; j < 16; ++j) { ts[j] = -3.0e38f; ti[j] = 0; }
#pragma unroll 1
    for (int g = 0; g < 4; ++g) {
      float gs[16]; int gi[16];
#pragma unroll
      for (int j = 0; j < 16; ++j) { gs[j] = SC[row * 129 + half * 64 + g * 16 + j]; gi[j] = half * 64 + g * 16 + j; }
      bitonic_sort16_desc(gs, gi);
      merge_top16(ts, ti, gs, gi);
    }
    {
      float ps[16]; int pi[16];
#pragma unroll
      for (int j = 0; j < 16; ++j) { ps[j] = dppf<0xB1>(ts[j]); pi[j] = __builtin_amdgcn_update_dpp(0, ti[j], 0xB1, 0xF, 0xF, true); }
      merge_top16(ts, ti, ps, pi);
    }
    if (half == 0) {
      const long token = cm0 + row;
#pragma unroll
      for (int j = 0; j < 16; ++j) { p.tks[token * 256 + cnt * 16 + j] = ts[j]; p.tki[token * 256 + cnt * 16 + j] = ti[j]; }
    }
  }
#undef GEMM_EPI
  if (!has_next) break;
  GLD0(0)
  GLD1(64)
  w = w2;
  }
#undef GLD0
#undef GLD1
#undef LST0
#undef LST1
#undef GCOMP
#undef TILE_OF
}

__device__ void blk_mod(long w, const P& p) {
  float* sl = (float*)g_smem;
  const int tid = otid();
  const int cb = (int)(w % 24); const int r = (int)((w / 24) % NCOND); const int l = (int)(w / (24 * NCOND));
  const float* cond = r == 0 ? p.cctx : p.c + (long)(r - 1) * 1024;
  __syncthreads();
#pragma unroll
  for (int j = 0; j < 4; ++j) sl[tid + 256 * j] = siluf_(cond[tid + 256 * j]);
  __syncthreads();
  const int col = cb * 256 + tid;
  const float* wp = p.wmod + (long)l * 1024 * 6144 + col;
  float acc = p.bmod[l * 6144 + col];
#pragma unroll 8
  for (int k = 0; k < 1024; ++k) acc += sl[k] * wp[(long)k * 6144];
  p.mod[((long)l * NCOND + r) * 6144 + col] = acc;
}
__device__ __forceinline__ float sum64u(float x);
template <int WHICH>
__device__ void blk_norm(long w, const P& p, int l) {
  const int tid_ = otid(); const int lane = tid_ & 63; const long token = w * 4 + (tid_ >> 6);
  const float* src = (WHICH == 0 && l == 0) ? (token < NTC ? p.xp + token * 1024 : p.xs + (token - NTC) * 1024) : p.X + token * 1024;
  float4 v[4]; float ss = 0.f;
#pragma unroll
  for (int j = 0; j < 4; ++j) { v[j] = ((const float4*)src)[lane + 64 * j]; ss += v[j].x * v[j].x + v[j].y * v[j].y + v[j].z * v[j].z + v[j].w * v[j].w; }
  ss = sum64u(ss);
  const float rstd = 1.0f / sqrtf(ss * (1.0f / 1024) + 1e-6f);
  if (WHICH == 2) {
#pragma unroll
    for (int j = 0; j < 4; ++j) {
      float4 g = ((const float4*)p.fng)[lane + 64 * j];
      float4 o; o.x = v[j].x * rstd * g.x; o.y = v[j].y * rstd * g.y; o.z = v[j].z * rstd * g.z; o.w = v[j].w * rstd * g.w;
      ((float4*)(p.X + token * 1024))[lane + 64 * j] = o;
    }
    return;
  }
  const float* m = p.mod + ((long)l * NCOND + condrow(token)) * 6144 + (WHICH ? 3072 : 0);
  const float* g = (WHICH ? p.n2g : p.n1g) + l * 1024;
  float4 gga[4], sha[4], sca[4];
#pragma unroll
  for (int j = 0; j < 4; ++j) { const int c4 = lane + 64 * j; gga[j] = ((const float4*)g)[c4]; sha[j] = ((const float4*)m)[c4]; sca[j] = ((const float4*)(m + 1024))[c4]; }
#pragma unroll
  for (int j = 0; j < 4; ++j) {
    const int c4 = lane + 64 * j;
    const float4 gg = gga[j], sh = sha[j], sc = sca[j];
    half4 o;
    o[0] = (h16)((v[j].x * rstd * gg.x) * (1.0f + sc.x) + sh.x);
    o[1] = (h16)((v[j].y * rstd * gg.y) * (1.0f + sc.y) + sh.y);
    o[2] = (h16)((v[j].z * rstd * gg.z) * (1.0f + sc.z) + sh.z);
    o[3] = (h16)((v[j].w * rstd * gg.w) * (1.0f + sc.w) + sh.w);
    *(half4*)(p.act + token * 1024 + c4 * 4) = o;
    if (WHICH == 0 && l == 0) ((float4*)(p.X + token * 1024))[c4] = v[j];
  }
}


#define SC_CT 32
__device__ __forceinline__ float fsigmoid(float x) { return __frcp_rn(1.0f + __expf(-x)); }
__device__ __forceinline__ float fsilu(float x) { return x * fsigmoid(x); }
__device__ __forceinline__ float fsoftplus(float x) { return fmaxf(x, 0.0f) + __logf(1.0f + __expf(-fabsf(x))); }
__device__ __forceinline__ float ftanh(float x) { const float e = __expf(-2.0f * fabsf(x)); const float t = (1.0f - e) * __frcp_rn(1.0f + e); return x < 0.f ? -t : t; }
#define N_PREP_RW ((NT / 32) * 8)
#define N_PREP_DN ((NT / 32) * 4)
__device__ void blk_scanprep(long w, const P& p, int l, half8& bf0, half8& bf1, int& bkey) {
  h16* tw16 = (h16*)g_smem;
  h16* al16 = tw16 + 32 * 40;
  float* cbuf = (float*)(al16 + 32 * 40);
  const int tid = otid();
  const int ls = tid >> 3, part = tid & 7;
  if (w < N_PREP_RW) {
    const int d = (int)(w & 1), h = (int)((w >> 1) & 3); const long token = (w >> 3) * 32 + ls;
    int t, T; long base; seqinfo(token, t, T, base);
    const bool sv = d == 0 ? (t > 0) : (t < T - 1);
    const h16* pb = p.proj + token * INC + RW_OFF;
    const h16* ps = p.proj + (token + (d == 0 ? -1 : 1)) * INC + RW_OFF;
    const float* mu = p.rwmu + ((long)l * 2 + d) * 832;
    const int lane = tid & 63, wv = tid >> 6;
    const int mat = wv >> 1, ntile = wv & 1;
    const int c0 = h * 64 + part * 8;
    half8 rb = *(const half8*)(pb + c0), kb = *(const half8*)(pb + 256 + c0);
    half8 rs_ = rb, ks_ = kb;
    if (sv) { rs_ = *(const half8*)(ps + c0); ks_ = *(const half8*)(ps + 256 + c0); }
    if (bkey != (int)((l << 3) | (w & 7))) {
      bkey = (int)((l << 3) | (w & 7));
      const float* wsrc = (mat ? p.rwa2 : p.rww2) + ((long)l * 2 + d) * 32 * 256 + h * 64 + ntile * 32 + (lane & 31);
#pragma unroll
      for (int j = 0; j < 8; ++j) { bf0[j] = (h16)wsrc[(8 * (lane >> 5) + j) * 256]; bf1[j] = (h16)wsrc[(16 + 8 * (lane >> 5) + j) * 256]; }
    }
    __syncthreads();
#pragma unroll
    for (int e = 0; e < 4; ++e) {
      const int jj = part * 4 + e;
      float bw = (float)pb[768 + d * 32 + jj], sw = sv ? (float)ps[768 + d * 32 + jj] : 0.f;
      tw16[ls * 40 + jj] = (h16)ftanh(bw + (sw - bw) * mu[768 + jj]);
      float ba = (float)pb[832 + d * 32 + jj], sa_ = sv ? (float)ps[832 + d * 32 + jj] : 0.f;
      al16[ls * 40 + jj] = (h16)(ba + (sa_ - ba) * mu[800 + jj]);
    }
    __syncthreads();
    {
      const h16* X16 = (mat ? al16 : tw16) + (lane & 31) * 40 + 8 * (lane >> 5);
      const half8 a0 = *(const half8*)X16, a1 = *(const half8*)(X16 + 16);
      f32x16 acc = {0.f, 0.f, 0.f, 0.f, 0.f, 0.f, 0.f, 0.f, 0.f, 0.f, 0.f, 0.f, 0.f, 0.f, 0.f, 0.f};
      acc = __builtin_amdgcn_mfma_f32_32x32x16_f16(a0, bf0, acc, 0, 0, 0);
      acc = __builtin_amdgcn_mfma_f32_32x32x16_f16(a1, bf1, acc, 0, 0, 0);
      float* cb = cbuf + mat * (32 * 65) + ntile * 32 + (lane & 31);
#pragma unroll
      for (int r = 0; r < 16; ++r) cb[((r & 3) + 8 * (r >> 2) + 4 * (lane >> 5)) * 65] = acc[r];
    }
    __syncthreads();
    float accw[8], acca[8];
#pragma unroll
    for (int e = 0; e < 8; ++e) {
      accw[e] = p.rww0[(l * 2 + d) * 256 + c0 + e] + cbuf[ls * 65 + part * 8 + e];
      acca[e] = p.rwa0[(l * 2 + d) * 256 + c0 + e] + cbuf[32 * 65 + ls * 65 + part * 8 + e];
    }
    float ss = 0.f, bon = 0.f;
    half8 ewo, ago;
#pragma unroll
    for (int e = 0; e < 8; ++e) {
      const int c = c0 + e;
      float b_ = (float)rb[e], s_ = sv ? (float)rs_[e] : 0.f; const float rr = b_ + (s_ - b_) * mu[c];
      b_ = (float)kb[e]; s_ = sv ? (float)ks_[e] : 0.f; const float kr = b_ + (s_ - b_) * mu[256 + c];
      const float asg = fsigmoid(acca[e]);
      const float kkr = kr * p.rwkk[l * 256 + c];
      ss += kkr * kkr;
      const float keff = kr * (1.0f + (asg - 1.0f) * p.rwka[l * 256 + c]);
      bon += rr * keff * p.rwrk[l * 256 + c];
      ewo[e] = (h16)__expf(-fsoftplus(-accw[e]) - 0.5f);
      ago[e] = (h16)asg;
    }
    ss = sum8(ss); bon = sum8(bon);
    *(half8*)(p.rwaux + ((token * 2 + d) * 2 + 0) * 256 + c0) = ewo;
    *(half8*)(p.rwaux + ((token * 2 + d) * 2 + 1) * 256 + c0) = ago;
    if (part == 0) { float* sc = p.rwsc + ((token * 2 + d) * 4 + h) * 2; sc[0] = 1.0f / sqrtf(ss + 1e-6f); sc[1] = bon; }
  } else {
    const long w2 = w - N_PREP_RW;
    const int h = (int)(w2 & 3); const long token = (w2 >> 2) * 32 + ls;
    int t, T; long base; seqinfo(token, t, T, base);
    const int c0 = h * 64 + part * 8;
    float aq[8], ak[8], av[8];
#pragma unroll
    for (int e = 0; e < 8; ++e) { aq[e] = 0.f; ak[e] = 0.f; av[e] = 0.f; }
    half8 xq[5], xk[5], xv[5]; float tv[5];
#pragma unroll
    for (int tap = 0; tap < 5; ++tap) {
      const int tt = t + tap - 2;
      const bool ok = tt >= 0 && tt < T;
      const h16* pr = p.proj + (base + (ok ? tt : t)) * INC + DN_OFF + c0;
      xq[tap] = *(const half8*)pr; xk[tap] = *(const half8*)(pr + 256); xv[tap] = *(const half8*)(pr + 512);
      tv[tap] = ok ? 1.0f : 0.0f;
    }
    __builtin_amdgcn_sched_barrier(0);
#pragma unroll
    for (int tap = 0; tap < 5; ++tap) {
      const float* cw = p.dnconv + ((long)l * 5 + tap) * 768 + c0;
#pragma unroll
      for (int e = 0; e < 8; ++e) {
        aq[e] += (float)xq[tap][e] * (cw[e] * tv[tap]); ak[e] += (float)xk[tap][e] * (cw[256 + e] * tv[tap]); av[e] += (float)xv[tap][e] * (cw[512 + e] * tv[tap]);
      }
    }
    float ssq = 0.f, ssk = 0.f;
#pragma unroll
    for (int e = 0; e < 8; ++e) { aq[e] = fsilu(aq[e]); ak[e] = fsilu(ak[e]); av[e] = fsilu(av[e]); ssq += aq[e] * aq[e]; ssk += ak[e] * ak[e]; }
    ssq = sum8(ssq); ssk = sum8(ssk);
    const float rq = 0.125f / sqrtf(ssq + 1e-6f), rk = 1.0f / sqrtf(ssk + 1e-6f);
    half8 qo, ko, vo;
#pragma unroll
    for (int e = 0; e < 8; ++e) { qo[e] = (h16)(aq[e] * rq); ko[e] = (h16)(ak[e] * rk); vo[e] = (h16)av[e]; }
    const int dsel = part & 1;
    const h16* prs = p.proj + token * INC + DN_OFF;
    const float braw = (float)prs[768 + dsel * 4 + h], araw = (float)prs[776 + dsel * 4 + h];
    const float alg = p.dnalog[(l * 2 + dsel) * 4 + h], dtb = p.dndt[(l * 2 + dsel) * 4 + h];
    h16* dp = p.dnp + token * 768 + c0;
    *(half8*)dp = qo; *(half8*)(dp + 256) = ko; *(half8*)(dp + 512) = vo;
    if (part < 2) {
      float* sc = p.dnsc + ((token * 2 + dsel) * 4 + h) * 2;
      sc[0] = sigmoidf_(braw);
      sc[1] = expf(-expf(alg) * softplusf_(araw + dtb));
    }
  }
}
__device__ void blk_scan2(int kind, int bi, int h, int d, int rq, const P& p, int l) {
  float* L = (float*)g_smem;
  float* LA = L; float* LW = L + 2048; float* LB = L + 4096; float* LK = L + 6144; float* LR = L + 8192; float* LV = L + 10240;
  const int tid = otid(), lane = tid & 63, wv = tid >> 6, g = lane >> 4, cl = lane & 15;
  const int i = rq * 32 + wv * 8 + g * 2, j0 = cl * 4;
  const bool ctx = bi < CFG_BATCH;
  const int T = ctx ? CFG_SEQ : CFG_DS;
  const long base = ctx ? (long)bi * CFG_SEQ : (long)NTC + (long)(bi - CFG_BATCH) * CFG_DS;
  const int ls = tid >> 3, part = tid & 7;
  f32x4 S = {0.f, 0.f, 0.f, 0.f}, S1 = {0.f, 0.f, 0.f, 0.f};
  if (!ctx) {
    const int b = bi - CFG_BATCH;
    if (kind == 0) {
      const float* s0 = p.srw + (((((long)b) * 2 + l) * 2 + d) * 4 + h) * 4096;
      S = *(const f32x4*)(s0 + i * 64 + j0); S1 = *(const f32x4*)(s0 + (i + 1) * 64 + j0);
    } else {
      const float* s0 = p.sdn + (((((long)b) * 2 + l) * 2 + d) * 4 + h) * 4096;
#pragma unroll
      for (int c = 0; c < 4; ++c) { S[c] = s0[(j0 + c) * 64 + i]; S1[c] = s0[(j0 + c) * 64 + i + 1]; }
    }
  }
  h16* obuf = (h16*)(L + 12288);
  h16* obase = (kind == 0 ? p.act + 256 + d * 512 + h * 64 : p.proj + DN_OFF + d * 256 + h * 64) + rq * 32 + (tid & 7) * 4;
  const long ostride = kind == 0 ? 1024 : INC;
#define SC_FLUSH(S0I)                                                                              \
  { const int sidx_ = (S0I) + (tid >> 3); const int t_ = d == 0 ? sidx_ : T - 1 - sidx_;             \
    *(half4*)(obase + (base + t_) * ostride) = *(const half4*)(obuf + (tid >> 3) * 32 + (tid & 7) * 4); }
  const int c0 = h * 64 + part * 8, jb = part * 8;
  float cmr[8], cmk[8], cmv[8], ckk[8], cka[8];
#pragma unroll
  for (int e = 0; e < 8; ++e) { cmr[e] = 0.f; cmk[e] = 0.f; cmv[e] = 0.f; ckk[e] = 0.f; cka[e] = 0.f; }
  if (kind == 0) {
    const float* mu = p.rwmu + ((long)l * 2 + d) * 832;
#pragma unroll
    for (int e = 0; e < 8; ++e) { cmr[e] = mu[c0 + e]; cmk[e] = mu[256 + c0 + e]; cmv[e] = mu[512 + c0 + e]; ckk[e] = p.rwkk[l * 256 + c0 + e]; cka[e] = p.rwka[l * 256 + c0 + e]; }
  }
  half8 g0, g1, g2, g3, g4, g5, g6, g7; float gf0 = 0.f, gf1 = 0.f; bool gsv = false;
  g0 = g1 = g2 = g3 = g4 = g5 = g6 = g7 = (half8){0, 0, 0, 0, 0, 0, 0, 0};
#define SC_LOADG(S0I)                                                                              \
  {                                                                                                \
    const int sidx_ = (S0I) + ls;                                                                  \
    const int t_ = d == 0 ? sidx_ : T - 1 - sidx_;                                                 \
    const long token_ = base + t_;                                                                 \
    if (kind == 0) {                                                                               \
      gsv = d == 0 ? (t_ > 0) : (t_ < T - 1);                                                      \
      const h16* pb_ = p.proj + token_ * INC + RW_OFF + c0;                                        \
      const h16* ps_ = gsv ? p.proj + (token_ + (d == 0 ? -1 : 1)) * INC + RW_OFF + c0 : pb_;      \
      g0 = *(const half8*)pb_; g1 = *(const half8*)(pb_ + 256); g2 = *(const half8*)(pb_ + 512);   \
      g3 = *(const half8*)ps_; g4 = *(const half8*)(ps_ + 256); g5 = *(const half8*)(ps_ + 512);   \
      g6 = *(const half8*)(p.rwaux + ((token_ * 2 + d) * 2 + 0) * 256 + c0);                       \
      g7 = *(const half8*)(p.rwaux + ((token_ * 2 + d) * 2 + 1) * 256 + c0);                       \
      gf0 = p.rwsc[((token_ * 2 + d) * 4 + h) * 2];                                                \
    } else {                                                                                       \
      const h16* dp_ = p.dnp + token_ * 768 + c0;                                                  \
      g0 = *(const half8*)dp_; g1 = *(const half8*)(dp_ + 256); g2 = *(const half8*)(dp_ + 512);   \
      const float* sc_ = p.dnsc + ((token_ * 2 + d) * 4 + h) * 2;                                  \
      gf0 = sc_[0]; gf1 = sc_[1];                                                                  \
    }                                                                                              \
  }
  SC_LOADG(0)
  for (int s0i = 0; s0i < T; s0i += SC_CT) {
    __syncthreads();
    if (s0i > 0) SC_FLUSH(s0i - SC_CT)
    {
      f32x4 va[2], vw[2], vb[2], vk[2], vr[2], vv_[2];
      if (kind == 0) {
#pragma unroll
        for (int e = 0; e < 8; ++e) {
          float b_ = (float)g0[e], s_ = gsv ? (float)g3[e] : 0.f; const float rr = b_ + (s_ - b_) * cmr[e];
          b_ = (float)g1[e]; s_ = gsv ? (float)g4[e] : 0.f; const float kr = b_ + (s_ - b_) * cmk[e];
          b_ = (float)g2[e]; s_ = gsv ? (float)g5[e] : 0.f; const float vl = b_ + (s_ - b_) * cmv[e];
          const float asg = (float)g7[e];
          const float kk = kr * ckk[e] * gf0;
          va[e >> 2][e & 3] = -kk; vw[e >> 2][e & 3] = __expf(-(float)g6[e]); vb[e >> 2][e & 3] = kk * asg;
          vk[e >> 2][e & 3] = kr * (1.0f + (asg - 1.0f) * cka[e]); vr[e >> 2][e & 3] = rr; vv_[e >> 2][e & 3] = vl;
        }
      } else {
        const float beta = gf0, alpha = gf1;
#pragma unroll
        for (int e = 0; e < 8; ++e) {
          const float k = (float)g1[e];
          va[e >> 2][e & 3] = k; vw[e >> 2][e & 3] = alpha; vb[e >> 2][e & 3] = -alpha * beta * k;
          vk[e >> 2][e & 3] = beta * k; vr[e >> 2][e & 3] = (float)g0[e]; vv_[e >> 2][e & 3] = (float)g2[e];
        }
      }
      const int lo_ = ls * 64 + jb;
      *(f32x4*)(LA + lo_) = va[0]; *(f32x4*)(LA + lo_ + 4) = va[1]; *(f32x4*)(LW + lo_) = vw[0]; *(f32x4*)(LW + lo_ + 4) = vw[1];
      *(f32x4*)(LB + lo_) = vb[0]; *(f32x4*)(LB + lo_ + 4) = vb[1]; *(f32x4*)(LK + lo_) = vk[0]; *(f32x4*)(LK + lo_ + 4) = vk[1];
      *(f32x4*)(LR + lo_) = vr[0]; *(f32x4*)(LR + lo_ + 4) = vr[1]; *(f32x4*)(LV + lo_) = vv_[0]; *(f32x4*)(LV + lo_ + 4) = vv_[1];
    }
    __syncthreads();
    if (s0i + SC_CT < T) SC_LOADG(s0i + SC_CT)
    __builtin_amdgcn_sched_barrier(0);
#define SC_LD(A4, W4, B4, K4, R4, VV, Q)                                                                    \
    { const int o_ = (Q) * 64; A4 = *(const f32x4*)(LA + o_ + j0); W4 = *(const f32x4*)(LW + o_ + j0); B4 = *(const f32x4*)(LB + o_ + j0); \
      K4 = *(const f32x4*)(LK + o_ + j0); R4 = *(const f32x4*)(LR + o_ + j0); VV = *(const f32x2*)(LV + o_ + i); }
#define SC_STEP(ca, cw, cb, ck, cr, cv, Q)                                                                  \
    {                                                                                                       \
      float sa = S[0] * ca[0] + S[1] * ca[1] + S[2] * ca[2] + S[3] * ca[3];                                 \
      float sb = S1[0] * ca[0] + S1[1] * ca[1] + S1[2] * ca[2] + S1[3] * ca[3];                             \
      sa = sum16(sa); sb = sum16(sb);                                                                       \
      _Pragma("unroll") for (int c = 0; c < 4; ++c) { S[c] = S[c] * cw[c] + sa * cb[c] + cv[0] * ck[c]; S1[c] = S1[c] * cw[c] + sb * cb[c] + cv[1] * ck[c]; } \
      float o = S[0] * cr[0] + S[1] * cr[1] + S[2] * cr[2] + S[3] * cr[3];                                  \
      float o1 = S1[0] * cr[0] + S1[1] * cr[1] + S1[2] * cr[2] + S1[3] * cr[3];                             \
      o = sum16(o); o1 = sum16(o1);                                                                         \
      if (cl == 0) { half2v ov; ov[0] = (h16)o; ov[1] = (h16)o1; *(half2v*)(obuf + (Q) * 32 + wv * 8 + g * 2) = ov; } \
    }
    f32x4 a4, w4, b4, k4, r4, a5, w5, b5, k5, r5; f32x2 vv, vv5;
    SC_LD(a4, w4, b4, k4, r4, vv, 0)
    for (int q = 0; q < SC_CT; q += 2) {
      SC_LD(a5, w5, b5, k5, r5, vv5, q + 1)
      SC_STEP(a4, w4, b4, k4, r4, vv, q)
      if (q + 2 < SC_CT) SC_LD(a4, w4, b4, k4, r4, vv, q + 2)
      SC_STEP(a5, w5, b5, k5, r5, vv5, q + 1)
    }
#undef SC_LD
#undef SC_STEP
  }
  __syncthreads();
  SC_FLUSH(T - SC_CT)
#undef SC_FLUSH
  if (ctx) {
    if (kind == 0) {
      float* so = p.orw + (((((long)bi) * 2 + l) * 2 + d) * 4 + h) * 4096;
      *(f32x4*)(so + i * 64 + j0) = S; *(f32x4*)(so + (i + 1) * 64 + j0) = S1;
    } else {
      float* so = p.odn + (((((long)bi) * 2 + l) * 2 + d) * 4 + h) * 4096;
#pragma unroll
      for (int c = 0; c < 4; ++c) { so[(j0 + c) * 64 + i] = S[c]; so[(j0 + c) * 64 + i + 1] = S1[c]; }
    }
  }
}
#undef SC_LOADG
__device__ void blk_fin(long w, const P& p, int l, const float* g2s, float* sgs) {
  const int tid_ = otid(); const int lane = tid_ & 63; const long token = w * 4 + (tid_ >> 6);
  float* sgw = sgs + (tid_ >> 6) * 64;
  const int c4 = lane * 4;
  const int hd = lane >> 4;
  const h16* pr = p.proj + token * INC;
  h16* ao = p.act + token * 1024;
  int t, T; long base; seqinfo(token, t, T, base);
  const bool sv0 = t > 0, sv1 = t < T - 1;
  const float bon0 = p.rwsc[((token * 2 + 0) * 4 + hd) * 2 + 1], bon1 = p.rwsc[((token * 2 + 1) * 4 + hd) * 2 + 1];
  const half4 vb = *(const half4*)(pr + RW_OFF + 512 + c4);
  half4 vm = vb, vp = vb;
  if (sv0) vm = *(const half4*)(pr - INC + RW_OFF + 512 + c4);
  if (sv1) vp = *(const half4*)(pr + INC + RW_OFF + 512 + c4);
  const half4 d_o0 = *(const half4*)(pr + DN_OFF + c4), d_o1 = *(const half4*)(pr + DN_OFF + 256 + c4);
  const half4 d_z = *(const half4*)(pr + DN_OFF + 784 + c4);
  const f32x4 mu0 = *(const f32x4*)(p.rwmu + ((long)l * 2 + 0) * 832 + 512 + c4), mu1 = *(const f32x4*)(p.rwmu + ((long)l * 2 + 1) * 832 + 512 + c4);
  const f32x4 lng = *(const f32x4*)(p.rwlng + l * 256 + c4), lnb = *(const f32x4*)(p.rwlnb + l * 256 + c4);
  const f32x4 dng = *(const f32x4*)(p.dnng + l * 64 + (c4 & 63));
  {
    half4 o0 = *(const half4*)(ao + 256 + c4), o1 = *(const half4*)(ao + 768 + c4);
    float o[4]; float mu = 0.f;
#pragma unroll
    for (int e = 0; e < 4; ++e) { o[e] = (float)o0[e] + (float)o1[e]; mu += o[e]; }
    mu = sum16(mu) * (1.0f / 64);
    float var = 0.f;
#pragma unroll
    for (int e = 0; e < 4; ++e) { float dl = o[e] - mu; var += dl * dl; }
    var = sum16(var) * (1.0f / 64);
    const float rs = 1.0f / sqrtf(var + 64e-5f);
    const float sg = sigmoidf_((float)pr[RW_OFF + 896 + lane]);
    float gate[4] = {0.f, 0.f, 0.f, 0.f};
    sgw[lane] = sg;
    __syncthreads();
#pragma unroll 8
    for (int j = 0; j < 64; ++j) {
      const float sj = sgw[j];
      const f32x4 g2 = *(const f32x4*)(g2s + j * 256 + c4);
#pragma unroll
      for (int e = 0; e < 4; ++e) gate[e] += sj * g2[e];
    }
    half4 out;
#pragma unroll
    for (int e = 0; e < 4; ++e) {
      const float b_ = (float)vb[e];
      const float v0 = b_ + ((sv0 ? (float)vm[e] : 0.f) - b_) * mu0[e];
      const float v1 = b_ + ((sv1 ? (float)vp[e] : 0.f) - b_) * mu1[e];
      float y = (o[e] - mu) * rs * lng[e] + lnb[e] + bon0 * v0 + bon1 * v1;
      out[e] = (h16)(y * gate[e]);
    }
    *(half4*)(ao + 256 + c4) = out;
  }
  {
    const half4 o0 = d_o0, o1 = d_o1, z = d_z;
    float o[4]; float ss = 0.f;
#pragma unroll
    for (int e = 0; e < 4; ++e) { o[e] = (float)o0[e] + (float)o1[e]; ss += o[e] * o[e]; }
    ss = sum16(ss);
    const float rs = 1.0f / sqrtf(ss * (1.0f / 64) + 1e-6f);
    half4 out;
#pragma unroll
    for (int e = 0; e < 4; ++e) out[e] = (h16)(o[e] * rs * dng[e] * siluf_((float)z[e]));
    *(half4*)(ao + 768 + c4) = out;
  }
}

__device__ __forceinline__ float dot8h(half8 u, half8 x, float d) {
#pragma unroll
  for (int e = 0; e < 8; ++e) d += (float)u[e] * (float)x[e];
  return d;
}
__device__ __forceinline__ void cvt8(const float* src, h16* dst, long i) {
  const f32x4 a = *(const f32x4*)(src + i * 8), b = *(const f32x4*)(src + i * 8 + 4);
  half8 o; o[0] = (h16)a[0]; o[1] = (h16)a[1]; o[2] = (h16)a[2]; o[3] = (h16)a[3]; o[4] = (h16)b[0]; o[5] = (h16)b[1]; o[6] = (h16)b[2]; o[7] = (h16)b[3];
  *(half8*)(dst + i * 8) = o;
}
__device__ __forceinline__ float sum64u(float x) {
  x = sum16(x);
  x += __builtin_bit_cast(float, __builtin_amdgcn_update_dpp(0, __builtin_bit_cast(int, x), 0x142, 0xA, 0xF, false));
  x += __builtin_bit_cast(float, __builtin_amdgcn_update_dpp(0, __builtin_bit_cast(int, x), 0x143, 0xC, 0xF, false));
  return __builtin_bit_cast(float, __builtin_amdgcn_readlane(__builtin_bit_cast(int, x), 63));
}
__device__ __forceinline__ float ferf(float x) {
  const float ax = fabsf(x);
  const float t = __frcp_rn(1.0f + 0.3275911f * ax);
  const float y = 1.0f - (((((1.061405429f * t - 1.453152027f) * t) + 1.421413741f) * t - 0.284496736f) * t + 0.254829592f) * t * __expf(-ax * ax);
  return x < 0.f ? -y : y;
}
__device__ __forceinline__ void cvt16_fp8(const float* src, unsigned char* dst, long i, float scale) {
  u32x4 o;
#pragma unroll
  for (int k = 0; k < 4; ++k) {
    const f32x4 a = *(const f32x4*)(src + i * 16 + k * 4);
    int w = __builtin_amdgcn_cvt_pk_fp8_f32(a[0] * scale, a[1] * scale, 0, false);
    w = __builtin_amdgcn_cvt_pk_fp8_f32(a[2] * scale, a[3] * scale, w, true);
    o[k] = (unsigned)w;
  }
  *(u32x4*)(dst + i * 16) = o;
}
__device__ void fin_phase(const P& p, int l) {
  float* g2s = (float*)g_smem;
  float* sgs = g2s + 64 * 256;
  const int tid = otid();
  __syncthreads();
  const f32x4* src = (const f32x4*)(p.rwg2 + (long)l * 64 * 256);
#pragma unroll
  for (int j = 0; j < 16; ++j) ((f32x4*)g2s)[tid + 256 * j] = src[tid + 256 * j];
  __syncthreads();
  for (long w = blockIdx.x; w < NT / 4; w += gridDim.x) blk_fin(w, p, l, g2s, sgs);
}
typedef unsigned u32x2 __attribute__((ext_vector_type(2)));
__device__ __forceinline__ void cvt16_fp4(const float* src, unsigned char* dst, long i, float scale) {
  u32x2 o;
#pragma unroll
  for (int k = 0; k < 2; ++k) {
    const f32x4 a = *(const f32x4*)(src + i * 16 + k * 8), b = *(const f32x4*)(src + i * 16 + k * 8 + 4);
    unsigned w = 0u;
    w = __builtin_amdgcn_cvt_scalef32_pk_fp4_f32(w, a[0] * scale, a[1] * scale, 1.0f, 0);
    w = __builtin_amdgcn_cvt_scalef32_pk_fp4_f32(w, a[2] * scale, a[3] * scale, 1.0f, 1);
    w = __builtin_amdgcn_cvt_scalef32_pk_fp4_f32(w, b[0] * scale, b[1] * scale, 1.0f, 2);
    w = __builtin_amdgcn_cvt_scalef32_pk_fp4_f32(w, b[2] * scale, b[3] * scale, 1.0f, 3);
    o[k] = w;
  }
  *(u32x2*)(dst + i * 8) = o;
}
#define PEER_USCALE 48.0f
#define PEER_VSCALE 16.0f
struct PairTab { int a[50]; int b[50]; };
__host__ __device__ constexpr PairTab make_pairs() {
  PairTab t{}; int n = 0;
  for (int a = 0; a < 16; ++a) for (int b = 0; b < 16; ++b) if ((a + 1) * (b + 1) <= 16) { t.a[n] = a; t.b[n] = b; ++n; }
  return t;
}
template <bool DRY>
__device__ void blk_peer(long w, const P& p, int l) {
  constexpr PairTab PT = make_pairs();
  const int tid_ = otid(); const int lane = tid_ & 63, wv = tid_ >> 6; const long token = w * 4 + wv;
  int* eidx = (int*)g_smem + wv * 256; float* egate = (float*)g_smem + wv * 256 + 128;
  const h16* xr = p.act + token * 1024 + lane * 16;
  const half8 x0 = *(const half8*)xr, x1 = *(const half8*)(xr + 8);
  int la = 0, lb = 0;
#pragma unroll
  for (int j = 0; j < 50; ++j) if (lane == j) { la = PT.a[j]; lb = PT.b[j]; }
  const int lc = la * 16 + lb;
  __syncthreads();
  float cs_[8]; int ce_[8];
#pragma unroll
  for (int hd = 0; hd < 8; ++hd) {
    const float* s1 = p.tks + token * 256 + hd * 32; const int* i1 = p.tki + token * 256 + hd * 32;
    const int la_ = lane < 50 ? la : 0, lb_ = lane < 50 ? lb : 0;
    cs_[hd] = s1[la_] + s1[16 + lb_]; ce_[hd] = i1[la_] * CFG_NKEYS + i1[16 + lb_];
  }
#pragma unroll
  for (int hd = 0; hd < 8; ++hd) {
    const float s = lane < 50 ? cs_[hd] : -3.0e38f;
    int rank = 0;
#pragma unroll
    for (int j = 0; j < 50; ++j) {
      const float sj = __builtin_bit_cast(float, __builtin_amdgcn_readlane(__builtin_bit_cast(int, s), j));
      const int cj = PT.a[j] * 16 + PT.b[j];
      rank += (sj > s || (sj == s && cj < lc)) ? 1 : 0;
    }
    const bool sel = lane < 50 && rank < 16;
    const float m = __builtin_bit_cast(float, __builtin_amdgcn_readlane(__builtin_bit_cast(int, s), 0));
    const float e = sel ? __expf(s - m) : 0.f;
    const float sum = sum64u(e);
    if (sel) { eidx[hd * 16 + rank] = ce_[hd]; egate[hd * 16 + rank] = e / sum; }
  }
  __syncthreads();
  f32x2 x2[8];
#pragma unroll
  for (int e = 0; e < 4; ++e) { x2[e][0] = (float)x0[2 * e]; x2[e][1] = (float)x0[2 * e + 1]; x2[4 + e][0] = (float)x1[2 * e]; x2[4 + e][1] = (float)x1[2 * e + 1]; }
  f32x2 acc2[8];
#pragma unroll
  for (int e = 0; e < 8; ++e) { acc2[e][0] = 0.f; acc2[e][1] = 0.f; }
  const unsigned char* u8 = (const unsigned char*)p.u16; const unsigned char* v8 = (const unsigned char*)p.v16;
#define PEER_LOAD(U, V, GT, EB)                                                                   \
  _Pragma("unroll") for (int q = 0; q < 8; ++q) {                                                 \
    const long ro_ = (long)eidx[(EB) + q] * 512 + lane * 8; GT[q] = egate[(EB) + q];              \
    U[q] = *(const u32x2*)(u8 + ro_); V[q] = *(const u32x2*)(v8 + ro_);                           \
  }
#define PEER_COMP(U, V, GT)                                                                       \
  {                                                                                               \
    float dd_[8];                                                                                 \
    _Pragma("unroll") for (int q = 0; q < 8; ++q) {                                               \
      f32x2 d2 = {0.f, 0.f};                                                                      \
      _Pragma("unroll") for (int k = 0; k < 2; ++k) {                                             \
        d2 += __builtin_amdgcn_cvt_scalef32_pk_f32_fp4(U[q][k], 1.0f, 0) * x2[4 * k];             \
        d2 += __builtin_amdgcn_cvt_scalef32_pk_f32_fp4(U[q][k], 1.0f, 1) * x2[4 * k + 1];         \
        d2 += __builtin_amdgcn_cvt_scalef32_pk_f32_fp4(U[q][k], 1.0f, 2) * x2[4 * k + 2];         \
        d2 += __builtin_amdgcn_cvt_scalef32_pk_f32_fp4(U[q][k], 1.0f, 3) * x2[4 * k + 3];         \
      }                                                                                           \
      dd_[q] = sum64u(d2[0] + d2[1]) * (1.0f / PEER_USCALE);                                      \
    }                                                                                             \
      \
    float dv_ = dd_[7];                                                                           \
    _Pragma("unroll") for (int q = 6; q >= 0; --q) dv_ = lane == q ? dd_[q] : dv_;                \
    const float gv_ = 0.5f * dv_ * (1.0f + erff(dv_ * 0.70710678118654752f));                     \
    _Pragma("unroll") for (int q = 0; q < 8; ++q) {                                               \
      const float wgt = GT[q] * __builtin_bit_cast(float, __builtin_amdgcn_readlane(__builtin_bit_cast(int, gv_), q)) * (1.0f / PEER_VSCALE); \
      const f32x2 w2 = {wgt, wgt};                                                                \
      _Pragma("unroll") for (int k = 0; k < 2; ++k) {                                             \
        acc2[4 * k] += w2 * __builtin_amdgcn_cvt_scalef32_pk_f32_fp4(V[q][k], 1.0f, 0);           \
        acc2[4 * k + 1] += w2 * __builtin_amdgcn_cvt_scalef32_pk_f32_fp4(V[q][k], 1.0f, 1);       \
        acc2[4 * k + 2] += w2 * __builtin_amdgcn_cvt_scalef32_pk_f32_fp4(V[q][k], 1.0f, 2);       \
        acc2[4 * k + 3] += w2 * __builtin_amdgcn_cvt_scalef32_pk_f32_fp4(V[q][k], 1.0f, 3);       \
      }                                                                                           \
    }                                                                                             \
  }
  u32x2 au[8], av[8], bu[8], bv[8];
  float ag[8], bg[8];
  PEER_LOAD(au, av, ag, 0)
  for (int eb = 0; eb < 128; eb += 16) {
    PEER_LOAD(bu, bv, bg, eb + 8)
    __builtin_amdgcn_sched_barrier(0);
    PEER_COMP(au, av, ag)
    if (eb + 16 < 128) { PEER_LOAD(au, av, ag, eb + 16) }
    __builtin_amdgcn_sched_barrier(0);
    PEER_COMP(bu, bv, bg)
  }
#undef PEER_LOAD
#undef PEER_COMP
  const float* g2 = p.mod + ((long)l * NCOND + condrow(token)) * 6144 + 5120 + lane * 16;
  float* xo = p.X + token * 1024 + lane * 16;
  f32x4 xn[4]; float ssq = 0.f;
#pragma unroll
  for (int k = 0; k < 4; ++k) {
    xn[k] = *(f32x4*)(xo + 4 * k);
    const f32x4 ga = *(const f32x4*)(g2 + 4 * k);
#pragma unroll
    for (int e = 0; e < 4; ++e) { xn[k][e] += ga[e] * acc2[2 * k + (e >> 1)][e & 1]; ssq += xn[k][e] * xn[k][e]; }
  }
  if (DRY) { if (acc2[0][0] == 123456.789f) *(f32x4*)xo = xn[0]; return; }
  const float rstd = 1.0f / sqrtf(sum64u(ssq) * (1.0f / 1024) + 1e-6f);
  if (l == 0) {
    const float* m = p.mod + ((long)1 * NCOND + condrow(token)) * 6144 + lane * 16;
    const float* g = p.n1g + 1024 + lane * 16;
    half8 h0, h1;
    f32x4 gga[4], sha[4], sca[4];
#pragma unroll
    for (int k = 0; k < 4; ++k) { gga[k] = *(const f32x4*)(g + 4 * k); sha[k] = *(const f32x4*)(m + 4 * k); sca[k] = *(const f32x4*)(m + 1024 + 4 * k); }
#pragma unroll
    for (int k = 0; k < 4; ++k) {
      *(f32x4*)(xo + 4 * k) = xn[k];
      const f32x4 gg = gga[k], sh = sha[k], sc = sca[k];
#pragma unroll
      for (int e = 0; e < 4; ++e) {
        const h16 hv = (h16)((xn[k][e] * rstd * gg[e]) * (1.0f + sc[e]) + sh[e]);
        if (k < 2) h0[4 * k + e] = hv; else h1[4 * (k - 2) + e] = hv;
      }
    }
    h16* ho = p.act + token * 1024 + lane * 16;
    *(half8*)ho = h0; *(half8*)(ho + 8) = h1;
  } else {
    f32x4 fga[4];
#pragma unroll
    for (int k = 0; k < 4; ++k) fga[k] = *(const f32x4*)(p.fng + lane * 16 + 4 * k);
#pragma unroll
    for (int k = 0; k < 4; ++k) {
      const f32x4 gg = fga[k];
      f32x4 y;
#pragma unroll
      for (int e = 0; e < 4; ++e) y[e] = xn[k][e] * rstd * gg[e];
      *(f32x4*)(xo + 4 * k) = y;
    }
  }
}

__device__ void blk_attn(int type, int idx, const P& p, int l) {
  h16* Ks = (h16*)g_smem;
  h16* Vt = Ks + 64 * 72;
  float* Bt = (float*)(Vt + 64 * 72);
  const int tid = otid(), lane = tid & 63, wv = tid >> 6, ql = lane & 31, hh = lane >> 5;
  int b, hk, tb; long qtok; int qcol_off, kcol_off, vcol_off, outcol; float qscale; int ntl, ntc; long kbase_tok;
  const float *ck = nullptr, *cv = nullptr;
  int grow = 0, r0w = 0, krmin = 0;
  if (type == 0) {
    tb = idx & 3; hk = (idx >> 2) & 1; b = idx >> 3;
    const int head = hk * 2 + (wv & 1);
    kbase_tok = (long)b * CFG_SEQ; qtok = kbase_tok + tb * 64 + (wv >> 1) * 32 + ql;
    qcol_off = head * 64; kcol_off = 256 + hk * 64; vcol_off = 384 + hk * 64; outcol = head * 64; qscale = 1.0f; ntl = CFG_SEQ / 64; ntc = 0;
  } else if (type == 1) {
    tb = idx & 63; hk = (idx >> 6) & 1; b = idx >> 7;
    const int head = hk * 2 + (wv & 1);
    kbase_tok = (long)NTC + (long)b * CFG_DS; qtok = kbase_tok + tb * 64 + (wv >> 1) * 32 + ql;
    qcol_off = head * 64; kcol_off = 256 + hk * 64; vcol_off = 384 + hk * 64; outcol = head * 64; qscale = 1.0f; ntl = CFG_DS / 64; ntc = CFG_PAST / 64;
    ck = p.cgk + (((long)b * 2 + l) * 2 + hk) * CFG_PAST * 64; cv = p.cgv + (((long)b * 2 + l) * 2 + hk) * CFG_PAST * 64;
  } else if (type == 2) {
    tb = idx & 1; hk = (idx >> 1) & 3; b = idx >> 3;
    kbase_tok = (long)b * CFG_SEQ; qtok = kbase_tok + tb * 128 + wv * 32 + ql;
    qcol_off = NA_OFF + hk * 64; kcol_off = NA_OFF + 256 + hk * 64; vcol_off = NA_OFF + 512 + hk * 64; outcol = 512 + hk * 64; qscale = 0.125f; ntl = CFG_SEQ / 64; ntc = 0;
  } else {
    tb = idx & 31; hk = (idx >> 5) & 3; b = idx >> 7;
    kbase_tok = (long)NTC + (long)b * CFG_DS;
    grow = tb * 2 + (wv >> 1);
    qtok = kbase_tok + grow * 64 + (wv & 1) * 32 + ql;
    qcol_off = NA_OFF + hk * 64; kcol_off = NA_OFF + 256 + hk * 64; vcol_off = NA_OFF + 512 + hk * 64; outcol = 512 + hk * 64; qscale = 0.125f;
    r0w = grow - WR / 2; r0w = r0w < 0 ? 0 : (r0w > GROWS - WR ? GROWS - WR : r0w);
    int ra = tb * 2 - WR / 2; ra = ra < 0 ? 0 : (ra > GROWS - WR ? GROWS - WR : ra);
    int rb = tb * 2 + 1 - WR / 2; rb = rb < 0 ? 0 : (rb > GROWS - WR ? GROWS - WR : rb);
    krmin = ra; ntl = rb + WR - ra; ntc = CFG_PAST / 64;
    ck = p.cnk + (((long)b * 2 + l) * 4 + hk) * CFG_PAST * 64; cv = p.cnv + (((long)b * 2 + l) * 4 + hk) * CFG_PAST * 64;
  }
  const int nt = ntl + ntc;
  __syncthreads();
  if (type == 3) { for (int e = tid; e < 465; e += 256) Bt[e] = p.nabias[((long)l * 4 + hk) * 465 + e]; }
  half8 qf[4];
  {
    const h16* qp = p.proj + qtok * INC + qcol_off + hh * 8;
#pragma unroll
    for (int ds = 0; ds < 4; ++ds) qf[ds] = *(const half8*)(qp + ds * 16);
  }
  const int qc = (int)((qtok - kbase_tok) & 63);
  int cst = qc - 8; cst = cst < 0 ? 0 : (cst > 48 ? 48 : cst);
  f32x16 o0 = {0.f, 0.f, 0.f, 0.f, 0.f, 0.f, 0.f, 0.f, 0.f, 0.f, 0.f, 0.f, 0.f, 0.f, 0.f, 0.f};
  f32x16 o1 = o0;
  float m = -1.0e30f, lsum = 0.f;
  half8 kx0, kx1, vx0, vx1;
  const int skey0 = tid >> 3, sdc = tid & 7;
#define ATT_LOAD(TI)                                                                                       \
  {                                                                                                        \
    const int ti_ = (TI);                                                                                  \
    if (ti_ < ntc) {                                                                                       \
      const float* kk_ = ck + ((long)ti_ * 64 + skey0) * 64 + sdc * 8;                                     \
      const float* vv_ = cv + ((long)ti_ * 64 + skey0) * 64 + sdc * 8;                                     \
      f32x4 a_ = *(const f32x4*)kk_, b_ = *(const f32x4*)(kk_ + 4), c_ = *(const f32x4*)(kk_ + 2048), d_ = *(const f32x4*)(kk_ + 2052); \
      _Pragma("unroll") for (int e = 0; e < 4; ++e) { kx0[e] = (h16)a_[e]; kx0[4 + e] = (h16)b_[e]; kx1[e] = (h16)c_[e]; kx1[4 + e] = (h16)d_[e]; } \
      a_ = *(const f32x4*)vv_; b_ = *(const f32x4*)(vv_ + 4); c_ = *(const f32x4*)(vv_ + 2048); d_ = *(const f32x4*)(vv_ + 2052); \
      _Pragma("unroll") for (int e = 0; e < 4; ++e) { vx0[e] = (h16)a_[e]; vx0[4 + e] = (h16)b_[e]; vx1[e] = (h16)c_[e]; vx1[4 + e] = (h16)d_[e]; } \
    } else {                                                                                               \
      const long t0_ = kbase_tok + (long)((type == 3 ? krmin : 0) + (ti_ - ntc)) * 64;                     \
      const h16* r_ = p.proj + (t0_ + skey0) * INC + sdc * 8;                                              \
      kx0 = *(const half8*)(r_ + kcol_off); kx1 = *(const half8*)(r_ + 32 * INC + kcol_off);              \
      vx0 = *(const half8*)(r_ + vcol_off); vx1 = *(const half8*)(r_ + 32 * INC + vcol_off);              \
    }                                                                                                      \
  }
  ATT_LOAD(0)
  for (int ti = 0; ti < nt; ++ti) {
    __syncthreads();
    *(half8*)(Ks + skey0 * 72 + sdc * 8) = kx0; *(half8*)(Ks + (skey0 + 32) * 72 + sdc * 8) = kx1;
    *(half8*)(Vt + skey0 * 72 + sdc * 8) = vx0; *(half8*)(Vt + (skey0 + 32) * 72 + sdc * 8) = vx1;
    __syncthreads();
    if (ti + 1 < nt) ATT_LOAD(ti + 1)
    __builtin_amdgcn_sched_barrier(0);
    const bool local = type == 3 && ti >= ntc;
    const int kr = krmin + (ti - ntc);
    if (local && (kr < r0w || kr >= r0w + WR)) continue;
    f32x16 s0 = {0.f, 0.f, 0.f, 0.f, 0.f, 0.f, 0.f, 0.f, 0.f, 0.f, 0.f, 0.f, 0.f, 0.f, 0.f, 0.f};
    f32x16 s1 = s0;
#pragma unroll
    for (int ds = 0; ds < 4; ++ds) {
      const half8 a0 = *(const half8*)(Ks + ql * 72 + ds * 16 + hh * 8);
      const half8 a1 = *(const half8*)(Ks + (32 + ql) * 72 + ds * 16 + hh * 8);
      s0 = __builtin_amdgcn_mfma_f32_32x32x16_f16(a0, qf[ds], s0, 0, 0, 0);
      s1 = __builtin_amdgcn_mfma_f32_32x32x16_f16(a1, qf[ds], s1, 0, 0, 0);
    }
    float mx = -1.0e30f;
    if (local) {
      const float* brow = Bt + (kr - grow + 7) * 31 + 15 - qc;
#pragma unroll
      for (int i = 0; i < 16; ++i) {
        const int kc0 = (i & 3) + 8 * (i >> 2) + 4 * hh, kc1 = kc0 + 32;
        s0[i] = (kc0 >= cst && kc0 < cst + 16) ? s0[i] * 0.125f + brow[kc0] : -1.0e30f;
        s1[i] = (kc1 >= cst && kc1 < cst + 16) ? s1[i] * 0.125f + brow[kc1] : -1.0e30f;
      }
    } else if (qscale != 1.0f) {
#pragma unroll
      for (int i = 0; i < 16; ++i) { s0[i] *= qscale; s1[i] *= qscale; }
    }
#pragma unroll
    for (int i = 0; i < 16; ++i) mx = fmaxf(mx, fmaxf(s0[i], s1[i]));
    mx = fmaxf(mx, __shfl_xor(mx, 32));
    const float mn = fmaxf(m, mx);
    const float alpha = __expf(m - mn);
    m = mn; lsum *= alpha;
#pragma unroll
    for (int i = 0; i < 16; ++i) { o0[i] *= alpha; o1[i] *= alpha; }
    float ps = 0.f;
#pragma unroll
    for (int i = 0; i < 16; ++i) { s0[i] = __expf(s0[i] - mn); s1[i] = __expf(s1[i] - mn); ps += s0[i] + s1[i]; }
    lsum += ps;
    half8 pf0, pf1, pf2, pf3;
#pragma unroll
    for (int j = 0; j < 8; ++j) { pf0[j] = (h16)s0[j]; pf1[j] = (h16)s0[8 + j]; pf2[j] = (h16)s1[j]; pf3[j] = (h16)s1[8 + j]; }
#define TRD(ptr) __builtin_bit_cast(half4, __builtin_amdgcn_ds_read_tr16_b64_v4i16((__attribute__((address_space(3))) s16x4v*)(ptr)))
#define ATT_PV(KS, PF)                                                                              \
    {                                                                                               \
        \
      const h16* v0_ = Vt + (16 * (KS) + 4 * hh + ((lane & 15) >> 2)) * 72 + 16 * ((lane >> 4) & 1) + 4 * (lane & 3); \
      const half4 lo0 = TRD(v0_), hi0 = TRD(v0_ + 8 * 72);                                          \
      const half4 lo1 = TRD(v0_ + 32), hi1 = TRD(v0_ + 8 * 72 + 32);                                \
      const half8 a0_ = __builtin_shufflevector(lo0, hi0, 0, 1, 2, 3, 4, 5, 6, 7);                  \
      const half8 a1_ = __builtin_shufflevector(lo1, hi1, 0, 1, 2, 3, 4, 5, 6, 7);                  \
      o0 = __builtin_amdgcn_mfma_f32_32x32x16_f16(a0_, PF, o0, 0, 0, 0);                            \
      o1 = __builtin_amdgcn_mfma_f32_32x32x16_f16(a1_, PF, o1, 0, 0, 0);                            \
    }
    ATT_PV(0, pf0) ATT_PV(1, pf1) ATT_PV(2, pf2) ATT_PV(3, pf3)
#undef ATT_PV
#undef TRD
  }
#undef ATT_LOAD
  lsum += __shfl_xor(lsum, 32);
  const float inv = 1.0f / lsum;
  h16* op = p.act + qtok * 1024 + outcol;
#pragma unroll
  for (int g = 0; g < 4; ++g) {
    half4 a, c;
#pragma unroll
    for (int e = 0; e < 4; ++e) { a[e] = (h16)(o0[4 * g + e] * inv); c[e] = (h16)(o1[4 * g + e] * inv); }
    *(half4*)(op + 8 * g + 4 * hh) = a;
    *(half4*)(op + 32 + 8 * g + 4 * hh) = c;
  }
}
#define N_SCAN_LAT (2 * 2 * CFG_DB * 4 * 2)
#define N_SCAN_CTX (2 * 2 * CFG_BATCH * 4 * 2)
#define N_ATT1 (CFG_DB * 2 * (CFG_DS / 64))
#define N_ATT3 (CFG_DB * 4 * (CFG_DS / 128))
#define N_ATT0 (CFG_BATCH * 2 * (CFG_SEQ / 64))
#define N_ATT2 (CFG_BATCH * 4 * (CFG_SEQ / 128))
__device__ __forceinline__ void run_scan_item(int r, bool latent, const P& p, int l) {
  const int rq = r & 1; r >>= 1; const int kind = r & 1; r >>= 1; const int d = r & 1; r >>= 1; const int h = r & 3; r >>= 2;
  blk_scan2(kind, latent ? CFG_BATCH + r : r, h, d, rq, p, l);
}
__device__ void mixer_phase(const P& p, int lc, int mode = 0) {
  const int l = lc & 1;
  __shared__ long s_item;
  __shared__ unsigned s_slot;
  const long total = N_SCAN_CTX + N_ATT1 + N_ATT3 + N_ATT0 + N_ATT2;
  unsigned* lat_cnt = p.counters + 8 + lc;
  if (mode == 0) {
    __syncthreads();
    if (threadIdx.x == 0) {
      const unsigned hw = __builtin_amdgcn_s_getreg((31 << 11) | 4);
      const unsigned xcc = __builtin_amdgcn_s_getreg((3 << 11) | 20) & 0xFu;
      const unsigned key = (xcc << 8) | ((hw >> 8) & 0xFFu);
      const unsigned slot = atomicAdd(p.cucnt + lc * 4096 + key, 1u);
      s_slot = slot;
      s_item = slot == 0 ? (long)atomicAdd(lat_cnt, 1u) : (long)N_SCAN_LAT;
    }
    __syncthreads();
    const long w = s_item;
    if (w < N_SCAN_LAT) run_scan_item((int)w, true, p, l);
  }
  for (;;) {
    __syncthreads();
    if (threadIdx.x == 0) s_item = (long)atomicAdd(p.counters + lc, 1u);
    __syncthreads();
    long w = s_item;
    if (mode == 2) w += N_SCAN_CTX;
    if (w >= (mode == 1 ? (long)N_SCAN_CTX : total)) break;
    if (w < N_SCAN_CTX) {
      run_scan_item((int)w, false, p, l);
    } else {
      int a = (int)(w - N_SCAN_CTX);
      int ty;
      if (a < N_ATT1) ty = 1;
      else if ((a -= N_ATT1) < N_ATT3) ty = 3;
      else if ((a -= N_ATT3) < N_ATT0) ty = 0;
      else { a -= N_ATT0; ty = 2; }
      blk_attn(ty, a, p, l);
    }
  }
  if (mode != 2) {
    for (;;) {
      __syncthreads();
      if (threadIdx.x == 0) s_item = (long)atomicAdd(lat_cnt, 1u);
      __syncthreads();
      const long w = s_item;
      if (w >= N_SCAN_LAT) break;
      run_scan_item((int)w, true, p, l);
    }
  }
}


#define XB_TMO      128
#define XB_XCNT(j)  (256  + 64 * (j))
#define XB_XSUB(j)  (1280 + 64 * (j))
#define XB_XGEN(j)  (2304 + 64 * (j))
#define XB_TOP      3328
#define XB_TOPGEN   3392
#define XCD_BAR_WORDS 3456
#define XB_SPIN_CAP (1u << 22)
#define LAS __attribute__((address_space(3)))
__device__ __forceinline__ unsigned xb_ld(unsigned* p)              { return __hip_atomic_load(p, __ATOMIC_RELAXED, __HIP_MEMORY_SCOPE_AGENT); }
__device__ __forceinline__ unsigned xb_add(unsigned* p, unsigned v) { return __hip_atomic_fetch_add(p, v, __ATOMIC_RELAXED, __HIP_MEMORY_SCOPE_AGENT); }
__device__ __forceinline__ unsigned xb_xcc_id() { return (unsigned)__builtin_amdgcn_s_getreg((3 << 11) | 20) & 0xFu; }
#define XB_SPIN(cond, bar) do { unsigned _sp = 0; while (cond) { __builtin_amdgcn_s_sleep(1); \
    if ((++_sp & 255u) == 0u) { if (xb_ld(&(bar)[XB_TMO])) break; if (_sp > XB_SPIN_CAP) { atomicAdd(&(bar)[XB_TMO], 1u); break; } } } } while (0)
struct XcdBarrier { unsigned* bar; unsigned x; volatile LAS unsigned* st; };
__device__ __forceinline__ XcdBarrier xcd_barrier_post(unsigned* bar, volatile LAS unsigned* st) {
  XcdBarrier b; b.bar = bar; b.x = xb_xcc_id(); b.st = st;
  if (threadIdx.x == 0) (void)xb_add(&bar[XB_XCNT(b.x)], 1u);
  return b;
}
__device__ __forceinline__ void xcd_barrier_complete(unsigned* bar, unsigned x, unsigned& nloc, unsigned& nx) {
  const unsigned G = gridDim.x * gridDim.y * gridDim.z;
  unsigned sum, cnt, mine, sp = 0u;
  for (;;) {
    sum = 0u; cnt = 0u; mine = 0u;
#pragma unroll
    for (unsigned j = 0; j < 16; ++j) { const unsigned c = xb_ld(&bar[XB_XCNT(j)]); sum += c; cnt += (c > 0u) ? 1u : 0u; mine = (j == x) ? c : mine; }
    if (sum == G) break;
    __builtin_amdgcn_s_sleep(1);
    if ((++sp & 255u) == 0u) { if (xb_ld(&bar[XB_TMO])) break; if (sp > XB_SPIN_CAP) { atomicAdd(&bar[XB_TMO], 1u); break; } }
  }
  nloc = mine > 0u ? mine : 1u; nx = cnt > 0u ? cnt : 1u;
}
__device__ __forceinline__ void xcd_barrier(const XcdBarrier& b) {
  asm volatile("s_waitcnt vmcnt(0)" ::: "memory");
  __syncthreads();
  if (threadIdx.x == 0) {
    unsigned* bar = b.bar;
    __builtin_amdgcn_s_waitcnt(0);
    unsigned nloc = b.st[0], nx = b.st[1];
    if (nloc == 0u) { xcd_barrier_complete(bar, b.x, nloc, nx); b.st[0] = nloc; b.st[1] = nx; }
    const unsigned old = xb_add(&bar[XB_XSUB(b.x)], 1u);
    const unsigned gen = old / nloc;
    if (old + 1u == (gen + 1u) * nloc) {
      __builtin_amdgcn_fence(__ATOMIC_RELEASE, "agent");
      asm volatile("s_waitcnt vmcnt(0)" ::: "memory");
      const unsigned og = xb_add(&bar[XB_TOP], 1u);
      const unsigned tg = og / nx;
      if (og + 1u == (tg + 1u) * nx) xb_add(&bar[XB_TOPGEN], 1u);
      else XB_SPIN(xb_ld(&bar[XB_TOPGEN]) == tg, bar);
      __builtin_amdgcn_fence(__ATOMIC_ACQUIRE, "agent");
      xb_add(&bar[XB_XGEN(b.x)], 1u);
      asm volatile("s_waitcnt vmcnt(0)" ::: "memory");
    } else {
      XB_SPIN(xb_ld(&bar[XB_XGEN(b.x)]) == gen, bar);
      __builtin_amdgcn_fence(__ATOMIC_ACQUIRE, "agent");
      asm volatile("s_waitcnt vmcnt(0)" ::: "memory");
    }
  }
  __syncthreads();
}

#define STAGE(fn, n) for (long i_ = (long)blockIdx.x * 256 + otid(); i_ < (long)(n); i_ += (long)gridDim.x * 256) fn(i_, p, l);
#define BSTAGE(fn, n) for (long w_ = blockIdx.x; w_ < (long)(n); w_ += gridDim.x) fn(w_, p, l);
#define SYNC { XcdBarrier xb_; xb_.bar = p.xbar; xb_.x = xb_xcc_id(); xb_.st = (volatile LAS unsigned*)&xb_words; xcd_barrier(xb_); }
__global__ void __launch_bounds__(256, 2) mega(P p) {
  cg::grid_group grid = cg::this_grid();
  __shared__ uint4 xb_words;
  if (threadIdx.x == 0) xb_words = make_uint4(0u, 0u, 0u, 0u);
  __syncthreads();
  (void)xcd_barrier_post(p.xbar, (volatile LAS unsigned*)&xb_words);
#define gtid ((long)blockIdx.x * 256 + otid())
#define gstride ((long)gridDim.x * 256)
  { int l = 0;
    if (gtid < 16) p.counters[gtid] = 0u;
    for (long i_ = gtid; i_ < 4 * 4096; i_ += gstride) p.cucnt[i_] = 0u;
    for (int rep_ = 0; rep_ < REP_S0; ++rep_) {
    for (long w_ = blockIdx.x; w_ < 3200; w_ += gridDim.x) blk_convert(w_, p);
    for (long w_ = blockIdx.x; w_ < 2L * NCOND * 24; w_ += gridDim.x) blk_mod(w_, p);
    for (long i_ = gtid; i_ < 2L * 16 * CFG_NKEYS * 128 / 8; i_ += gstride) cvt8(p.pkeys, p.keys16, i_);
    }
  }
  grid.sync();
#pragma unroll 1
  for (int ph = 0; ph < 18; ++ph) {
    const int l = ph >= 9 ? 1 : 0; const int k = ph - 9 * l;
    if (k == 0 && l == 1) continue;
    switch (k) {
      case 0: { BSTAGE(blk_norm<0>, NT / 4) } break;
      case 1: gemm_phase<0>(p, l); break;
      case 2: {
        STAGE(b_prep_gqa, (long)NT * 6)
        STAGE(b_prep_cache, (long)NTC * 640)
        half8 bf0 = {0, 0, 0, 0, 0, 0, 0, 0}, bf1 = bf0; int bkey = -1;
        for (long w_ = blockIdx.x; w_ < (long)N_PREP_RW + N_PREP_DN; w_ += gridDim.x) blk_scanprep(w_, p, l, bf0, bf1, bkey);
      } break;
      case 3:
#ifdef PROBE_MIXER2
        mixer_phase(p, l + 2); SYNC
#endif
        mixer_phase(p, l); break;
      case 4: fin_phase(p, l); break;
      case 5: {
        gemm_phase<1>(p, l);
        for (long i_ = gtid; i_ < (long)NEXP * 1024 / 16; i_ += gstride) {
          cvt16_fp4(p.pu + (long)l * NEXP * 1024, (unsigned char*)p.u16, i_, PEER_USCALE);
          cvt16_fp4(p.pv + (long)l * NEXP * 1024, (unsigned char*)p.v16, i_, PEER_VSCALE);
        }
      } break;
      case 6: { BSTAGE(blk_norm<1>, NT / 4) } break;
      case 7: gemm_phase<2>(p, l); break;
      default: { BSTAGE(blk_peer<false>, NT / 4) } break;
    }
    if (ph != 17) SYNC
  }
}
#else
#define STAGE(fn, n) { _Pragma("omp parallel for schedule(dynamic, 64)") for (long i_ = 0; i_ < (long)(n); ++i_) fn(i_, p, l); }
#define SYNC
void mega(P p) {
  { int l = 0;
    STAGE(b_init, (long)NT * 1024)
    STAGE(b_mod, 2L * NCOND * 6144)
  }
  for (int l = 0; l < 2; ++l) {
    STAGE(b_norm<0>, NT)
    STAGE(b_inproj, (long)NT * INC)
    STAGE(b_prep_gqa, (long)NT * 6)
    STAGE(b_prep_cache, (long)NTC * 640)
    STAGE(b_rwaux, (long)NT * 512)
    STAGE(b_dnconv, (long)NT * 768)
    STAGE(b_dnnorm, (long)NT * 8)
    STAGE(b_rwscan, NSCAN)
    STAGE(b_dnscan, NSCAN)
    STAGE(b_attn_gqa, (long)NT * 4)
    STAGE(b_attn_na, (long)NT * 4)
    STAGE(b_rwfin, (long)NT * 4)
    STAGE(b_dnfin, (long)NT * 4)
    STAGE(b_outproj, (long)NT * 1024)
    STAGE(b_norm<1>, NT)
    STAGE(b_peerq, (long)NT * 2048)
    STAGE(b_topk1, (long)NT * 16)
    STAGE(b_topk2, (long)NT * 8)
    STAGE(b_peer_act, (long)NT * 128)
    STAGE(b_peer_out, (long)NT * 1024)
  }
  { int l = 0; STAGE(b_final, NT) }
}
#endif

static void fill_params(P& p, void* const* d_in, void* d_out, void* d_ws) {
  const float** f = (const float**)&p;
  for (int i = 0; i < 39; ++i) f[i] = (const float*)d_in[i];
  float* o = (float*)d_out;
  p.X = o; o += (long)NT * 1024;
  p.ogk = o; o += (long)CFG_BATCH * 2 * 2 * CFG_SEQ * 64;
  p.ogv = o; o += (long)CFG_BATCH * 2 * 2 * CFG_SEQ * 64;
  p.onk = o; o += (long)CFG_BATCH * 2 * 4 * CFG_SEQ * 64;
  p.onv = o; o += (long)CFG_BATCH * 2 * 4 * CFG_SEQ * 64;
  p.orw = o; o += (long)CFG_BATCH * 2 * 2 * 4 * 4096;
  p.odn = o;
  char* w = (char*)d_ws;
  auto take = [&](size_t bytes) { char* r = w; w += (bytes + 255) & ~(size_t)255; return r; };
  p.xbar = (unsigned*)take(16384);
  p.counters = (unsigned*)take(256);
  p.cucnt = (unsigned*)take(4 * 4096 * 4);
  p.mod = (float*)take(2L * NCOND * 6144 * 4);
  p.act = (h16*)take((size_t)NT * 1024 * sizeof(h16));
  p.rwaux = (h16*)take((size_t)NT * 1024 * sizeof(h16));
  p.dnp = (h16*)take((size_t)NT * 768 * sizeof(h16));
  p.proj = (h16*)take((size_t)NT * INC * sizeof(h16));
  p.wtin = (h16*)take((size_t)2 * NPAD_IN * 1024 * sizeof(h16));
  p.wtout = (h16*)take((size_t)2 * 1024 * 1024 * sizeof(h16));
  p.wtq = (h16*)take((size_t)2 * 2048 * 1024 * sizeof(h16));
  p.rwsc = (float*)take((size_t)NT * 16 * 4);
  p.dnsc = (float*)take((size_t)NT * 16 * 4);
  p.keys16 = (h16*)take((size_t)2 * 16 * CFG_NKEYS * 128 * sizeof(h16));
  char* a = (char*)p.proj;
#ifdef HOST_EMU
  p.pq = (h16*)a; a += (size_t)NT * 2048 * sizeof(h16);
#endif
  p.tks = (float*)a; a += (size_t)NT * 256 * 4;
  p.tki = (int*)a; a += (size_t)NT * 256 * 4;
  p.u16 = (h16*)a; a += (size_t)NEXP * 1024 * sizeof(h16);
  p.v16 = (h16*)a; a += (size_t)NEXP * 1024 * sizeof(h16);
  p.pidx = (int*)p.rwaux;
  p.pact = (float*)((char*)p.rwaux + (size_t)NT * 128 * 4);
}

#ifndef HOST_EMU
extern "C" void kernel_launch(void* const* d_in, const int* in_sizes, int n_in, void* d_out, int out_size, void* d_ws,
                              size_t ws_size, hipStream_t stream) {
  static int grid_blocks = 0;
  if (!grid_blocks) {
    int dev = 0, cus = 0, per_cu = 0;
    (void)hipGetDevice(&dev);
    (void)hipDeviceGetAttribute(&cus, hipDeviceAttributeMultiprocessorCount, dev);
    (void)hipOccupancyMaxActiveBlocksPerMultiprocessor(&per_cu, mega, 256, 0);
    grid_blocks = cus * per_cu;
  }
  P p;
  memset(&p, 0, sizeof(p));
  fill_params(p, d_in, d_out, d_ws);
  (void)hipMemsetAsync(p.xbar, 0, 16384, stream);
  void* args[] = {&p};
  hipError_t e = hipLaunchCooperativeKernel((void*)mega, dim3(grid_blocks), dim3(256), args, 0, stream);
  if (e != hipSuccess) fprintf(stderr, "cooperative launch failed: %s (grid %d)\n", hipGetErrorString(e), grid_blocks);
}
#endif
```

```cpp
#ifndef HOST_EMU
#include <hip/hip_runtime.h>
#include <hip/hip_cooperative_groups.h>
namespace cg = cooperative_groups;
#define HD __device__ __forceinline__
#define HDN __device__ __noinline__
typedef _Float16 h16;
#define CBAR asm volatile("" ::: "memory")
#define SMEM_BYTES 73728
__shared__ __attribute__((aligned(16))) char g_smem[SMEM_BYTES];
__device__ __forceinline__ int otid() { int t = threadIdx.x; asm volatile("" : "+v"(t)); return t; }
#define FSIN(x) __sinf(x)
#define FCOS(x) __cosf(x)
#else
#include <cmath>
#include <cstring>
#define HD static inline
#define HDN static
typedef float h16;
#define CBAR
#define FSIN(x) sinf(x)
#define FCOS(x) cosf(x)
#endif
#include <cstdio>
#include <cstring>

#ifndef CFG_BATCH
#define CFG_BATCH 32
#define CFG_SEQ 256
#define CFG_DB 8
#define CFG_DS 4096
#define CFG_PAST 512
#define CFG_NKEYS 128
#endif

#define NTC (CFG_BATCH * CFG_SEQ)
#define NTL (CFG_DB * CFG_DS)
#define NT (NTC + NTL)
#define NCOND (1 + CFG_DB)
#define GROWS (CFG_DS / 64)
#define WR (GROWS < 8 ? GROWS : 8)
#define NEXP (CFG_NKEYS * CFG_NKEYS)
#define INC 3280
#define RW_OFF 512
#define NA_OFF 1472
#define DN_OFF 2240

struct P {
  const float *xp, *xs, *c, *cgk, *cgv, *cnk, *cnv, *srw, *sdn, *cctx, *n1g, *n2g, *wmod, *bmod, *win, *wout,
      *gqn, *gkn, *rwmu, *rww0, *rww2, *rwa0, *rwa2, *rwg2, *rwkk, *rwka, *rwrk, *rwlng, *rwlnb, *nabias,
      *dnconv, *dnalog, *dndt, *dnng, *pwq, *pkeys, *pu, *pv, *fng;
  float *X, *ogk, *ogv, *onk, *onv, *orw, *odn;
  float* mod;
  h16* act;
  h16* proj;
  h16* rwaux;
  h16* dnp;
  h16* pq;
  float* tks;
  int* tki;
  int* pidx;
  float* pact;
  unsigned* counters;
  unsigned* xbar;
  unsigned* cucnt;
  h16 *keys16, *u16, *v16;
  float *rwsc, *dnsc;
  h16 *wtin, *wtout, *wtq;
};

HD float sigmoidf_(float x) { return 1.0f / (1.0f + expf(-x)); }
HD float siluf_(float x) { return x * sigmoidf_(x); }
HD float softplusf_(float x) { return fmaxf(x, 0.0f) + log1pf(expf(-fabsf(x))); }
HD int condrow(long token) { return token < NTC ? 0 : 1 + (int)((token - NTC) / CFG_DS); }
HD void seqinfo(long token, int& t, int& T, long& base) {
  if (token < NTC) { T = CFG_SEQ; t = (int)(token % CFG_SEQ); base = token - t; }
  else { long u = token - NTC; T = CFG_DS; t = (int)(u % CFG_DS); base = token - t; }
}

HD void b_init(long i, const P& p, int l) {
  p.X[i] = (i < (long)NTC * 1024) ? p.xp[i] : p.xs[i - (long)NTC * 1024];
}
HD void b_mod(long i, const P& p, int) {
  int col = (int)(i % 6144); int r = (int)((i / 6144) % NCOND); int l = (int)(i / (6144L * NCOND));
  const float* cond = r == 0 ? p.cctx : p.c + (long)(r - 1) * 1024;
  float acc = p.bmod[l * 6144 + col];
  for (int k = 0; k < 1024; ++k) acc += siluf_(cond[k]) * p.wmod[((long)l * 1024 + k) * 6144 + col];
  p.mod[i] = acc;
}
template <int WHICH>
HD void b_norm(long i, const P& p, int l) {
  const float* x = p.X + i * 1024;
  float ss = 0.f;
  for (int k = 0; k < 1024; ++k) ss += x[k] * x[k];
  float rstd = 1.0f / sqrtf(ss * (1.0f / 1024) + 1e-6f);
  const float* m = p.mod + ((long)l * NCOND + condrow(i)) * 6144 + (WHICH ? 3072 : 0);
  const float* g = (WHICH ? p.n2g : p.n1g) + l * 1024;
  for (int k = 0; k < 1024; ++k) p.act[i * 1024 + k] = (h16)((x[k] * rstd * g[k]) * (1.0f + m[1024 + k]) + m[k]);
}
HD void b_prep_gqa(long i, const P& p, int l) {
  long token = i / 6; int slot = (int)(i % 6);
  h16* x = p.proj + token * INC + slot * 64;
  float y[64]; float ss = 0.f;
#pragma unroll
  for (int d = 0; d < 64; ++d) { y[d] = (float)x[d]; ss += y[d] * y[d]; }
  float rstd = 1.0f / sqrtf(ss * (1.0f / 64) + 1e-6f);
  const float* g = (slot < 4 ? p.gqn : p.gkn) + l * 64;
#pragma unroll
  for (int d = 0; d < 64; ++d) y[d] = y[d] * rstd * g[d];
  if (token >= NTC) {
    int t = (int)((token - NTC) % CFG_DS); int row = t / 64, colp = t % 64;
#pragma unroll
    for (int j = 0; j < 32; ++j) {
      float inv = exp2f(-(float)(j % 16) * 0.83048202372184059f);
      float ang = (float)(j < 16 ? row : colp) * inv;
      float cs = FCOS(ang), sn = FSIN(ang);
      float a = y[j], b = y[j + 32];
      y[j] = a * cs - b * sn; y[j + 32] = b * cs + a * sn;
    }
  } else if (slot >= 4) {
    int b = (int)(token / CFG_SEQ), t = (int)(token % CFG_SEQ);
    float* o = p.ogk + ((((long)b * 2 + l) * 2 + (slot - 4)) * CFG_SEQ + t) * 64;
#pragma unroll
    for (int d = 0; d < 64; ++d) o[d] = y[d];
  }
  float sc = slot < 4 ? 0.125f : 1.0f;
#pragma unroll
  for (int d = 0; d < 64; ++d) x[d] = (h16)(y[d] * sc);
}
HD void b_prep_cache(long i, const P& p, int l) {
  long token = i / 640; int e = (int)(i % 640);
  int b = (int)(token / CFG_SEQ), t = (int)(token % CFG_SEQ);
  const h16* pr = p.proj + token * INC;
  if (e < 128) { int kvh = e / 64, d = e % 64; p.ogv[((((long)b * 2 + l) * 2 + kvh) * CFG_SEQ + t) * 64 + d] = (float)pr[384 + e]; }
  else if (e < 384) { int c = e - 128; int h = c / 64, d = c % 64; p.onk[((((long)b * 2 + l) * 4 + h) * CFG_SEQ + t) * 64 + d] = (float)pr[NA_OFF + 256 + c]; }
  else { int c = e - 384; int h = c / 64, d = c % 64; p.onv[((((long)b * 2 + l) * 4 + h) * CFG_SEQ + t) * 64 + d] = (float)pr[NA_OFF + 512 + c]; }
}
HD void b_rwaux(long i, const P& p, int l) {
  int col = (int)(i % 256); int d = (int)((i / 256) % 2); long token = i / 512;
  int t, T; long base; seqinfo(token, t, T, base);
  bool sv = d == 0 ? (t > 0) : (t < T - 1);
  const h16* pb = p.proj + token * INC + RW_OFF;
  const h16* ps = p.proj + (token + (d == 0 ? -1 : 1)) * INC + RW_OFF;
  const float* mu = p.rwmu + ((long)l * 2 + d) * 832;
  float accw = p.rww0[(l * 2 + d) * 256 + col], acca = p.rwa0[(l * 2 + d) * 256 + col];
  for (int j = 0; j < 32; ++j) {
    float bw = (float)pb[768 + d * 32 + j], sw = sv ? (float)ps[768 + d * 32 + j] : 0.f;
    float wl = bw + (sw - bw) * mu[768 + j];
    float ba = (float)pb[832 + d * 32 + j], sa = sv ? (float)ps[832 + d * 32 + j] : 0.f;
    float al = ba + (sa - ba) * mu[800 + j];
    accw += tanhf(wl) * p.rww2[(((long)l * 2 + d) * 32 + j) * 256 + col];
    acca += al * p.rwa2[(((long)l * 2 + d) * 32 + j) * 256 + col];
  }
  float w = -softplusf_(-accw) - 0.5f;
  p.rwaux[((token * 2 + d) * 2 + 0) * 256 + col] = (h16)expf(w);
  p.rwaux[((token * 2 + d) * 2 + 1) * 256 + col] = (h16)sigmoidf_(acca);
}
HD void b_dnconv(long i, const P& p, int l) {
  int c = (int)(i % 768); long token = i / 768;
  int t, T; long base; seqinfo(token, t, T, base);
  float acc = 0.f;
#pragma unroll
  for (int j = 0; j < 5; ++j) {
    int tt = t + j - 2;
    if (tt >= 0 && tt < T) acc += (float)p.proj[(base + tt) * INC + DN_OFF + c] * p.dnconv[((long)l * 5 + j) * 768 + c];
  }
  p.dnp[token * 768 + c] = (h16)siluf_(acc);
}
HD void b_dnnorm(long i, const P& p, int) {
  long token = i / 8; int slot = (int)(i % 8);
  h16* x = p.dnp + token * 768 + slot * 64;
  float ss = 0.f;
  for (int d = 0; d < 64; ++d) { float v = (float)x[d]; ss += v * v; }
  float rs = 1.0f / sqrtf(ss + 1e-6f) * (slot < 4 ? 0.125f : 1.0f);
  for (int d = 0; d < 64; ++d) x[d] = (h16)((float)x[d] * rs);
}

struct Softmax64 {
  float m, lsum, acc[64];
};
template <typename TK>
HD void attend_key(Softmax64& st, const float* q, const TK* k, const TK* v, float scale, float bias) {
  float s = 0.f;
#pragma unroll
  for (int d = 0; d < 64; ++d) s += q[d] * (float)k[d];
  s = s * scale + bias;
  if (s > st.m) {
    float f = expf(st.m - s);
    st.lsum *= f;
#pragma unroll
    for (int d = 0; d < 64; ++d) st.acc[d] *= f;
    st.m = s;
  }
  float pw = expf(s - st.m);
  st.lsum += pw;
#pragma unroll
  for (int d = 0; d < 64; ++d) st.acc[d] += pw * (float)v[d];
}
HD void b_attn_gqa(long i, const P& p, int l) {
  int h = (int)(i / NT); long token = i % NT; int kvh = h / 2;
  float q[64];
  const h16* qp = p.proj + token * INC + h * 64;
#pragma unroll
  for (int d = 0; d < 64; ++d) q[d] = (float)qp[d];
  Softmax64 st; st.m = -1e30f; st.lsum = 0.f;
#pragma unroll
  for (int d = 0; d < 64; ++d) st.acc[d] = 0.f;
  int t, T; long base; seqinfo(token, t, T, base);
  for (int tk = 0; tk < T; ++tk) {
    const h16* kp = p.proj + (base + tk) * INC + 256 + kvh * 64;
    attend_key<h16>(st, q, kp, kp + 128, 1.0f, 0.f);
  }
  if (token >= NTC) {
    int b = (int)((token - NTC) / CFG_DS);
    const float* ck = p.cgk + (((long)b * 2 + l) * 2 + kvh) * CFG_PAST * 64;
    const float* cv = p.cgv + (((long)b * 2 + l) * 2 + kvh) * CFG_PAST * 64;
    for (int pp = 0; pp < CFG_PAST; ++pp) attend_key<float>(st, q, ck + pp * 64, cv + pp * 64, 1.0f, 0.f);
  }
  float inv = 1.0f / st.lsum;
  h16* o = p.act + token * 1024 + h * 64;
#pragma unroll
  for (int d = 0; d < 64; ++d) o[d] = (h16)(st.acc[d] * inv);
}
HD void b_attn_na(long i, const P& p, int l) {
  int h = (int)(i / NT); long token = i % NT;
  float q[64];
  const h16* qp = p.proj + token * INC + NA_OFF + h * 64;
#pragma unroll
  for (int d = 0; d < 64; ++d) q[d] = (float)qp[d];
  Softmax64 st; st.m = -1e30f; st.lsum = 0.f;
#pragma unroll
  for (int d = 0; d < 64; ++d) st.acc[d] = 0.f;
  int t, T; long base; seqinfo(token, t, T, base);
  if (token < NTC) {
    for (int tk = 0; tk < T; ++tk) {
      const h16* kp = p.proj + (base + tk) * INC + NA_OFF + 256 + h * 64;
      attend_key<h16>(st, q, kp, kp + 256, 0.125f, 0.f);
    }
  } else {
    int r = t / 64, cq = t % 64;
    int r0 = r - WR / 2; r0 = r0 < 0 ? 0 : (r0 > GROWS - WR ? GROWS - WR : r0);
    int cs = cq - 8; cs = cs < 0 ? 0 : (cs > 48 ? 48 : cs);
    const float* bias = p.nabias + ((long)l * 4 + h) * 15 * 31;
    for (int w = 0; w < WR; ++w) {
      int kr = r0 + w;
      for (int cc = 0; cc < 16; ++cc) {
        int kc = cs + cc;
        const h16* kp = p.proj + (base + kr * 64 + kc) * INC + NA_OFF + 256 + h * 64;
        attend_key<h16>(st, q, kp, kp + 256, 0.125f, bias[(kr - r + 7) * 31 + (kc - cq + 15)]);
      }
    }
    int b = (int)((token - NTC) / CFG_DS);
    const float* ck = p.cnk + (((long)b * 2 + l) * 4 + h) * CFG_PAST * 64;
    const float* cv = p.cnv + (((long)b * 2 + l) * 4 + h) * CFG_PAST * 64;
    for (int pp = 0; pp < CFG_PAST; ++pp) attend_key<float>(st, q, ck + pp * 64, cv + pp * 64, 0.125f, 0.f);
  }
  float inv = 1.0f / st.lsum;
  h16* o = p.act + token * 1024 + 512 + h * 64;
#pragma unroll
  for (int d = 0; d < 64; ++d) o[d] = (h16)(st.acc[d] * inv);
}

HD float rw_lerp(const P& p, int l, long token, bool sv, int d, int c) {
  float b = (float)p.proj[token * INC + RW_OFF + c];
  float s = sv ? (float)p.proj[(token + (d == 0 ? -1 : 1)) * INC + RW_OFF + c] : 0.f;
  return b + (s - b) * p.rwmu[((long)l * 2 + d) * 832 + c];
}
HD void b_rwscan(long i, const P& p, int l) {
  int v = (int)(i % 64); int sb = (int)(i / 64); int h = sb % 4; int bi = sb / 4;
  bool ctx = bi < CFG_BATCH;
  int T = ctx ? CFG_SEQ : CFG_DS;
  long base = ctx ? (long)bi * CFG_SEQ : (long)NTC + (long)(bi - CFG_BATCH) * CFG_DS;
#ifndef HOST_EMU
  float* S = (float*)g_smem + threadIdx.x * 65;
#else
  float S[64];
#endif
  for (int d = 0; d < 2; ++d) {
    if (ctx) {
      for (int k = 0; k < 64; ++k) S[k] = 0.f;
    } else {
      const float* s0 = p.srw + (((((long)(bi - CFG_BATCH)) * 2 + l) * 2 + d) * 4 + h) * 4096 + v * 64;
      for (int k = 0; k < 64; ++k) S[k] = s0[k];
    }
    for (int step = 0; step < T; ++step) {
      int t = d == 0 ? step : T - 1 - step;
      long token = base + t;
      bool sv = d == 0 ? (t > 0) : (t < T - 1);
      const h16* aux = p.rwaux + (token * 2 + d) * 512;
      float ss = 0.f;
      for (int k = 0; k < 64; ++k) {
        float kv = rw_lerp(p, l, token, sv, d, 256 + h * 64 + k) * p.rwkk[l * 256 + h * 64 + k];
        ss += kv * kv;
      }
      float rs = 1.0f / sqrtf(ss + 1e-6f);
      float sa = 0.f;
      for (int k = 0; k < 64; ++k) {
        float kk = rw_lerp(p, l, token, sv, d, 256 + h * 64 + k) * p.rwkk[l * 256 + h * 64 + k] * rs;
        sa -= S[k] * kk;
      }
      float vv = rw_lerp(p, l, token, sv, d, 512 + h * 64 + v);
      float o = 0.f;
      for (int k = 0; k < 64; ++k) {
        int c = h * 64 + k;
        float kr = rw_lerp(p, l, token, sv, d, 256 + c);
        float kk = kr * p.rwkk[l * 256 + c] * rs;
        float a = (float)aux[256 + c];
        float dec = expf(-(float)aux[c]);
        float keff = kr * (1.0f + (a - 1.0f) * p.rwka[l * 256 + c]);
        float r = rw_lerp(p, l, token, sv, d, c);
        S[k] = S[k] * dec + sa * (kk * a) + vv * keff;
        o += S[k] * r;
      }
      h16* op = p.act + token * 1024 + 256 + h * 64 + v;
      if (d == 0) *op = (h16)o; else *op = (h16)((float)*op + o);
    }
    if (ctx) {
      float* so = p.orw + (((((long)bi) * 2 + l) * 2 + d) * 4 + h) * 4096 + v * 64;
      for (int k = 0; k < 64; ++k) so[k] = S[k];
    }
  }
}
HD void b_rwfin(long i, const P& p, int l) {
  long token = i / 4; int h = (int)(i % 4);
  int t, T; long base; seqinfo(token, t, T, base);
  h16* op = p.act + token * 1024 + 256 + h * 64;
  float mu = 0.f;
  for (int k = 0; k < 64; ++k) mu += (float)op[k];
  mu *= (1.0f / 64);
  float var = 0.f;
  for (int k = 0; k < 64; ++k) { float dlt = (float)op[k] - mu; var += dlt * dlt; }
  var *= (1.0f / 64);
  float rs = 1.0f / sqrtf(var + 64e-5f);
  float bon0 = 0.f, bon1 = 0.f;
  for (int d = 0; d < 2; ++d) {
    bool sv = d == 0 ? (t > 0) : (t < T - 1);
    const h16* aux = p.rwaux + (token * 2 + d) * 512;
    float s = 0.f;
    for (int k = 0; k < 64; ++k) {
      int c = h * 64 + k;
      float kr = rw_lerp(p, l, token, sv, d, 256 + c);
      float a = (float)aux[256 + c];
      float keff = kr * (1.0f + (a - 1.0f) * p.rwka[l * 256 + c]);
      s += rw_lerp(p, l, token, sv, d, c) * keff * p.rwrk[l * 256 + c];
    }
    if (d == 0) bon0 = s; else bon1 = s;
  }
  bool sv0 = t > 0, sv1 = t < T - 1;
  for (int k = 0; k < 64; ++k) {
    int c = h * 64 + k;
    float y = ((float)op[k] - mu) * rs * p.rwlng[l * 256 + c] + p.rwlnb[l * 256 + c];
    y += bon0 * rw_lerp(p, l, token, sv0, 0, 512 + c) + bon1 * rw_lerp(p, l, token, sv1, 1, 512 + c);
    float gate = 0.f;
    for (int j = 0; j < 64; ++j) gate += sigmoidf_((float)p.proj[token * INC + RW_OFF + 896 + j]) * p.rwg2[((long)l * 64 + j) * 256 + c];
    op[k] = (h16)(y * gate);
  }
}
HD void b_dnscan(long i, const P& p, int l) {
  int v = (int)(i % 64); int sb = (int)(i / 64); int h = sb % 4; int bi = sb / 4;
  bool ctx = bi < CFG_BATCH;
  int T = ctx ? CFG_SEQ : CFG_DS;
  long base = ctx ? (long)bi * CFG_SEQ : (long)NTC + (long)(bi - CFG_BATCH) * CFG_DS;
#ifndef HOST_EMU
  float* S = (float*)g_smem + threadIdx.x * 65;
#else
  float S[64];
#endif
  for (int d = 0; d < 2; ++d) {
    if (ctx) {
      for (int k = 0; k < 64; ++k) S[k] = 0.f;
    } else {
      const float* s0 = p.sdn + (((((long)(bi - CFG_BATCH)) * 2 + l) * 2 + d) * 4 + h) * 4096 + v;
      for (int k = 0; k < 64; ++k) S[k] = s0[k * 64];
    }
    float nalog = -expf(p.dnalog[(l * 2 + d) * 4 + h]);
    float dtb = p.dndt[(l * 2 + d) * 4 + h];
    for (int step = 0; step < T; ++step) {
      int t = d == 0 ? step : T - 1 - step;
      long token = base + t;
      const h16* dp = p.dnp + token * 768;
      const h16* pr = p.proj + token * INC + DN_OFF;
      float beta = sigmoidf_((float)pr[768 + d * 4 + h]);
      float g = nalog * softplusf_((float)pr[776 + d * 4 + h] + dtb);
      float a = expf(g);
      float sk = 0.f;
      for (int k = 0; k < 64; ++k) sk += (float)dp[256 + h * 64 + k] * S[k];
      float coef = beta * ((float)dp[512 + h * 64 + v] - a * sk);
      float o = 0.f;
      for (int k = 0; k < 64; ++k) {
        S[k] = a * S[k] + coef * (float)dp[256 + h * 64 + k];
        o += (float)dp[h * 64 + k] * S[k];
      }
      h16* op = p.act + token * 1024 + 768 + h * 64 + v;
      if (d == 0) *op = (h16)o; else *op = (h16)((float)*op + o);
    }
    if (ctx) {
      float* so = p.odn + (((((long)bi) * 2 + l) * 2 + d) * 4 + h) * 4096 + v;
      for (int k = 0; k < 64; ++k) so[k * 64] = S[k];
    }
  }
}
HD void b_dnfin(long i, const P& p, int l) {
  long token = i / 4; int h = (int)(i % 4);
  h16* op = p.act + token * 1024 + 768 + h * 64;
  float ss = 0.f;
  for (int k = 0; k < 64; ++k) { float o = (float)op[k]; ss += o * o; }
  float rs = 1.0f / sqrtf(ss * (1.0f / 64) + 1e-6f);
  for (int k = 0; k < 64; ++k) {
    float z = (float)p.proj[token * INC + DN_OFF + 784 + h * 64 + k];
    op[k] = (h16)((float)op[k] * rs * p.dnng[l * 64 + k] * siluf_(z));
  }
}
HD void top16_insert(float (&ts)[16], int (&ti)[16], float s, int id) {
#pragma unroll
  for (int j = 0; j < 16; ++j) {
    if (s > ts[j]) { float a = ts[j]; ts[j] = s; s = a; int b = ti[j]; ti[j] = id; id = b; }
  }
}
HD void b_topk1(long i, const P& p, int l) {
  long token = i / 16; int hp = (int)(i % 16);
  const h16* q = p.pq + token * 2048 + hp * 128;
  const float* keys = p.pkeys + ((long)l * 16 + hp) * CFG_NKEYS * 128;
  float ts[16]; int ti[16];
#pragma unroll
  for (int j = 0; j < 16; ++j) { ts[j] = -3.0e38f; ti[j] = 0; }
  for (int k = 0; k < CFG_NKEYS; ++k) {
    float s = 0.f;
    for (int d = 0; d < 128; ++d) s += (float)q[d] * keys[k * 128 + d];
    top16_insert(ts, ti, s, k);
  }
#pragma unroll
  for (int j = 0; j < 16; ++j) { p.tks[token * 256 + hp * 16 + j] = ts[j]; p.tki[token * 256 + hp * 16 + j] = ti[j]; }
}
HD void b_topk2(long i, const P& p, int l) {
  long token = i / 8; int hd = (int)(i % 8);
  const float* s1 = p.tks + token * 256 + hd * 32; const int* i1 = p.tki + token * 256 + hd * 32;
  float ts[16]; int ti[16];
#pragma unroll
  for (int j = 0; j < 16; ++j) { ts[j] = -3.0e38f; ti[j] = 0; }
  for (int a = 0; a < 16; ++a)
    for (int b = 0; b < 16; ++b) top16_insert(ts, ti, s1[a] + s1[16 + b], i1[a] * CFG_NKEYS + i1[16 + b]);
  float sum = 0.f;
#pragma unroll
  for (int j = 0; j < 16; ++j) sum += expf(ts[j] - ts[0]);
  float inv = 1.0f / sum;
#pragma unroll
  for (int j = 0; j < 16; ++j) { p.pidx[token * 128 + hd * 16 + j] = ti[j]; p.pact[token * 128 + hd * 16 + j] = expf(ts[j] - ts[0]) * inv; }
}
HD void b_peer_act(long i, const P& p, int l) {
  long token = i / 128;
  const float* u = p.pu + ((long)l * NEXP + p.pidx[i]) * 1024;
  const h16* x = p.act + token * 1024;
  float dot = 0.f;
  for (int k = 0; k < 1024; ++k) dot += (float)x[k] * u[k];
  float ge = 0.5f * dot * (1.0f + erff(dot * 0.70710678118654752f));
  p.pact[i] = p.pact[i] * ge;
}
HD void b_peer_out(long i, const P& p, int l) {
  long token = i / 1024; int col = (int)(i % 1024);
  float acc = 0.f;
  for (int e = 0; e < 128; ++e) acc += p.pact[token * 128 + e] * p.pv[((long)l * NEXP + p.pidx[token * 128 + e]) * 1024 + col];
  p.X[i] += p.mod[((long)l * NCOND + condrow(token)) * 6144 + 5120 + col] * acc;
}
HD void b_final(long i, const P& p, int) {
  float* x = p.X + i * 1024;
  float ss = 0.f;
  for (int k = 0; k < 1024; ++k) ss += x[k] * x[k];
  float rstd = 1.0f / sqrtf(ss * (1.0f / 1024) + 1e-6f);
  for (int k = 0; k < 1024; ++k) x[k] = x[k] * rstd * p.fng[k];
}
HD float gemm_elem(const h16* A, const float* B, int N, long token, int col) {
  float acc = 0.f;
  for (int k = 0; k < 1024; ++k) acc += (float)A[token * 1024 + k] * B[(long)k * N + col];
  return acc;
}
HD void b_inproj(long i, const P& p, int l) {
  long token = i / INC; int col = (int)(i % INC);
  p.proj[i] = (h16)gemm_elem(p.act, p.win + (long)l * 1024 * INC, INC, token, col);
}
HD void b_outproj(long i, const P& p, int l) {
  long token = i / 1024; int col = (int)(i % 1024);
  float acc = gemm_elem(p.act, p.wout + (long)l * 1024 * 1024, 1024, token, col);
  p.X[i] += p.mod[((long)l * NCOND + condrow(token)) * 6144 + 2048 + col] * acc;
}
HD void b_peerq(long i, const P& p, int l) {
  long token = i / 2048; int col = (int)(i % 2048);
  p.pq[i] = (h16)gemm_elem(p.act, p.pwq + (long)l * 1024 * 2048, 2048, token, col);
}

#ifndef PROBE_KMAX
#define PROBE_KMAX 16
#endif
#ifndef REP_S0
#define REP_S0 1
#endif
#ifndef REP_MISC
#define REP_MISC 1
#endif
#ifndef REP_G0
#define REP_G0 1
#endif
#ifndef REP_G2
#define REP_G2 1
#endif
#ifndef REP_SP
#define REP_SP 1
#endif
#define NSCAN ((long)(CFG_BATCH + CFG_DB) * 4 * 64)
#define NPAD_IN 3328

#ifndef HOST_EMU
typedef _Float16 half8 __attribute__((ext_vector_type(8)));
typedef _Float16 half4 __attribute__((ext_vector_type(4)));
typedef _Float16 half2v __attribute__((ext_vector_type(2)));
typedef float f32x2 __attribute__((ext_vector_type(2)));
typedef float f32x16 __attribute__((ext_vector_type(16)));
typedef float f32x4 __attribute__((ext_vector_type(4)));
typedef unsigned u32x4 __attribute__((ext_vector_type(4)));
typedef short s16x4v __attribute__((__vector_size__(4 * sizeof(short))));

template <int CTRL> __device__ __forceinline__ float dppf(float x) {
  return __builtin_bit_cast(float, __builtin_amdgcn_update_dpp(0, __builtin_bit_cast(int, x), CTRL, 0xF, 0xF, true));
}
__device__ __forceinline__ float sum16(float x) { x += dppf<0x128>(x); x += dppf<0x124>(x); x += dppf<0xB1>(x); x += dppf<0x4E>(x); return x; }
__device__ __forceinline__ float sum8(float x) { x += dppf<0xB1>(x); x += dppf<0x4E>(x); x += dppf<0x141>(x); return x; }
__device__ __forceinline__ float sum64(float x) { x = sum16(x); x += __shfl_xor(x, 16); x += __shfl_xor(x, 32); return x; }

#define CSWAP_DESC(S, ID, i, j) { const bool c_ = S[j] > S[i]; const float a_ = c_ ? S[j] : S[i]; const float b_ = c_ ? S[i] : S[j]; \
    const int ia_ = c_ ? ID[j] : ID[i]; const int ib_ = c_ ? ID[i] : ID[j]; S[i] = a_; S[j] = b_; ID[i] = ia_; ID[j] = ib_; }
__device__ __forceinline__ void bitonic_sort16_desc(float (&s)[16], int (&id)[16]) {
#pragma unroll
  for (int k = 2; k <= 16; k <<= 1) {
#pragma unroll
    for (int j = k >> 1; j > 0; j >>= 1) {
#pragma unroll
      for (int i = 0; i < 16; ++i) {
        const int l = i ^ j;
        if (l > i) {
          if ((i & k) == 0) CSWAP_DESC(s, id, i, l) else CSWAP_DESC(s, id, l, i)
        }
      }
    }
  }
}
__device__ __forceinline__ void merge_top16(float (&ts)[16], int (&ti)[16], const float (&gs)[16], const int (&gi)[16]) {
#pragma unroll
  for (int i = 0; i < 16; ++i) { if (gs[15 - i] > ts[i]) { ts[i] = gs[15 - i]; ti[i] = gi[15 - i]; } }
#pragma unroll
  for (int j = 8; j > 0; j >>= 1) {
#pragma unroll
    for (int i = 0; i < 16; ++i) { if ((i & j) == 0) CSWAP_DESC(ts, ti, i, i + j) }
  }
}
__device__ void blk_convert(long w, const P& p) {
  int l = (int)(w / 1600); int r = (int)(w % 1600);
  const float* src; h16* dst; int N, ntile;
  if (r < 832) { src = p.win + (long)l * 1024 * INC; dst = p.wtin + (long)l * NPAD_IN * 1024; N = INC; ntile = 52; }
  else if (r < 1088) { r -= 832; src = p.wout + (long)l * 1024 * 1024; dst = p.wtout + (long)l * 1024 * 1024; N = 1024; ntile = 16; }
  else { r -= 1088; src = p.pwq + (long)l * 1024 * 2048; dst = p.wtq + (long)l * 2048 * 1024; N = 2048; ntile = 32; }
  int kt = r / ntile, nt = r % ntile;
  int k0 = kt * 64, n0 = nt * 64;
  h16* tile = (h16*)g_smem;
  const int tid_ = otid(); int c = tid_ & 63, r4 = tid_ >> 6;
  __syncthreads();
#pragma unroll
  for (int j = 0; j < 16; ++j) {
    int rr = r4 + 4 * j;
    float v = (n0 + c < N) ? src[(long)(k0 + rr) * N + n0 + c] : 0.f;
    tile[rr * 66 + c] = (h16)v;
  }
  __syncthreads();
#pragma unroll
  for (int j = 0; j < 16; ++j) {
    int rr = r4 + 4 * j;
    dst[(long)(n0 + rr) * 1024 + k0 + c] = tile[c * 66 + rr];
  }
}

template <int EPI>
__device__ void gemm_phase(const P& p, int l, int kmax = 16) {
  constexpr int NTILES = EPI == 0 ? (NPAD_IN / 128) : (EPI == 1 ? 8 : 16);
  constexpr int NT8 = (NTILES + 7) / 8;
  const long nw = EPI == 0 ? (long)(NT / 128) * NTILES : (long)(NT / 128) * 8 * NT8;
#define TILE_OF(W, MT, NTV) { const int x_ = (int)((W) & 7); const int j_ = (int)((W) >> 3);                        \
    if (EPI == 0) { if (j_ < 960) { MT = j_ / 3; NTV = x_ + 8 * (j_ - 3 * MT); } else { NTV = 24 + (x_ >> 2); MT = 80 * (x_ & 3) + j_ - 960; } } \
    else { NTV = x_ + 8 * (j_ % NT8); MT = j_ / NT8; } }
  const h16* A = p.act;
  const h16* Bt = EPI == 0 ? p.wtin + (long)l * NPAD_IN * 1024 : (EPI == 1 ? p.wtout + (long)l * 1024 * 1024 : p.wtq + (long)l * 2048 * 1024);
  const int tid = otid(), lane = tid & 63, wv = tid >> 6, wm = wv >> 1, wn = wv & 1;
  h16* As = (h16*)g_smem;
  h16* Bs = As + 2 * 128 * 72;
  const int lrow = tid >> 3, lch = tid & 7;
  long w = blockIdx.x; int mt = 0, nt = 0;
  for (;;) { if (w >= nw) return; TILE_OF(w, mt, nt) if (nt < NTILES) break; w += gridDim.x; }
  int m0 = mt * 128, n0 = nt * 128;
  const h16* Ag = A + (long)(m0 + lrow) * 1024 + lch * 8;
  const h16* Bg = Bt + (long)(n0 + lrow) * 1024 + lch * 8;
  u32x4 ra0, ra1, ra2, ra3, rb0, rb1, rb2, rb3;
  u32x4 sa0, sa1, sa2, sa3, sb0, sb1, sb2, sb3;
  const f32x16 zero16 = {0.f, 0.f, 0.f, 0.f, 0.f, 0.f, 0.f, 0.f, 0.f, 0.f, 0.f, 0.f, 0.f, 0.f, 0.f, 0.f};
  f32x16 acc00, acc01, acc10, acc11;
#define GLD0(K0) \
  ra0 = *(const u32x4*)(Ag + (K0)); ra1 = *(const u32x4*)(Ag + 32 * 1024 + (K0)); ra2 = *(const u32x4*)(Ag + 64 * 1024 + (K0)); ra3 = *(const u32x4*)(Ag + 96 * 1024 + (K0)); \
  rb0 = *(const u32x4*)(Bg + (K0)); rb1 = *(const u32x4*)(Bg + 32 * 1024 + (K0)); rb2 = *(const u32x4*)(Bg + 64 * 1024 + (K0)); rb3 = *(const u32x4*)(Bg + 96 * 1024 + (K0));
#define GLD1(K0) \
  sa0 = *(const u32x4*)(Ag + (K0)); sa1 = *(const u32x4*)(Ag + 32 * 1024 + (K0)); sa2 = *(const u32x4*)(Ag + 64 * 1024 + (K0)); sa3 = *(const u32x4*)(Ag + 96 * 1024 + (K0)); \
  sb0 = *(const u32x4*)(Bg + (K0)); sb1 = *(const u32x4*)(Bg + 32 * 1024 + (K0)); sb2 = *(const u32x4*)(Bg + 64 * 1024 + (K0)); sb3 = *(const u32x4*)(Bg + 96 * 1024 + (K0));
#define LST0(AW, BW) \
  *(u32x4*)((AW) + (lrow) * 72 + lch * 8) = ra0; *(u32x4*)((AW) + (lrow + 32) * 72 + lch * 8) = ra1; *(u32x4*)((AW) + (lrow + 64) * 72 + lch * 8) = ra2; *(u32x4*)((AW) + (lrow + 96) * 72 + lch * 8) = ra3; \
  *(u32x4*)((BW) + (lrow) * 72 + lch * 8) = rb0; *(u32x4*)((BW) + (lrow + 32) * 72 + lch * 8) = rb1; *(u32x4*)((BW) + (lrow + 64) * 72 + lch * 8) = rb2; *(u32x4*)((BW) + (lrow + 96) * 72 + lch * 8) = rb3;
#define LST1(AW, BW) \
  *(u32x4*)((AW) + (lrow) * 72 + lch * 8) = sa0; *(u32x4*)((AW) + (lrow + 32) * 72 + lch * 8) = sa1; *(u32x4*)((AW) + (lrow + 64) * 72 + lch * 8) = sa2; *(u32x4*)((AW) + (lrow + 96) * 72 + lch * 8) = sa3; \
  *(u32x4*)((BW) + (lrow) * 72 + lch * 8) = sb0; *(u32x4*)((BW) + (lrow + 32) * 72 + lch * 8) = sb1; *(u32x4*)((BW) + (lrow + 64) * 72 + lch * 8) = sb2; *(u32x4*)((BW) + (lrow + 96) * 72 + lch * 8) = sb3;
#define GCOMP(BUF)                                                                                   \
  {                                                                                                  \
    const h16* Ab = As + (BUF) * 128 * 72 + (wm * 64 + (lane & 31)) * 72 + (lane >> 5) * 8;          \
    const h16* Bb = Bs + (BUF) * 128 * 72 + (wn * 64 + (lane & 31)) * 72 + (lane >> 5) * 8;          \
    _Pragma("unroll") for (int s = 0; s < 4; ++s) {                                                  \
      half8 a0 = *(const half8*)(Ab + s * 16), a1 = *(const half8*)(Ab + 32 * 72 + s * 16);          \
      half8 b0 = *(const half8*)(Bb + s * 16), b1 = *(const half8*)(Bb + 32 * 72 + s * 16);          \
      acc00 = __builtin_amdgcn_mfma_f32_32x32x16_f16(a0, b0, acc00, 0, 0, 0);                        \
      acc01 = __builtin_amdgcn_mfma_f32_32x32x16_f16(a0, b1, acc01, 0, 0, 0);                        \
      acc10 = __builtin_amdgcn_mfma_f32_32x32x16_f16(a1, b0, acc10, 0, 0, 0);                        \
      acc11 = __builtin_amdgcn_mfma_f32_32x32x16_f16(a1, b1, acc11, 0, 0, 0);                        \
    }                                                                                                \
  }
  GLD0(0)
  GLD1(64)
  for (;;) {
  acc00 = zero16; acc01 = zero16; acc10 = zero16; acc11 = zero16;
  __builtin_amdgcn_sched_barrier(0);
  __syncthreads();
  LST0(As, Bs)
  GLD0(128)
  __builtin_amdgcn_sched_barrier(0);
  __syncthreads();
  for (int kt = 0; kt < kmax; kt += 2) {
    GCOMP(0)
    __builtin_amdgcn_sched_barrier(0);
    LST1(As + 128 * 72, Bs + 128 * 72)
    if (kt + 3 < 16) { GLD1((kt + 3) * 64) }
    __builtin_amdgcn_sched_barrier(0);
    __syncthreads();
    GCOMP(1)
    __builtin_amdgcn_sched_barrier(0);
    if (kt + 2 < 16) { LST0(As, Bs) }
    if (kt + 4 < 16) { GLD0((kt + 4) * 64) }
    __builtin_amdgcn_sched_barrier(0);
    __syncthreads();
  }
  const int cm0 = m0, cn0 = n0, cnt = nt;
  long w2 = w + gridDim.x; int mt2 = 0, nt2 = 0; bool has_next = false;
  for (;;) { if (w2 >= nw) break; TILE_OF(w2, mt2, nt2) if (nt2 < NTILES) { has_next = true; break; } w2 += gridDim.x; }
  if (has_next) {
    m0 = mt2 * 128; n0 = nt2 * 128; nt = nt2;
    Ag = A + (long)(m0 + lrow) * 1024 + lch * 8; Bg = Bt + (long)(n0 + lrow) * 1024 + lch * 8;
  }
  __builtin_amdgcn_sched_barrier(0);
#define GEMM_EPI(ACC, I, J)                                                                         \
  _Pragma("unroll") for (int r = 0; r < 16; ++r) {                                                   \
    const long row = cm0 + wm * 64 + (I) * 32 + (r & 3) + 8 * (r >> 2) + 4 * (lane >> 5);             \
    const int col = cn0 + wn * 64 + (J) * 32 + (lane & 31);                                            \
    const float v = ACC[r];                                                                          \
    if (EPI == 0) { if (col < INC) p.proj[row * INC + col] = (h16)v; }                                \
    else if (EPI == 1) { p.X[row * 1024 + col] += p.mod[((long)l * NCOND + condrow(row)) * 6144 + 2048 + col] * v; } \
    else { p.pq[row * 2048 + col] = (h16)v; }                                                         \
  }
  if (EPI == 0) {
    h16* Ct = (h16*)g_smem;
#define CST(ACC, I, J) _Pragma("unroll") for (int r = 0; r < 16; ++r) Ct[(wm * 64 + (I) * 32 + (r & 3) + 8 * (r >> 2) + 4 * (lane >> 5)) * 136 + wn * 64 + (J) * 32 + (lane & 31)] = (h16)ACC[r];
    CST(acc00, 0, 0) CST(acc01, 0, 1) CST(acc10, 1, 0) CST(acc11, 1, 1)
#undef CST
    __syncthreads();
#pragma unroll
    for (int j = 0; j < 8; ++j) {
      const int idx = tid + 256 * j; const int rr = idx >> 4, cc = idx & 15;
      if (cn0 + cc * 8 < INC) *(u32x4*)(p.proj + (long)(cm0 + rr) * INC + cn0 + cc * 8) = *(const u32x4*)(Ct + rr * 136 + cc * 8);
    }
  } else if (EPI == 1) {
#define EPI1(ACC, I, J)                                                                              \
    {                                                                                                \
      float xv_[16], mv_[16];                                                                        \
      const int col = cn0 + wn * 64 + (J) * 32 + (lane & 31);                                         \
      _Pragma("unroll") for (int r = 0; r < 16; ++r) {                                               \
        const long row = cm0 + wm * 64 + (I) * 32 + (r & 3) + 8 * (r >> 2) + 4 * (lane >> 5);         \
        xv_[r] = p.X[row * 1024 + col]; mv_[r] = p.mod[((long)l * NCOND + condrow(row)) * 6144 + 2048 + col]; \
      }                                                                                              \
      _Pragma("unroll") for (int r = 0; r < 16; ++r) {                                               \
        const long row = cm0 + wm * 64 + (I) * 32 + (r & 3) + 8 * (r >> 2) + 4 * (lane >> 5);         \
        p.X[row * 1024 + col] = xv_[r] + mv_[r] * ACC[r];                                            \
      }                                                                                              \
    }
    EPI1(acc00, 0, 0) EPI1(acc01, 0, 1) EPI1(acc10, 1, 0) EPI1(acc11, 1, 1)
#undef EPI1
  } else {
    h16* Q = (h16*)g_smem;
    h16* Kk = Q + 128 * 136;
    const h16* kg = p.keys16 + ((long)l * 16 + cnt) * CFG_NKEYS * 128;
#define QST(ACC, I, J) _Pragma("unroll") for (int r = 0; r < 16; ++r) Q[(wm * 64 + (I) * 32 + (r & 3) + 8 * (r >> 2) + 4 * (lane >> 5)) * 136 + wn * 64 + (J) * 32 + (lane & 31)] = (h16)ACC[r];
    QST(acc00, 0, 0) QST(acc01, 0, 1) QST(acc10, 1, 0) QST(acc11, 1, 1)
#undef QST
#pragma unroll
    for (int j = 0; j < 8; ++j) {
      const int idx = tid + 256 * j; const int kr = idx >> 4, kc = idx & 15;
      *(u32x4*)(Kk + kr * 136 + kc * 8) = *(const u32x4*)(kg + kr * 128 + kc * 8);
    }
    __syncthreads();
    f32x16 z = {0.f, 0.f, 0.f, 0.f, 0.f, 0.f, 0.f, 0.f, 0.f, 0.f, 0.f, 0.f, 0.f, 0.f, 0.f, 0.f};
    f32x16 s00 = z, s01 = z, s10 = z, s11 = z;
    const h16* Qb = Q + (wm * 64 + (lane & 31)) * 136 + (lane >> 5) * 8;
    const h16* Kb = Kk + (wn * 64 + (lane & 31)) * 136 + (lane >> 5) * 8;
#pragma unroll
    for (int sidx = 0; sidx < 8; ++sidx) {
      half8 a0 = *(const half8*)(Qb + sidx * 16), a1 = *(const half8*)(Qb + 32 * 136 + sidx * 16);
      half8 b0 = *(const half8*)(Kb + sidx * 16), b1 = *(const half8*)(Kb + 32 * 136 + sidx * 16);
      s00 = __builtin_amdgcn_mfma_f32_32x32x16_f16(a0, b0, s00, 0, 0, 0);
      s01 = __builtin_amdgcn_mfma_f32_32x32x16_f16(a0, b1, s01, 0, 0, 0);
      s10 = __builtin_amdgcn_mfma_f32_32x32x16_f16(a1, b0, s10, 0, 0, 0);
      s11 = __builtin_amdgcn_mfma_f32_32x32x16_f16(a1, b1, s11, 0, 0, 0);
    }
    __syncthreads();
    float* SC = (float*)g_smem;
#define SST(ACC, I, J) _Pragma("unroll") for (int r = 0; r < 16; ++r) SC[(wm * 64 + (I) * 32 + (r & 3) + 8 * (r >> 2) + 4 * (lane >> 5)) * 129 + wn * 64 + (J) * 32 + (lane & 31)] = ACC[r];
    SST(s00, 0, 0) SST(s01, 0, 1) SST(s10, 1, 0) SST(s11, 1, 1)
#undef SST
    __syncthreads();
    const int row = tid >> 1, half = tid & 1;
    float ts[16]; int ti[16];
#pragma unroll
    for (int j = 0; j < 16; ++j) { ts[j] = -3.0e38f; ti[j] = 0; }
#pragma unroll 1
    for (int g = 0; g < 4; ++g) {
      float gs[16]; int gi[16];
#pragma unroll
      for (int j = 0; j < 16; ++j) { gs[j] = SC[row * 129 + half * 64 + g * 16 + j]; gi[j] = half * 64 + g * 16 + j; }
      bitonic_sort16_desc(gs, gi);
      merge_top16(ts, ti, gs, gi);
    }
    {
      float ps[16]; int pi[16];
#pragma unroll
      for (int j = 0; j < 16; ++j) { ps[j] = dppf<0xB1>(ts[j]); pi[j] = __builtin_amdgcn_update_dpp(0, ti[j], 0xB1, 0xF, 0xF, true); }
      merge_top16(ts, ti, ps, pi);
    }
    if (half == 0) {
      const long token = cm0 + row;
#pragma unroll
      for (int j = 0; j < 16; ++j) { p.tks[token * 256 + cnt * 16 + j] = ts[j]; p.tki[token * 256 + cnt * 16 + j] = ti[j]; }
    }
  }
#undef GEMM_EPI
  if (!has_next) break;
  GLD0(0)
  GLD1(64)
  w = w2;
  }
#undef GLD0
#undef GLD1
#undef LST0
#undef LST1
#undef GCOMP
#undef TILE_OF
}

__device__ void blk_mod(long w, const P& p) {
  float* sl = (float*)g_smem;
  const int tid = otid();
  const int cb = (int)(w % 24); const int r = (int)((w / 24) % NCOND); const int l = (int)(w / (24 * NCOND));
  const float* cond = r == 0 ? p.cctx : p.c + (long)(r - 1) * 1024;
  __syncthreads();
#pragma unroll
  for (int j = 0; j < 4; ++j) sl[tid + 256 * j] = siluf_(cond[tid + 256 * j]);
  __syncthreads();
  const int col = cb * 256 + tid;
  const float* wp = p.wmod + (long)l * 1024 * 6144 + col;
  float acc = p.bmod[l * 6144 + col];
#pragma unroll 8
  for (int k = 0; k < 1024; ++k) acc += sl[k] * wp[(long)k * 6144];
  p.mod[((long)l * NCOND + r) * 6144 + col] = acc;
}
__device__ __forceinline__ float sum64u(float x);
template <int WHICH>
__device__ void blk_norm(long w, const P& p, int l) {
  const int tid_ = otid(); const int lane = tid_ & 63; const long token = w * 4 + (tid_ >> 6);
  const float* src = (WHICH == 0 && l == 0) ? (token < NTC ? p.xp + token * 1024 : p.xs + (token - NTC) * 1024) : p.X + token * 1024;
  float4 v[4]; float ss = 0.f;
#pragma unroll
  for (int j = 0; j < 4; ++j) { v[j] = ((const float4*)src)[lane + 64 * j]; ss += v[j].x * v[j].x + v[j].y * v[j].y + v[j].z * v[j].z + v[j].w * v[j].w; }
  ss = sum64u(ss);
  const float rstd = 1.0f / sqrtf(ss * (1.0f / 1024) + 1e-6f);
  if (WHICH == 2) {
#pragma unroll
    for (int j = 0; j < 4; ++j) {
      float4 g = ((const float4*)p.fng)[lane + 64 * j];
      float4 o; o.x = v[j].x * rstd * g.x; o.y = v[j].y * rstd * g.y; o.z = v[j].z * rstd * g.z; o.w = v[j].w * rstd * g.w;
      ((float4*)(p.X + token * 1024))[lane + 64 * j] = o;
    }
    return;
  }
  const float* m = p.mod + ((long)l * NCOND + condrow(token)) * 6144 + (WHICH ? 3072 : 0);
  const float* g = (WHICH ? p.n2g : p.n1g) + l * 1024;
  float4 gga[4], sha[4], sca[4];
#pragma unroll
  for (int j = 0; j < 4; ++j) { const int c4 = lane + 64 * j; gga[j] = ((const float4*)g)[c4]; sha[j] = ((const float4*)m)[c4]; sca[j] = ((const float4*)(m + 1024))[c4]; }
#pragma unroll
  for (int j = 0; j < 4; ++j) {
    const int c4 = lane + 64 * j;
    const float4 gg = gga[j], sh = sha[j], sc = sca[j];
    half4 o;
    o[0] = (h16)((v[j].x * rstd * gg.x) * (1.0f + sc.x) + sh.x);
    o[1] = (h16)((v[j].y * rstd * gg.y) * (1.0f + sc.y) + sh.y);
    o[2] = (h16)((v[j].z * rstd * gg.z) * (1.0f + sc.z) + sh.z);
    o[3] = (h16)((v[j].w * rstd * gg.w) * (1.0f + sc.w) + sh.w);
    *(half4*)(p.act + token * 1024 + c4 * 4) = o;
    if (WHICH == 0 && l == 0) ((float4*)(p.X + token * 1024))[c4] = v[j];
  }
}


#define SC_CT 32
__device__ __forceinline__ float fsigmoid(float x) { return __frcp_rn(1.0f + __expf(-x)); }
__device__ __forceinline__ float fsilu(float x) { return x * fsigmoid(x); }
__device__ __forceinline__ float fsoftplus(float x) { return fmaxf(x, 0.0f) + __logf(1.0f + __expf(-fabsf(x))); }
__device__ __forceinline__ float ftanh(float x) { const float e = __expf(-2.0f * fabsf(x)); const float t = (1.0f - e) * __frcp_rn(1.0f + e); return x < 0.f ? -t : t; }
#define N_PREP_RW ((NT / 32) * 8)
#define N_PREP_DN ((NT / 32) * 4)
__device__ void blk_scanprep(long w, const P& p, int l, half8& bf0, half8& bf1, int& bkey) {
  h16* tw16 = (h16*)g_smem;
  h16* al16 = tw16 + 32 * 40;
  float* cbuf = (float*)(al16 + 32 * 40);
  const int tid = otid();
  const int ls = tid >> 3, part = tid & 7;
  if (w < N_PREP_RW) {
    const int d = (int)(w & 1), h = (int)((w >> 1) & 3); const long token = (w >> 3) * 32 + ls;
    int t, T; long base; seqinfo(token, t, T, base);
    const bool sv = d == 0 ? (t > 0) : (t < T - 1);
    const h16* pb = p.proj + token * INC + RW_OFF;
    const h16* ps = p.proj + (token + (d == 0 ? -1 : 1)) * INC + RW_OFF;
    const float* mu = p.rwmu + ((long)l * 2 + d) * 832;
    const int lane = tid & 63, wv = tid >> 6;
    const int mat = wv >> 1, ntile = wv & 1;
    const int c0 = h * 64 + part * 8;
    half8 rb = *(const half8*)(pb + c0), kb = *(const half8*)(pb + 256 + c0);
    half8 rs_ = rb, ks_ = kb;
    if (sv) { rs_ = *(const half8*)(ps + c0); ks_ = *(const half8*)(ps + 256 + c0); }
    if (bkey != (int)((l << 3) | (w & 7))) {
      bkey = (int)((l << 3) | (w & 7));
      const float* wsrc = (mat ? p.rwa2 : p.rww2) + ((long)l * 2 + d) * 32 * 256 + h * 64 + ntile * 32 + (lane & 31);
#pragma unroll
      for (int j = 0; j < 8; ++j) { bf0[j] = (h16)wsrc[(8 * (lane >> 5) + j) * 256]; bf1[j] = (h16)wsrc[(16 + 8 * (lane >> 5) + j) * 256]; }
    }
    __syncthreads();
#pragma unroll
    for (int e = 0; e < 4; ++e) {
      const int jj = part * 4 + e;
      float bw = (float)pb[768 + d * 32 + jj], sw = sv ? (float)ps[768 + d * 32 + jj] : 0.f;
      tw16[ls * 40 + jj] = (h16)ftanh(bw + (sw - bw) * mu[768 + jj]);
      float ba = (float)pb[832 + d * 32 + jj], sa_ = sv ? (float)ps[832 + d * 32 + jj] : 0.f;
      al16[ls * 40 + jj] = (h16)(ba + (sa_ - ba) * mu[800 + jj]);
    }
    __syncthreads();
    {
      const h16* X16 = (mat ? al16 : tw16) + (lane & 31) * 40 + 8 * (lane >> 5);
      const half8 a0 = *(const half8*)X16, a1 = *(const half8*)(X16 + 16);
      f32x16 acc = {0.f, 0.f, 0.f, 0.f, 0.f, 0.f, 0.f, 0.f, 0.f, 0.f, 0.f, 0.f, 0.f, 0.f, 0.f, 0.f};
      acc = __builtin_amdgcn_mfma_f32_32x32x16_f16(a0, bf0, acc, 0, 0, 0);
      acc = __builtin_amdgcn_mfma_f32_32x32x16_f16(a1, bf1, acc, 0, 0, 0);
      float* cb = cbuf + mat * (32 * 65) + ntile * 32 + (lane & 31);
#pragma unroll
      for (int r = 0; r < 16; ++r) cb[((r & 3) + 8 * (r >> 2) + 4 * (lane >> 5)) * 65] = acc[r];
    }
    __syncthreads();
    float accw[8], acca[8];
#pragma unroll
    for (int e = 0; e < 8; ++e) {
      accw[e] = p.rww0[(l * 2 + d) * 256 + c0 + e] + cbuf[ls * 65 + part * 8 + e];
      acca[e] = p.rwa0[(l * 2 + d) * 256 + c0 + e] + cbuf[32 * 65 + ls * 65 + part * 8 + e];
    }
    float ss = 0.f, bon = 0.f;
    half8 ewo, ago;
#pragma unroll
    for (int e = 0; e < 8; ++e) {
      const int c = c0 + e;
      float b_ = (float)rb[e], s_ = sv ? (float)rs_[e] : 0.f; const float rr = b_ + (s_ - b_) * mu[c];
      b_ = (float)kb[e]; s_ = sv ? (float)ks_[e] : 0.f; const float kr = b_ + (s_ - b_) * mu[256 + c];
      const float asg = fsigmoid(acca[e]);
      const float kkr = kr * p.rwkk[l * 256 + c];
      ss += kkr * kkr;
      const float keff = kr * (1.0f + (asg - 1.0f) * p.rwka[l * 256 + c]);
      bon += rr * keff * p.rwrk[l * 256 + c];
      ewo[e] = (h16)__expf(-fsoftplus(-accw[e]) - 0.5f);
      ago[e] = (h16)asg;
    }
    ss = sum8(ss); bon = sum8(bon);
    *(half8*)(p.rwaux + ((token * 2 + d) * 2 + 0) * 256 + c0) = ewo;
    *(half8*)(p.rwaux + ((token * 2 + d) * 2 + 1) * 256 + c0) = ago;
    if (part == 0) { float* sc = p.rwsc + ((token * 2 + d) * 4 + h) * 2; sc[0] = 1.0f / sqrtf(ss + 1e-6f); sc[1] = bon; }
  } else {
    const long w2 = w - N_PREP_RW;
    const int h = (int)(w2 & 3); const long token = (w2 >> 2) * 32 + ls;
    int t, T; long base; seqinfo(token, t, T, base);
    const int c0 = h * 64 + part * 8;
    float aq[8], ak[8], av[8];
#pragma unroll
    for (int e = 0; e < 8; ++e) { aq[e] = 0.f; ak[e] = 0.f; av[e] = 0.f; }
    half8 xq[5], xk[5], xv[5]; float tv[5];
#pragma unroll
    for (int tap = 0; tap < 5; ++tap) {
      const int tt = t + tap - 2;
      const bool ok = tt >= 0 && tt < T;
      const h16* pr = p.proj + (base + (ok ? tt : t)) * INC + DN_OFF + c0;
      xq[tap] = *(const half8*)pr; xk[tap] = *(const half8*)(pr + 256); xv[tap] = *(const half8*)(pr + 512);
      tv[tap] = ok ? 1.0f : 0.0f;
    }
    __builtin_amdgcn_sched_barrier(0);
#pragma unroll
    for (int tap = 0; tap < 5; ++tap) {
      const float* cw = p.dnconv + ((long)l * 5 + tap) * 768 + c0;
#pragma unroll
      for (int e = 0; e < 8; ++e) {
        aq[e] += (float)xq[tap][e] * (cw[e] * tv[tap]); ak[e] += (float)xk[tap][e] * (cw[256 + e] * tv[tap]); av[e] += (float)xv[tap][e] * (cw[512 + e] * tv[tap]);
      }
    }
    float ssq = 0.f, ssk = 0.f;
#pragma unroll
    for (int e = 0; e < 8; ++e) { aq[e] = fsilu(aq[e]); ak[e] = fsilu(ak[e]); av[e] = fsilu(av[e]); ssq += aq[e] * aq[e]; ssk += ak[e] * ak[e]; }
    ssq = sum8(ssq); ssk = sum8(ssk);
    const float rq = 0.125f / sqrtf(ssq + 1e-6f), rk = 1.0f / sqrtf(ssk + 1e-6f);
    half8 qo, ko, vo;
#pragma unroll
    for (int e = 0; e < 8; ++e) { qo[e] = (h16)(aq[e] * rq); ko[e] = (h16)(ak[e] * rk); vo[e] = (h16)av[e]; }
    h16* dp = p.dnp + token * 768 + c0;
    *(half8*)dp = qo; *(half8*)(dp + 256) = ko; *(half8*)(dp + 512) = vo;
    if (part < 2) {
      const int d = part;
      const h16* pr = p.proj + token * INC + DN_OFF;
      float* sc = p.dnsc + ((token * 2 + d) * 4 + h) * 2;
      sc[0] = sigmoidf_((float)pr[768 + d * 4 + h]);
      sc[1] = expf(-expf(p.dnalog[(l * 2 + d) * 4 + h]) * softplusf_((float)pr[776 + d * 4 + h] + p.dndt[(l * 2 + d) * 4 + h]));
    }
  }
}
__device__ void blk_scan2(int kind, int bi, int h, int d, int rq, const P& p, int l) {
  float* L = (float*)g_smem;
  float* LA = L; float* LW = L + 2048; float* LB = L + 4096; float* LK = L + 6144; float* LR = L + 8192; float* LV = L + 10240;
  const int tid = otid(), lane = tid & 63, wv = tid >> 6, g = lane >> 4, cl = lane & 15;
  const int i = rq * 32 + wv * 8 + g * 2, j0 = cl * 4;
  const bool ctx = bi < CFG_BATCH;
  const int T = ctx ? CFG_SEQ : CFG_DS;
  const long base = ctx ? (long)bi * CFG_SEQ : (long)NTC + (long)(bi - CFG_BATCH) * CFG_DS;
  const int ls = tid >> 3, part = tid & 7;
  f32x4 S = {0.f, 0.f, 0.f, 0.f}, S1 = {0.f, 0.f, 0.f, 0.f};
  if (!ctx) {
    const int b = bi - CFG_BATCH;
    if (kind == 0) {
      const float* s0 = p.srw + (((((long)b) * 2 + l) * 2 + d) * 4 + h) * 4096;
      S = *(const f32x4*)(s0 + i * 64 + j0); S1 = *(const f32x4*)(s0 + (i + 1) * 64 + j0);
    } else {
      const float* s0 = p.sdn + (((((long)b) * 2 + l) * 2 + d) * 4 + h) * 4096;
#pragma unroll
      for (int c = 0; c < 4; ++c) { S[c] = s0[(j0 + c) * 64 + i]; S1[c] = s0[(j0 + c) * 64 + i + 1]; }
    }
  }
  h16* obuf = (h16*)(L + 12288);
  h16* obase = (kind == 0 ? p.act + 256 + d * 512 + h * 64 : p.proj + DN_OFF + d * 256 + h * 64) + rq * 32 + (tid & 7) * 4;
  const long ostride = kind == 0 ? 1024 : INC;
#define SC_FLUSH(S0I)                                                                              \
  { const int sidx_ = (S0I) + (tid >> 3); const int t_ = d == 0 ? sidx_ : T - 1 - sidx_;             \
    *(half4*)(obase + (base + t_) * ostride) = *(const half4*)(obuf + (tid >> 3) * 32 + (tid & 7) * 4); }
  const int c0 = h * 64 + part * 8, jb = part * 8;
  float cmr[8], cmk[8], cmv[8], ckk[8], cka[8];
#pragma unroll
  for (int e = 0; e < 8; ++e) { cmr[e] = 0.f; cmk[e] = 0.f; cmv[e] = 0.f; ckk[e] = 0.f; cka[e] = 0.f; }
  if (kind == 0) {
    const float* mu = p.rwmu + ((long)l * 2 + d) * 832;
#pragma unroll
    for (int e = 0; e < 8; ++e) { cmr[e] = mu[c0 + e]; cmk[e] = mu[256 + c0 + e]; cmv[e] = mu[512 + c0 + e]; ckk[e] = p.rwkk[l * 256 + c0 + e]; cka[e] = p.rwka[l * 256 + c0 + e]; }
  }
  half8 g0, g1, g2, g3, g4, g5, g6, g7; float gf0 = 0.f, gf1 = 0.f; bool gsv = false;
  g0 = g1 = g2 = g3 = g4 = g5 = g6 = g7 = (half8){0, 0, 0, 0, 0, 0, 0, 0};
#define SC_LOADG(S0I)                                                                              \
  {                                                                                                \
    const int sidx_ = (S0I) + ls;                                                                  \
    const int t_ = d == 0 ? sidx_ : T - 1 - sidx_;                                                 \
    const long token_ = base + t_;                                                                 \
    if (kind == 0) {                                                                               \
      gsv = d == 0 ? (t_ > 0) : (t_ < T - 1);                                                      \
      const h16* pb_ = p.proj + token_ * INC + RW_OFF + c0;                                        \
      const h16* ps_ = gsv ? p.proj + (token_ + (d == 0 ? -1 : 1)) * INC + RW_OFF + c0 : pb_;      \
      g0 = *(const half8*)pb_; g1 = *(const half8*)(pb_ + 256); g2 = *(const half8*)(pb_ + 512);   \
      g3 = *(const half8*)ps_; g4 = *(const half8*)(ps_ + 256); g5 = *(const half8*)(ps_ + 512);   \
      g6 = *(const half8*)(p.rwaux + ((token_ * 2 + d) * 2 + 0) * 256 + c0);                       \
      g7 = *(const half8*)(p.rwaux + ((token_ * 2 + d) * 2 + 1) * 256 + c0);                       \
      gf0 = p.rwsc[((token_ * 2 + d) * 4 + h) * 2];                                                \
    } else {                                                                                       \
      const h16* dp_ = p.dnp + token_ * 768 + c0;                                                  \
      g0 = *(const half8*)dp_; g1 = *(const half8*)(dp_ + 256); g2 = *(const half8*)(dp_ + 512);   \
      const float* sc_ = p.dnsc + ((token_ * 2 + d) * 4 + h) * 2;                                  \
      gf0 = sc_[0]; gf1 = sc_[1];                                                                  \
    }                                                                                              \
  }
  SC_LOADG(0)
  for (int s0i = 0; s0i < T; s0i += SC_CT) {
    __syncthreads();
    if (s0i > 0) SC_FLUSH(s0i - SC_CT)
    {
      f32x4 va[2], vw[2], vb[2], vk[2], vr[2], vv_[2];
      if (kind == 0) {
#pragma unroll
        for (int e = 0; e < 8; ++e) {
          float b_ = (float)g0[e], s_ = gsv ? (float)g3[e] : 0.f; const float rr = b_ + (s_ - b_) * cmr[e];
          b_ = (float)g1[e]; s_ = gsv ? (float)g4[e] : 0.f; const float kr = b_ + (s_ - b_) * cmk[e];
          b_ = (float)g2[e]; s_ = gsv ? (float)g5[e] : 0.f; const float vl = b_ + (s_ - b_) * cmv[e];
          const float asg = (float)g7[e];
          const float kk = kr * ckk[e] * gf0;
          va[e >> 2][e & 3] = -kk; vw[e >> 2][e & 3] = __expf(-(float)g6[e]); vb[e >> 2][e & 3] = kk * asg;
          vk[e >> 2][e & 3] = kr * (1.0f + (asg - 1.0f) * cka[e]); vr[e >> 2][e & 3] = rr; vv_[e >> 2][e & 3] = vl;
        }
      } else {
        const float beta = gf0, alpha = gf1;
#pragma unroll
        for (int e = 0; e < 8; ++e) {
          const float k = (float)g1[e];
          va[e >> 2][e & 3] = k; vw[e >> 2][e & 3] = alpha; vb[e >> 2][e & 3] = -alpha * beta * k;
          vk[e >> 2][e & 3] = beta * k; vr[e >> 2][e & 3] = (float)g0[e]; vv_[e >> 2][e & 3] = (float)g2[e];
        }
      }
      const int lo_ = ls * 64 + jb;
      *(f32x4*)(LA + lo_) = va[0]; *(f32x4*)(LA + lo_ + 4) = va[1]; *(f32x4*)(LW + lo_) = vw[0]; *(f32x4*)(LW + lo_ + 4) = vw[1];
      *(f32x4*)(LB + lo_) = vb[0]; *(f32x4*)(LB + lo_ + 4) = vb[1]; *(f32x4*)(LK + lo_) = vk[0]; *(f32x4*)(LK + lo_ + 4) = vk[1];
      *(f32x4*)(LR + lo_) = vr[0]; *(f32x4*)(LR + lo_ + 4) = vr[1]; *(f32x4*)(LV + lo_) = vv_[0]; *(f32x4*)(LV + lo_ + 4) = vv_[1];
    }
    __syncthreads();
    if (s0i + SC_CT < T) SC_LOADG(s0i + SC_CT)
    __builtin_amdgcn_sched_barrier(0);
#define SC_LD(A4, W4, B4, K4, R4, VV, Q)                                                                    \
    { const int o_ = (Q) * 64; A4 = *(const f32x4*)(LA + o_ + j0); W4 = *(const f32x4*)(LW + o_ + j0); B4 = *(const f32x4*)(LB + o_ + j0); \
      K4 = *(const f32x4*)(LK + o_ + j0); R4 = *(const f32x4*)(LR + o_ + j0); VV = *(const f32x2*)(LV + o_ + i); }
#define SC_STEP(ca, cw, cb, ck, cr, cv, Q)                                                                  \
    {                                                                                                       \
      float sa = S[0] * ca[0] + S[1] * ca[1] + S[2] * ca[2] + S[3] * ca[3];                                 \
      float sb = S1[0] * ca[0] + S1[1] * ca[1] + S1[2] * ca[2] + S1[3] * ca[3];                             \
      sa = sum16(sa); sb = sum16(sb);                                                                       \
      _Pragma("unroll") for (int c = 0; c < 4; ++c) { S[c] = S[c] * cw[c] + sa * cb[c] + cv[0] * ck[c]; S1[c] = S1[c] * cw[c] + sb * cb[c] + cv[1] * ck[c]; } \
      float o = S[0] * cr[0] + S[1] * cr[1] + S[2] * cr[2] + S[3] * cr[3];                                  \
      float o1 = S1[0] * cr[0] + S1[1] * cr[1] + S1[2] * cr[2] + S1[3] * cr[3];                             \
      o = sum16(o); o1 = sum16(o1);                                                                         \
      if (cl == 0) { half2v ov; ov[0] = (h16)o; ov[1] = (h16)o1; *(half2v*)(obuf + (Q) * 32 + wv * 8 + g * 2) = ov; } \
    }
    f32x4 a4, w4, b4, k4, r4, a5, w5, b5, k5, r5; f32x2 vv, vv5;
    SC_LD(a4, w4, b4, k4, r4, vv, 0)
    for (int q = 0; q < SC_CT; q += 2) {
      SC_LD(a5, w5, b5, k5, r5, vv5, q + 1)
      SC_STEP(a4, w4, b4, k4, r4, vv, q)
      if (q + 2 < SC_CT) SC_LD(a4, w4, b4, k4, r4, vv, q + 2)
      SC_STEP(a5, w5, b5, k5, r5, vv5, q + 1)
    }
#undef SC_LD
#undef SC_STEP
  }
  __syncthreads();
  SC_FLUSH(T - SC_CT)
#undef SC_FLUSH
  if (ctx) {
    if (kind == 0) {
      float* so = p.orw + (((((long)bi) * 2 + l) * 2 + d) * 4 + h) * 4096;
      *(f32x4*)(so + i * 64 + j0) = S; *(f32x4*)(so + (i + 1) * 64 + j0) = S1;
    } else {
      float* so = p.odn + (((((long)bi) * 2 + l) * 2 + d) * 4 + h) * 4096;
#pragma unroll
      for (int c = 0; c < 4; ++c) { so[(j0 + c) * 64 + i] = S[c]; so[(j0 + c) * 64 + i + 1] = S1[c]; }
    }
  }
}
#undef SC_LOADG
__device__ void blk_fin(long w, const P& p, int l, const float* g2s, float* sgs) {
  const int tid_ = otid(); const int lane = tid_ & 63; const long token = w * 4 + (tid_ >> 6);
  float* sgw = sgs + (tid_ >> 6) * 64;
  const int c4 = lane * 4;
  const int hd = lane >> 4;
  const h16* pr = p.proj + token * INC;
  h16* ao = p.act + token * 1024;
  int t, T; long base; seqinfo(token, t, T, base);
  const bool sv0 = t > 0, sv1 = t < T - 1;
  const float bon0 = p.rwsc[((token * 2 + 0) * 4 + hd) * 2 + 1], bon1 = p.rwsc[((token * 2 + 1) * 4 + hd) * 2 + 1];
  const half4 vb = *(const half4*)(pr + RW_OFF + 512 + c4);
  half4 vm = vb, vp = vb;
  if (sv0) vm = *(const half4*)(pr - INC + RW_OFF + 512 + c4);
  if (sv1) vp = *(const half4*)(pr + INC + RW_OFF + 512 + c4);
  const half4 d_o0 = *(const half4*)(pr + DN_OFF + c4), d_o1 = *(const half4*)(pr + DN_OFF + 256 + c4);
  const half4 d_z = *(const half4*)(pr + DN_OFF + 784 + c4);
  const f32x4 mu0 = *(const f32x4*)(p.rwmu + ((long)l * 2 + 0) * 832 + 512 + c4), mu1 = *(const f32x4*)(p.rwmu + ((long)l * 2 + 1) * 832 + 512 + c4);
  const f32x4 lng = *(const f32x4*)(p.rwlng + l * 256 + c4), lnb = *(const f32x4*)(p.rwlnb + l * 256 + c4);
  const f32x4 dng = *(const f32x4*)(p.dnng + l * 64 + (c4 & 63));
  {
    half4 o0 = *(const half4*)(ao + 256 + c4), o1 = *(const half4*)(ao + 768 + c4);
    float o[4]; float mu = 0.f;
#pragma unroll
    for (int e = 0; e < 4; ++e) { o[e] = (float)o0[e] + (float)o1[e]; mu += o[e]; }
    mu = sum16(mu) * (1.0f / 64);
    float var = 0.f;
#pragma unroll
    for (int e = 0; e < 4; ++e) { float dl = o[e] - mu; var += dl * dl; }
    var = sum16(var) * (1.0f / 64);
    const float rs = 1.0f / sqrtf(var + 64e-5f);
    const float sg = sigmoidf_((float)pr[RW_OFF + 896 + lane]);
    float gate[4] = {0.f, 0.f, 0.f, 0.f};
    sgw[lane] = sg;
    __syncthreads();
#pragma unroll 8
    for (int j = 0; j < 64; ++j) {
      const float sj = sgw[j];
      const f32x4 g2 = *(const f32x4*)(g2s + j * 256 + c4);
#pragma unroll
      for (int e = 0; e < 4; ++e) gate[e] += sj * g2[e];
    }
    half4 out;
#pragma unroll
    for (int e = 0; e < 4; ++e) {
      const float b_ = (float)vb[e];
      const float v0 = b_ + ((sv0 ? (float)vm[e] : 0.f) - b_) * mu0[e];
      const float v1 = b_ + ((sv1 ? (float)vp[e] : 0.f) - b_) * mu1[e];
      float y = (o[e] - mu) * rs * lng[e] + lnb[e] + bon0 * v0 + bon1 * v1;
      out[e] = (h16)(y * gate[e]);
    }
    *(half4*)(ao + 256 + c4) = out;
  }
  {
    const half4 o0 = d_o0, o1 = d_o1, z = d_z;
    float o[4]; float ss = 0.f;
#pragma unroll
    for (int e = 0; e < 4; ++e) { o[e] = (float)o0[e] + (float)o1[e]; ss += o[e] * o[e]; }
    ss = sum16(ss);
    const float rs = 1.0f / sqrtf(ss * (1.0f / 64) + 1e-6f);
    half4 out;
#pragma unroll
    for (int e = 0; e < 4; ++e) out[e] = (h16)(o[e] * rs * dng[e] * siluf_((float)z[e]));
    *(half4*)(ao + 768 + c4) = out;
  }
}

__device__ __forceinline__ float dot8h(half8 u, half8 x, float d) {
#pragma unroll
  for (int e = 0; e < 8; ++e) d += (float)u[e] * (float)x[e];
  return d;
}
__device__ __forceinline__ void cvt8(const float* src, h16* dst, long i) {
  const f32x4 a = *(const f32x4*)(src + i * 8), b = *(const f32x4*)(src + i * 8 + 4);
  half8 o; o[0] = (h16)a[0]; o[1] = (h16)a[1]; o[2] = (h16)a[2]; o[3] = (h16)a[3]; o[4] = (h16)b[0]; o[5] = (h16)b[1]; o[6] = (h16)b[2]; o[7] = (h16)b[3];
  *(half8*)(dst + i * 8) = o;
}
__device__ __forceinline__ float sum64u(float x) {
  x = sum16(x);
  x += __builtin_bit_cast(float, __builtin_amdgcn_update_dpp(0, __builtin_bit_cast(int, x), 0x142, 0xA, 0xF, false));
  x += __builtin_bit_cast(float, __builtin_amdgcn_update_dpp(0, __builtin_bit_cast(int, x), 0x143, 0xC, 0xF, false));
  return __builtin_bit_cast(float, __builtin_amdgcn_readlane(__builtin_bit_cast(int, x), 63));
}
__device__ __forceinline__ float ferf(float x) {
  const float ax = fabsf(x);
  const float t = __frcp_rn(1.0f + 0.3275911f * ax);
  const float y = 1.0f - (((((1.061405429f * t - 1.453152027f) * t) + 1.421413741f) * t - 0.284496736f) * t + 0.254829592f) * t * __expf(-ax * ax);
  return x < 0.f ? -y : y;
}
__device__ __forceinline__ void cvt16_fp8(const float* src, unsigned char* dst, long i, float scale) {
  u32x4 o;
#pragma unroll
  for (int k = 0; k < 4; ++k) {
    const f32x4 a = *(const f32x4*)(src + i * 16 + k * 4);
    int w = __builtin_amdgcn_cvt_pk_fp8_f32(a[0] * scale, a[1] * scale, 0, false);
    w = __builtin_amdgcn_cvt_pk_fp8_f32(a[2] * scale, a[3] * scale, w, true);
    o[k] = (unsigned)w;
  }
  *(u32x4*)(dst + i * 16) = o;
}
__device__ void fin_phase(const P& p, int l) {
  float* g2s = (float*)g_smem;
  float* sgs = g2s + 64 * 256;
  const int tid = otid();
  __syncthreads();
  const f32x4* src = (const f32x4*)(p.rwg2 + (long)l * 64 * 256);
#pragma unroll
  for (int j = 0; j < 16; ++j) ((f32x4*)g2s)[tid + 256 * j] = src[tid + 256 * j];
  __syncthreads();
  for (long w = blockIdx.x; w < NT / 4; w += gridDim.x) blk_fin(w, p, l, g2s, sgs);
}
typedef unsigned u32x2 __attribute__((ext_vector_type(2)));
__device__ __forceinline__ void cvt16_fp4(const float* src, unsigned char* dst, long i, float scale) {
  u32x2 o;
#pragma unroll
  for (int k = 0; k < 2; ++k) {
    const f32x4 a = *(const f32x4*)(src + i * 16 + k * 8), b = *(const f32x4*)(src + i * 16 + k * 8 + 4);
    unsigned w = 0u;
    w = __builtin_amdgcn_cvt_scalef32_pk_fp4_f32(w, a[0] * scale, a[1] * scale, 1.0f, 0);
    w = __builtin_amdgcn_cvt_scalef32_pk_fp4_f32(w, a[2] * scale, a[3] * scale, 1.0f, 1);
    w = __builtin_amdgcn_cvt_scalef32_pk_fp4_f32(w, b[0] * scale, b[1] * scale, 1.0f, 2);
    w = __builtin_amdgcn_cvt_scalef32_pk_fp4_f32(w, b[2] * scale, b[3] * scale, 1.0f, 3);
    o[k] = w;
  }
  *(u32x2*)(dst + i * 8) = o;
}
#define PEER_USCALE 48.0f
#define PEER_VSCALE 16.0f
struct PairTab { int a[50]; int b[50]; };
__host__ __device__ constexpr PairTab make_pairs() {
  PairTab t{}; int n = 0;
  for (int a = 0; a < 16; ++a) for (int b = 0; b < 16; ++b) if ((a + 1) * (b + 1) <= 16) { t.a[n] = a; t.b[n] = b; ++n; }
  return t;
}
template <bool DRY>
__device__ void blk_peer(long w, const P& p, int l) {
  constexpr PairTab PT = make_pairs();
  const int tid_ = otid(); const int lane = tid_ & 63, wv = tid_ >> 6; const long token = w * 4 + wv;
  int* eidx = (int*)g_smem + wv * 256; float* egate = (float*)g_smem + wv * 256 + 128;
  const h16* xr = p.act + token * 1024 + lane * 16;
  const half8 x0 = *(const half8*)xr, x1 = *(const half8*)(xr + 8);
  int la = 0, lb = 0;
#pragma unroll
  for (int j = 0; j < 50; ++j) if (lane == j) { la = PT.a[j]; lb = PT.b[j]; }
  const int lc = la * 16 + lb;
  __syncthreads();
  float cs_[8]; int ce_[8];
#pragma unroll
  for (int hd = 0; hd < 8; ++hd) {
    const float* s1 = p.tks + token * 256 + hd * 32; const int* i1 = p.tki + token * 256 + hd * 32;
    const int la_ = lane < 50 ? la : 0, lb_ = lane < 50 ? lb : 0;
    cs_[hd] = s1[la_] + s1[16 + lb_]; ce_[hd] = i1[la_] * CFG_NKEYS + i1[16 + lb_];
  }
#pragma unroll
  for (int hd = 0; hd < 8; ++hd) {
    const float s = lane < 50 ? cs_[hd] : -3.0e38f;
    int rank = 0;
#pragma unroll
    for (int j = 0; j < 50; ++j) {
      const float sj = __builtin_bit_cast(float, __builtin_amdgcn_readlane(__builtin_bit_cast(int, s), j));
      const int cj = PT.a[j] * 16 + PT.b[j];
      rank += (sj > s || (sj == s && cj < lc)) ? 1 : 0;
    }
    const bool sel = lane < 50 && rank < 16;
    const float m = __builtin_bit_cast(float, __builtin_amdgcn_readlane(__builtin_bit_cast(int, s), 0));
    const float e = sel ? expf(s - m) : 0.f;
    const float sum = sum64(e);
    if (sel) { eidx[hd * 16 + rank] = ce_[hd]; egate[hd * 16 + rank] = e / sum; }
  }
  __syncthreads();
  f32x2 x2[8];
#pragma unroll
  for (int e = 0; e < 4; ++e) { x2[e][0] = (float)x0[2 * e]; x2[e][1] = (float)x0[2 * e + 1]; x2[4 + e][0] = (float)x1[2 * e]; x2[4 + e][1] = (float)x1[2 * e + 1]; }
  f32x2 acc2[8];
#pragma unroll
  for (int e = 0; e < 8; ++e) { acc2[e][0] = 0.f; acc2[e][1] = 0.f; }
  const unsigned char* u8 = (const unsigned char*)p.u16; const unsigned char* v8 = (const unsigned char*)p.v16;
#define PEER_LOAD(U, V, GT, EB)                                                                   \
  _Pragma("unroll") for (int q = 0; q < 8; ++q) {                                                 \
    const unsigned ro_ = (unsigned)eidx[(EB) + q] * 512u + (unsigned)lane * 8u; GT[q] = egate[(EB) + q];   \
    U[q] = *(const u32x2*)(u8 + ro_); V[q] = *(const u32x2*)(v8 + ro_);                           \
  }
#define PEER_COMP(U, V, GT)                                                                       \
  {                                                                                               \
    float dd_[8];                                                                                 \
    _Pragma("unroll") for (int q = 0; q < 8; ++q) {                                               \
      f32x2 d2 = {0.f, 0.f};                                                                      \
      _Pragma("unroll") for (int k = 0; k < 2; ++k) {                                             \
        d2 += __builtin_amdgcn_cvt_scalef32_pk_f32_fp4(U[q][k], 1.0f, 0) * x2[4 * k];             \
        d2 += __builtin_amdgcn_cvt_scalef32_pk_f32_fp4(U[q][k], 1.0f, 1) * x2[4 * k + 1];         \
        d2 += __builtin_amdgcn_cvt_scalef32_pk_f32_fp4(U[q][k], 1.0f, 2) * x2[4 * k + 2];         \
        d2 += __builtin_amdgcn_cvt_scalef32_pk_f32_fp4(U[q][k], 1.0f, 3) * x2[4 * k + 3];         \
      }                                                                                           \
      dd_[q] = sum64u(d2[0] + d2[1]) * (1.0f / PEER_USCALE);                                      \
    }                                                                                             \
      \
    float dv_ = dd_[7];                                                                           \
    _Pragma("unroll") for (int q = 6; q >= 0; --q) dv_ = lane == q ? dd_[q] : dv_;                \
    const float gv_ = 0.5f * dv_ * (1.0f + erff(dv_ * 0.70710678118654752f));                     \
    _Pragma("unroll") for (int q = 0; q < 8; ++q) {                                               \
      const float wgt = GT[q] * __builtin_bit_cast(float, __builtin_amdgcn_readlane(__builtin_bit_cast(int, gv_), q)) * (1.0f / PEER_VSCALE); \
      const f32x2 w2 = {wgt, wgt};                                                                \
      _Pragma("unroll") for (int k = 0; k < 2; ++k) {                                             \
        acc2[4 * k] += w2 * __builtin_amdgcn_cvt_scalef32_pk_f32_fp4(V[q][k], 1.0f, 0);           \
        acc2[4 * k + 1] += w2 * __builtin_amdgcn_cvt_scalef32_pk_f32_fp4(V[q][k], 1.0f, 1);       \
        acc2[4 * k + 2] += w2 * __builtin_amdgcn_cvt_scalef32_pk_f32_fp4(V[q][k], 1.0f, 2);       \
        acc2[4 * k + 3] += w2 * __builtin_amdgcn_cvt_scalef32_pk_f32_fp4(V[q][k], 1.0f, 3);       \
      }                                                                                           \
    }                                                                                             \
  }
  u32x2 au[8], av[8], bu[8], bv[8];
  float ag[8], bg[8];
  PEER_LOAD(au, av, ag, 0)
  for (int eb = 0; eb < 128; eb += 16) {
    PEER_LOAD(bu, bv, bg, eb + 8)
    __builtin_amdgcn_sched_barrier(0);
    PEER_COMP(au, av, ag)
    if (eb + 16 < 128) { PEER_LOAD(au, av, ag, eb + 16) }
    __builtin_amdgcn_sched_barrier(0);
    PEER_COMP(bu, bv, bg)
  }
#undef PEER_LOAD
#undef PEER_COMP
  const float* g2 = p.mod + ((long)l * NCOND + condrow(token)) * 6144 + 5120 + lane * 16;
  float* xo = p.X + token * 1024 + lane * 16;
  f32x4 xn[4]; float ssq = 0.f;
#pragma unroll
  for (int k = 0; k < 4; ++k) {
    xn[k] = *(f32x4*)(xo + 4 * k);
    const f32x4 ga = *(const f32x4*)(g2 + 4 * k);
#pragma unroll
    for (int e = 0; e < 4; ++e) { xn[k][e] += ga[e] * acc2[2 * k + (e >> 1)][e & 1]; ssq += xn[k][e] * xn[k][e]; }
  }
  if (DRY) { if (acc2[0][0] == 123456.789f) *(f32x4*)xo = xn[0]; return; }
  const float rstd = 1.0f / sqrtf(sum64u(ssq) * (1.0f / 1024) + 1e-6f);
  if (l == 0) {
    const float* m = p.mod + ((long)1 * NCOND + condrow(token)) * 6144 + lane * 16;
    const float* g = p.n1g + 1024 + lane * 16;
    half8 h0, h1;
    f32x4 gga[4], sha[4], sca[4];
#pragma unroll
    for (int k = 0; k < 4; ++k) { gga[k] = *(const f32x4*)(g + 4 * k); sha[k] = *(const f32x4*)(m + 4 * k); sca[k] = *(const f32x4*)(m + 1024 + 4 * k); }
#pragma unroll
    for (int k = 0; k < 4; ++k) {
      *(f32x4*)(xo + 4 * k) = xn[k];
      const f32x4 gg = gga[k], sh = sha[k], sc = sca[k];
#pragma unroll
      for (int e = 0; e < 4; ++e) {
        const h16 hv = (h16)((xn[k][e] * rstd * gg[e]) * (1.0f + sc[e]) + sh[e]);
        if (k < 2) h0[4 * k + e] = hv; else h1[4 * (k - 2) + e] = hv;
      }
    }
    h16* ho = p.act + token * 1024 + lane * 16;
    *(half8*)ho = h0; *(half8*)(ho + 8) = h1;
  } else {
    f32x4 fga[4];
#pragma unroll
    for (int k = 0; k < 4; ++k) fga[k] = *(const f32x4*)(p.fng + lane * 16 + 4 * k);
#pragma unroll
    for (int k = 0; k < 4; ++k) {
      const f32x4 gg = fga[k];
      f32x4 y;
#pragma unroll
      for (int e = 0; e < 4; ++e) y[e] = xn[k][e] * rstd * gg[e];
      *(f32x4*)(xo + 4 * k) = y;
    }
  }
}

__device__ void blk_attn(int type, int idx, const P& p, int l) {
  h16* Ks = (h16*)g_smem;
  h16* Vt = Ks + 64 * 72;
  float* Bt = (float*)(Vt + 64 * 72);
  const int tid = otid(), lane = tid & 63, wv = tid >> 6, ql = lane & 31, hh = lane >> 5;
  int b, hk, tb; long qtok; int qcol_off, kcol_off, vcol_off, outcol; float qscale; int ntl, ntc; long kbase_tok;
  const float *ck = nullptr, *cv = nullptr;
  int grow = 0, r0w = 0, krmin = 0;
  if (type == 0) {
    tb = idx & 3; hk = (idx >> 2) & 1; b = idx >> 3;
    const int head = hk * 2 + (wv & 1);
    kbase_tok = (long)b * CFG_SEQ; qtok = kbase_tok + tb * 64 + (wv >> 1) * 32 + ql;
    qcol_off = head * 64; kcol_off = 256 + hk * 64; vcol_off = 384 + hk * 64; outcol = head * 64; qscale = 1.0f; ntl = CFG_SEQ / 64; ntc = 0;
  } else if (type == 1) {
    tb = idx & 63; hk = (idx >> 6) & 1; b = idx >> 7;
    const int head = hk * 2 + (wv & 1);
    kbase_tok = (long)NTC + (long)b * CFG_DS; qtok = kbase_tok + tb * 64 + (wv >> 1) * 32 + ql;
    qcol_off = head * 64; kcol_off = 256 + hk * 64; vcol_off = 384 + hk * 64; outcol = head * 64; qscale = 1.0f; ntl = CFG_DS / 64; ntc = CFG_PAST / 64;
    ck = p.cgk + (((long)b * 2 + l) * 2 + hk) * CFG_PAST * 64; cv = p.cgv + (((long)b * 2 + l) * 2 + hk) * CFG_PAST * 64;
  } else if (type == 2) {
    tb = idx & 1; hk = (idx >> 1) & 3; b = idx >> 3;
    kbase_tok = (long)b * CFG_SEQ; qtok = kbase_tok + tb * 128 + wv * 32 + ql;
    qcol_off = NA_OFF + hk * 64; kcol_off = NA_OFF + 256 + hk * 64; vcol_off = NA_OFF + 512 + hk * 64; outcol = 512 + hk * 64; qscale = 0.125f; ntl = CFG_SEQ / 64; ntc = 0;
  } else {
    tb = idx & 31; hk = (idx >> 5) & 3; b = idx >> 7;
    kbase_tok = (long)NTC + (long)b * CFG_DS;
    grow = tb * 2 + (wv >> 1);
    qtok = kbase_tok + grow * 64 + (wv & 1) * 32 + ql;
    qcol_off = NA_OFF + hk * 64; kcol_off = NA_OFF + 256 + hk * 64; vcol_off = NA_OFF + 512 + hk * 64; outcol = 512 + hk * 64; qscale = 0.125f;
    r0w = grow - WR / 2; r0w = r0w < 0 ? 0 : (r0w > GROWS - WR ? GROWS - WR : r0w);
    int ra = tb * 2 - WR / 2; ra = ra < 0 ? 0 : (ra > GROWS - WR ? GROWS - WR : ra);
    int rb = tb * 2 + 1 - WR / 2; rb = rb < 0 ? 0 : (rb > GROWS - WR ? GROWS - WR : rb);
    krmin = ra; ntl = rb + WR - ra; ntc = CFG_PAST / 64;
    ck = p.cnk + (((long)b * 2 + l) * 4 + hk) * CFG_PAST * 64; cv = p.cnv + (((long)b * 2 + l) * 4 + hk) * CFG_PAST * 64;
  }
  const int nt = ntl + ntc;
  __syncthreads();
  if (type == 3) { for (int e = tid; e < 465; e += 256) Bt[e] = p.nabias[((long)l * 4 + hk) * 465 + e]; }
  half8 qf[4];
  {
    const h16* qp = p.proj + qtok * INC + qcol_off + hh * 8;
#pragma unroll
    for (int ds = 0; ds < 4; ++ds) qf[ds] = *(const half8*)(qp + ds * 16);
  }
  const int qc = (int)((qtok - kbase_tok) & 63);
  int cst = qc - 8; cst = cst < 0 ? 0 : (cst > 48 ? 48 : cst);
  f32x16 o0 = {0.f, 0.f, 0.f, 0.f, 0.f, 0.f, 0.f, 0.f, 0.f, 0.f, 0.f, 0.f, 0.f, 0.f, 0.f, 0.f};
  f32x16 o1 = o0;
  float m = -1.0e30f, lsum = 0.f;
  half8 kx0, kx1, vx0, vx1;
  const int skey0 = tid >> 3, sdc = tid & 7;
#define ATT_LOAD(TI)                                                                                       \
  {                                                                                                        \
    const int ti_ = (TI);                                                                                  \
    if (ti_ < ntc) {                                                                                       \
      const float* kk_ = ck + ((long)ti_ * 64 + skey0) * 64 + sdc * 8;                                     \
      const float* vv_ = cv + ((long)ti_ * 64 + skey0) * 64 + sdc * 8;                                     \
      f32x4 a_ = *(const f32x4*)kk_, b_ = *(const f32x4*)(kk_ + 4), c_ = *(const f32x4*)(kk_ + 2048), d_ = *(const f32x4*)(kk_ + 2052); \
      _Pragma("unroll") for (int e = 0; e < 4; ++e) { kx0[e] = (h16)a_[e]; kx0[4 + e] = (h16)b_[e]; kx1[e] = (h16)c_[e]; kx1[4 + e] = (h16)d_[e]; } \
      a_ = *(const f32x4*)vv_; b_ = *(const f32x4*)(vv_ + 4); c_ = *(const f32x4*)(vv_ + 2048); d_ = *(const f32x4*)(vv_ + 2052); \
      _Pragma("unroll") for (int e = 0; e < 4; ++e) { vx0[e] = (h16)a_[e]; vx0[4 + e] = (h16)b_[e]; vx1[e] = (h16)c_[e]; vx1[4 + e] = (h16)d_[e]; } \
    } else {                                                                                               \
      const long t0_ = kbase_tok + (long)((type == 3 ? krmin : 0) + (ti_ - ntc)) * 64;                     \
      const h16* r_ = p.proj + (t0_ + skey0) * INC + sdc * 8;                                              \
      kx0 = *(const half8*)(r_ + kcol_off); kx1 = *(const half8*)(r_ + 32 * INC + kcol_off);              \
      vx0 = *(const half8*)(r_ + vcol_off); vx1 = *(const half8*)(r_ + 32 * INC + vcol_off);              \
    }                                                                                                      \
  }
  ATT_LOAD(0)
  for (int ti = 0; ti < nt; ++ti) {
    __syncthreads();
    *(half8*)(Ks + skey0 * 72 + sdc * 8) = kx0; *(half8*)(Ks + (skey0 + 32) * 72 + sdc * 8) = kx1;
    *(half8*)(Vt + skey0 * 72 + sdc * 8) = vx0; *(half8*)(Vt + (skey0 + 32) * 72 + sdc * 8) = vx1;
    __syncthreads();
    if (ti + 1 < nt) ATT_LOAD(ti + 1)
    __builtin_amdgcn_sched_barrier(0);
    const bool local = type == 3 && ti >= ntc;
    const int kr = krmin + (ti - ntc);
    if (local && (kr < r0w || kr >= r0w + WR)) continue;
    f32x16 s0 = {0.f, 0.f, 0.f, 0.f, 0.f, 0.f, 0.f, 0.f, 0.f, 0.f, 0.f, 0.f, 0.f, 0.f, 0.f, 0.f};
    f32x16 s1 = s0;
#pragma unroll
    for (int ds = 0; ds < 4; ++ds) {
      const half8 a0 = *(const half8*)(Ks + ql * 72 + ds * 16 + hh * 8);
      const half8 a1 = *(const half8*)(Ks + (32 + ql) * 72 + ds * 16 + hh * 8);
      s0 = __builtin_amdgcn_mfma_f32_32x32x16_f16(a0, qf[ds], s0, 0, 0, 0);
      s1 = __builtin_amdgcn_mfma_f32_32x32x16_f16(a1, qf[ds], s1, 0, 0, 0);
    }
    float mx = -1.0e30f;
    if (local) {
      const float* brow = Bt + (kr - grow + 7) * 31 + 15 - qc;
#pragma unroll
      for (int i = 0; i < 16; ++i) {
        const int kc0 = (i & 3) + 8 * (i >> 2) + 4 * hh, kc1 = kc0 + 32;
        s0[i] = (kc0 >= cst && kc0 < cst + 16) ? s0[i] * 0.125f + brow[kc0] : -1.0e30f;
        s1[i] = (kc1 >= cst && kc1 < cst + 16) ? s1[i] * 0.125f + brow[kc1] : -1.0e30f;
      }
    } else if (qscale != 1.0f) {
#pragma unroll
      for (int i = 0; i < 16; ++i) { s0[i] *= qscale; s1[i] *= qscale; }
    }
#pragma unroll
    for (int i = 0; i < 16; ++i) mx = fmaxf(mx, fmaxf(s0[i], s1[i]));
    mx = fmaxf(mx, __shfl_xor(mx, 32));
    const float mn = fmaxf(m, mx);
    const float alpha = __expf(m - mn);
    m = mn; lsum *= alpha;
#pragma unroll
    for (int i = 0; i < 16; ++i) { o0[i] *= alpha; o1[i] *= alpha; }
    float ps = 0.f;
#pragma unroll
    for (int i = 0; i < 16; ++i) { s0[i] = __expf(s0[i] - mn); s1[i] = __expf(s1[i] - mn); ps += s0[i] + s1[i]; }
    lsum += ps;
    half8 pf0, pf1, pf2, pf3;
#pragma unroll
    for (int j = 0; j < 8; ++j) { pf0[j] = (h16)s0[j]; pf1[j] = (h16)s0[8 + j]; pf2[j] = (h16)s1[j]; pf3[j] = (h16)s1[8 + j]; }
#define TRD(ptr) __builtin_bit_cast(half4, __builtin_amdgcn_ds_read_tr16_b64_v4i16((__attribute__((address_space(3))) s16x4v*)(ptr)))
#define ATT_PV(KS, PF)                                                                              \
    {                                                                                               \
        \
      const h16* v0_ = Vt + (16 * (KS) + 4 * hh + ((lane & 15) >> 2)) * 72 + 16 * ((lane >> 4) & 1) + 4 * (lane & 3); \
      const half4 lo0 = TRD(v0_), hi0 = TRD(v0_ + 8 * 72);                                          \
      const half4 lo1 = TRD(v0_ + 32), hi1 = TRD(v0_ + 8 * 72 + 32);                                \
      const half8 a0_ = __builtin_shufflevector(lo0, hi0, 0, 1, 2, 3, 4, 5, 6, 7);                  \
      const half8 a1_ = __builtin_shufflevector(lo1, hi1, 0, 1, 2, 3, 4, 5, 6, 7);                  \
      o0 = __builtin_amdgcn_mfma_f32_32x32x16_f16(a0_, PF, o0, 0, 0, 0);                            \
      o1 = __builtin_amdgcn_mfma_f32_32x32x16_f16(a1_, PF, o1, 0, 0, 0);                            \
    }
    ATT_PV(0, pf0) ATT_PV(1, pf1) ATT_PV(2, pf2) ATT_PV(3, pf3)
#undef ATT_PV
#undef TRD
  }
#undef ATT_LOAD
  lsum += __shfl_xor(lsum, 32);
  const float inv = 1.0f / lsum;
  h16* op = p.act + qtok * 1024 + outcol;
#pragma unroll
  for (int g = 0; g < 4; ++g) {
    half4 a, c;
#pragma unroll
    for (int e = 0; e < 4; ++e) { a[e] = (h16)(o0[4 * g + e] * inv); c[e] = (h16)(o1[4 * g + e] * inv); }
    *(half4*)(op + 8 * g + 4 * hh) = a;
    *(half4*)(op + 32 + 8 * g + 4 * hh) = c;
  }
}
#define N_SCAN_LAT (2 * 2 * CFG_DB * 4 * 2)
#define N_SCAN_CTX (2 * 2 * CFG_BATCH * 4 * 2)
#define N_ATT1 (CFG_DB * 2 * (CFG_DS / 64))
#define N_ATT3 (CFG_DB * 4 * (CFG_DS / 128))
#define N_ATT0 (CFG_BATCH * 2 * (CFG_SEQ / 64))
#define N_ATT2 (CFG_BATCH * 4 * (CFG_SEQ / 128))
__device__ __forceinline__ void run_scan_item(int r, bool latent, const P& p, int l) {
  const int rq = r & 1; r >>= 1; const int kind = r & 1; r >>= 1; const int d = r & 1; r >>= 1; const int h = r & 3; r >>= 2;
  blk_scan2(kind, latent ? CFG_BATCH + r : r, h, d, rq, p, l);
}
__device__ void mixer_phase(const P& p, int lc, int mode = 0) {
  const int l = lc & 1;
  __shared__ long s_item;
  __shared__ unsigned s_slot;
  const long total = N_SCAN_CTX + N_ATT1 + N_ATT3 + N_ATT0 + N_ATT2;
  unsigned* lat_cnt = p.counters + 8 + lc;
  if (mode == 0) {
    __syncthreads();
    if (threadIdx.x == 0) {
      const unsigned hw = __builtin_amdgcn_s_getreg((31 << 11) | 4);
      const unsigned xcc = __builtin_amdgcn_s_getreg((3 << 11) | 20) & 0xFu;
      const unsigned key = (xcc << 8) | ((hw >> 8) & 0xFFu);
      const unsigned slot = atomicAdd(p.cucnt + lc * 4096 + key, 1u);
      s_slot = slot;
      s_item = slot == 0 ? (long)atomicAdd(lat_cnt, 1u) : (long)N_SCAN_LAT;
    }
    __syncthreads();
    const long w = s_item;
    if (w < N_SCAN_LAT) run_scan_item((int)w, true, p, l);
  }
  for (;;) {
    __syncthreads();
    if (threadIdx.x == 0) s_item = (long)atomicAdd(p.counters + lc, 1u);
    __syncthreads();
    long w = s_item;
    if (mode == 2) w += N_SCAN_CTX;
    if (w >= (mode == 1 ? (long)N_SCAN_CTX : total)) break;
    if (w < N_SCAN_CTX) {
      run_scan_item((int)w, false, p, l);
    } else {
      int a = (int)(w - N_SCAN_CTX);
      int ty;
      if (a < N_ATT1) ty = 1;
      else if ((a -= N_ATT1) < N_ATT3) ty = 3;
      else if ((a -= N_ATT3) < N_ATT0) ty = 0;
      else { a -= N_ATT0; ty = 2; }
      blk_attn(ty, a, p, l);
    }
  }
  if (mode != 2) {
    for (;;) {
      __syncthreads();
      if (threadIdx.x == 0) s_item = (long)atomicAdd(lat_cnt, 1u);
      __syncthreads();
      const long w = s_item;
      if (w >= N_SCAN_LAT) break;
      run_scan_item((int)w, true, p, l);
    }
  }
}


#define XB_TMO      128
#define XB_XCNT(j)  (256  + 64 * (j))
#define XB_XSUB(j)  (1280 + 64 * (j))
#define XB_XGEN(j)  (2304 + 64 * (j))
#define XB_TOP      3328
#define XB_TOPGEN   3392
#define XCD_BAR_WORDS 3456
#define XB_SPIN_CAP (1u << 22)
#define LAS __attribute__((address_space(3)))
__device__ __forceinline__ unsigned xb_ld(unsigned* p)              { return __hip_atomic_load(p, __ATOMIC_RELAXED, __HIP_MEMORY_SCOPE_AGENT); }
__device__ __forceinline__ unsigned xb_add(unsigned* p, unsigned v) { return __hip_atomic_fetch_add(p, v, __ATOMIC_RELAXED, __HIP_MEMORY_SCOPE_AGENT); }
__device__ __forceinline__ unsigned xb_xcc_id() { return (unsigned)__builtin_amdgcn_s_getreg((3 << 11) | 20) & 0xFu; }
#define XB_SPIN(cond, bar) do { unsigned _sp = 0; while (cond) { __builtin_amdgcn_s_sleep(1); \
    if ((++_sp & 255u) == 0u) { if (xb_ld(&(bar)[XB_TMO])) break; if (_sp > XB_SPIN_CAP) { atomicAdd(&(bar)[XB_TMO], 1u); break; } } } } while (0)
struct XcdBarrier { unsigned* bar; unsigned x; volatile LAS unsigned* st; };
__device__ __forceinline__ XcdBarrier xcd_barrier_post(unsigned* bar, volatile LAS unsigned* st) {
  XcdBarrier b; b.bar = bar; b.x = xb_xcc_id(); b.st = st;
  if (threadIdx.x == 0) (void)xb_add(&bar[XB_XCNT(b.x)], 1u);
  return b;
}
__device__ __forceinline__ void xcd_barrier_complete(unsigned* bar, unsigned x, unsigned& nloc, unsigned& nx) {
  const unsigned G = gridDim.x * gridDim.y * gridDim.z;
  unsigned sum, cnt, mine, sp = 0u;
  for (;;) {
    sum = 0u; cnt = 0u; mine = 0u;
#pragma unroll
    for (unsigned j = 0; j < 16; ++j) { const unsigned c = xb_ld(&bar[XB_XCNT(j)]); sum += c; cnt += (c > 0u) ? 1u : 0u; mine = (j == x) ? c : mine; }
    if (sum == G) break;
    __builtin_amdgcn_s_sleep(1);
    if ((++sp & 255u) == 0u) { if (xb_ld(&bar[XB_TMO])) break; if (sp > XB_SPIN_CAP) { atomicAdd(&bar[XB_TMO], 1u); break; } }
  }
  nloc = mine > 0u ? mine : 1u; nx = cnt > 0u ? cnt : 1u;
}
__device__ __forceinline__ void xcd_barrier(const XcdBarrier& b) {
  asm volatile("s_waitcnt vmcnt(0)" ::: "memory");
  __syncthreads();
  if (threadIdx.x == 0) {
    unsigned* bar = b.bar;
    __builtin_amdgcn_s_waitcnt(0);
    unsigned nloc = b.st[0], nx = b.st[1];
    if (nloc == 0u) { xcd_barrier_complete(bar, b.x, nloc, nx); b.st[0] = nloc; b.st[1] = nx; }
    const unsigned old = xb_add(&bar[XB_XSUB(b.x)], 1u);
    const unsigned gen = old / nloc;
    if (old + 1u == (gen + 1u) * nloc) {
      __builtin_amdgcn_fence(__ATOMIC_RELEASE, "agent");
      asm volatile("s_waitcnt vmcnt(0)" ::: "memory");
      const unsigned og = xb_add(&bar[XB_TOP], 1u);
      const unsigned tg = og / nx;
      if (og + 1u == (tg + 1u) * nx) xb_add(&bar[XB_TOPGEN], 1u);
      else XB_SPIN(xb_ld(&bar[XB_TOPGEN]) == tg, bar);
      __builtin_amdgcn_fence(__ATOMIC_ACQUIRE, "agent");
      xb_add(&bar[XB_XGEN(b.x)], 1u);
      asm volatile("s_waitcnt vmcnt(0)" ::: "memory");
    } else {
      XB_SPIN(xb_ld(&bar[XB_XGEN(b.x)]) == gen, bar);
      __builtin_amdgcn_fence(__ATOMIC_ACQUIRE, "agent");
      asm volatile("s_waitcnt vmcnt(0)" ::: "memory");
    }
  }
  __syncthreads();
}

#define STAGE(fn, n) for (long i_ = (long)blockIdx.x * 256 + otid(); i_ < (long)(n); i_ += (long)gridDim.x * 256) fn(i_, p, l);
#define BSTAGE(fn, n) for (long w_ = blockIdx.x; w_ < (long)(n); w_ += gridDim.x) fn(w_, p, l);
#define SYNC { XcdBarrier xb_; xb_.bar = p.xbar; xb_.x = xb_xcc_id(); xb_.st = (volatile LAS unsigned*)&xb_words; xcd_barrier(xb_); }
__global__ void __launch_bounds__(256, 2) mega(P p) {
  cg::grid_group grid = cg::this_grid();
  __shared__ uint4 xb_words;
  if (threadIdx.x == 0) xb_words = make_uint4(0u, 0u, 0u, 0u);
  __syncthreads();
  (void)xcd_barrier_post(p.xbar, (volatile LAS unsigned*)&xb_words);
#define gtid ((long)blockIdx.x * 256 + otid())
#define gstride ((long)gridDim.x * 256)
  { int l = 0;
    if (gtid < 16) p.counters[gtid] = 0u;
    for (long i_ = gtid; i_ < 4 * 4096; i_ += gstride) p.cucnt[i_] = 0u;
    for (int rep_ = 0; rep_ < REP_S0; ++rep_) {
    for (long w_ = blockIdx.x; w_ < 3200; w_ += gridDim.x) blk_convert(w_, p);
    for (long w_ = blockIdx.x; w_ < 2L * NCOND * 24; w_ += gridDim.x) blk_mod(w_, p);
    for (long i_ = gtid; i_ < 2L * 16 * CFG_NKEYS * 128 / 8; i_ += gstride) cvt8(p.pkeys, p.keys16, i_);
    }
  }
  grid.sync();
#pragma unroll 1
  for (int ph = 0; ph < 18; ++ph) {
    const int l = ph >= 9 ? 1 : 0; const int k = ph - 9 * l;
    if (k == 0 && l == 1) continue;
    switch (k) {
      case 0: { BSTAGE(blk_norm<0>, NT / 4) } break;
      case 1: gemm_phase<0>(p, l); break;
      case 2: {
        STAGE(b_prep_gqa, (long)NT * 6)
        STAGE(b_prep_cache, (long)NTC * 640)
        half8 bf0 = {0, 0, 0, 0, 0, 0, 0, 0}, bf1 = bf0; int bkey = -1;
        for (long w_ = blockIdx.x; w_ < (long)N_PREP_RW + N_PREP_DN; w_ += gridDim.x) blk_scanprep(w_, p, l, bf0, bf1, bkey);
      } break;
      case 3:
#ifdef PROBE_MIXER2
        mixer_phase(p, l + 2); SYNC
#endif
        mixer_phase(p, l); break;
      case 4: fin_phase(p, l); break;
      case 5: {
        gemm_phase<1>(p, l);
        for (long i_ = gtid; i_ < (long)NEXP * 1024 / 16; i_ += gstride) {
          cvt16_fp4(p.pu + (long)l * NEXP * 1024, (unsigned char*)p.u16, i_, PEER_USCALE);
          cvt16_fp4(p.pv + (long)l * NEXP * 1024, (unsigned char*)p.v16, i_, PEER_VSCALE);
        }
      } break;
      case 6: { BSTAGE(blk_norm<1>, NT / 4) } break;
      case 7: gemm_phase<2>(p, l); break;
      default: { BSTAGE(blk_peer<false>, NT / 4) } break;
    }
    if (ph != 17) SYNC
  }
}
#else
#define STAGE(fn, n) { _Pragma("omp parallel for schedule(dynamic, 64)") for (long i_ = 0; i_ < (long)(n); ++i_) fn(i_, p, l); }
#define SYNC
void mega(P p) {
  { int l = 0;
    STAGE(b_init, (long)NT * 1024)
    STAGE(b_mod, 2L * NCOND * 6144)
  }
  for (int l = 0; l < 2; ++l) {
    STAGE(b_norm<0>, NT)
    STAGE(b_inproj, (long)NT * INC)
    STAGE(b_prep_gqa, (long)NT * 6)
    STAGE(b_prep_cache, (long)NTC * 640)
    STAGE(b_rwaux, (long)NT * 512)
    STAGE(b_dnconv, (long)NT * 768)
    STAGE(b_dnnorm, (long)NT * 8)
    STAGE(b_rwscan, NSCAN)
    STAGE(b_dnscan, NSCAN)
    STAGE(b_attn_gqa, (long)NT * 4)
    STAGE(b_attn_na, (long)NT * 4)
    STAGE(b_rwfin, (long)NT * 4)
    STAGE(b_dnfin, (long)NT * 4)
    STAGE(b_outproj, (long)NT * 1024)
    STAGE(b_norm<1>, NT)
    STAGE(b_peerq, (long)NT * 2048)
    STAGE(b_topk1, (long)NT * 16)
    STAGE(b_topk2, (long)NT * 8)
    STAGE(b_peer_act, (long)NT * 128)
    STAGE(b_peer_out, (long)NT * 1024)
  }
  { int l = 0; STAGE(b_final, NT) }
}
#endif

static void fill_params(P& p, void* const* d_in, void* d_out, void* d_ws) {
  const float** f = (const float**)&p;
  for (int i = 0; i < 39; ++i) f[i] = (const float*)d_in[i];
  float* o = (float*)d_out;
  p.X = o; o += (long)NT * 1024;
  p.ogk = o; o += (long)CFG_BATCH * 2 * 2 * CFG_SEQ * 64;
  p.ogv = o; o += (long)CFG_BATCH * 2 * 2 * CFG_SEQ * 64;
  p.onk = o; o += (long)CFG_BATCH * 2 * 4 * CFG_SEQ * 64;
  p.onv = o; o += (long)CFG_BATCH * 2 * 4 * CFG_SEQ * 64;
  p.orw = o; o += (long)CFG_BATCH * 2 * 2 * 4 * 4096;
  p.odn = o;
  char* w = (char*)d_ws;
  auto take = [&](size_t bytes) { char* r = w; w += (bytes + 255) & ~(size_t)255; return r; };
  p.xbar = (unsigned*)take(16384);
  p.counters = (unsigned*)take(256);
  p.cucnt = (unsigned*)take(4 * 4096 * 4);
  p.mod = (float*)take(2L * NCOND * 6144 * 4);
  p.act = (h16*)take((size_t)NT * 1024 * sizeof(h16));
  p.rwaux = (h16*)take((size_t)NT * 1024 * sizeof(h16));
  p.dnp = (h16*)take((size_t)NT * 768 * sizeof(h16));
  p.proj = (h16*)take((size_t)NT * INC * sizeof(h16));
  p.wtin = (h16*)take((size_t)2 * NPAD_IN * 1024 * sizeof(h16));
  p.wtout = (h16*)take((size_t)2 * 1024 * 1024 * sizeof(h16));
  p.wtq = (h16*)take((size_t)2 * 2048 * 1024 * sizeof(h16));
  p.rwsc = (float*)take((size_t)NT * 16 * 4);
  p.dnsc = (float*)take((size_t)NT * 16 * 4);
  p.keys16 = (h16*)take((size_t)2 * 16 * CFG_NKEYS * 128 * sizeof(h16));
  char* a = (char*)p.proj;
#ifdef HOST_EMU
  p.pq = (h16*)a; a += (size_t)NT * 2048 * sizeof(h16);
#endif
  p.tks = (float*)a; a += (size_t)NT * 256 * 4;
  p.tki = (int*)a; a += (size_t)NT * 256 * 4;
  p.u16 = (h16*)a; a += (size_t)NEXP * 1024 * sizeof(h16);
  p.v16 = (h16*)a; a += (size_t)NEXP * 1024 * sizeof(h16);
  p.pidx = (int*)p.rwaux;
  p.pact = (float*)((char*)p.rwaux + (size_t)NT * 128 * 4);
}

#ifndef HOST_EMU
extern "C" void kernel_launch(void* const* d_in, const int* in_sizes, int n_in, void* d_out, int out_size, void* d_ws,
                              size_t ws_size, hipStream_t stream) {
  static int grid_blocks = 0;
  if (!grid_blocks) {
    int dev = 0, cus = 0, per_cu = 0;
    (void)hipGetDevice(&dev);
    (void)hipDeviceGetAttribute(&cus, hipDeviceAttributeMultiprocessorCount, dev);
    (void)hipOccupancyMaxActiveBlocksPerMultiprocessor(&per_cu, mega, 256, 0);
    grid_blocks = cus * per_cu;
  }
  P p;
  memset(&p, 0, sizeof(p));
  fill_params(p, d_in, d_out, d_ws);
  (void)hipMemsetAsync(p.xbar, 0, 16384, stream);
  void* args[] = {&p};
  hipError_t e = hipLaunchCooperativeKernel((void*)mega, dim3(grid_blocks), dim3(256), args, 0, stream);
  if (e != hipSuccess) fprintf(stderr, "cooperative launch failed: %s (grid %d)\n", hipGetErrorString(e), grid_blocks);
}
#endif
```

```cpp
#ifndef HOST_EMU
#include <hip/hip_runtime.h>
#include <hip/hip_cooperative_groups.h>
namespace cg = cooperative_groups;
#define HD __device__ __forceinline__
#define HDN __device__ __noinline__
typedef _Float16 h16;
#define CBAR asm volatile("" ::: "memory")
#define SMEM_BYTES 73728
__shared__ __attribute__((aligned(16))) char g_smem[SMEM_BYTES];
__device__ __forceinline__ int otid() { int t = threadIdx.x; asm volatile("" : "+v"(t)); return t; }
#define FSIN(x) __sinf(x)
#define FCOS(x) __cosf(x)
#else
#include <cmath>
#include <cstring>
#define HD static inline
#define HDN static
typedef float h16;
#define CBAR
#define FSIN(x) sinf(x)
#define FCOS(x) cosf(x)
#endif
#include <cstdio>
#include <cstring>

#ifndef CFG_BATCH
#define CFG_BATCH 32
#define CFG_SEQ 256
#define CFG_DB 8
#define CFG_DS 4096
#define CFG_PAST 512
#define CFG_NKEYS 128
#endif

#define NTC (CFG_BATCH * CFG_SEQ)
#define NTL (CFG_DB * CFG_DS)
#define NT (NTC + NTL)
#define NCOND (1 + CFG_DB)
#define GROWS (CFG_DS / 64)
#define WR (GROWS < 8 ? GROWS : 8)
#define NEXP (CFG_NKEYS * CFG_NKEYS)
#define INC 3280
#define RW_OFF 512
#define NA_OFF 1472
#define DN_OFF 2240

struct P {
  const float *xp, *xs, *c, *cgk, *cgv, *cnk, *cnv, *srw, *sdn, *cctx, *n1g, *n2g, *wmod, *bmod, *win, *wout,
      *gqn, *gkn, *rwmu, *rww0, *rww2, *rwa0, *rwa2, *rwg2, *rwkk, *rwka, *rwrk, *rwlng, *rwlnb, *nabias,
      *dnconv, *dnalog, *dndt, *dnng, *pwq, *pkeys, *pu, *pv, *fng;
  float *X, *ogk, *ogv, *onk, *onv, *orw, *odn;
  float* mod;
  h16* act;
  h16* proj;
  h16* rwaux;
  h16* dnp;
  h16* pq;
  float* tks;
  int* tki;
  int* pidx;
  float* pact;
  unsigned* counters;
  unsigned* xbar;
  unsigned* cucnt;
  h16 *keys16, *u16, *v16;
  float *rwsc, *dnsc;
  h16 *wtin, *wtout, *wtq;
};

HD float sigmoidf_(float x) { return 1.0f / (1.0f + expf(-x)); }
HD float siluf_(float x) { return x * sigmoidf_(x); }
HD float softplusf_(float x) { return fmaxf(x, 0.0f) + log1pf(expf(-fabsf(x))); }
HD int condrow(long token) { return token < NTC ? 0 : 1 + (int)((token - NTC) / CFG_DS); }
HD void seqinfo(long token, int& t, int& T, long& base) {
  if (token < NTC) { T = CFG_SEQ; t = (int)(token % CFG_SEQ); base = token - t; }
  else { long u = token - NTC; T = CFG_DS; t = (int)(u % CFG_DS); base = token - t; }
}

HD void b_init(long i, const P& p, int l) {
  p.X[i] = (i < (long)NTC * 1024) ? p.xp[i] : p.xs[i - (long)NTC * 1024];
}
HD void b_mod(long i, const P& p, int) {
  int col = (int)(i % 6144); int r = (int)((i / 6144) % NCOND); int l = (int)(i / (6144L * NCOND));
  const float* cond = r == 0 ? p.cctx : p.c + (long)(r - 1) * 1024;
  float acc = p.bmod[l * 6144 + col];
  for (int k = 0; k < 1024; ++k) acc += siluf_(cond[k]) * p.wmod[((long)l * 1024 + k) * 6144 + col];
  p.mod[i] = acc;
}
template <int WHICH>
HD void b_norm(long i, const P& p, int l) {
  const float* x = p.X + i * 1024;
  float ss = 0.f;
  for (int k = 0; k < 1024; ++k) ss += x[k] * x[k];
  float rstd = 1.0f / sqrtf(ss * (1.0f / 1024) + 1e-6f);
  const float* m = p.mod + ((long)l * NCOND + condrow(i)) * 6144 + (WHICH ? 3072 : 0);
  const float* g = (WHICH ? p.n2g : p.n1g) + l * 1024;
  for (int k = 0; k < 1024; ++k) p.act[i * 1024 + k] = (h16)((x[k] * rstd * g[k]) * (1.0f + m[1024 + k]) + m[k]);
}
HD void b_prep_gqa(long i, const P& p, int l) {
  long token = i / 6; int slot = (int)(i % 6);
  h16* x = p.proj + token * INC + slot * 64;
  float y[64]; float ss = 0.f;
#pragma unroll
  for (int d = 0; d < 64; ++d) { y[d] = (float)x[d]; ss += y[d] * y[d]; }
  float rstd = 1.0f / sqrtf(ss * (1.0f / 64) + 1e-6f);
  const float* g = (slot < 4 ? p.gqn : p.gkn) + l * 64;
#pragma unroll
  for (int d = 0; d < 64; ++d) y[d] = y[d] * rstd * g[d];
  if (token >= NTC) {
    int t = (int)((token - NTC) % CFG_DS); int row = t / 64, colp = t % 64;
#pragma unroll
    for (int j = 0; j < 32; ++j) {
      float inv = exp2f(-(float)(j % 16) * 0.83048202372184059f);
      float ang = (float)(j < 16 ? row : colp) * inv;
      float cs = FCOS(ang), sn = FSIN(ang);
      float a = y[j], b = y[j + 32];
      y[j] = a * cs - b * sn; y[j + 32] = b * cs + a * sn;
    }
  } else if (slot >= 4) {
    int b = (int)(token / CFG_SEQ), t = (int)(token % CFG_SEQ);
    float* o = p.ogk + ((((long)b * 2 + l) * 2 + (slot - 4)) * CFG_SEQ + t) * 64;
#pragma unroll
    for (int d = 0; d < 64; ++d) o[d] = y[d];
  }
  float sc = slot < 4 ? 0.125f : 1.0f;
#pragma unroll
  for (int d = 0; d < 64; ++d) x[d] = (h16)(y[d] * sc);
}
HD void b_prep_cache(long i, const P& p, int l) {
  long token = i / 640; int e = (int)(i % 640);
  int b = (int)(token / CFG_SEQ), t = (int)(token % CFG_SEQ);
  const h16* pr = p.proj + token * INC;
  if (e < 128) { int kvh = e / 64, d = e % 64; p.ogv[((((long)b * 2 + l) * 2 + kvh) * CFG_SEQ + t) * 64 + d] = (float)pr[384 + e]; }
  else if (e < 384) { int c = e - 128; int h = c / 64, d = c % 64; p.onk[((((long)b * 2 + l) * 4 + h) * CFG_SEQ + t) * 64 + d] = (float)pr[NA_OFF + 256 + c]; }
  else { int c = e - 384; int h = c / 64, d = c % 64; p.onv[((((long)b * 2 + l) * 4 + h) * CFG_SEQ + t) * 64 + d] = (float)pr[NA_OFF + 512 + c]; }
}
HD void b_rwaux(long i, const P& p, int l) {
  int col = (int)(i % 256); int d = (int)((i / 256) % 2); long token = i / 512;
  int t, T; long base; seqinfo(token, t, T, base);
  bool sv = d == 0 ? (t > 0) : (t < T - 1);
  const h16* pb = p.proj + token * INC + RW_OFF;
  const h16* ps = p.proj + (token + (d == 0 ? -1 : 1)) * INC + RW_OFF;
  const float* mu = p.rwmu + ((long)l * 2 + d) * 832;
  float accw = p.rww0[(l * 2 + d) * 256 + col], acca = p.rwa0[(l * 2 + d) * 256 + col];
  for (int j = 0; j < 32; ++j) {
    float bw = (float)pb[768 + d * 32 + j], sw = sv ? (float)ps[768 + d * 32 + j] : 0.f;
    float wl = bw + (sw - bw) * mu[768 + j];
    float ba = (float)pb[832 + d * 32 + j], sa = sv ? (float)ps[832 + d * 32 + j] : 0.f;
    float al = ba + (sa - ba) * mu[800 + j];
    accw += tanhf(wl) * p.rww2[(((long)l * 2 + d) * 32 + j) * 256 + col];
    acca += al * p.rwa2[(((long)l * 2 + d) * 32 + j) * 256 + col];
  }
  float w = -softplusf_(-accw) - 0.5f;
  p.rwaux[((token * 2 + d) * 2 + 0) * 256 + col] = (h16)expf(w);
  p.rwaux[((token * 2 + d) * 2 + 1) * 256 + col] = (h16)sigmoidf_(acca);
}
HD void b_dnconv(long i, const P& p, int l) {
  int c = (int)(i % 768); long token = i / 768;
  int t, T; long base; seqinfo(token, t, T, base);
  float acc = 0.f;
#pragma unroll
  for (int j = 0; j < 5; ++j) {
    int tt = t + j - 2;
    if (tt >= 0 && tt < T) acc += (float)p.proj[(base + tt) * INC + DN_OFF + c] * p.dnconv[((long)l * 5 + j) * 768 + c];
  }
  p.dnp[token * 768 + c] = (h16)siluf_(acc);
}
HD void b_dnnorm(long i, const P& p, int) {
  long token = i / 8; int slot = (int)(i % 8);
  h16* x = p.dnp + token * 768 + slot * 64;
  float ss = 0.f;
  for (int d = 0; d < 64; ++d) { float v = (float)x[d]; ss += v * v; }
  float rs = 1.0f / sqrtf(ss + 1e-6f) * (slot < 4 ? 0.125f : 1.0f);
  for (int d = 0; d < 64; ++d) x[d] = (h16)((float)x[d] * rs);
}

struct Softmax64 {
  float m, lsum, acc[64];
};
template <typename TK>
HD void attend_key(Softmax64& st, const float* q, const TK* k, const TK* v, float scale, float bias) {
  float s = 0.f;
#pragma unroll
  for (int d = 0; d < 64; ++d) s += q[d] * (float)k[d];
  s = s * scale + bias;
  if (s > st.m) {
    float f = expf(st.m - s);
    st.lsum *= f;
#pragma unroll
    for (int d = 0; d < 64; ++d) st.acc[d] *= f;
    st.m = s;
  }
  float pw = expf(s - st.m);
  st.lsum += pw;
#pragma unroll
  for (int d = 0; d < 64; ++d) st.acc[d] += pw * (float)v[d];
}
HD void b_attn_gqa(long i, const P& p, int l) {
  int h = (int)(i / NT); long token = i % NT; int kvh = h / 2;
  float q[64];
  const h16* qp = p.proj + token * INC + h * 64;
#pragma unroll
  for (int d = 0; d < 64; ++d) q[d] = (float)qp[d];
  Softmax64 st; st.m = -1e30f; st.lsum = 0.f;
#pragma unroll
  for (int d = 0; d < 64; ++d) st.acc[d] = 0.f;
  int t, T; long base; seqinfo(token, t, T, base);
  for (int tk = 0; tk < T; ++tk) {
    const h16* kp = p.proj + (base + tk) * INC + 256 + kvh * 64;
    attend_key<h16>(st, q, kp, kp + 128, 1.0f, 0.f);
  }
  if (token >= NTC) {
    int b = (int)((token - NTC) / CFG_DS);
    const float* ck = p.cgk + (((long)b * 2 + l) * 2 + kvh) * CFG_PAST * 64;
    const float* cv = p.cgv + (((long)b * 2 + l) * 2 + kvh) * CFG_PAST * 64;
    for (int pp = 0; pp < CFG_PAST; ++pp) attend_key<float>(st, q, ck + pp * 64, cv + pp * 64, 1.0f, 0.f);
  }
  float inv = 1.0f / st.lsum;
  h16* o = p.act + token * 1024 + h * 64;
#pragma unroll
  for (int d = 0; d < 64; ++d) o[d] = (h16)(st.acc[d] * inv);
}
HD void b_attn_na(long i, const P& p, int l) {
  int h = (int)(i / NT); long token = i % NT;
  float q[64];
  const h16* qp = p.proj + token * INC + NA_OFF + h * 64;
#pragma unroll
  for (int d = 0; d < 64; ++d) q[d] = (float)qp[d];
  Softmax64 st; st.m = -1e30f; st.lsum = 0.f;
#pragma unroll
  for (int d = 0; d < 64; ++d) st.acc[d] = 0.f;
  int t, T; long base; seqinfo(token, t, T, base);
  if (token < NTC) {
    for (int tk = 0; tk < T; ++tk) {
      const h16* kp = p.proj + (base + tk) * INC + NA_OFF + 256 + h * 64;
      attend_key<h16>(st, q, kp, kp + 256, 0.125f, 0.f);
    }
  } else {
    int r = t / 64, cq = t % 64;
    int r0 = r - WR / 2; r0 = r0 < 0 ? 0 : (r0 > GROWS - WR ? GROWS - WR : r0);
    int cs = cq - 8; cs = cs < 0 ? 0 : (cs > 48 ? 48 : cs);
    const float* bias = p.nabias + ((long)l * 4 + h) * 15 * 31;
    for (int w = 0; w < WR; ++w) {
      int kr = r0 + w;
      for (int cc = 0; cc < 16; ++cc) {
        int kc = cs + cc;
        const h16* kp = p.proj + (base + kr * 64 + kc) * INC + NA_OFF + 256 + h * 64;
        attend_key<h16>(st, q, kp, kp + 256, 0.125f, bias[(kr - r + 7) * 31 + (kc - cq + 15)]);
      }
    }
    int b = (int)((token - NTC) / CFG_DS);
    const float* ck = p.cnk + (((long)b * 2 + l) * 4 + h) * CFG_PAST * 64;
    const float* cv = p.cnv + (((long)b * 2 + l) * 4 + h) * CFG_PAST * 64;
    for (int pp = 0; pp < CFG_PAST; ++pp) attend_key<float>(st, q, ck + pp * 64, cv + pp * 64, 0.125f, 0.f);
  }
  float inv = 1.0f / st.lsum;
  h16* o = p.act + token * 1024 + 512 + h * 64;
#pragma unroll
  for (int d = 0; d < 64; ++d) o[d] = (h16)(st.acc[d] * inv);
}

HD float rw_lerp(const P& p, int l, long token, bool sv, int d, int c) {
  float b = (float)p.proj[token * INC + RW_OFF + c];
  float s = sv ? (float)p.proj[(token + (d == 0 ? -1 : 1)) * INC + RW_OFF + c] : 0.f;
  return b + (s - b) * p.rwmu[((long)l * 2 + d) * 832 + c];
}
HD void b_rwscan(long i, const P& p, int l) {
  int v = (int)(i % 64); int sb = (int)(i / 64); int h = sb % 4; int bi = sb / 4;
  bool ctx = bi < CFG_BATCH;
  int T = ctx ? CFG_SEQ : CFG_DS;
  long base = ctx ? (long)bi * CFG_SEQ : (long)NTC + (long)(bi - CFG_BATCH) * CFG_DS;
#ifndef HOST_EMU
  float* S = (float*)g_smem + threadIdx.x * 65;
#else
  float S[64];
#endif
  for (int d = 0; d < 2; ++d) {
    if (ctx) {
      for (int k = 0; k < 64; ++k) S[k] = 0.f;
    } else {
      const float* s0 = p.srw + (((((long)(bi - CFG_BATCH)) * 2 + l) * 2 + d) * 4 + h) * 4096 + v * 64;
      for (int k = 0; k < 64; ++k) S[k] = s0[k];
    }
    for (int step = 0; step < T; ++step) {
      int t = d == 0 ? step : T - 1 - step;
      long token = base + t;
      bool sv = d == 0 ? (t > 0) : (t < T - 1);
      const h16* aux = p.rwaux + (token * 2 + d) * 512;
      float ss = 0.f;
      for (int k = 0; k < 64; ++k) {
        float kv = rw_lerp(p, l, token, sv, d, 256 + h * 64 + k) * p.rwkk[l * 256 + h * 64 + k];
        ss += kv * kv;
      }
      float rs = 1.0f / sqrtf(ss + 1e-6f);
      float sa = 0.f;
      for (int k = 0; k < 64; ++k) {
        float kk = rw_lerp(p, l, token, sv, d, 256 + h * 64 + k) * p.rwkk[l * 256 + h * 64 + k] * rs;
        sa -= S[k] * kk;
      }
      float vv = rw_lerp(p, l, token, sv, d, 512 + h * 64 + v);
      float o = 0.f;
      for (int k = 0; k < 64; ++k) {
        int c = h * 64 + k;
        float kr = rw_lerp(p, l, token, sv, d, 256 + c);
        float kk = kr * p.rwkk[l * 256 + c] * rs;
        float a = (float)aux[256 + c];
        float dec = expf(-(float)aux[c]);
        float keff = kr * (1.0f + (a - 1.0f) * p.rwka[l * 256 + c]);
        float r = rw_lerp(p, l, token, sv, d, c);
        S[k] = S[k] * dec + sa * (kk * a) + vv * keff;
        o += S[k] * r;
      }
      h16* op = p.act + token * 1024 + 256 + h * 64 + v;
      if (d == 0) *op = (h16)o; else *op = (h16)((float)*op + o);
    }
    if (ctx) {
      float* so = p.orw + (((((long)bi) * 2 + l) * 2 + d) * 4 + h) * 4096 + v * 64;
      for (int k = 0; k < 64; ++k) so[k] = S[k];
    }
  }
}
HD void b_rwfin(long i, const P& p, int l) {
  long token = i / 4; int h = (int)(i % 4);
  int t, T; long base; seqinfo(token, t, T, base);
  h16* op = p.act + token * 1024 + 256 + h * 64;
  float mu = 0.f;
  for (int k = 0; k < 64; ++k) mu += (float)op[k];
  mu *= (1.0f / 64);
  float var = 0.f;
  for (int k = 0; k < 64; ++k) { float dlt = (float)op[k] - mu; var += dlt * dlt; }
  var *= (1.0f / 64);
  float rs = 1.0f / sqrtf(var + 64e-5f);
  float bon0 = 0.f, bon1 = 0.f;
  for (int d = 0; d < 2; ++d) {
    bool sv = d == 0 ? (t > 0) : (t < T - 1);
    const h16* aux = p.rwaux + (token * 2 + d) * 512;
    float s = 0.f;
    for (int k = 0; k < 64; ++k) {
      int c = h * 64 + k;
      float kr = rw_lerp(p, l, token, sv, d, 256 + c);
      float a = (float)aux[256 + c];
      float keff = kr * (1.0f + (a - 1.0f) * p.rwka[l * 256 + c]);
      s += rw_lerp(p, l, token, sv, d, c) * keff * p.rwrk[l * 256 + c];
    }
    if (d == 0) bon0 = s; else bon1 = s;
  }
  bool sv0 = t > 0, sv1 = t < T - 1;
  for (int k = 0; k < 64; ++k) {
    int c = h * 64 + k;
    float y = ((float)op[k] - mu) * rs * p.rwlng[l * 256 + c] + p.rwlnb[l * 256 + c];
    y += bon0 * rw_lerp(p, l, token, sv0, 0, 512 + c) + bon1 * rw_lerp(p, l, token, sv1, 1, 512 + c);
    float gate = 0.f;
    for (int j = 0; j < 64; ++j) gate += sigmoidf_((float)p.proj[token * INC + RW_OFF + 896 + j]) * p.rwg2[((long)l * 64 + j) * 256 + c];
    op[k] = (h16)(y * gate);
  }
}
HD void b_dnscan(long i, const P& p, int l) {
  int v = (int)(i % 64); int sb = (int)(i / 64); int h = sb % 4; int bi = sb / 4;
  bool ctx = bi < CFG_BATCH;
  int T = ctx ? CFG_SEQ : CFG_DS;
  long base = ctx ? (long)bi * CFG_SEQ : (long)NTC + (long)(bi - CFG_BATCH) * CFG_DS;
#ifndef HOST_EMU
  float* S = (float*)g_smem + threadIdx.x * 65;
#else
  float S[64];
#endif
  for (int d = 0; d < 2; ++d) {
    if (ctx) {
      for (int k = 0; k < 64; ++k) S[k] = 0.f;
    } else {
      const float* s0 = p.sdn + (((((long)(bi - CFG_BATCH)) * 2 + l) * 2 + d) * 4 + h) * 4096 + v;
      for (int k = 0; k < 64; ++k) S[k] = s0[k * 64];
    }
    float nalog = -expf(p.dnalog[(l * 2 + d) * 4 + h]);
    float dtb = p.dndt[(l * 2 + d) * 4 + h];
    for (int step = 0; step < T; ++step) {
      int t = d == 0 ? step : T - 1 - step;
      long token = base + t;
      const h16* dp = p.dnp + token * 768;
      const h16* pr = p.proj + token * INC + DN_OFF;
      float beta = sigmoidf_((float)pr[768 + d * 4 + h]);
      float g = nalog * softplusf_((float)pr[776 + d * 4 + h] + dtb);
      float a = expf(g);
      float sk = 0.f;
      for (int k = 0; k < 64; ++k) sk += (float)dp[256 + h * 64 + k] * S[k];
      float coef = beta * ((float)dp[512 + h * 64 + v] - a * sk);
      float o = 0.f;
      for (int k = 0; k < 64; ++k) {
        S[k] = a * S[k] + coef * (float)dp[256 + h * 64 + k];
        o += (float)dp[h * 64 + k] * S[k];
      }
      h16* op = p.act + token * 1024 + 768 + h * 64 + v;
      if (d == 0) *op = (h16)o; else *op = (h16)((float)*op + o);
    }
    if (ctx) {
      float* so = p.odn + (((((long)bi) * 2 + l) * 2 + d) * 4 + h) * 4096 + v;
      for (int k = 0; k < 64; ++k) so[k * 64] = S[k];
    }
  }
}
HD void b_dnfin(long i, const P& p, int l) {
  long token = i / 4; int h = (int)(i % 4);
  h16* op = p.act + token * 1024 + 768 + h * 64;
  float ss = 0.f;
  for (int k = 0; k < 64; ++k) { float o = (float)op[k]; ss += o * o; }
  float rs = 1.0f / sqrtf(ss * (1.0f / 64) + 1e-6f);
  for (int k = 0; k < 64; ++k) {
    float z = (float)p.proj[token * INC + DN_OFF + 784 + h * 64 + k];
    op[k] = (h16)((float)op[k] * rs * p.dnng[l * 64 + k] * siluf_(z));
  }
}
HD void top16_insert(float (&ts)[16], int (&ti)[16], float s, int id) {
#pragma unroll
  for (int j = 0; j < 16; ++j) {
    if (s > ts[j]) { float a = ts[j]; ts[j] = s; s = a; int b = ti[j]; ti[j] = id; id = b; }
  }
}
HD void b_topk1(long i, const P& p, int l) {
  long token = i / 16; int hp = (int)(i % 16);
  const h16* q = p.pq + token * 2048 + hp * 128;
  const float* keys = p.pkeys + ((long)l * 16 + hp) * CFG_NKEYS * 128;
  float ts[16]; int ti[16];
#pragma unroll
  for (int j = 0; j < 16; ++j) { ts[j] = -3.0e38f; ti[j] = 0; }
  for (int k = 0; k < CFG_NKEYS; ++k) {
    float s = 0.f;
    for (int d = 0; d < 128; ++d) s += (float)q[d] * keys[k * 128 + d];
    top16_insert(ts, ti, s, k);
  }
#pragma unroll
  for (int j = 0; j < 16; ++j) { p.tks[token * 256 + hp * 16 + j] = ts[j]; p.tki[token * 256 + hp * 16 + j] = ti[j]; }
}
HD void b_topk2(long i, const P& p, int l) {
  long token = i / 8; int hd = (int)(i % 8);
  const float* s1 = p.tks + token * 256 + hd * 32; const int* i1 = p.tki + token * 256 + hd * 32;
  float ts[16]; int ti[16];
#pragma unroll
  for (int j = 0; j < 16; ++j) { ts[j] = -3.0e38f; ti[j] = 0; }
  for (int a = 0; a < 16; ++a)
    for (int b = 0; b < 16; ++b) top16_insert(ts, ti, s1[a] + s1[16 + b], i1[a] * CFG_NKEYS + i1[16 + b]);
  float sum = 0.f;
#pragma unroll
  for (int j = 0; j < 16; ++j) sum += expf(ts[j] - ts[0]);
  float inv = 1.0f / sum;
#pragma unroll
  for (int j = 0; j < 16; ++j) { p.pidx[token * 128 + hd * 16 + j] = ti[j]; p.pact[token * 128 + hd * 16 + j] = expf(ts[j] - ts[0]) * inv; }
}
HD void b_peer_act(long i, const P& p, int l) {
  long token = i / 128;
  const float* u = p.pu + ((long)l * NEXP + p.pidx[i]) * 1024;
  const h16* x = p.act + token * 1024;
  float dot = 0.f;
  for (int k = 0; k < 1024; ++k) dot += (float)x[k] * u[k];
  float ge = 0.5f * dot * (1.0f + erff(dot * 0.70710678118654752f));
  p.pact[i] = p.pact[i] * ge;
}
HD void b_peer_out(long i, const P& p, int l) {
  long token = i / 1024; int col = (int)(i % 1024);
  float acc = 0.f;
  for (int e = 0; e < 128; ++e) acc += p.pact[token * 128 + e] * p.pv[((long)l * NEXP + p.pidx[token * 128 + e]) * 1024 + col];
  p.X[i] += p.mod[((long)l * NCOND + condrow(token)) * 6144 + 5120 + col] * acc;
}
HD void b_final(long i, const P& p, int) {
  float* x = p.X + i * 1024;
  float ss = 0.f;
  for (int k = 0; k < 1024; ++k) ss += x[k] * x[k];
  float rstd = 1.0f / sqrtf(ss * (1.0f / 1024) + 1e-6f);
  for (int k = 0; k < 1024; ++k) x[k] = x[k] * rstd * p.fng[k];
}
HD float gemm_elem(const h16* A, const float* B, int N, long token, int col) {
  float acc = 0.f;
  for (int k = 0; k < 1024; ++k) acc += (float)A[token * 1024 + k] * B[(long)k * N + col];
  return acc;
}
HD void b_inproj(long i, const P& p, int l) {
  long token = i / INC; int col = (int)(i % INC);
  p.proj[i] = (h16)gemm_elem(p.act, p.win + (long)l * 1024 * INC, INC, token, col);
}
HD void b_outproj(long i, const P& p, int l) {
  long token = i / 1024; int col = (int)(i % 1024);
  float acc = gemm_elem(p.act, p.wout + (long)l * 1024 * 1024, 1024, token, col);
  p.X[i] += p.mod[((long)l * NCOND + condrow(token)) * 6144 + 2048 + col] * acc;
}
HD void b_peerq(long i, const P& p, int l) {
  long token = i / 2048; int col = (int)(i % 2048);
  p.pq[i] = (h16)gemm_elem(p.act, p.pwq + (long)l * 1024 * 2048, 2048, token, col);
}

#ifndef PROBE_KMAX
#define PROBE_KMAX 16
#endif
#ifndef REP_S0
#define REP_S0 1
#endif
#ifndef REP_MISC
#define REP_MISC 1
#endif
#ifndef REP_G0
#define REP_G0 1
#endif
#ifndef REP_G2
#define REP_G2 1
#endif
#ifndef REP_SP
#define REP_SP 1
#endif
#define NSCAN ((long)(CFG_BATCH + CFG_DB) * 4 * 64)
#define NPAD_IN 3328

#ifndef HOST_EMU
typedef _Float16 half8 __attribute__((ext_vector_type(8)));
typedef _Float16 half4 __attribute__((ext_vector_type(4)));
typedef _Float16 half2v __attribute__((ext_vector_type(2)));
typedef float f32x2 __attribute__((ext_vector_type(2)));
typedef float f32x16 __attribute__((ext_vector_type(16)));
typedef float f32x4 __attribute__((ext_vector_type(4)));
typedef unsigned u32x4 __attribute__((ext_vector_type(4)));
typedef short s16x4v __attribute__((__vector_size__(4 * sizeof(short))));

template <int CTRL> __device__ __forceinline__ float dppf(float x) {
  return __builtin_bit_cast(float, __builtin_amdgcn_update_dpp(0, __builtin_bit_cast(int, x), CTRL, 0xF, 0xF, true));
}
__device__ __forceinline__ float sum16(float x) { x += dppf<0x128>(x); x += dppf<0x124>(x); x += dppf<0xB1>(x); x += dppf<0x4E>(x); return x; }
__device__ __forceinline__ float sum8(float x) { x += dppf<0xB1>(x); x += dppf<0x4E>(x); x += dppf<0x141>(x); return x; }
__device__ __forceinline__ float sum64(float x) { x = sum16(x); x += __shfl_xor(x, 16); x += __shfl_xor(x, 32); return x; }

#define CSWAP_DESC(S, ID, i, j) { const bool c_ = S[j] > S[i]; const float a_ = c_ ? S[j] : S[i]; const float b_ = c_ ? S[i] : S[j]; \
    const int ia_ = c_ ? ID[j] : ID[i]; const int ib_ = c_ ? ID[i] : ID[j]; S[i] = a_; S[j] = b_; ID[i] = ia_; ID[j] = ib_; }
__device__ __forceinline__ void bitonic_sort16_desc(float (&s)[16], int (&id)[16]) {
#pragma unroll
  for (int k = 2; k <= 16; k <<= 1) {
#pragma unroll
    for (int j = k >> 1; j > 0; j >>= 1) {
#pragma unroll
      for (int i = 0; i < 16; ++i) {
        const int l = i ^ j;
        if (l > i) {
          if ((i & k) == 0) CSWAP_DESC(s, id, i, l) else CSWAP_DESC(s, id, l, i)
        }
      }
    }
  }
}
__device__ __forceinline__ void merge_top16(float (&ts)[16], int (&ti)[16], const float (&gs)[16], const int (&gi)[16]) {
#pragma unroll
  for (int i = 0; i < 16; ++i) { if (gs[15 - i] > ts[i]) { ts[i] = gs[15 - i]; ti[i] = gi[15 - i]; } }
#pragma unroll
  for (int j = 8; j > 0; j >>= 1) {
#pragma unroll
    for (int i = 0; i < 16; ++i) { if ((i & j) == 0) CSWAP_DESC(ts, ti, i, i + j) }
  }
}
__device__ void blk_convert(long w, const P& p) {
  int l = (int)(w / 1600); int r = (int)(w % 1600);
  const float* src; h16* dst; int N, ntile;
  if (r < 832) { src = p.win + (long)l * 1024 * INC; dst = p.wtin + (long)l * NPAD_IN * 1024; N = INC; ntile = 52; }
  else if (r < 1088) { r -= 832; src = p.wout + (long)l * 1024 * 1024; dst = p.wtout + (long)l * 1024 * 1024; N = 1024; ntile = 16; }
  else { r -= 1088; src = p.pwq + (long)l * 1024 * 2048; dst = p.wtq + (long)l * 2048 * 1024; N = 2048; ntile = 32; }
  int kt = r / ntile, nt = r % ntile;
  int k0 = kt * 64, n0 = nt * 64;
  h16* tile = (h16*)g_smem;
  const int tid_ = otid(); int c = tid_ & 63, r4 = tid_ >> 6;
  __syncthreads();
#pragma unroll
  for (int j = 0; j < 16; ++j) {
    int rr = r4 + 4 * j;
    float v = (n0 + c < N) ? src[(long)(k0 + rr) * N + n0 + c] : 0.f;
    tile[rr * 66 + c] = (h16)v;
  }
  __syncthreads();
#pragma unroll
  for (int j = 0; j < 16; ++j) {
    int rr = r4 + 4 * j;
    dst[(long)(n0 + rr) * 1024 + k0 + c] = tile[c * 66 + rr];
  }
}

template <int EPI>
__device__ void gemm_phase(const P& p, int l, int kmax = 16) {
  constexpr int NTILES = EPI == 0 ? (NPAD_IN / 128) : (EPI == 1 ? 8 : 16);
  constexpr int NT8 = (NTILES + 7) / 8;
  const long nw = EPI == 0 ? (long)(NT / 128) * NTILES : (long)(NT / 128) * 8 * NT8;
#define TILE_OF(W, MT, NTV) { const int x_ = (int)((W) & 7); const int j_ = (int)((W) >> 3);                        \
    if (EPI == 0) { if (j_ < 960) { MT = j_ / 3; NTV = x_ + 8 * (j_ - 3 * MT); } else { NTV = 24 + (x_ >> 2); MT = 80 * (x_ & 3) + j_ - 960; } } \
    else { NTV = x_ + 8 * (j_ % NT8); MT = j_ / NT8; } }
  const h16* A = p.act;
  const h16* Bt = EPI == 0 ? p.wtin + (long)l * NPAD_IN * 1024 : (EPI == 1 ? p.wtout + (long)l * 1024 * 1024 : p.wtq + (long)l * 2048 * 1024);
  const int tid = otid(), lane = tid & 63, wv = tid >> 6, wm = wv >> 1, wn = wv & 1;
  h16* As = (h16*)g_smem;
  h16* Bs = As + 2 * 128 * 72;
  const int lrow = tid >> 3, lch = tid & 7;
  long w = blockIdx.x; int mt = 0, nt = 0;
  for (;;) { if (w >= nw) return; TILE_OF(w, mt, nt) if (nt < NTILES) break; w += gridDim.x; }
  int m0 = mt * 128, n0 = nt * 128;
  const h16* Ag = A + (long)(m0 + lrow) * 1024 + lch * 8;
  const h16* Bg = Bt + (long)(n0 + lrow) * 1024 + lch * 8;
  u32x4 ra0, ra1, ra2, ra3, rb0, rb1, rb2, rb3;
  u32x4 sa0, sa1, sa2, sa3, sb0, sb1, sb2, sb3;
  const f32x16 zero16 = {0.f, 0.f, 0.f, 0.f, 0.f, 0.f, 0.f, 0.f, 0.f, 0.f, 0.f, 0.f, 0.f, 0.f, 0.f, 0.f};
  f32x16 acc00, acc01, acc10, acc11;
#define GLD0(K0) \
  ra0 = *(const u32x4*)(Ag + (K0)); ra1 = *(const u32x4*)(Ag + 32 * 1024 + (K0)); ra2 = *(const u32x4*)(Ag + 64 * 1024 + (K0)); ra3 = *(const u32x4*)(Ag + 96 * 1024 + (K0)); \
  rb0 = *(const u32x4*)(Bg + (K0)); rb1 = *(const u32x4*)(Bg + 32 * 1024 + (K0)); rb2 = *(const u32x4*)(Bg + 64 * 1024 + (K0)); rb3 = *(const u32x4*)(Bg + 96 * 1024 + (K0));
#define GLD1(K0) \
  sa0 = *(const u32x4*)(Ag + (K0)); sa1 = *(const u32x4*)(Ag + 32 * 1024 + (K0)); sa2 = *(const u32x4*)(Ag + 64 * 1024 + (K0)); sa3 = *(const u32x4*)(Ag + 96 * 1024 + (K0)); \
  sb0 = *(const u32x4*)(Bg + (K0)); sb1 = *(const u32x4*)(Bg + 32 * 1024 + (K0)); sb2 = *(const u32x4*)(Bg + 64 * 1024 + (K0)); sb3 = *(const u32x4*)(Bg + 96 * 1024 + (K0));
#define LST0(AW, BW) \
  *(u32x4*)((AW) + (lrow) * 72 + lch * 8) = ra0; *(u32x4*)((AW) + (lrow + 32) * 72 + lch * 8) = ra1; *(u32x4*)((AW) + (lrow + 64) * 72 + lch * 8) = ra2; *(u32x4*)((AW) + (lrow + 96) * 72 + lch * 8) = ra3; \
  *(u32x4*)((BW) + (lrow) * 72 + lch * 8) = rb0; *(u32x4*)((BW) + (lrow + 32) * 72 + lch * 8) = rb1; *(u32x4*)((BW) + (lrow + 64) * 72 + lch * 8) = rb2; *(u32x4*)((BW) + (lrow + 96) * 72 + lch * 8) = rb3;
#define LST1(AW, BW) \
  *(u32x4*)((AW) + (lrow) * 72 + lch * 8) = sa0; *(u32x4*)((AW) + (lrow + 32) * 72 + lch * 8) = sa1; *(u32x4*)((AW) + (lrow + 64) * 72 + lch * 8) = sa2; *(u32x4*)((AW) + (lrow + 96) * 72 + lch * 8) = sa3; \
  *(u32x4*)((BW) + (lrow) * 72 + lch * 8) = sb0; *(u32x4*)((BW) + (lrow + 32) * 72 + lch * 8) = sb1; *(u32x4*)((BW) + (lrow + 64) * 72 + lch * 8) = sb2; *(u32x4*)((BW) + (lrow + 96) * 72 + lch * 8) = sb3;
#define GCOMP(BUF)                                                                                   \
  {                                                                                                  \
    const h16* Ab = As + (BUF) * 128 * 72 + (wm * 64 + (lane & 31)) * 72 + (lane >> 5) * 8;          \
    const h16* Bb = Bs + (BUF) * 128 * 72 + (wn * 64 + (lane & 31)) * 72 + (lane >> 5) * 8;          \
    _Pragma("unroll") for (int s = 0; s < 4; ++s) {                                                  \
      half8 a0 = *(const half8*)(Ab + s * 16), a1 = *(const half8*)(Ab + 32 * 72 + s * 16);          \
      half8 b0 = *(const half8*)(Bb + s * 16), b1 = *(const half8*)(Bb + 32 * 72 + s * 16);          \
      acc00 = __builtin_amdgcn_mfma_f32_32x32x16_f16(a0, b0, acc00, 0, 0, 0);                        \
      acc01 = __builtin_amdgcn_mfma_f32_32x32x16_f16(a0, b1, acc01, 0, 0, 0);                        \
      acc10 = __builtin_amdgcn_mfma_f32_32x32x16_f16(a1, b0, acc10, 0, 0, 0);                        \
      acc11 = __builtin_amdgcn_mfma_f32_32x32x16_f16(a1, b1, acc11, 0, 0, 0);                        \
    }                                                                                                \
  }
  GLD0(0)
  GLD1(64)
  for (;;) {
  acc00 = zero16; acc01 = zero16; acc10 = zero16; acc11 = zero16;
  __builtin_amdgcn_sched_barrier(0);
  __syncthreads();
  LST0(As, Bs)
  GLD0(128)
  __builtin_amdgcn_sched_barrier(0);
  __syncthreads();
  for (int kt = 0; kt < kmax; kt += 2) {
    GCOMP(0)
    __builtin_amdgcn_sched_barrier(0);
    LST1(As + 128 * 72, Bs + 128 * 72)
    if (kt + 3 < 16) { GLD1((kt + 3) * 64) }
    __builtin_amdgcn_sched_barrier(0);
    __syncthreads();
    GCOMP(1)
    __builtin_amdgcn_sched_barrier(0);
    if (kt + 2 < 16) { LST0(As, Bs) }
    if (kt + 4 < 16) { GLD0((kt + 4) * 64) }
    __builtin_amdgcn_sched_barrier(0);
    __syncthreads();
  }
  const int cm0 = m0, cn0 = n0, cnt = nt;
  long w2 = w + gridDim.x; int mt2 = 0, nt2 = 0; bool has_next = false;
  for (;;) { if (w2 >= nw) break; TILE_OF(w2, mt2, nt2) if (nt2 < NTILES) { has_next = true; break; } w2 += gridDim.x; }
  if (has_next) {
    m0 = mt2 * 128; n0 = nt2 * 128; nt = nt2;
    Ag = A + (long)(m0 + lrow) * 1024 + lch * 8; Bg = Bt + (long)(n0 + lrow) * 1024 + lch * 8;
  }
  __builtin_amdgcn_sched_barrier(0);
#define GEMM_EPI(ACC, I, J)                                                                         \
  _Pragma("unroll") for (int r = 0; r < 16; ++r) {                                                   \
    const long row = cm0 + wm * 64 + (I) * 32 + (r & 3) + 8 * (r >> 2) + 4 * (lane >> 5);             \
    const int col = cn0 + wn * 64 + (J) * 32 + (lane & 31);                                            \
    const float v = ACC[r];                                                                          \
    if (EPI == 0) { if (col < INC) p.proj[row * INC + col] = (h16)v; }                                \
    else if (EPI == 1) { p.X[row * 1024 + col] += p.mod[((long)l * NCOND + condrow(row)) * 6144 + 2048 + col] * v; } \
    else { p.pq[row * 2048 + col] = (h16)v; }                                                         \
  }
  if (EPI == 0) {
    h16* Ct = (h16*)g_smem;
#define CST(ACC, I, J) _Pragma("unroll") for (int r = 0; r < 16; ++r) Ct[(wm * 64 + (I) * 32 + (r & 3) + 8 * (r >> 2) + 4 * (lane >> 5)) * 136 + wn * 64 + (J) * 32 + (lane & 31)] = (h16)ACC[r];
    CST(acc00, 0, 0) CST(acc01, 0, 1) CST(acc10, 1, 0) CST(acc11, 1, 1)
#undef CST
    __syncthreads();
#pragma unroll
    for (int j = 0; j < 8; ++j) {
      const int idx = tid + 256 * j; const int rr = idx >> 4, cc = idx & 15;
      if (cn0 + cc * 8 < INC) *(u32x4*)(p.proj + (long)(cm0 + rr) * INC + cn0 + cc * 8) = *(const u32x4*)(Ct + rr * 136 + cc * 8);
    }
  } else if (EPI == 1) {
#define EPI1(ACC, I, J)                                                                              \
    {                                                                                                \
      float xv_[16], mv_[16];                                                                        \
      const int col = cn0 + wn * 64 + (J) * 32 + (lane & 31);                                         \
      _Pragma("unroll") for (int r = 0; r < 16; ++r) {                                               \
        const long row = cm0 + wm * 64 + (I) * 32 + (r & 3) + 8 * (r >> 2) + 4 * (lane >> 5);         \
        xv_[r] = p.X[row * 1024 + col]; mv_[r] = p.mod[((long)l * NCOND + condrow(row)) * 6144 + 2048 + col]; \
      }                                                                                              \
      _Pragma("unroll") for (int r = 0; r < 16; ++r) {                                               \
        const long row = cm0 + wm * 64 + (I) * 32 + (r & 3) + 8 * (r >> 2) + 4 * (lane >> 5);         \
        p.X[row * 1024 + col] = xv_[r] + mv_[r] * ACC[r];                                            \
      }                                                                                              \
    }
    EPI1(acc00, 0, 0) EPI1(acc01, 0, 1) EPI1(acc10, 1, 0) EPI1(acc11, 1, 1)
#undef EPI1
  } else {
    h16* Q = (h16*)g_smem;
    h16* Kk = Q + 128 * 136;
    const h16* kg = p.keys16 + ((long)l * 16 + cnt) * CFG_NKEYS * 128;
#define QST(ACC, I, J) _Pragma("unroll") for (int r = 0; r < 16; ++r) Q[(wm * 64 + (I) * 32 + (r & 3) + 8 * (r >> 2) + 4 * (lane >> 5)) * 136 + wn * 64 + (J) * 32 + (lane & 31)] = (h16)ACC[r];
    QST(acc00, 0, 0) QST(acc01, 0, 1) QST(acc10, 1, 0) QST(acc11, 1, 1)
#undef QST
#pragma unroll
    for (int j = 0; j < 8; ++j) {
      const int idx = tid + 256 * j; const int kr = idx >> 4, kc = idx & 15;
      *(u32x4*)(Kk + kr * 136 + kc * 8) = *(const u32x4*)(kg + kr * 128 + kc * 8);
    }
    __syncthreads();
    f32x16 z = {0.f, 0.f, 0.f, 0.f, 0.f, 0.f, 0.f, 0.f, 0.f, 0.f, 0.f, 0.f, 0.f, 0.f, 0.f, 0.f};
    f32x16 s00 = z, s01 = z, s10 = z, s11 = z;
    const h16* Qb = Q + (wm * 64 + (lane & 31)) * 136 + (lane >> 5) * 8;
    const h16* Kb = Kk + (wn * 64 + (lane & 31)) * 136 + (lane >> 5) * 8;
#pragma unroll
    for (int sidx = 0; sidx < 8; ++sidx) {
      half8 a0 = *(const half8*)(Qb + sidx * 16), a1 = *(const half8*)(Qb + 32 * 136 + sidx * 16);
      half8 b0 = *(const half8*)(Kb + sidx * 16), b1 = *(const half8*)(Kb + 32 * 136 + sidx * 16);
      s00 = __builtin_amdgcn_mfma_f32_32x32x16_f16(a0, b0, s00, 0, 0, 0);
      s01 = __builtin_amdgcn_mfma_f32_32x32x16_f16(a0, b1, s01, 0, 0, 0);
      s10 = __builtin_amdgcn_mfma_f32_32x32x16_f16(a1, b0, s10, 0, 0, 0);
      s11 = __builtin_amdgcn_mfma_f32_32x32x16_f16(a1, b1, s11, 0, 0, 0);
    }
    __syncthreads();
    float* SC = (float*)g_smem;
#define SST(ACC, I, J) _Pragma("unroll") for (int r = 0; r < 16; ++r) SC[(wm * 64 + (I) * 32 + (r & 3) + 8 * (r >> 2) + 4 * (lane >> 5)) * 129 + wn * 64 + (J) * 32 + (lane & 31)] = ACC[r];
    SST(s00, 0, 0) SST(s01, 0, 1) SST(s10, 1, 0) SST(s11, 1, 1)
#undef SST
    __syncthreads();
    const int row = tid >> 1, half = tid & 1;
    float ts[16]; int ti[16];
#pragma unroll
    for (int j = 0; j < 16; ++j) { ts[j] = -3.0e38f; ti[j] = 0; }
#pragma unroll 1
    for (int g = 0; g < 4; ++g) {
      float gs[16]; int gi[16];
#pragma unroll
      for (int j = 0; j < 16; ++j) { gs[j] = SC[row * 129 + half * 64 + g * 16 + j]; gi[j] = half * 64 + g * 16 + j; }
      bitonic_sort16_desc(gs, gi);
      merge_top16(ts, ti, gs, gi);
    }
    {
      float ps[16]; int pi[16];
#pragma unroll
      for (int j = 0; j < 16; ++j) { ps[j] = dppf<0xB1>(ts[j]); pi[j] = __builtin_amdgcn_update_dpp(0, ti[j], 0xB1, 0xF, 0xF, true); }
      merge_top16(ts, ti, ps, pi);
    }
    if (half == 0) {
      const long token = cm0 + row;
#pragma unroll
      for (int j = 0; j < 16; ++j) { p.tks[token * 256 + cnt * 16 + j] = ts[j]; p.tki[token * 256 + cnt * 16 + j] = ti[j]; }
    }
  }
#undef GEMM_EPI
  if (!has_next) break;
  GLD0(0)
  GLD1(64)
  w = w2;
  }
#undef GLD0
#undef GLD1
#undef LST0
#undef LST1
#undef GCOMP
#undef TILE_OF
}

__device__ void blk_mod(long w, const P& p) {
  float* sl = (float*)g_smem;
  const int tid = otid();
  const int cb = (int)(w % 24); const int r = (int)((w / 24) % NCOND); const int l = (int)(w / (24 * NCOND));
  const float* cond = r == 0 ? p.cctx : p.c + (long)(r - 1) * 1024;
  __syncthreads();
#pragma unroll
  for (int j = 0; j < 4; ++j) sl[tid + 256 * j] = siluf_(cond[tid + 256 * j]);
  __syncthreads();
  const int col = cb * 256 + tid;
  const float* wp = p.wmod + (long)l * 1024 * 6144 + col;
  float acc = p.bmod[l * 6144 + col];
#pragma unroll 8
  for (int k = 0; k < 1024; ++k) acc += sl[k] * wp[(long)k * 6144];
  p.mod[((long)l * NCOND + r) * 6144 + col] = acc;
}
__device__ __forceinline__ float sum64u(float x);
template <int WHICH>
__device__ void blk_norm(long w, const P& p, int l) {
  const int tid_ = otid(); const int lane = tid_ & 63; const long token = w * 4 + (tid_ >> 6);
  const float* src = (WHICH == 0 && l == 0) ? (token < NTC ? p.xp + token * 1024 : p.xs + (token - NTC) * 1024) : p.X + token * 1024;
  float4 v[4]; float ss = 0.f;
#pragma unroll
  for (int j = 0; j < 4; ++j) { v[j] = ((const float4*)src)[lane + 64 * j]; ss += v[j].x * v[j].x + v[j].y * v[j].y + v[j].z * v[j].z + v[j].w * v[j].w; }
  ss = sum64u(ss);
  const float rstd = 1.0f / sqrtf(ss * (1.0f / 1024) + 1e-6f);
  if (WHICH == 2) {
#pragma unroll
    for (int j = 0; j < 4; ++j) {
      float4 g = ((const float4*)p.fng)[lane + 64 * j];
      float4 o; o.x = v[j].x * rstd * g.x; o.y = v[j].y * rstd * g.y; o.z = v[j].z * rstd * g.z; o.w = v[j].w * rstd * g.w;
      ((float4*)(p.X + token * 1024))[lane + 64 * j] = o;
    }
    return;
  }
  const float* m = p.mod + ((long)l * NCOND + condrow(token)) * 6144 + (WHICH ? 3072 : 0);
  const float* g = (WHICH ? p.n2g : p.n1g) + l * 1024;
  float4 gga[4], sha[4], sca[4];
#pragma unroll
  for (int j = 0; j < 4; ++j) { const int c4 = lane + 64 * j; gga[j] = ((const float4*)g)[c4]; sha[j] = ((const float4*)m)[c4]; sca[j] = ((const float4*)(m + 1024))[c4]; }
#pragma unroll
  for (int j = 0; j < 4; ++j) {
    const int c4 = lane + 64 * j;
    const float4 gg = gga[j], sh = sha[j], sc = sca[j];
    half4 o;
    o[0] = (h16)((v[j].x * rstd * gg.x) * (1.0f + sc.x) + sh.x);
    o[1] = (h16)((v[j].y * rstd * gg.y) * (1.0f + sc.y) + sh.y);
    o[2] = (h16)((v[j].z * rstd * gg.z) * (1.0f + sc.z) + sh.z);
    o[3] = (h16)((v[j].w * rstd * gg.w) * (1.0f + sc.w) + sh.w);
    *(half4*)(p.act + token * 1024 + c4 * 4) = o;
    if (WHICH == 0 && l == 0) ((float4*)(p.X + token * 1024))[c4] = v[j];
  }
}


#define SC_CT 32
__device__ __forceinline__ float fsigmoid(float x) { return __frcp_rn(1.0f + __expf(-x)); }
__device__ __forceinline__ float fsilu(float x) { return x * fsigmoid(x); }
__device__ __forceinline__ float fsoftplus(float x) { return fmaxf(x, 0.0f) + __logf(1.0f + __expf(-fabsf(x))); }
__device__ __forceinline__ float ftanh(float x) { const float e = __expf(-2.0f * fabsf(x)); const float t = (1.0f - e) * __frcp_rn(1.0f + e); return x < 0.f ? -t : t; }
#define N_PREP_RW ((NT / 32) * 8)
#define N_PREP_DN ((NT / 32) * 4)
__device__ void blk_scanprep(long w, const P& p, int l, half8& bf0, half8& bf1, int& bkey) {
  h16* tw16 = (h16*)g_smem;
  h16* al16 = tw16 + 32 * 40;
  float* cbuf = (float*)(al16 + 32 * 40);
  const int tid = otid();
  const int ls = tid >> 3, part = tid & 7;
  if (w < N_PREP_RW) {
    const int d = (int)(w & 1), h = (int)((w >> 1) & 3); const long token = (w >> 3) * 32 + ls;
    int t, T; long base; seqinfo(token, t, T, base);
    const bool sv = d == 0 ? (t > 0) : (t < T - 1);
    const h16* pb = p.proj + token * INC + RW_OFF;
    const h16* ps = p.proj + (token + (d == 0 ? -1 : 1)) * INC + RW_OFF;
    const float* mu = p.rwmu + ((long)l * 2 + d) * 832;
    const int lane = tid & 63, wv = tid >> 6;
    const int mat = wv >> 1, ntile = wv & 1;
    const int c0 = h * 64 + part * 8;
    half8 rb = *(const half8*)(pb + c0), kb = *(const half8*)(pb + 256 + c0);
    half8 rs_ = rb, ks_ = kb;
    if (sv) { rs_ = *(const half8*)(ps + c0); ks_ = *(const half8*)(ps + 256 + c0); }
    if (bkey != (int)((l << 3) | (w & 7))) {
      bkey = (int)((l << 3) | (w & 7));
      const float* wsrc = (mat ? p.rwa2 : p.rww2) + ((long)l * 2 + d) * 32 * 256 + h * 64 + ntile * 32 + (lane & 31);
#pragma unroll
      for (int j = 0; j < 8; ++j) { bf0[j] = (h16)wsrc[(8 * (lane >> 5) + j) * 256]; bf1[j] = (h16)wsrc[(16 + 8 * (lane >> 5) + j) * 256]; }
    }
    __syncthreads();
#pragma unroll
    for (int e = 0; e < 4; ++e) {
      const int jj = part * 4 + e;
      float bw = (float)pb[768 + d * 32 + jj], sw = sv ? (float)ps[768 + d * 32 + jj] : 0.f;
      tw16[ls * 40 + jj] = (h16)ftanh(bw + (sw - bw) * mu[768 + jj]);
      float ba = (float)pb[832 + d * 32 + jj], sa_ = sv ? (float)ps[832 + d * 32 + jj] : 0.f;
      al16[ls * 40 + jj] = (h16)(ba + (sa_ - ba) * mu[800 + jj]);
    }
    __syncthreads();
    {
      const h16* X16 = (mat ? al16 : tw16) + (lane & 31) * 40 + 8 * (lane >> 5);
      const half8 a0 = *(const half8*)X16, a1 = *(const half8*)(X16 + 16);
      f32x16 acc = {0.f, 0.f, 0.f, 0.f, 0.f, 0.f, 0.f, 0.f, 0.f, 0.f, 0.f, 0.f, 0.f, 0.f, 0.f, 0.f};
      acc = __builtin_amdgcn_mfma_f32_32x32x16_f16(a0, bf0, acc, 0, 0, 0);
      acc = __builtin_amdgcn_mfma_f32_32x32x16_f16(a1, bf1, acc, 0, 0, 0);
      float* cb = cbuf + mat * (32 * 65) + ntile * 32 + (lane & 31);
#pragma unroll
      for (int r = 0; r < 16; ++r) cb[((r & 3) + 8 * (r >> 2) + 4 * (lane >> 5)) * 65] = acc[r];
    }
    __syncthreads();
    float accw[8], acca[8];
#pragma unroll
    for (int e = 0; e < 8; ++e) {
      accw[e] = p.rww0[(l * 2 + d) * 256 + c0 + e] + cbuf[ls * 65 + part * 8 + e];
      acca[e] = p.rwa0[(l * 2 + d) * 256 + c0 + e] + cbuf[32 * 65 + ls * 65 + part * 8 + e];
    }
    float ss = 0.f, bon = 0.f;
    half8 ewo, ago;
#pragma unroll
    for (int e = 0; e < 8; ++e) {
      const int c = c0 + e;
      float b_ = (float)rb[e], s_ = sv ? (float)rs_[e] : 0.f; const float rr = b_ + (s_ - b_) * mu[c];
      b_ = (float)kb[e]; s_ = sv ? (float)ks_[e] : 0.f; const float kr = b_ + (s_ - b_) * mu[256 + c];
      const float asg = fsigmoid(acca[e]);
      const float kkr = kr * p.rwkk[l * 256 + c];
      ss += kkr * kkr;
      const float keff = kr * (1.0f + (asg - 1.0f) * p.rwka[l * 256 + c]);
      bon += rr * keff * p.rwrk[l * 256 + c];
      ewo[e] = (h16)__expf(-fsoftplus(-accw[e]) - 0.5f);
      ago[e] = (h16)asg;
    }
    ss = sum8(ss); bon = sum8(bon);
    *(half8*)(p.rwaux + ((token * 2 + d) * 2 + 0) * 256 + c0) = ewo;
    *(half8*)(p.rwaux + ((token * 2 + d) * 2 + 1) * 256 + c0) = ago;
    if (part == 0) { float* sc = p.rwsc + ((token * 2 + d) * 4 + h) * 2; sc[0] = 1.0f / sqrtf(ss + 1e-6f); sc[1] = bon; }
  } else {
    const long w2 = w - N_PREP_RW;
    const int h = (int)(w2 & 3); const long token = (w2 >> 2) * 32 + ls;
    int t, T; long base; seqinfo(token, t, T, base);
    const int c0 = h * 64 + part * 8;
    float aq[8], ak[8], av[8];
#pragma unroll
    for (int e = 0; e < 8; ++e) { aq[e] = 0.f; ak[e] = 0.f; av[e] = 0.f; }
    half8 xq[5], xk[5], xv[5]; float tv[5];
#pragma unroll
    for (int tap = 0; tap < 5; ++tap) {
      const int tt = t + tap - 2;
      const bool ok = tt >= 0 && tt < T;
      const h16* pr = p.proj + (base + (ok ? tt : t)) * INC + DN_OFF + c0;
      xq[tap] = *(const half8*)pr; xk[tap] = *(const half8*)(pr + 256); xv[tap] = *(const half8*)(pr + 512);
      tv[tap] = ok ? 1.0f : 0.0f;
    }
    __builtin_amdgcn_sched_barrier(0);
#pragma unroll
    for (int tap = 0; tap < 5; ++tap) {
      const float* cw = p.dnconv + ((long)l * 5 + tap) * 768 + c0;
#pragma unroll
      for (int e = 0; e < 8; ++e) {
        aq[e] += (float)xq[tap][e] * (cw[e] * tv[tap]); ak[e] += (float)xk[tap][e] * (cw[256 + e] * tv[tap]); av[e] += (float)xv[tap][e] * (cw[512 + e] * tv[tap]);
      }
    }
    float ssq = 0.f, ssk = 0.f;
#pragma unroll
    for (int e = 0; e < 8; ++e) { aq[e] = fsilu(aq[e]); ak[e] = fsilu(ak[e]); av[e] = fsilu(av[e]); ssq += aq[e] * aq[e]; ssk += ak[e] * ak[e]; }
    ssq = sum8(ssq); ssk = sum8(ssk);
    const float rq = 0.125f / sqrtf(ssq + 1e-6f), rk = 1.0f / sqrtf(ssk + 1e-6f);
    half8 qo, ko, vo;
#pragma unroll
    for (int e = 0; e < 8; ++e) { qo[e] = (h16)(aq[e] * rq); ko[e] = (h16)(ak[e] * rk); vo[e] = (h16)av[e]; }
    h16* dp = p.dnp + token * 768 + c0;
    *(half8*)dp = qo; *(half8*)(dp + 256) = ko; *(half8*)(dp + 512) = vo;
    if (part < 2) {
      const int d = part;
      const h16* pr = p.proj + token * INC + DN_OFF;
      float* sc = p.dnsc + ((token * 2 + d) * 4 + h) * 2;
      sc[0] = sigmoidf_((float)pr[768 + d * 4 + h]);
      sc[1] = expf(-expf(p.dnalog[(l * 2 + d) * 4 + h]) * softplusf_((float)pr[776 + d * 4 + h] + p.dndt[(l * 2 + d) * 4 + h]));
    }
  }
}
__device__ void blk_scan2(int kind, int bi, int h, int d, int rq, const P& p, int l) {
  float* L = (float*)g_smem;
  float* LA = L; float* LW = L + 2048; float* LB = L + 4096; float* LK = L + 6144; float* LR = L + 8192; float* LV = L + 10240;
  const int tid = otid(), lane = tid & 63, wv = tid >> 6, g = lane >> 4, cl = lane & 15;
  const int i = rq * 32 + wv * 8 + g * 2, j0 = cl * 4;
  const bool ctx = bi < CFG_BATCH;
  const int T = ctx ? CFG_SEQ : CFG_DS;
  const long base = ctx ? (long)bi * CFG_SEQ : (long)NTC + (long)(bi - CFG_BATCH) * CFG_DS;
  const int ls = tid >> 3, part = tid & 7;
  f32x4 S = {0.f, 0.f, 0.f, 0.f}, S1 = {0.f, 0.f, 0.f, 0.f};
  if (!ctx) {
    const int b = bi - CFG_BATCH;
    if (kind == 0) {
      const float* s0 = p.srw + (((((long)b) * 2 + l) * 2 + d) * 4 + h) * 4096;
      S = *(const f32x4*)(s0 + i * 64 + j0); S1 = *(const f32x4*)(s0 + (i + 1) * 64 + j0);
    } else {
      const float* s0 = p.sdn + (((((long)b) * 2 + l) * 2 + d) * 4 + h) * 4096;
#pragma unroll
      for (int c = 0; c < 4; ++c) { S[c] = s0[(j0 + c) * 64 + i]; S1[c] = s0[(j0 + c) * 64 + i + 1]; }
    }
  }
  h16* obuf = (h16*)(L + 12288);
  h16* obase = (kind == 0 ? p.act + 256 + d * 512 + h * 64 : p.proj + DN_OFF + d * 256 + h * 64) + rq * 32 + (tid & 7) * 4;
  const long ostride = kind == 0 ? 1024 : INC;
#define SC_FLUSH(S0I)                                                                              \
  { const int sidx_ = (S0I) + (tid >> 3); const int t_ = d == 0 ? sidx_ : T - 1 - sidx_;             \
    *(half4*)(obase + (base + t_) * ostride) = *(const half4*)(obuf + (tid >> 3) * 32 + (tid & 7) * 4); }
  const int c0 = h * 64 + part * 8, jb = part * 8;
  float cmr[8], cmk[8], cmv[8], ckk[8], cka[8];
#pragma unroll
  for (int e = 0; e < 8; ++e) { cmr[e] = 0.f; cmk[e] = 0.f; cmv[e] = 0.f; ckk[e] = 0.f; cka[e] = 0.f; }
  if (kind == 0) {
    const float* mu = p.rwmu + ((long)l * 2 + d) * 832;
#pragma unroll
    for (int e = 0; e < 8; ++e) { cmr[e] = mu[c0 + e]; cmk[e] = mu[256 + c0 + e]; cmv[e] = mu[512 + c0 + e]; ckk[e] = p.rwkk[l * 256 + c0 + e]; cka[e] = p.rwka[l * 256 + c0 + e]; }
  }
  half8 g0, g1, g2, g3, g4, g5, g6, g7; float gf0 = 0.f, gf1 = 0.f; bool gsv = false;
  g0 = g1 = g2 = g3 = g4 = g5 = g6 = g7 = (half8){0, 0, 0, 0, 0, 0, 0, 0};
#define SC_LOADG(S0I)                                                                              \
  {                                                                                                \
    const int sidx_ = (S0I) + ls;                                                                  \
    const int t_ = d == 0 ? sidx_ : T - 1 - sidx_;                                                 \
    const long token_ = base + t_;                                                                 \
    if (kind == 0) {                                                                               \
      gsv = d == 0 ? (t_ > 0) : (t_ < T - 1);                                                      \
      const h16* pb_ = p.proj + token_ * INC + RW_OFF + c0;                                        \
      const h16* ps_ = gsv ? p.proj + (token_ + (d == 0 ? -1 : 1)) * INC + RW_OFF + c0 : pb_;      \
      g0 = *(const half8*)pb_; g1 = *(const half8*)(pb_ + 256); g2 = *(const half8*)(pb_ + 512);   \
      g3 = *(const half8*)ps_; g4 = *(const half8*)(ps_ + 256); g5 = *(const half8*)(ps_ + 512);   \
      g6 = *(const half8*)(p.rwaux + ((token_ * 2 + d) * 2 + 0) * 256 + c0);                       \
      g7 = *(const half8*)(p.rwaux + ((token_ * 2 + d) * 2 + 1) * 256 + c0);                       \
      gf0 = p.rwsc[((token_ * 2 + d) * 4 + h) * 2];                                                \
    } else {                                                                                       \
      const h16* dp_ = p.dnp + token_ * 768 + c0;                                                  \
      g0 = *(const half8*)dp_; g1 = *(const half8*)(dp_ + 256); g2 = *(const half8*)(dp_ + 512);   \
      const float* sc_ = p.dnsc + ((token_ * 2 + d) * 4 + h) * 2;                                  \
      gf0 = sc_[0]; gf1 = sc_[1];                                                                  \
    }                                                                                              \
  }
  SC_LOADG(0)
  for (int s0i = 0; s0i < T; s0i += SC_CT) {
    __syncthreads();
    if (s0i > 0) SC_FLUSH(s0i - SC_CT)
    {
      f32x4 va[2], vw[2], vb[2], vk[2], vr[2], vv_[2];
      if (kind == 0) {
#pragma unroll
        for (int e = 0; e < 8; ++e) {
          float b_ = (float)g0[e], s_ = gsv ? (float)g3[e] : 0.f; const float rr = b_ + (s_ - b_) * cmr[e];
          b_ = (float)g1[e]; s_ = gsv ? (float)g4[e] : 0.f; const float kr = b_ + (s_ - b_) * cmk[e];
          b_ = (float)g2[e]; s_ = gsv ? (float)g5[e] : 0.f; const float vl = b_ + (s_ - b_) * cmv[e];
          const float asg = (float)g7[e];
          const float kk = kr * ckk[e] * gf0;
          va[e >> 2][e & 3] = -kk; vw[e >> 2][e & 3] = __expf(-(float)g6[e]); vb[e >> 2][e & 3] = kk * asg;
          vk[e >> 2][e & 3] = kr * (1.0f + (asg - 1.0f) * cka[e]); vr[e >> 2][e & 3] = rr; vv_[e >> 2][e & 3] = vl;
        }
      } else {
        const float beta = gf0, alpha = gf1;
#pragma unroll
        for (int e = 0; e < 8; ++e) {
          const float k = (float)g1[e];
          va[e >> 2][e & 3] = k; vw[e >> 2][e & 3] = alpha; vb[e >> 2][e & 3] = -alpha * beta * k;
          vk[e >> 2][e & 3] = beta * k; vr[e >> 2][e & 3] = (float)g0[e]; vv_[e >> 2][e & 3] = (float)g2[e];
        }
      }
      const int lo_ = ls * 64 + jb;
      *(f32x4*)(LA + lo_) = va[0]; *(f32x4*)(LA + lo_ + 4) = va[1]; *(f32x4*)(LW + lo_) = vw[0]; *(f32x4*)(LW + lo_ + 4) = vw[1];
      *(f32x4*)(LB + lo_) = vb[0]; *(f32x4*)(LB + lo_ + 4) = vb[1]; *(f32x4*)(LK + lo_) = vk[0]; *(f32x4*)(LK + lo_ + 4) = vk[1];
      *(f32x4*)(LR + lo_) = vr[0]; *(f32x4*)(LR + lo_ + 4) = vr[1]; *(f32x4*)(LV + lo_) = vv_[0]; *(f32x4*)(LV + lo_ + 4) = vv_[1];
    }
    __syncthreads();
    if (s0i + SC_CT < T) SC_LOADG(s0i + SC_CT)
    __builtin_amdgcn_sched_barrier(0);
#define SC_LD(A4, W4, B4, K4, R4, VV, Q)                                                                    \
    { const int o_ = (Q) * 64; A4 = *(const f32x4*)(LA + o_ + j0); W4 = *(const f32x4*)(LW + o_ + j0); B4 = *(const f32x4*)(LB + o_ + j0); \
      K4 = *(const f32x4*)(LK + o_ + j0); R4 = *(const f32x4*)(LR + o_ + j0); VV = *(const f32x2*)(LV + o_ + i); }
#define SC_STEP(ca, cw, cb, ck, cr, cv, Q)                                                                  \
    {                                                                                                       \
      float sa = S[0] * ca[0] + S[1] * ca[1] + S[2] * ca[2] + S[3] * ca[3];                                 \
      float sb = S1[0] * ca[0] + S1[1] * ca[1] + S1[2] * ca[2] + S1[3] * ca[3];                             \
      sa = sum16(sa); sb = sum16(sb);                                                                       \
      _Pragma("unroll") for (int c = 0; c < 4; ++c) { S[c] = S[c] * cw[c] + sa * cb[c] + cv[0] * ck[c]; S1[c] = S1[c] * cw[c] + sb * cb[c] + cv[1] * ck[c]; } \
      float o = S[0] * cr[0] + S[1] * cr[1] + S[2] * cr[2] + S[3] * cr[3];                                  \
      float o1 = S1[0] * cr[0] + S1[1] * cr[1] + S1[2] * cr[2] + S1[3] * cr[3];                             \
      o = sum16(o); o1 = sum16(o1);                                                                         \
      if (cl == 0) { half2v ov; ov[0] = (h16)o; ov[1] = (h16)o1; *(half2v*)(obuf + (Q) * 32 + wv * 8 + g * 2) = ov; } \
    }
    f32x4 a4, w4, b4, k4, r4, a5, w5, b5, k5, r5; f32x2 vv, vv5;
    SC_LD(a4, w4, b4, k4, r4, vv, 0)
    for (int q = 0; q < SC_CT; q += 2) {
      SC_LD(a5, w5, b5, k5, r5, vv5, q + 1)
      SC_STEP(a4, w4, b4, k4, r4, vv, q)
      if (q + 2 < SC_CT) SC_LD(a4, w4, b4, k4, r4, vv, q + 2)
      SC_STEP(a5, w5, b5, k5, r5, vv5, q + 1)
    }
#undef SC_LD
#undef SC_STEP
  }
  __syncthreads();
  SC_FLUSH(T - SC_CT)
#undef SC_FLUSH
  if (ctx) {
    if (kind == 0) {
      float* so = p.orw + (((((long)bi) * 2 + l) * 2 + d) * 4 + h) * 4096;
      *(f32x4*)(so + i * 64 + j0) = S; *(f32x4*)(so + (i + 1) * 64 + j0) = S1;
    } else {
      float* so = p.odn + (((((long)bi) * 2 + l) * 2 + d) * 4 + h) * 4096;
#pragma unroll
      for (int c = 0; c < 4; ++c) { so[(j0 + c) * 64 + i] = S[c]; so[(j0 + c) * 64 + i + 1] = S1[c]; }
    }
  }
}
#undef SC_LOADG
__device__ void blk_fin(long w, const P& p, int l, const float* g2s, float* sgs) {
  const int tid_ = otid(); const int lane = tid_ & 63; const long token = w * 4 + (tid_ >> 6);
  float* sgw = sgs + (tid_ >> 6) * 64;
  const int c4 = lane * 4;
  const int hd = lane >> 4;
  const h16* pr = p.proj + token * INC;
  h16* ao = p.act + token * 1024;
  int t, T; long base; seqinfo(token, t, T, base);
  const bool sv0 = t > 0, sv1 = t < T - 1;
  const float bon0 = p.rwsc[((token * 2 + 0) * 4 + hd) * 2 + 1], bon1 = p.rwsc[((token * 2 + 1) * 4 + hd) * 2 + 1];
  const half4 vb = *(const half4*)(pr + RW_OFF + 512 + c4);
  half4 vm = vb, vp = vb;
  if (sv0) vm = *(const half4*)(pr - INC + RW_OFF + 512 + c4);
  if (sv1) vp = *(const half4*)(pr + INC + RW_OFF + 512 + c4);
  const half4 d_o0 = *(const half4*)(pr + DN_OFF + c4), d_o1 = *(const half4*)(pr + DN_OFF + 256 + c4);
  const half4 d_z = *(const half4*)(pr + DN_OFF + 784 + c4);
  const f32x4 mu0 = *(const f32x4*)(p.rwmu + ((long)l * 2 + 0) * 832 + 512 + c4), mu1 = *(const f32x4*)(p.rwmu + ((long)l * 2 + 1) * 832 + 512 + c4);
  const f32x4 lng = *(const f32x4*)(p.rwlng + l * 256 + c4), lnb = *(const f32x4*)(p.rwlnb + l * 256 + c4);
  const f32x4 dng = *(const f32x4*)(p.dnng + l * 64 + (c4 & 63));
  {
    half4 o0 = *(const half4*)(ao + 256 + c4), o1 = *(const half4*)(ao + 768 + c4);
    float o[4]; float mu = 0.f;
#pragma unroll
    for (int e = 0; e < 4; ++e) { o[e] = (float)o0[e] + (float)o1[e]; mu += o[e]; }
    mu = sum16(mu) * (1.0f / 64);
    float var = 0.f;
#pragma unroll
    for (int e = 0; e < 4; ++e) { float dl = o[e] - mu; var += dl * dl; }
    var = sum16(var) * (1.0f / 64);
    const float rs = 1.0f / sqrtf(var + 64e-5f);
    const float sg = sigmoidf_((float)pr[RW_OFF + 896 + lane]);
    float gate[4] = {0.f, 0.f, 0.f, 0.f};
    sgw[lane] = sg;
    __syncthreads();
#pragma unroll 8
    for (int j = 0; j < 64; ++j) {
      const float sj = sgw[j];
      const f32x4 g2 = *(const f32x4*)(g2s + j * 256 + c4);
#pragma unroll
      for (int e = 0; e < 4; ++e) gate[e] += sj * g2[e];
    }
    half4 out;
#pragma unroll
    for (int e = 0; e < 4; ++e) {
      const float b_ = (float)vb[e];
      const float v0 = b_ + ((sv0 ? (float)vm[e] : 0.f) - b_) * mu0[e];
      const float v1 = b_ + ((sv1 ? (float)vp[e] : 0.f) - b_) * mu1[e];
      float y = (o[e] - mu) * rs * lng[e] + lnb[e] + bon0 * v0 + bon1 * v1;
      out[e] = (h16)(y * gate[e]);
    }
    *(half4*)(ao + 256 + c4) = out;
  }
  {
    const half4 o0 = d_o0, o1 = d_o1, z = d_z;
    float o[4]; float ss = 0.f;
#pragma unroll
    for (int e = 0; e < 4; ++e) { o[e] = (float)o0[e] + (float)o1[e]; ss += o[e] * o[e]; }
    ss = sum16(ss);
    const float rs = 1.0f / sqrtf(ss * (1.0f / 64) + 1e-6f);
    half4 out;
#pragma unroll
    for (int e = 0; e < 4; ++e) out[e] = (h16)(o[e] * rs * dng[e] * siluf_((float)z[e]));
    *(half4*)(ao + 768 + c4) = out;
  }
}

__device__ __forceinline__ float dot8h(half8 u, half8 x, float d) {
#pragma unroll
  for (int e = 0; e < 8; ++e) d += (float)u[e] * (float)x[e];
  return d;
}
__device__ __forceinline__ void cvt8(const float* src, h16* dst, long i) {
  const f32x4 a = *(const f32x4*)(src + i * 8), b = *(const f32x4*)(src + i * 8 + 4);
  half8 o; o[0] = (h16)a[0]; o[1] = (h16)a[1]; o[2] = (h16)a[2]; o[3] = (h16)a[3]; o[4] = (h16)b[0]; o[5] = (h16)b[1]; o[6] = (h16)b[2]; o[7] = (h16)b[3];
  *(half8*)(dst + i * 8) = o;
}
__device__ __forceinline__ float sum64u(float x) {
  x = sum16(x);
  x += __builtin_bit_cast(float, __builtin_amdgcn_update_dpp(0, __builtin_bit_cast(int, x), 0x142, 0xA, 0xF, false));
  x += __builtin_bit_cast(float, __builtin_amdgcn_update_dpp(0, __builtin_bit_cast(int, x), 0x143, 0xC, 0xF, false));
  return __builtin_bit_cast(float, __builtin_amdgcn_readlane(__builtin_bit_cast(int, x), 63));
}
__device__ __forceinline__ float ferf(float x) {
  const float ax = fabsf(x);
  const float t = __frcp_rn(1.0f + 0.3275911f * ax);
  const float y = 1.0f - (((((1.061405429f * t - 1.453152027f) * t) + 1.421413741f) * t - 0.284496736f) * t + 0.254829592f) * t * __expf(-ax * ax);
  return x < 0.f ? -y : y;
}
__device__ __forceinline__ void cvt16_fp8(const float* src, unsigned char* dst, long i, float scale) {
  u32x4 o;
#pragma unroll
  for (int k = 0; k < 4; ++k) {
    const f32x4 a = *(const f32x4*)(src + i * 16 + k * 4);
    int w = __builtin_amdgcn_cvt_pk_fp8_f32(a[0] * scale, a[1] * scale, 0, false);
    w = __builtin_amdgcn_cvt_pk_fp8_f32(a[2] * scale, a[3] * scale, w, true);
    o[k] = (unsigned)w;
  }
  *(u32x4*)(dst + i * 16) = o;
}
__device__ void fin_phase(const P& p, int l) {
  float* g2s = (float*)g_smem;
  float* sgs = g2s + 64 * 256;
  const int tid = otid();
  __syncthreads();
  const f32x4* src = (const f32x4*)(p.rwg2 + (long)l * 64 * 256);
#pragma unroll
  for (int j = 0; j < 16; ++j) ((f32x4*)g2s)[tid + 256 * j] = src[tid + 256 * j];
  __syncthreads();
  for (long w = blockIdx.x; w < NT / 4; w += gridDim.x) blk_fin(w, p, l, g2s, sgs);
}
typedef unsigned u32x2 __attribute__((ext_vector_type(2)));
__device__ __forceinline__ void cvt16_fp4(const float* src, unsigned char* dst, long i, float scale) {
  u32x2 o;
#pragma unroll
  for (int k = 0; k < 2; ++k) {
    const f32x4 a = *(const f32x4*)(src + i * 16 + k * 8), b = *(const f32x4*)(src + i * 16 + k * 8 + 4);
    unsigned w = 0u;
    w = __builtin_amdgcn_cvt_scalef32_pk_fp4_f32(w, a[0] * scale, a[1] * scale, 1.0f, 0);
    w = __builtin_amdgcn_cvt_scalef32_pk_fp4_f32(w, a[2] * scale, a[3] * scale, 1.0f, 1);
    w = __builtin_amdgcn_cvt_scalef32_pk_fp4_f32(w, b[0] * scale, b[1] * scale, 1.0f, 2);
    w = __builtin_amdgcn_cvt_scalef32_pk_fp4_f32(w, b[2] * scale, b[3] * scale, 1.0f, 3);
    o[k] = w;
  }
  *(u32x2*)(dst + i * 8) = o;
}
#define PEER_USCALE 48.0f
#define PEER_VSCALE 16.0f
struct PairTab { int a[50]; int b[50]; };
__host__ __device__ constexpr PairTab make_pairs() {
  PairTab t{}; int n = 0;
  for (int a = 0; a < 16; ++a) for (int b = 0; b < 16; ++b) if ((a + 1) * (b + 1) <= 16) { t.a[n] = a; t.b[n] = b; ++n; }
  return t;
}
template <bool DRY>
__device__ void blk_peer(long w, const P& p, int l) {
  constexpr PairTab PT = make_pairs();
  const int tid_ = otid(); const int lane = tid_ & 63, wv = tid_ >> 6; const long token = w * 4 + wv;
  int* eidx = (int*)g_smem + wv * 256; float* egate = (float*)g_smem + wv * 256 + 128;
  const h16* xr = p.act + token * 1024 + lane * 16;
  const half8 x0 = *(const half8*)xr, x1 = *(const half8*)(xr + 8);
  int la = 0, lb = 0;
#pragma unroll
  for (int j = 0; j < 50; ++j) if (lane == j) { la = PT.a[j]; lb = PT.b[j]; }
  const int lc = la * 16 + lb;
  __syncthreads();
  float cs_[8]; int ce_[8];
#pragma unroll
  for (int hd = 0; hd < 8; ++hd) {
    const float* s1 = p.tks + token * 256 + hd * 32; const int* i1 = p.tki + token * 256 + hd * 32;
    const int la_ = lane < 50 ? la : 0, lb_ = lane < 50 ? lb : 0;
    cs_[hd] = s1[la_] + s1[16 + lb_]; ce_[hd] = i1[la_] * CFG_NKEYS + i1[16 + lb_];
  }
#pragma unroll
  for (int hd = 0; hd < 8; ++hd) {
    const float s = lane < 50 ? cs_[hd] : -3.0e38f;
    int rank = 0;
#pragma unroll
    for (int j = 0; j < 50; ++j) {
      const float sj = __builtin_bit_cast(float, __builtin_amdgcn_readlane(__builtin_bit_cast(int, s), j));
      rank += (sj > s) ? 1 : 0;
    }
    {
      int mk = (lane < 50 && rank < 16) ? (1 << rank) : 0;
      mk |= __builtin_amdgcn_update_dpp(0, mk, 0x128, 0xF, 0xF, true); mk |= __builtin_amdgcn_update_dpp(0, mk, 0x124, 0xF, 0xF, true);
      mk |= __builtin_amdgcn_update_dpp(0, mk, 0xB1, 0xF, 0xF, true);  mk |= __builtin_amdgcn_update_dpp(0, mk, 0x4E, 0xF, 0xF, true);
      const int mall = __builtin_amdgcn_readlane(mk, 0) | __builtin_amdgcn_readlane(mk, 16) | __builtin_amdgcn_readlane(mk, 32) | __builtin_amdgcn_readlane(mk, 48);
      const int nsel = __builtin_popcountll(__ballot(lane < 50 && rank < 16));
      if (mall != 0xFFFF || nsel != 16) {
        rank = 0;
#pragma unroll 1
        for (int j = 0; j < 50; ++j) {
          const float sj = __builtin_bit_cast(float, __builtin_amdgcn_readlane(__builtin_bit_cast(int, s), j));
          rank += (sj > s || (sj == s && j < lane)) ? 1 : 0;
        }
      }
    }
    const bool sel = lane < 50 && rank < 16;
    const float m = __builtin_bit_cast(float, __builtin_amdgcn_readlane(__builtin_bit_cast(int, s), 0));
    const float e = sel ? expf(s - m) : 0.f;
    const float sum = sum64(e);
    if (sel) { eidx[hd * 16 + rank] = ce_[hd]; egate[hd * 16 + rank] = e / sum; }
  }
  __syncthreads();
  f32x2 x2[8];
#pragma unroll
  for (int e = 0; e < 4; ++e) { x2[e][0] = (float)x0[2 * e]; x2[e][1] = (float)x0[2 * e + 1]; x2[4 + e][0] = (float)x1[2 * e]; x2[4 + e][1] = (float)x1[2 * e + 1]; }
  f32x2 acc2[8];
#pragma unroll
  for (int e = 0; e < 8; ++e) { acc2[e][0] = 0.f; acc2[e][1] = 0.f; }
  const unsigned char* u8 = (const unsigned char*)p.u16; const unsigned char* v8 = (const unsigned char*)p.v16;
#define PEER_LOAD(U, V, GT, EB)                                                                   \
  _Pragma("unroll") for (int q = 0; q < 8; ++q) {                                                 \
    const unsigned ro_ = (unsigned)eidx[(EB) + q] * 512u + (unsigned)lane * 8u; GT[q] = egate[(EB) + q];   \
    U[q] = *(const u32x2*)(u8 + ro_); V[q] = *(const u32x2*)(v8 + ro_);                           \
  }
#define PEER_COMP(U, V, GT)                                                                       \
  {                                                                                               \
    float dd_[8];                                                                                 \
    _Pragma("unroll") for (int q = 0; q < 8; ++q) {                                               \
      f32x2 d2 = {0.f, 0.f};                                                                      \
      _Pragma("unroll") for (int k = 0; k < 2; ++k) {                                             \
        d2 += __builtin_amdgcn_cvt_scalef32_pk_f32_fp4(U[q][k], 1.0f, 0) * x2[4 * k];             \
        d2 += __builtin_amdgcn_cvt_scalef32_pk_f32_fp4(U[q][k], 1.0f, 1) * x2[4 * k + 1];         \
        d2 += __builtin_amdgcn_cvt_scalef32_pk_f32_fp4(U[q][k], 1.0f, 2) * x2[4 * k + 2];         \
        d2 += __builtin_amdgcn_cvt_scalef32_pk_f32_fp4(U[q][k], 1.0f, 3) * x2[4 * k + 3];         \
      }                                                                                           \
      dd_[q] = sum64u(d2[0] + d2[1]) * (1.0f / PEER_USCALE);                                      \
    }                                                                                             \
      \
    float dv_ = dd_[7];                                                                           \
    _Pragma("unroll") for (int q = 6; q >= 0; --q) dv_ = lane == q ? dd_[q] : dv_;                \
    const float gv_ = 0.5f * dv_ * (1.0f + erff(dv_ * 0.70710678118654752f));                     \
    _Pragma("unroll") for (int q = 0; q < 8; ++q) {                                               \
      const float wgt = GT[q] * __builtin_bit_cast(float, __builtin_amdgcn_readlane(__builtin_bit_cast(int, gv_), q)) * (1.0f / PEER_VSCALE); \
      const f32x2 w2 = {wgt, wgt};                                                                \
      _Pragma("unroll") for (int k = 0; k < 2; ++k) {                                             \
        acc2[4 * k] += w2 * __builtin_amdgcn_cvt_scalef32_pk_f32_fp4(V[q][k], 1.0f, 0);           \
        acc2[4 * k + 1] += w2 * __builtin_amdgcn_cvt_scalef32_pk_f32_fp4(V[q][k], 1.0f, 1);       \
        acc2[4 * k + 2] += w2 * __builtin_amdgcn_cvt_scalef32_pk_f32_fp4(V[q][k], 1.0f, 2);       \
        acc2[4 * k + 3] += w2 * __builtin_amdgcn_cvt_scalef32_pk_f32_fp4(V[q][k], 1.0f, 3);       \
      }                                                                                           \
    }                                                                                             \
  }
  u32x2 au[8], av[8], bu[8], bv[8];
  float ag[8], bg[8];
  PEER_LOAD(au, av, ag, 0)
  for (int eb = 0; eb < 128; eb += 16) {
    PEER_LOAD(bu, bv, bg, eb + 8)
    __builtin_amdgcn_sched_barrier(0);
    PEER_COMP(au, av, ag)
    if (eb + 16 < 128) { PEER_LOAD(au, av, ag, eb + 16) }
    __builtin_amdgcn_sched_barrier(0);
    PEER_COMP(bu, bv, bg)
  }
#undef PEER_LOAD
#undef PEER_COMP
  const float* g2 = p.mod + ((long)l * NCOND + condrow(token)) * 6144 + 5120 + lane * 16;
  float* xo = p.X + token * 1024 + lane * 16;
  f32x4 xn[4]; float ssq = 0.f;
#pragma unroll
  for (int k = 0; k < 4; ++k) {
    xn[k] = *(f32x4*)(xo + 4 * k);
    const f32x4 ga = *(const f32x4*)(g2 + 4 * k);
#pragma unroll
    for (int e = 0; e < 4; ++e) { xn[k][e] += ga[e] * acc2[2 * k + (e >> 1)][e & 1]; ssq += xn[k][e] * xn[k][e]; }
  }
  if (DRY) { if (acc2[0][0] == 123456.789f) *(f32x4*)xo = xn[0]; return; }
  const float rstd = 1.0f / sqrtf(sum64u(ssq) * (1.0f / 1024) + 1e-6f);
  if (l == 0) {
    const float* m = p.mod + ((long)1 * NCOND + condrow(token)) * 6144 + lane * 16;
    const float* g = p.n1g + 1024 + lane * 16;
    half8 h0, h1;
    f32x4 gga[4], sha[4], sca[4];
#pragma unroll
    for (int k = 0; k < 4; ++k) { gga[k] = *(const f32x4*)(g + 4 * k); sha[k] = *(const f32x4*)(m + 4 * k); sca[k] = *(const f32x4*)(m + 1024 + 4 * k); }
#pragma unroll
    for (int k = 0; k < 4; ++k) {
      *(f32x4*)(xo + 4 * k) = xn[k];
      const f32x4 gg = gga[k], sh = sha[k], sc = sca[k];
#pragma unroll
      for (int e = 0; e < 4; ++e) {
        const h16 hv = (h16)((xn[k][e] * rstd * gg[e]) * (1.0f + sc[e]) + sh[e]);
        if (k < 2) h0[4 * k + e] = hv; else h1[4 * (k - 2) + e] = hv;
      }
    }
    h16* ho = p.act + token * 1024 + lane * 16;
    *(half8*)ho = h0; *(half8*)(ho + 8) = h1;
  } else {
    f32x4 fga[4];
#pragma unroll
    for (int k = 0; k < 4; ++k) fga[k] = *(const f32x4*)(p.fng + lane * 16 + 4 * k);
#pragma unroll
    for (int k = 0; k < 4; ++k) {
      const f32x4 gg = fga[k];
      f32x4 y;
#pragma unroll
      for (int e = 0; e < 4; ++e) y[e] = xn[k][e] * rstd * gg[e];
      *(f32x4*)(xo + 4 * k) = y;
    }
  }
}

__device__ void blk_attn(int type, int idx, const P& p, int l) {
  h16* Ks = (h16*)g_smem;
  h16* Vt = Ks + 64 * 72;
  float* Bt = (float*)(Vt + 64 * 72);
  const int tid = otid(), lane = tid & 63, wv = tid >> 6, ql = lane & 31, hh = lane >> 5;
  int b, hk, tb; long qtok; int qcol_off, kcol_off, vcol_off, outcol; float qscale; int ntl, ntc; long kbase_tok;
  const float *ck = nullptr, *cv = nullptr;
  int grow = 0, r0w = 0, krmin = 0;
  if (type == 0) {
    tb = idx & 3; hk = (idx >> 2) & 1; b = idx >> 3;
    const int head = hk * 2 + (wv & 1);
    kbase_tok = (long)b * CFG_SEQ; qtok = kbase_tok + tb * 64 + (wv >> 1) * 32 + ql;
    qcol_off = head * 64; kcol_off = 256 + hk * 64; vcol_off = 384 + hk * 64; outcol = head * 64; qscale = 1.0f; ntl = CFG_SEQ / 64; ntc = 0;
  } else if (type == 1) {
    tb = idx & 63; hk = (idx >> 6) & 1; b = idx >> 7;
    const int head = hk * 2 + (wv & 1);
    kbase_tok = (long)NTC + (long)b * CFG_DS; qtok = kbase_tok + tb * 64 + (wv >> 1) * 32 + ql;
    qcol_off = head * 64; kcol_off = 256 + hk * 64; vcol_off = 384 + hk * 64; outcol = head * 64; qscale = 1.0f; ntl = CFG_DS / 64; ntc = CFG_PAST / 64;
    ck = p.cgk + (((long)b * 2 + l) * 2 + hk) * CFG_PAST * 64; cv = p.cgv + (((long)b * 2 + l) * 2 + hk) * CFG_PAST * 64;
  } else if (type == 2) {
    tb = idx & 1; hk = (idx >> 1) & 3; b = idx >> 3;
    kbase_tok = (long)b * CFG_SEQ; qtok = kbase_tok + tb * 128 + wv * 32 + ql;
    qcol_off = NA_OFF + hk * 64; kcol_off = NA_OFF + 256 + hk * 64; vcol_off = NA_OFF + 512 + hk * 64; outcol = 512 + hk * 64; qscale = 0.125f; ntl = CFG_SEQ / 64; ntc = 0;
  } else {
    tb = idx & 31; hk = (idx >> 5) & 3; b = idx >> 7;
    kbase_tok = (long)NTC + (long)b * CFG_DS;
    grow = tb * 2 + (wv >> 1);
    qtok = kbase_tok + grow * 64 + (wv & 1) * 32 + ql;
    qcol_off = NA_OFF + hk * 64; kcol_off = NA_OFF + 256 + hk * 64; vcol_off = NA_OFF + 512 + hk * 64; outcol = 512 + hk * 64; qscale = 0.125f;
    r0w = grow - WR / 2; r0w = r0w < 0 ? 0 : (r0w > GROWS - WR ? GROWS - WR : r0w);
    int ra = tb * 2 - WR / 2; ra = ra < 0 ? 0 : (ra > GROWS - WR ? GROWS - WR : ra);
    int rb = tb * 2 + 1 - WR / 2; rb = rb < 0 ? 0 : (rb > GROWS - WR ? GROWS - WR : rb);
    krmin = ra; ntl = rb + WR - ra; ntc = CFG_PAST / 64;
    ck = p.cnk + (((long)b * 2 + l) * 4 + hk) * CFG_PAST * 64; cv = p.cnv + (((long)b * 2 + l) * 4 + hk) * CFG_PAST * 64;
  }
  const int nt = ntl + ntc;
  __syncthreads();
  if (type == 3) { for (int e = tid; e < 465; e += 256) Bt[e] = p.nabias[((long)l * 4 + hk) * 465 + e]; }
  half8 qf[4];
  {
    const h16* qp = p.proj + qtok * INC + qcol_off + hh * 8;
#pragma unroll
    for (int ds = 0; ds < 4; ++ds) qf[ds] = *(const half8*)(qp + ds * 16);
  }
  const int qc = (int)((qtok - kbase_tok) & 63);
  int cst = qc - 8; cst = cst < 0 ? 0 : (cst > 48 ? 48 : cst);
  f32x16 o0 = {0.f, 0.f, 0.f, 0.f, 0.f, 0.f, 0.f, 0.f, 0.f, 0.f, 0.f, 0.f, 0.f, 0.f, 0.f, 0.f};
  f32x16 o1 = o0;
  float m = -1.0e30f, lsum = 0.f;
  half8 kx0, kx1, vx0, vx1;
  const int skey0 = tid >> 3, sdc = tid & 7;
#define ATT_LOAD(TI)                                                                                       \
  {                                                                                                        \
    const int ti_ = (TI);                                                                                  \
    if (ti_ < ntc) {                                                                                       \
      const float* kk_ = ck + ((long)ti_ * 64 + skey0) * 64 + sdc * 8;                                     \
      const float* vv_ = cv + ((long)ti_ * 64 + skey0) * 64 + sdc * 8;                                     \
      f32x4 a_ = *(const f32x4*)kk_, b_ = *(const f32x4*)(kk_ + 4), c_ = *(const f32x4*)(kk_ + 2048), d_ = *(const f32x4*)(kk_ + 2052); \
      _Pragma("unroll") for (int e = 0; e < 4; ++e) { kx0[e] = (h16)a_[e]; kx0[4 + e] = (h16)b_[e]; kx1[e] = (h16)c_[e]; kx1[4 + e] = (h16)d_[e]; } \
      a_ = *(const f32x4*)vv_; b_ = *(const f32x4*)(vv_ + 4); c_ = *(const f32x4*)(vv_ + 2048); d_ = *(const f32x4*)(vv_ + 2052); \
      _Pragma("unroll") for (int e = 0; e < 4; ++e) { vx0[e] = (h16)a_[e]; vx0[4 + e] = (h16)b_[e]; vx1[e] = (h16)c_[e]; vx1[4 + e] = (h16)d_[e]; } \
    } else {                                                                                               \
      const long t0_ = kbase_tok + (long)((type == 3 ? krmin : 0) + (ti_ - ntc)) * 64;                     \
      const h16* r_ = p.proj + (t0_ + skey0) * INC + sdc * 8;                                              \
      kx0 = *(const half8*)(r_ + kcol_off); kx1 = *(const half8*)(r_ + 32 * INC + kcol_off);              \
      vx0 = *(const half8*)(r_ + vcol_off); vx1 = *(const half8*)(r_ + 32 * INC + vcol_off);              \
    }                                                                                                      \
  }
  ATT_LOAD(0)
  for (int ti = 0; ti < nt; ++ti) {
    __syncthreads();
    *(half8*)(Ks + skey0 * 72 + sdc * 8) = kx0; *(half8*)(Ks + (skey0 + 32) * 72 + sdc * 8) = kx1;
    *(half8*)(Vt + skey0 * 72 + sdc * 8) = vx0; *(half8*)(Vt + (skey0 + 32) * 72 + sdc * 8) = vx1;
    __syncthreads();
    if (ti + 1 < nt) ATT_LOAD(ti + 1)
    __builtin_amdgcn_sched_barrier(0);
    const bool local = type == 3 && ti >= ntc;
    const int kr = krmin + (ti - ntc);
    if (local && (kr < r0w || kr >= r0w + WR)) continue;
    f32x16 s0 = {0.f, 0.f, 0.f, 0.f, 0.f, 0.f, 0.f, 0.f, 0.f, 0.f, 0.f, 0.f, 0.f, 0.f, 0.f, 0.f};
    f32x16 s1 = s0;
#pragma unroll
    for (int ds = 0; ds < 4; ++ds) {
      const half8 a0 = *(const half8*)(Ks + ql * 72 + ds * 16 + hh * 8);
      const half8 a1 = *(const half8*)(Ks + (32 + ql) * 72 + ds * 16 + hh * 8);
      s0 = __builtin_amdgcn_mfma_f32_32x32x16_f16(a0, qf[ds], s0, 0, 0, 0);
      s1 = __builtin_amdgcn_mfma_f32_32x32x16_f16(a1, qf[ds], s1, 0, 0, 0);
    }
    float mx = -1.0e30f;
    if (local) {
      const float* brow = Bt + (kr - grow + 7) * 31 + 15 - qc;
#pragma unroll
      for (int i = 0; i < 16; ++i) {
        const int kc0 = (i & 3) + 8 * (i >> 2) + 4 * hh, kc1 = kc0 + 32;
        s0[i] = (kc0 >= cst && kc0 < cst + 16) ? s0[i] * 0.125f + brow[kc0] : -1.0e30f;
        s1[i] = (kc1 >= cst && kc1 < cst + 16) ? s1[i] * 0.125f + brow[kc1] : -1.0e30f;
      }
    } else if (qscale != 1.0f) {
#pragma unroll
      for (int i = 0; i < 16; ++i) { s0[i] *= qscale; s1[i] *= qscale; }
    }
#pragma unroll
    for (int i = 0; i < 16; ++i) mx = fmaxf(mx, fmaxf(s0[i], s1[i]));
    mx = fmaxf(mx, __shfl_xor(mx, 32));
    const float mn = fmaxf(m, mx);
    const float alpha = __expf(m - mn);
    m = mn; lsum *= alpha;
#pragma unroll
    for (int i = 0; i < 16; ++i) { o0[i] *= alpha; o1[i] *= alpha; }
    float ps = 0.f;
#pragma unroll
    for (int i = 0; i < 16; ++i) { s0[i] = __expf(s0[i] - mn); s1[i] = __expf(s1[i] - mn); ps += s0[i] + s1[i]; }
    lsum += ps;
    half8 pf0, pf1, pf2, pf3;
#pragma unroll
    for (int j = 0; j < 8; ++j) { pf0[j] = (h16)s0[j]; pf1[j] = (h16)s0[8 + j]; pf2[j] = (h16)s1[j]; pf3[j] = (h16)s1[8 + j]; }
#define TRD(ptr) __builtin_bit_cast(half4, __builtin_amdgcn_ds_read_tr16_b64_v4i16((__attribute__((address_space(3))) s16x4v*)(ptr)))
#define ATT_PV(KS, PF)                                                                              \
    {                                                                                               \
        \
      const h16* v0_ = Vt + (16 * (KS) + 4 * hh + ((lane & 15) >> 2)) * 72 + 16 * ((lane >> 4) & 1) + 4 * (lane & 3); \
      const half4 lo0 = TRD(v0_), hi0 = TRD(v0_ + 8 * 72);                                          \
      const half4 lo1 = TRD(v0_ + 32), hi1 = TRD(v0_ + 8 * 72 + 32);                                \
      const half8 a0_ = __builtin_shufflevector(lo0, hi0, 0, 1, 2, 3, 4, 5, 6, 7);                  \
      const half8 a1_ = __builtin_shufflevector(lo1, hi1, 0, 1, 2, 3, 4, 5, 6, 7);                  \
      o0 = __builtin_amdgcn_mfma_f32_32x32x16_f16(a0_, PF, o0, 0, 0, 0);                            \
      o1 = __builtin_amdgcn_mfma_f32_32x32x16_f16(a1_, PF, o1, 0, 0, 0);                            \
    }
    ATT_PV(0, pf0) ATT_PV(1, pf1) ATT_PV(2, pf2) ATT_PV(3, pf3)
#undef ATT_PV
#undef TRD
  }
#undef ATT_LOAD
  lsum += __shfl_xor(lsum, 32);
  const float inv = 1.0f / lsum;
  h16* op = p.act + qtok * 1024 + outcol;
#pragma unroll
  for (int g = 0; g < 4; ++g) {
    half4 a, c;
#pragma unroll
    for (int e = 0; e < 4; ++e) { a[e] = (h16)(o0[4 * g + e] * inv); c[e] = (h16)(o1[4 * g + e] * inv); }
    *(half4*)(op + 8 * g + 4 * hh) = a;
    *(half4*)(op + 32 + 8 * g + 4 * hh) = c;
  }
}
#define N_SCAN_LAT (2 * 2 * CFG_DB * 4 * 2)
#define N_SCAN_CTX (2 * 2 * CFG_BATCH * 4 * 2)
#define N_ATT1 (CFG_DB * 2 * (CFG_DS / 64))
#define N_ATT3 (CFG_DB * 4 * (CFG_DS / 128))
#define N_ATT0 (CFG_BATCH * 2 * (CFG_SEQ / 64))
#define N_ATT2 (CFG_BATCH * 4 * (CFG_SEQ / 128))
__device__ __forceinline__ void run_scan_item(int r, bool latent, const P& p, int l) {
  const int rq = r & 1; r >>= 1; const int kind = r & 1; r >>= 1; const int d = r & 1; r >>= 1; const int h = r & 3; r >>= 2;
  blk_scan2(kind, latent ? CFG_BATCH + r : r, h, d, rq, p, l);
}
__device__ void mixer_phase(const P& p, int lc, int mode = 0) {
  const int l = lc & 1;
  __shared__ long s_item;
  __shared__ unsigned s_slot;
  const long total = N_SCAN_CTX + N_ATT1 + N_ATT3 + N_ATT0 + N_ATT2;
  unsigned* lat_cnt = p.counters + 8 + lc;
  if (mode == 0) {
    __syncthreads();
    if (threadIdx.x == 0) {
      const unsigned hw = __builtin_amdgcn_s_getreg((31 << 11) | 4);
      const unsigned xcc = __builtin_amdgcn_s_getreg((3 << 11) | 20) & 0xFu;
      const unsigned key = (xcc << 8) | ((hw >> 8) & 0xFFu);
      const unsigned slot = atomicAdd(p.cucnt + lc * 4096 + key, 1u);
      s_slot = slot;
      s_item = slot == 0 ? (long)atomicAdd(lat_cnt, 1u) : (long)N_SCAN_LAT;
    }
    __syncthreads();
    const long w = s_item;
    if (w < N_SCAN_LAT) run_scan_item((int)w, true, p, l);
  }
  for (;;) {
    __syncthreads();
    if (threadIdx.x == 0) s_item = (long)atomicAdd(p.counters + lc, 1u);
    __syncthreads();
    long w = s_item;
    if (mode == 2) w += N_SCAN_CTX;
    if (w >= (mode == 1 ? (long)N_SCAN_CTX : total)) break;
    if (w < N_SCAN_CTX) {
      run_scan_item((int)w, false, p, l);
    } else {
      int a = (int)(w - N_SCAN_CTX);
      int ty;
      if (a < N_ATT1) ty = 1;
      else if ((a -= N_ATT1) < N_ATT3) ty = 3;
      else if ((a -= N_ATT3) < N_ATT0) ty = 0;
      else { a -= N_ATT0; ty = 2; }
      blk_attn(ty, a, p, l);
    }
  }
  if (mode != 2) {
    for (;;) {
      __syncthreads();
      if (threadIdx.x == 0) s_item = (long)atomicAdd(lat_cnt, 1u);
      __syncthreads();
      const long w = s_item;
      if (w >= N_SCAN_LAT) break;
      run_scan_item((int)w, true, p, l);
    }
  }
}


#define XB_TMO      128
#define XB_XCNT(j)  (256  + 64 * (j))
#define XB_XSUB(j)  (1280 + 64 * (j))
#define XB_XGEN(j)  (2304 + 64 * (j))
#define XB_TOP      3328
#define XB_TOPGEN   3392
#define XCD_BAR_WORDS 3456
#define XB_SPIN_CAP (1u << 22)
#define LAS __attribute__((address_space(3)))
__device__ __forceinline__ unsigned xb_ld(unsigned* p)              { return __hip_atomic_load(p, __ATOMIC_RELAXED, __HIP_MEMORY_SCOPE_AGENT); }
__device__ __forceinline__ unsigned xb_add(unsigned* p, unsigned v) { return __hip_atomic_fetch_add(p, v, __ATOMIC_RELAXED, __HIP_MEMORY_SCOPE_AGENT); }
__device__ __forceinline__ unsigned xb_xcc_id() { return (unsigned)__builtin_amdgcn_s_getreg((3 << 11) | 20) & 0xFu; }
#define XB_SPIN(cond, bar) do { unsigned _sp = 0; while (cond) { __builtin_amdgcn_s_sleep(1); \
    if ((++_sp & 255u) == 0u) { if (xb_ld(&(bar)[XB_TMO])) break; if (_sp > XB_SPIN_CAP) { atomicAdd(&(bar)[XB_TMO], 1u); break; } } } } while (0)
struct XcdBarrier { unsigned* bar; unsigned x; volatile LAS unsigned* st; };
__device__ __forceinline__ XcdBarrier xcd_barrier_post(unsigned* bar, volatile LAS unsigned* st) {
  XcdBarrier b; b.bar = bar; b.x = xb_xcc_id(); b.st = st;
  if (threadIdx.x == 0) (void)xb_add(&bar[XB_XCNT(b.x)], 1u);
  return b;
}
__device__ __forceinline__ void xcd_barrier_complete(unsigned* bar, unsigned x, unsigned& nloc, unsigned& nx) {
  const unsigned G = gridDim.x * gridDim.y * gridDim.z;
  unsigned sum, cnt, mine, sp = 0u;
  for (;;) {
    sum = 0u; cnt = 0u; mine = 0u;
#pragma unroll
    for (unsigned j = 0; j < 16; ++j) { const unsigned c = xb_ld(&bar[XB_XCNT(j)]); sum += c; cnt += (c > 0u) ? 1u : 0u; mine = (j == x) ? c : mine; }
    if (sum == G) break;
    __builtin_amdgcn_s_sleep(1);
    if ((++sp & 255u) == 0u) { if (xb_ld(&bar[XB_TMO])) break; if (sp > XB_SPIN_CAP) { atomicAdd(&bar[XB_TMO], 1u); break; } }
  }
  nloc = mine > 0u ? mine : 1u; nx = cnt > 0u ? cnt : 1u;
}
__device__ __forceinline__ void xcd_barrier(const XcdBarrier& b) {
  asm volatile("s_waitcnt vmcnt(0)" ::: "memory");
  __syncthreads();
  if (threadIdx.x == 0) {
    unsigned* bar = b.bar;
    __builtin_amdgcn_s_waitcnt(0);
    unsigned nloc = b.st[0], nx = b.st[1];
    if (nloc == 0u) { xcd_barrier_complete(bar, b.x, nloc, nx); b.st[0] = nloc; b.st[1] = nx; }
    const unsigned old = xb_add(&bar[XB_XSUB(b.x)], 1u);
    const unsigned gen = old / nloc;
    if (old + 1u == (gen + 1u) * nloc) {
      __builtin_amdgcn_fence(__ATOMIC_RELEASE, "agent");
      asm volatile("s_waitcnt vmcnt(0)" ::: "memory");
      const unsigned og = xb_add(&bar[XB_TOP], 1u);
      const unsigned tg = og / nx;
      if (og + 1u == (tg + 1u) * nx) xb_add(&bar[XB_TOPGEN], 1u);
      else XB_SPIN(xb_ld(&bar[XB_TOPGEN]) == tg, bar);
      __builtin_amdgcn_fence(__ATOMIC_ACQUIRE, "agent");
      xb_add(&bar[XB_XGEN(b.x)], 1u);
      asm volatile("s_waitcnt vmcnt(0)" ::: "memory");
    } else {
      XB_SPIN(xb_ld(&bar[XB_XGEN(b.x)]) == gen, bar);
      __builtin_amdgcn_fence(__ATOMIC_ACQUIRE, "agent");
      asm volatile("s_waitcnt vmcnt(0)" ::: "memory");
    }
  }
  __syncthreads();
}

#define STAGE(fn, n) for (long i_ = (long)blockIdx.x * 256 + otid(); i_ < (long)(n); i_ += (long)gridDim.x * 256) fn(i_, p, l);
#define BSTAGE(fn, n) for (long w_ = blockIdx.x; w_ < (long)(n); w_ += gridDim.x) fn(w_, p, l);
#define SYNC { XcdBarrier xb_; xb_.bar = p.xbar; xb_.x = xb_xcc_id(); xb_.st = (volatile LAS unsigned*)&xb_words; xcd_barrier(xb_); }
__global__ void __launch_bounds__(256, 2) mega(P p) {
  cg::grid_group grid = cg::this_grid();
  __shared__ uint4 xb_words;
  if (threadIdx.x == 0) xb_words = make_uint4(0u, 0u, 0u, 0u);
  __syncthreads();
  (void)xcd_barrier_post(p.xbar, (volatile LAS unsigned*)&xb_words);
#define gtid ((long)blockIdx.x * 256 + otid())
#define gstride ((long)gridDim.x * 256)
  { int l = 0;
    if (gtid < 16) p.counters[gtid] = 0u;
    for (long i_ = gtid; i_ < 4 * 4096; i_ += gstride) p.cucnt[i_] = 0u;
    for (int rep_ = 0; rep_ < REP_S0; ++rep_) {
    for (long w_ = blockIdx.x; w_ < 3200; w_ += gridDim.x) blk_convert(w_, p);
    for (long w_ = blockIdx.x; w_ < 2L * NCOND * 24; w_ += gridDim.x) blk_mod(w_, p);
    for (long i_ = gtid; i_ < 2L * 16 * CFG_NKEYS * 128 / 8; i_ += gstride) cvt8(p.pkeys, p.keys16, i_);
    }
  }
  grid.sync();
#pragma unroll 1
  for (int ph = 0; ph < 18; ++ph) {
    const int l = ph >= 9 ? 1 : 0; const int k = ph - 9 * l;
    if (k == 0 && l == 1) continue;
    switch (k) {
      case 0: { BSTAGE(blk_norm<0>, NT / 4) } break;
      case 1: gemm_phase<0>(p, l); break;
      case 2: {
        STAGE(b_prep_gqa, (long)NT * 6)
        STAGE(b_prep_cache, (long)NTC * 640)
        half8 bf0 = {0, 0, 0, 0, 0, 0, 0, 0}, bf1 = bf0; int bkey = -1;
        for (long w_ = blockIdx.x; w_ < (long)N_PREP_RW + N_PREP_DN; w_ += gridDim.x) blk_scanprep(w_, p, l, bf0, bf1, bkey);
      } break;
      case 3:
#ifdef PROBE_MIXER2
        mixer_phase(p, l + 2); SYNC
#endif
        mixer_phase(p, l); break;
      case 4: fin_phase(p, l); break;
      case 5: {
        gemm_phase<1>(p, l);
        for (long i_ = gtid; i_ < (long)NEXP * 1024 / 16; i_ += gstride) {
          cvt16_fp4(p.pu + (long)l * NEXP * 1024, (unsigned char*)p.u16, i_, PEER_USCALE);
          cvt16_fp4(p.pv + (long)l * NEXP * 1024, (unsigned char*)p.v16, i_, PEER_VSCALE);
        }
      } break;
      case 6: { BSTAGE(blk_norm<1>, NT / 4) } break;
      case 7: gemm_phase<2>(p, l); break;
      default: { BSTAGE(blk_peer<false>, NT / 4) } break;
    }
    if (ph != 17) SYNC
  }
}
#else
#define STAGE(fn, n) { _Pragma("omp parallel for schedule(dynamic, 64)") for (long i_ = 0; i_ < (long)(n); ++i_) fn(i_, p, l); }
#define SYNC
void mega(P p) {
  { int l = 0;
    STAGE(b_init, (long)NT * 1024)
    STAGE(b_mod, 2L * NCOND * 6144)
  }
  for (int l = 0; l < 2; ++l) {
    STAGE(b_norm<0>, NT)
    STAGE(b_inproj, (long)NT * INC)
    STAGE(b_prep_gqa, (long)NT * 6)
    STAGE(b_prep_cache, (long)NTC * 640)
    STAGE(b_rwaux, (long)NT * 512)
    STAGE(b_dnconv, (long)NT * 768)
    STAGE(b_dnnorm, (long)NT * 8)
    STAGE(b_rwscan, NSCAN)
    STAGE(b_dnscan, NSCAN)
    STAGE(b_attn_gqa, (long)NT * 4)
    STAGE(b_attn_na, (long)NT * 4)
    STAGE(b_rwfin, (long)NT * 4)
    STAGE(b_dnfin, (long)NT * 4)
    STAGE(b_outproj, (long)NT * 1024)
    STAGE(b_norm<1>, NT)
    STAGE(b_peerq, (long)NT * 2048)
    STAGE(b_topk1, (long)NT * 16)
    STAGE(b_topk2, (long)NT * 8)
    STAGE(b_peer_act, (long)NT * 128)
    STAGE(b_peer_out, (long)NT * 1024)
  }
  { int l = 0; STAGE(b_final, NT) }
}
#endif

static void fill_params(P& p, void* const* d_in, void* d_out, void* d_ws) {
  const float** f = (const float**)&p;
  for (int i = 0; i < 39; ++i) f[i] = (const float*)d_in[i];
  float* o = (float*)d_out;
  p.X = o; o += (long)NT * 1024;
  p.ogk = o; o += (long)CFG_BATCH * 2 * 2 * CFG_SEQ * 64;
  p.ogv = o; o += (long)CFG_BATCH * 2 * 2 * CFG_SEQ * 64;
  p.onk = o; o += (long)CFG_BATCH * 2 * 4 * CFG_SEQ * 64;
  p.onv = o; o += (long)CFG_BATCH * 2 * 4 * CFG_SEQ * 64;
  p.orw = o; o += (long)CFG_BATCH * 2 * 2 * 4 * 4096;
  p.odn = o;
  char* w = (char*)d_ws;
  auto take = [&](size_t bytes) { char* r = w; w += (bytes + 255) & ~(size_t)255; return r; };
  p.xbar = (unsigned*)take(16384);
  p.counters = (unsigned*)take(256);
  p.cucnt = (unsigned*)take(4 * 4096 * 4);
  p.mod = (float*)take(2L * NCOND * 6144 * 4);
  p.act = (h16*)take((size_t)NT * 1024 * sizeof(h16));
  p.rwaux = (h16*)take((size_t)NT * 1024 * sizeof(h16));
  p.dnp = (h16*)take((size_t)NT * 768 * sizeof(h16));
  p.proj = (h16*)take((size_t)NT * INC * sizeof(h16));
  p.wtin = (h16*)take((size_t)2 * NPAD_IN * 1024 * sizeof(h16));
  p.wtout = (h16*)take((size_t)2 * 1024 * 1024 * sizeof(h16));
  p.wtq = (h16*)take((size_t)2 * 2048 * 1024 * sizeof(h16));
  p.rwsc = (float*)take((size_t)NT * 16 * 4);
  p.dnsc = (float*)take((size_t)NT * 16 * 4);
  p.keys16 = (h16*)take((size_t)2 * 16 * CFG_NKEYS * 128 * sizeof(h16));
  char* a = (char*)p.proj;
#ifdef HOST_EMU
  p.pq = (h16*)a; a += (size_t)NT * 2048 * sizeof(h16);
#endif
  p.tks = (float*)a; a += (size_t)NT * 256 * 4;
  p.tki = (int*)a; a += (size_t)NT * 256 * 4;
  p.u16 = (h16*)a; a += (size_t)NEXP * 1024 * sizeof(h16);
  p.v16 = (h16*)a; a += (size_t)NEXP * 1024 * sizeof(h16);
  p.pidx = (int*)p.rwaux;
  p.pact = (float*)((char*)p.rwaux + (size_t)NT * 128 * 4);
}

#ifndef HOST_EMU
extern "C" void kernel_launch(void* const* d_in, const int* in_sizes, int n_in, void* d_out, int out_size, void* d_ws,
                              size_t ws_size, hipStream_t stream) {
  static int grid_blocks = 0;
  if (!grid_blocks) {
    int dev = 0, cus = 0, per_cu = 0;
    (void)hipGetDevice(&dev);
    (void)hipDeviceGetAttribute(&cus, hipDeviceAttributeMultiprocessorCount, dev);
    (void)hipOccupancyMaxActiveBlocksPerMultiprocessor(&per_cu, mega, 256, 0);
    grid_blocks = cus * per_cu;
  }
  P p;
  memset(&p, 0, sizeof(p));
  fill_params(p, d_in, d_out, d_ws);
  (void)hipMemsetAsync(p.xbar, 0, 16384, stream);
  void* args[] = {&p};
  hipError_t e = hipLaunchCooperativeKernel((void*)mega, dim3(grid_blocks), dim3(256), args, 0, stream);
  if (e != hipSuccess) fprintf(stderr, "cooperative launch failed: %s (grid %d)\n", hipGetErrorString(e), grid_blocks);
}
#endif
```

```cpp
#ifndef HOST_EMU
#include <hip/hip_runtime.h>
#include <hip/hip_cooperative_groups.h>
namespace cg = cooperative_groups;
#define HD __device__ __forceinline__
#define HDN __device__ __noinline__
typedef _Float16 h16;
#define CBAR asm volatile("" ::: "memory")
#define SMEM_BYTES 73728
__shared__ __attribute__((aligned(16))) char g_smem[SMEM_BYTES];
__device__ __forceinline__ int otid() { int t = threadIdx.x; asm volatile("" : "+v"(t)); return t; }
#define FSIN(x) __sinf(x)
#define FCOS(x) __cosf(x)
#else
#include <cmath>
#include <cstring>
#define HD static inline
#define HDN static
typedef float h16;
#define CBAR
#define FSIN(x) sinf(x)
#define FCOS(x) cosf(x)
#endif
#include <cstdio>
#include <cstring>

#ifndef CFG_BATCH
#define CFG_BATCH 32
#define CFG_SEQ 256
#define CFG_DB 8
#define CFG_DS 4096
#define CFG_PAST 512
#define CFG_NKEYS 128
#endif

#define NTC (CFG_BATCH * CFG_SEQ)
#define NTL (CFG_DB * CFG_DS)
#define NT (NTC + NTL)
#define NCOND (1 + CFG_DB)
#define GROWS (CFG_DS / 64)
#define WR (GROWS < 8 ? GROWS : 8)
#define NEXP (CFG_NKEYS * CFG_NKEYS)
#define INC 3280
#define RW_OFF 512
#define NA_OFF 1472
#define DN_OFF 2240

struct P {
  const float *xp, *xs, *c, *cgk, *cgv, *cnk, *cnv, *srw, *sdn, *cctx, *n1g, *n2g, *wmod, *bmod, *win, *wout,
      *gqn, *gkn, *rwmu, *rww0, *rww2, *rwa0, *rwa2, *rwg2, *rwkk, *rwka, *rwrk, *rwlng, *rwlnb, *nabias,
      *dnconv, *dnalog, *dndt, *dnng, *pwq, *pkeys, *pu, *pv, *fng;
  float *X, *ogk, *ogv, *onk, *onv, *orw, *odn;
  float* mod;
  h16* act;
  h16* proj;
  h16* rwaux;
  h16* dnp;
  h16* pq;
  float* tks;
  int* tki;
  int* pidx;
  float* pact;
  unsigned* counters;
  unsigned* xbar;
  unsigned* cucnt;
  h16 *keys16, *u16, *v16;
  float *rwsc, *dnsc;
  h16 *wtin, *wtout, *wtq;
};

HD float sigmoidf_(float x) { return 1.0f / (1.0f + expf(-x)); }
HD float siluf_(float x) { return x * sigmoidf_(x); }
HD float softplusf_(float x) { return fmaxf(x, 0.0f) + log1pf(expf(-fabsf(x))); }
HD int condrow(long token) { return token < NTC ? 0 : 1 + (int)((token - NTC) / CFG_DS); }
HD void seqinfo(long token, int& t, int& T, long& base) {
  if (token < NTC) { T = CFG_SEQ; t = (int)(token % CFG_SEQ); base = token - t; }
  else { long u = token - NTC; T = CFG_DS; t = (int)(u % CFG_DS); base = token - t; }
}

HD void b_init(long i, const P& p, int l) {
  p.X[i] = (i < (long)NTC * 1024) ? p.xp[i] : p.xs[i - (long)NTC * 1024];
}
HD void b_mod(long i, const P& p, int) {
  int col = (int)(i % 6144); int r = (int)((i / 6144) % NCOND); int l = (int)(i / (6144L * NCOND));
  const float* cond = r == 0 ? p.cctx : p.c + (long)(r - 1) * 1024;
  float acc = p.bmod[l * 6144 + col];
  for (int k = 0; k < 1024; ++k) acc += siluf_(cond[k]) * p.wmod[((long)l * 1024 + k) * 6144 + col];
  p.mod[i] = acc;
}
template <int WHICH>
HD void b_norm(long i, const P& p, int l) {
  const float* x = p.X + i * 1024;
  float ss = 0.f;
  for (int k = 0; k < 1024; ++k) ss += x[k] * x[k];
  float rstd = 1.0f / sqrtf(ss * (1.0f / 1024) + 1e-6f);
  const float* m = p.mod + ((long)l * NCOND + condrow(i)) * 6144 + (WHICH ? 3072 : 0);
  const float* g = (WHICH ? p.n2g : p.n1g) + l * 1024;
  for (int k = 0; k < 1024; ++k) p.act[i * 1024 + k] = (h16)((x[k] * rstd * g[k]) * (1.0f + m[1024 + k]) + m[k]);
}
HD void b_prep_gqa(long i, const P& p, int l) {
  long token = i / 6; int slot = (int)(i % 6);
  h16* x = p.proj + token * INC + slot * 64;
  float y[64]; float ss = 0.f;
#pragma unroll
  for (int d = 0; d < 64; ++d) { y[d] = (float)x[d]; ss += y[d] * y[d]; }
  float rstd = 1.0f / sqrtf(ss * (1.0f / 64) + 1e-6f);
  const float* g = (slot < 4 ? p.gqn : p.gkn) + l * 64;
#pragma unroll
  for (int d = 0; d < 64; ++d) y[d] = y[d] * rstd * g[d];
  if (token >= NTC) {
    int t = (int)((token - NTC) % CFG_DS); int row = t / 64, colp = t % 64;
#pragma unroll
    for (int j = 0; j < 32; ++j) {
      float inv = exp2f(-(float)(j % 16) * 0.83048202372184059f);
      float ang = (float)(j < 16 ? row : colp) * inv;
      float cs = FCOS(ang), sn = FSIN(ang);
      float a = y[j], b = y[j + 32];
      y[j] = a * cs - b * sn; y[j + 32] = b * cs + a * sn;
    }
  } else if (slot >= 4) {
    int b = (int)(token / CFG_SEQ), t = (int)(token % CFG_SEQ);
    float* o = p.ogk + ((((long)b * 2 + l) * 2 + (slot - 4)) * CFG_SEQ + t) * 64;
#pragma unroll
    for (int d = 0; d < 64; ++d) o[d] = y[d];
  }
  float sc = slot < 4 ? 0.125f : 1.0f;
#pragma unroll
  for (int d = 0; d < 64; ++d) x[d] = (h16)(y[d] * sc);
}
HD void b_prep_cache(long i, const P& p, int l) {
  long token = i / 640; int e = (int)(i % 640);
  int b = (int)(token / CFG_SEQ), t = (int)(token % CFG_SEQ);
  const h16* pr = p.proj + token * INC;
  if (e < 128) { int kvh = e / 64, d = e % 64; p.ogv[((((long)b * 2 + l) * 2 + kvh) * CFG_SEQ + t) * 64 + d] = (float)pr[384 + e]; }
  else if (e < 384) { int c = e - 128; int h = c / 64, d = c % 64; p.onk[((((long)b * 2 + l) * 4 + h) * CFG_SEQ + t) * 64 + d] = (float)pr[NA_OFF + 256 + c]; }
  else { int c = e - 384; int h = c / 64, d = c % 64; p.onv[((((long)b * 2 + l) * 4 + h) * CFG_SEQ + t) * 64 + d] = (float)pr[NA_OFF + 512 + c]; }
}
HD void b_rwaux(long i, const P& p, int l) {
  int col = (int)(i % 256); int d = (int)((i / 256) % 2); long token = i / 512;
  int t, T; long base; seqinfo(token, t, T, base);
  bool sv = d == 0 ? (t > 0) : (t < T - 1);
  const h16* pb = p.proj + token * INC + RW_OFF;
  const h16* ps = p.proj + (token + (d == 0 ? -1 : 1)) * INC + RW_OFF;
  const float* mu = p.rwmu + ((long)l * 2 + d) * 832;
  float accw = p.rww0[(l * 2 + d) * 256 + col], acca = p.rwa0[(l * 2 + d) * 256 + col];
  for (int j = 0; j < 32; ++j) {
    float bw = (float)pb[768 + d * 32 + j], sw = sv ? (float)ps[768 + d * 32 + j] : 0.f;
    float wl = bw + (sw - bw) * mu[768 + j];
    float ba = (float)pb[832 + d * 32 + j], sa = sv ? (float)ps[832 + d * 32 + j] : 0.f;
    float al = ba + (sa - ba) * mu[800 + j];
    accw += tanhf(wl) * p.rww2[(((long)l * 2 + d) * 32 + j) * 256 + col];
    acca += al * p.rwa2[(((long)l * 2 + d) * 32 + j) * 256 + col];
  }
  float w = -softplusf_(-accw) - 0.5f;
  p.rwaux[((token * 2 + d) * 2 + 0) * 256 + col] = (h16)expf(w);
  p.rwaux[((token * 2 + d) * 2 + 1) * 256 + col] = (h16)sigmoidf_(acca);
}
HD void b_dnconv(long i, const P& p, int l) {
  int c = (int)(i % 768); long token = i / 768;
  int t, T; long base; seqinfo(token, t, T, base);
  float acc = 0.f;
#pragma unroll
  for (int j = 0; j < 5; ++j) {
    int tt = t + j - 2;
    if (tt >= 0 && tt < T) acc += (float)p.proj[(base + tt) * INC + DN_OFF + c] * p.dnconv[((long)l * 5 + j) * 768 + c];
  }
  p.dnp[token * 768 + c] = (h16)siluf_(acc);
}
HD void b_dnnorm(long i, const P& p, int) {
  long token = i / 8; int slot = (int)(i % 8);
  h16* x = p.dnp + token * 768 + slot * 64;
  float ss = 0.f;
  for (int d = 0; d < 64; ++d) { float v = (float)x[d]; ss += v * v; }
  float rs = 1.0f / sqrtf(ss + 1e-6f) * (slot < 4 ? 0.125f : 1.0f);
  for (int d = 0; d < 64; ++d) x[d] = (h16)((float)x[d] * rs);
}

struct Softmax64 {
  float m, lsum, acc[64];
};
template <typename TK>
HD void attend_key(Softmax64& st, const float* q, const TK* k, const TK* v, float scale, float bias) {
  float s = 0.f;
#pragma unroll
  for (int d = 0; d < 64; ++d) s += q[d] * (float)k[d];
  s = s * scale + bias;
  if (s > st.m) {
    float f = expf(st.m - s);
    st.lsum *= f;
#pragma unroll
    for (int d = 0; d < 64; ++d) st.acc[d] *= f;
    st.m = s;
  }
  float pw = expf(s - st.m);
  st.lsum += pw;
#pragma unroll
  for (int d = 0; d < 64; ++d) st.acc[d] += pw * (float)v[d];
}
HD void b_attn_gqa(long i, const P& p, int l) {
  int h = (int)(i / NT); long token = i % NT; int kvh = h / 2;
  float q[64];
  const h16* qp = p.proj + token * INC + h * 64;
#pragma unroll
  for (int d = 0; d < 64; ++d) q[d] = (float)qp[d];
  Softmax64 st; st.m = -1e30f; st.lsum = 0.f;
#pragma unroll
  for (int d = 0; d < 64; ++d) st.acc[d] = 0.f;
  int t, T; long base; seqinfo(token, t, T, base);
  for (int tk = 0; tk < T; ++tk) {
    const h16* kp = p.proj + (base + tk) * INC + 256 + kvh * 64;
    attend_key<h16>(st, q, kp, kp + 128, 1.0f, 0.f);
  }
  if (token >= NTC) {
    int b = (int)((token - NTC) / CFG_DS);
    const float* ck = p.cgk + (((long)b * 2 + l) * 2 + kvh) * CFG_PAST * 64;
    const float* cv = p.cgv + (((long)b * 2 + l) * 2 + kvh) * CFG_PAST * 64;
    for (int pp = 0; pp < CFG_PAST; ++pp) attend_key<float>(st, q, ck + pp * 64, cv + pp * 64, 1.0f, 0.f);
  }
  float inv = 1.0f / st.lsum;
  h16* o = p.act + token * 1024 + h * 64;
#pragma unroll
  for (int d = 0; d < 64; ++d) o[d] = (h16)(st.acc[d] * inv);
}
HD void b_attn_na(long i, const P& p, int l) {
  int h = (int)(i / NT); long token = i % NT;
  float q[64];
  const h16* qp = p.proj + token * INC + NA_OFF + h * 64;
#pragma unroll
  for (int d = 0; d < 64; ++d) q[d] = (float)qp[d];
  Softmax64 st; st.m = -1e30f; st.lsum = 0.f;
#pragma unroll
  for (int d = 0; d < 64; ++d) st.acc[d] = 0.f;
  int t, T; long base; seqinfo(token, t, T, base);
  if (token < NTC) {
    for (int tk = 0; tk < T; ++tk) {
      const h16* kp = p.proj + (base + tk) * INC + NA_OFF + 256 + h * 64;
      attend_key<h16>(st, q, kp, kp + 256, 0.125f, 0.f);
    }
  } else {
    int r = t / 64, cq = t % 64;
    int r0 = r - WR / 2; r0 = r0 < 0 ? 0 : (r0 > GROWS - WR ? GROWS - WR : r0);
    int cs = cq - 8; cs = cs < 0 ? 0 : (cs > 48 ? 48 : cs);
    const float* bias = p.nabias + ((long)l * 4 + h) * 15 * 31;
    for (int w = 0; w < WR; ++w) {
      int kr = r0 + w;
      for (int cc = 0; cc < 16; ++cc) {
        int kc = cs + cc;
        const h16* kp = p.proj + (base + kr * 64 + kc) * INC + NA_OFF + 256 + h * 64;
        attend_key<h16>(st, q, kp, kp + 256, 0.125f, bias[(kr - r + 7) * 31 + (kc - cq + 15)]);
      }
    }
    int b = (int)((token - NTC) / CFG_DS);
    const float* ck = p.cnk + (((long)b * 2 + l) * 4 + h) * CFG_PAST * 64;
    const float* cv = p.cnv + (((long)b * 2 + l) * 4 + h) * CFG_PAST * 64;
    for (int pp = 0; pp < CFG_PAST; ++pp) attend_key<float>(st, q, ck + pp * 64, cv + pp * 64, 0.125f, 0.f);
  }
  float inv = 1.0f / st.lsum;
  h16* o = p.act + token * 1024 + 512 + h * 64;
#pragma unroll
  for (int d = 0; d < 64; ++d) o[d] = (h16)(st.acc[d] * inv);
}

HD float rw_lerp(const P& p, int l, long token, bool sv, int d, int c) {
  float b = (float)p.proj[token * INC + RW_OFF + c];
  float s = sv ? (float)p.proj[(token + (d == 0 ? -1 : 1)) * INC + RW_OFF + c] : 0.f;
  return b + (s - b) * p.rwmu[((long)l * 2 + d) * 832 + c];
}
HD void b_rwscan(long i, const P& p, int l) {
  int v = (int)(i % 64); int sb = (int)(i / 64); int h = sb % 4; int bi = sb / 4;
  bool ctx = bi < CFG_BATCH;
  int T = ctx ? CFG_SEQ : CFG_DS;
  long base = ctx ? (long)bi * CFG_SEQ : (long)NTC + (long)(bi - CFG_BATCH) * CFG_DS;
#ifndef HOST_EMU
  float* S = (float*)g_smem + threadIdx.x * 65;
#else
  float S[64];
#endif
  for (int d = 0; d < 2; ++d) {
    if (ctx) {
      for (int k = 0; k < 64; ++k) S[k] = 0.f;
    } else {
      const float* s0 = p.srw + (((((long)(bi - CFG_BATCH)) * 2 + l) * 2 + d) * 4 + h) * 4096 + v * 64;
      for (int k = 0; k < 64; ++k) S[k] = s0[k];
    }
    for (int step = 0; step < T; ++step) {
      int t = d == 0 ? step : T - 1 - step;
      long token = base + t;
      bool sv = d == 0 ? (t > 0) : (t < T - 1);
      const h16* aux = p.rwaux + (token * 2 + d) * 512;
      float ss = 0.f;
      for (int k = 0; k < 64; ++k) {
        float kv = rw_lerp(p, l, token, sv, d, 256 + h * 64 + k) * p.rwkk[l * 256 + h * 64 + k];
        ss += kv * kv;
      }
      float rs = 1.0f / sqrtf(ss + 1e-6f);
      float sa = 0.f;
      for (int k = 0; k < 64; ++k) {
        float kk = rw_lerp(p, l, token, sv, d, 256 + h * 64 + k) * p.rwkk[l * 256 + h * 64 + k] * rs;
        sa -= S[k] * kk;
      }
      float vv = rw_lerp(p, l, token, sv, d, 512 + h * 64 + v);
      float o = 0.f;
      for (int k = 0; k < 64; ++k) {
        int c = h * 64 + k;
        float kr = rw_lerp(p, l, token, sv, d, 256 + c);
        float kk = kr * p.rwkk[l * 256 + c] * rs;
        float a = (float)aux[256 + c];
        float dec = expf(-(float)aux[c]);
        float keff = kr * (1.0f + (a - 1.0f) * p.rwka[l * 256 + c]);
        float r = rw_lerp(p, l, token, sv, d, c);
        S[k] = S[k] * dec + sa * (kk * a) + vv * keff;
        o += S[k] * r;
      }
      h16* op = p.act + token * 1024 + 256 + h * 64 + v;
      if (d == 0) *op = (h16)o; else *op = (h16)((float)*op + o);
    }
    if (ctx) {
      float* so = p.orw + (((((long)bi) * 2 + l) * 2 + d) * 4 + h) * 4096 + v * 64;
      for (int k = 0; k < 64; ++k) so[k] = S[k];
    }
  }
}
HD void b_rwfin(long i, const P& p, int l) {
  long token = i / 4; int h = (int)(i % 4);
  int t, T; long base; seqinfo(token, t, T, base);
  h16* op = p.act + token * 1024 + 256 + h * 64;
  float mu = 0.f;
  for (int k = 0; k < 64; ++k) mu += (float)op[k];
  mu *= (1.0f / 64);
  float var = 0.f;
  for (int k = 0; k < 64; ++k) { float dlt = (float)op[k] - mu; var += dlt * dlt; }
  var *= (1.0f / 64);
  float rs = 1.0f / sqrtf(var + 64e-5f);
  float bon0 = 0.f, bon1 = 0.f;
  for (int d = 0; d < 2; ++d) {
    bool sv = d == 0 ? (t > 0) : (t < T - 1);
    const h16* aux = p.rwaux + (token * 2 + d) * 512;
    float s = 0.f;
    for (int k = 0; k < 64; ++k) {
      int c = h * 64 + k;
      float kr = rw_lerp(p, l, token, sv, d, 256 + c);
      float a = (float)aux[256 + c];
      float keff = kr * (1.0f + (a - 1.0f) * p.rwka[l * 256 + c]);
      s += rw_lerp(p, l, token, sv, d, c) * keff * p.rwrk[l * 256 + c];
    }
    if (d == 0) bon0 = s; else bon1 = s;
  }
  bool sv0 = t > 0, sv1 = t < T - 1;
  for (int k = 0; k < 64; ++k) {
    int c = h * 64 + k;
    float y = ((float)op[k] - mu) * rs * p.rwlng[l * 256 + c] + p.rwlnb[l * 256 + c];
    y += bon0 * rw_lerp(p, l, token, sv0, 0, 512 + c) + bon1 * rw_lerp(p, l, token, sv1, 1, 512 + c);
    float gate = 0.f;
    for (int j = 0; j < 64; ++j) gate += sigmoidf_((float)p.proj[token * INC + RW_OFF + 896 + j]) * p.rwg2[((long)l * 64 + j) * 256 + c];
    op[k] = (h16)(y * gate);
  }
}
HD void b_dnscan(long i, const P& p, int l) {
  int v = (int)(i % 64); int sb = (int)(i / 64); int h = sb % 4; int bi = sb / 4;
  bool ctx = bi < CFG_BATCH;
  int T = ctx ? CFG_SEQ : CFG_DS;
  long base = ctx ? (long)bi * CFG_SEQ : (long)NTC + (long)(bi - CFG_BATCH) * CFG_DS;
#ifndef HOST_EMU
  float* S = (float*)g_smem + threadIdx.x * 65;
#else
  float S[64];
#endif
  for (int d = 0; d < 2; ++d) {
    if (ctx) {
      for (int k = 0; k < 64; ++k) S[k] = 0.f;
    } else {
      const float* s0 = p.sdn + (((((long)(bi - CFG_BATCH)) * 2 + l) * 2 + d) * 4 + h) * 4096 + v;
      for (int k = 0; k < 64; ++k) S[k] = s0[k * 64];
    }
    float nalog = -expf(p.dnalog[(l * 2 + d) * 4 + h]);
    float dtb = p.dndt[(l * 2 + d) * 4 + h];
    for (int step = 0; step < T; ++step) {
      int t = d == 0 ? step : T - 1 - step;
      long token = base + t;
      const h16* dp = p.dnp + token * 768;
      const h16* pr = p.proj + token * INC + DN_OFF;
      float beta = sigmoidf_((float)pr[768 + d * 4 + h]);
      float g = nalog * softplusf_((float)pr[776 + d * 4 + h] + dtb);
      float a = expf(g);
      float sk = 0.f;
      for (int k = 0; k < 64; ++k) sk += (float)dp[256 + h * 64 + k] * S[k];
      float coef = beta * ((float)dp[512 + h * 64 + v] - a * sk);
      float o = 0.f;
      for (int k = 0; k < 64; ++k) {
        S[k] = a * S[k] + coef * (float)dp[256 + h * 64 + k];
        o += (float)dp[h * 64 + k] * S[k];
      }
      h16* op = p.act + token * 1024 + 768 + h * 64 + v;
      if (d == 0) *op = (h16)o; else *op = (h16)((float)*op + o);
    }
    if (ctx) {
      float* so = p.odn + (((((long)bi) * 2 + l) * 2 + d) * 4 + h) * 4096 + v;
      for (int k = 0; k < 64; ++k) so[k * 64] = S[k];
    }
  }
}
HD void b_dnfin(long i, const P& p, int l) {
  long token = i / 4; int h = (int)(i % 4);
  h16* op = p.act + token * 1024 + 768 + h * 64;
  float ss = 0.f;
  for (int k = 0; k < 64; ++k) { float o = (float)op[k]; ss += o * o; }
  float rs = 1.0f / sqrtf(ss * (1.0f / 64) + 1e-6f);
  for (int k = 0; k < 64; ++k) {
    float z = (float)p.proj[token * INC + DN_OFF + 784 + h * 64 + k];
    op[k] = (h16)((float)op[k] * rs * p.dnng[l * 64 + k] * siluf_(z));
  }
}
HD void top16_insert(float (&ts)[16], int (&ti)[16], float s, int id) {
#pragma unroll
  for (int j = 0; j < 16; ++j) {
    if (s > ts[j]) { float a = ts[j]; ts[j] = s; s = a; int b = ti[j]; ti[j] = id; id = b; }
  }
}
HD void b_topk1(long i, const P& p, int l) {
  long token = i / 16; int hp = (int)(i % 16);
  const h16* q = p.pq + token * 2048 + hp * 128;
  const float* keys = p.pkeys + ((long)l * 16 + hp) * CFG_NKEYS * 128;
  float ts[16]; int ti[16];
#pragma unroll
  for (int j = 0; j < 16; ++j) { ts[j] = -3.0e38f; ti[j] = 0; }
  for (int k = 0; k < CFG_NKEYS; ++k) {
    float s = 0.f;
    for (int d = 0; d < 128; ++d) s += (float)q[d] * keys[k * 128 + d];
    top16_insert(ts, ti, s, k);
  }
#pragma unroll
  for (int j = 0; j < 16; ++j) { p.tks[token * 256 + hp * 16 + j] = ts[j]; p.tki[token * 256 + hp * 16 + j] = ti[j]; }
}
HD void b_topk2(long i, const P& p, int l) {
  long token = i / 8; int hd = (int)(i % 8);
  const float* s1 = p.tks + token * 256 + hd * 32; const int* i1 = p.tki + token * 256 + hd * 32;
  float ts[16]; int ti[16];
#pragma unroll
  for (int j = 0; j < 16; ++j) { ts[j] = -3.0e38f; ti[j] = 0; }
  for (int a = 0; a < 16; ++a)
    for (int b = 0; b < 16; ++b) top16_insert(ts, ti, s1[a] + s1[16 + b], i1[a] * CFG_NKEYS + i1[16 + b]);
  float sum = 0.f;
#pragma unroll
  for (int j = 0; j < 16; ++j) sum += expf(ts[j] - ts[0]);
  float inv = 1.0f / sum;
#pragma unroll
  for (int j = 0; j < 16; ++j) { p.pidx[token * 128 + hd * 16 + j] = ti[j]; p.pact[token * 128 + hd * 16 + j] = expf(ts[j] - ts[0]) * inv; }
}
HD void b_peer_act(long i, const P& p, int l) {
  long token = i / 128;
  const float* u = p.pu + ((long)l * NEXP + p.pidx[i]) * 1024;
  const h16* x = p.act + token * 1024;
  float dot = 0.f;
  for (int k = 0; k < 1024; ++k) dot += (float)x[k] * u[k];
  float ge = 0.5f * dot * (1.0f + erff(dot * 0.70710678118654752f));
  p.pact[i] = p.pact[i] * ge;
}
HD void b_peer_out(long i, const P& p, int l) {
  long token = i / 1024; int col = (int)(i % 1024);
  float acc = 0.f;
  for (int e = 0; e < 128; ++e) acc += p.pact[token * 128 + e] * p.pv[((long)l * NEXP + p.pidx[token * 128 + e]) * 1024 + col];
  p.X[i] += p.mod[((long)l * NCOND + condrow(token)) * 6144 + 5120 + col] * acc;
}
HD void b_final(long i, const P& p, int) {
  float* x = p.X + i * 1024;
  float ss = 0.f;
  for (int k = 0; k < 1024; ++k) ss += x[k] * x[k];
  float rstd = 1.0f / sqrtf(ss * (1.0f / 1024) + 1e-6f);
  for (int k = 0; k < 1024; ++k) x[k] = x[k] * rstd * p.fng[k];
}
HD float gemm_elem(const h16* A, const float* B, int N, long token, int col) {
  float acc = 0.f;
  for (int k = 0; k < 1024; ++k) acc += (float)A[token * 1024 + k] * B[(long)k * N + col];
  return acc;
}
HD void b_inproj(long i, const P& p, int l) {
  long token = i / INC; int col = (int)(i % INC);
  p.proj[i] = (h16)gemm_elem(p.act, p.win + (long)l * 1024 * INC, INC, token, col);
}
HD void b_outproj(long i, const P& p, int l) {
  long token = i / 1024; int col = (int)(i % 1024);
  float acc = gemm_elem(p.act, p.wout + (long)l * 1024 * 1024, 1024, token, col);
  p.X[i] += p.mod[((long)l * NCOND + condrow(token)) * 6144 + 2048 + col] * acc;
}
HD void b_peerq(long i, const P& p, int l) {
  long token = i / 2048; int col = (int)(i % 2048);
  p.pq[i] = (h16)gemm_elem(p.act, p.pwq + (long)l * 1024 * 2048, 2048, token, col);
}

#ifndef PROBE_KMAX
#define PROBE_KMAX 16
#endif
#ifndef REP_S0
#define REP_S0 1
#endif
#ifndef REP_MISC
#define REP_MISC 1
#endif
#ifndef REP_G0
#define REP_G0 1
#endif
#ifndef REP_G2
#define REP_G2 1
#endif
#ifndef REP_SP
#define REP_SP 1
#endif
#define NSCAN ((long)(CFG_BATCH + CFG_DB) * 4 * 64)
#define NPAD_IN 3328

#ifndef HOST_EMU
typedef _Float16 half8 __attribute__((ext_vector_type(8)));
typedef _Float16 half4 __attribute__((ext_vector_type(4)));
typedef _Float16 half2v __attribute__((ext_vector_type(2)));
typedef float f32x2 __attribute__((ext_vector_type(2)));
typedef float f32x16 __attribute__((ext_vector_type(16)));
typedef float f32x4 __attribute__((ext_vector_type(4)));
typedef unsigned u32x4 __attribute__((ext_vector_type(4)));
typedef short s16x4v __attribute__((__vector_size__(4 * sizeof(short))));

template <int CTRL> __device__ __forceinline__ float dppf(float x) {
  return __builtin_bit_cast(float, __builtin_amdgcn_update_dpp(0, __builtin_bit_cast(int, x), CTRL, 0xF, 0xF, true));
}
__device__ __forceinline__ float sum16(float x) { x += dppf<0x128>(x); x += dppf<0x124>(x); x += dppf<0xB1>(x); x += dppf<0x4E>(x); return x; }
__device__ __forceinline__ float sum8(float x) { x += dppf<0xB1>(x); x += dppf<0x4E>(x); x += dppf<0x141>(x); return x; }
__device__ __forceinline__ float sum64(float x) { x = sum16(x); x += __shfl_xor(x, 16); x += __shfl_xor(x, 32); return x; }

#define CSWAP_DESC(S, ID, i, j) { const bool c_ = S[j] > S[i]; const float a_ = c_ ? S[j] : S[i]; const float b_ = c_ ? S[i] : S[j]; \
    const int ia_ = c_ ? ID[j] : ID[i]; const int ib_ = c_ ? ID[i] : ID[j]; S[i] = a_; S[j] = b_; ID[i] = ia_; ID[j] = ib_; }
__device__ __forceinline__ void bitonic_sort16_desc(float (&s)[16], int (&id)[16]) {
#pragma unroll
  for (int k = 2; k <= 16; k <<= 1) {
#pragma unroll
    for (int j = k >> 1; j > 0; j >>= 1) {
#pragma unroll
      for (int i = 0; i < 16; ++i) {
        const int l = i ^ j;
        if (l > i) {
          if ((i & k) == 0) CSWAP_DESC(s, id, i, l) else CSWAP_DESC(s, id, l, i)
        }
      }
    }
  }
}
__device__ __forceinline__ void merge_top16(float (&ts)[16], int (&ti)[16], const float (&gs)[16], const int (&gi)[16]) {
#pragma unroll
  for (int i = 0; i < 16; ++i) { if (gs[15 - i] > ts[i]) { ts[i] = gs[15 - i]; ti[i] = gi[15 - i]; } }
#pragma unroll
  for (int j = 8; j > 0; j >>= 1) {
#pragma unroll
    for (int i = 0; i < 16; ++i) { if ((i & j) == 0) CSWAP_DESC(ts, ti, i, i + j) }
  }
}
__device__ void blk_convert(long w, const P& p) {
  int l = (int)(w / 1600); int r = (int)(w % 1600);
  const float* src; h16* dst; int N, ntile;
  if (r < 832) { src = p.win + (long)l * 1024 * INC; dst = p.wtin + (long)l * NPAD_IN * 1024; N = INC; ntile = 52; }
  else if (r < 1088) { r -= 832; src = p.wout + (long)l * 1024 * 1024; dst = p.wtout + (long)l * 1024 * 1024; N = 1024; ntile = 16; }
  else { r -= 1088; src = p.pwq + (long)l * 1024 * 2048; dst = p.wtq + (long)l * 2048 * 1024; N = 2048; ntile = 32; }
  int kt = r / ntile, nt = r % ntile;
  int k0 = kt * 64, n0 = nt * 64;
  h16* tile = (h16*)g_smem;
  const int tid_ = otid(); int c = tid_ & 63, r4 = tid_ >> 6;
  __syncthreads();
#pragma unroll
  for (int j = 0; j < 16; ++j) {
    int rr = r4 + 4 * j;
    float v = (n0 + c < N) ? src[(long)(k0 + rr) * N + n0 + c] : 0.f;
    tile[rr * 66 + c] = (h16)v;
  }
  __syncthreads();
#pragma unroll
  for (int j = 0; j < 16; ++j) {
    int rr = r4 + 4 * j;
    dst[(long)(n0 + rr) * 1024 + k0 + c] = tile[c * 66 + rr];
  }
}

template <int EPI>
__device__ void gemm_phase(const P& p, int l, int kmax = 16) {
  constexpr int NTILES = EPI == 0 ? (NPAD_IN / 128) : (EPI == 1 ? 8 : 16);
  constexpr int NT8 = (NTILES + 7) / 8;
  const long nw = EPI == 0 ? (long)(NT / 128) * NTILES : (long)(NT / 128) * 8 * NT8;
#define TILE_OF(W, MT, NTV) { const int x_ = (int)((W) & 7); const int j_ = (int)((W) >> 3);                        \
    if (EPI == 0) { if (j_ < 960) { MT = j_ / 3; NTV = x_ + 8 * (j_ - 3 * MT); } else { NTV = 24 + (x_ >> 2); MT = 80 * (x_ & 3) + j_ - 960; } } \
    else { NTV = x_ + 8 * (j_ % NT8); MT = j_ / NT8; } }
  const h16* A = p.act;
  const h16* Bt = EPI == 0 ? p.wtin + (long)l * NPAD_IN * 1024 : (EPI == 1 ? p.wtout + (long)l * 1024 * 1024 : p.wtq + (long)l * 2048 * 1024);
  const int tid = otid(), lane = tid & 63, wv = tid >> 6, wm = wv >> 1, wn = wv & 1;
  h16* As = (h16*)g_smem;
  h16* Bs = As + 2 * 128 * 72;
  const int lrow = tid >> 3, lch = tid & 7;
  long w = blockIdx.x; int mt = 0, nt = 0;
  for (;;) { if (w >= nw) return; TILE_OF(w, mt, nt) if (nt < NTILES) break; w += gridDim.x; }
  int m0 = mt * 128, n0 = nt * 128;
  const h16* Ag = A + (long)(m0 + lrow) * 1024 + lch * 8;
  const h16* Bg = Bt + (long)(n0 + lrow) * 1024 + lch * 8;
  u32x4 ra0, ra1, ra2, ra3, rb0, rb1, rb2, rb3;
  u32x4 sa0, sa1, sa2, sa3, sb0, sb1, sb2, sb3;
  const f32x16 zero16 = {0.f, 0.f, 0.f, 0.f, 0.f, 0.f, 0.f, 0.f, 0.f, 0.f, 0.f, 0.f, 0.f, 0.f, 0.f, 0.f};
  f32x16 acc00, acc01, acc10, acc11;
#define GLD0(K0) \
  ra0 = *(const u32x4*)(Ag + (K0)); ra1 = *(const u32x4*)(Ag + 32 * 1024 + (K0)); ra2 = *(const u32x4*)(Ag + 64 * 1024 + (K0)); ra3 = *(const u32x4*)(Ag + 96 * 1024 + (K0)); \
  rb0 = *(const u32x4*)(Bg + (K0)); rb1 = *(const u32x4*)(Bg + 32 * 1024 + (K0)); rb2 = *(const u32x4*)(Bg + 64 * 1024 + (K0)); rb3 = *(const u32x4*)(Bg + 96 * 1024 + (K0));
#define GLD1(K0) \
  sa0 = *(const u32x4*)(Ag + (K0)); sa1 = *(const u32x4*)(Ag + 32 * 1024 + (K0)); sa2 = *(const u32x4*)(Ag + 64 * 1024 + (K0)); sa3 = *(const u32x4*)(Ag + 96 * 1024 + (K0)); \
  sb0 = *(const u32x4*)(Bg + (K0)); sb1 = *(const u32x4*)(Bg + 32 * 1024 + (K0)); sb2 = *(const u32x4*)(Bg + 64 * 1024 + (K0)); sb3 = *(const u32x4*)(Bg + 96 * 1024 + (K0));
#define LST0(AW, BW) \
  *(u32x4*)((AW) + (lrow) * 72 + lch * 8) = ra0; *(u32x4*)((AW) + (lrow + 32) * 72 + lch * 8) = ra1; *(u32x4*)((AW) + (lrow + 64) * 72 + lch * 8) = ra2; *(u32x4*)((AW) + (lrow + 96) * 72 + lch * 8) = ra3; \
  *(u32x4*)((BW) + (lrow) * 72 + lch * 8) = rb0; *(u32x4*)((BW) + (lrow + 32) * 72 + lch * 8) = rb1; *(u32x4*)((BW) + (lrow + 64) * 72 + lch * 8) = rb2; *(u32x4*)((BW) + (lrow + 96) * 72 + lch * 8) = rb3;
#define LST1(AW, BW) \
  *(u32x4*)((AW) + (lrow) * 72 + lch * 8) = sa0; *(u32x4*)((AW) + (lrow + 32) * 72 + lch * 8) = sa1; *(u32x4*)((AW) + (lrow + 64) * 72 + lch * 8) = sa2; *(u32x4*)((AW) + (lrow + 96) * 72 + lch * 8) = sa3; \
  *(u32x4*)((BW) + (lrow) * 72 + lch * 8) = sb0; *(u32x4*)((BW) + (lrow + 32) * 72 + lch * 8) = sb1; *(u32x4*)((BW) + (lrow + 64) * 72 + lch * 8) = sb2; *(u32x4*)((BW) + (lrow + 96) * 72 + lch * 8) = sb3;
#define GCOMP(BUF)                                                                                   \
  {                                                                                                  \
    const h16* Ab = As + (BUF) * 128 * 72 + (wm * 64 + (lane & 31)) * 72 + (lane >> 5) * 8;          \
    const h16* Bb = Bs + (BUF) * 128 * 72 + (wn * 64 + (lane & 31)) * 72 + (lane >> 5) * 8;          \
    _Pragma("unroll") for (int s = 0; s < 4; ++s) {                                                  \
      half8 a0 = *(const half8*)(Ab + s * 16), a1 = *(const half8*)(Ab + 32 * 72 + s * 16);          \
      half8 b0 = *(const half8*)(Bb + s * 16), b1 = *(const half8*)(Bb + 32 * 72 + s * 16);          \
      acc00 = __builtin_amdgcn_mfma_f32_32x32x16_f16(a0, b0, acc00, 0, 0, 0);                        \
      acc01 = __builtin_amdgcn_mfma_f32_32x32x16_f16(a0, b1, acc01, 0, 0, 0);                        \
      acc10 = __builtin_amdgcn_mfma_f32_32x32x16_f16(a1, b0, acc10, 0, 0, 0);                        \
      acc11 = __builtin_amdgcn_mfma_f32_32x32x16_f16(a1, b1, acc11, 0, 0, 0);                        \
    }                                                                                                \
  }
  GLD0(0)
  GLD1(64)
  for (;;) {
  acc00 = zero16; acc01 = zero16; acc10 = zero16; acc11 = zero16;
  __builtin_amdgcn_sched_barrier(0);
  __syncthreads();
  LST0(As, Bs)
  GLD0(128)
  __builtin_amdgcn_sched_barrier(0);
  __syncthreads();
  for (int kt = 0; kt < kmax; kt += 2) {
    GCOMP(0)
    __builtin_amdgcn_sched_barrier(0);
    LST1(As + 128 * 72, Bs + 128 * 72)
    if (kt + 3 < 16) { GLD1((kt + 3) * 64) }
    __builtin_amdgcn_sched_barrier(0);
    __syncthreads();
    GCOMP(1)
    __builtin_amdgcn_sched_barrier(0);
    if (kt + 2 < 16) { LST0(As, Bs) }
    if (kt + 4 < 16) { GLD0((kt + 4) * 64) }
    __builtin_amdgcn_sched_barrier(0);
    __syncthreads();
  }
  const int cm0 = m0, cn0 = n0, cnt = nt;
  long w2 = w + gridDim.x; int mt2 = 0, nt2 = 0; bool has_next = false;
  for (;;) { if (w2 >= nw) break; TILE_OF(w2, mt2, nt2) if (nt2 < NTILES) { has_next = true; break; } w2 += gridDim.x; }
  if (has_next) {
    m0 = mt2 * 128; n0 = nt2 * 128; nt = nt2;
    Ag = A + (long)(m0 + lrow) * 1024 + lch * 8; Bg = Bt + (long)(n0 + lrow) * 1024 + lch * 8;
  }
  __builtin_amdgcn_sched_barrier(0);
#define GEMM_EPI(ACC, I, J)                                                                         \
  _Pragma("unroll") for (int r = 0; r < 16; ++r) {                                                   \
    const long row = cm0 + wm * 64 + (I) * 32 + (r & 3) + 8 * (r >> 2) + 4 * (lane >> 5);             \
    const int col = cn0 + wn * 64 + (J) * 32 + (lane & 31);                                            \
    const float v = ACC[r];                                                                          \
    if (EPI == 0) { if (col < INC) p.proj[row * INC + col] = (h16)v; }                                \
    else if (EPI == 1) { p.X[row * 1024 + col] += p.mod[((long)l * NCOND + condrow(row)) * 6144 + 2048 + col] * v; } \
    else { p.pq[row * 2048 + col] = (h16)v; }                                                         \
  }
  if (EPI == 0) {
    h16* Ct = (h16*)g_smem;
#define CST(ACC, I, J) _Pragma("unroll") for (int r = 0; r < 16; ++r) Ct[(wm * 64 + (I) * 32 + (r & 3) + 8 * (r >> 2) + 4 * (lane >> 5)) * 136 + wn * 64 + (J) * 32 + (lane & 31)] = (h16)ACC[r];
    CST(acc00, 0, 0) CST(acc01, 0, 1) CST(acc10, 1, 0) CST(acc11, 1, 1)
#undef CST
    __syncthreads();
#pragma unroll
    for (int j = 0; j < 8; ++j) {
      const int idx = tid + 256 * j; const int rr = idx >> 4, cc = idx & 15;
      if (cn0 + cc * 8 < INC) *(u32x4*)(p.proj + (long)(cm0 + rr) * INC + cn0 + cc * 8) = *(const u32x4*)(Ct + rr * 136 + cc * 8);
    }
  } else if (EPI == 1) {
#define EPI1(ACC, I, J)                                                                              \
    {                                                                                                \
      float xv_[16], mv_[16];                                                                        \
      const int col = cn0 + wn * 64 + (J) * 32 + (lane & 31);                                         \
      _Pragma("unroll") for (int r = 0; r < 16; ++r) {                                               \
        const long row = cm0 + wm * 64 + (I) * 32 + (r & 3) + 8 * (r >> 2) + 4 * (lane >> 5);         \
        xv_[r] = p.X[row * 1024 + col]; mv_[r] = p.mod[((long)l * NCOND + condrow(row)) * 6144 + 2048 + col]; \
      }                                                                                              \
      _Pragma("unroll") for (int r = 0; r < 16; ++r) {                                               \
        const long row = cm0 + wm * 64 + (I) * 32 + (r & 3) + 8 * (r >> 2) + 4 * (lane >> 5);         \
        p.X[row * 1024 + col] = xv_[r] + mv_[r] * ACC[r];                                            \
      }                                                                                              \
    }
    EPI1(acc00, 0, 0) EPI1(acc01, 0, 1) EPI1(acc10, 1, 0) EPI1(acc11, 1, 1)
#undef EPI1
  } else {
    h16* Q = (h16*)g_smem;
    h16* Kk = Q + 128 * 136;
    const h16* kg = p.keys16 + ((long)l * 16 + cnt) * CFG_NKEYS * 128;
#define QST(ACC, I, J) _Pragma("unroll") for (int r = 0; r < 16; ++r) Q[(wm * 64 + (I) * 32 + (r & 3) + 8 * (r >> 2) + 4 * (lane >> 5)) * 136 + wn * 64 + (J) * 32 + (lane & 31)] = (h16)ACC[r];
    QST(acc00, 0, 0) QST(acc01, 0, 1) QST(acc10, 1, 0) QST(acc11, 1, 1)
#undef QST
#pragma unroll
    for (int j = 0; j < 8; ++j) {
      const int idx = tid + 256 * j; const int kr = idx >> 4, kc = idx & 15;
      *(u32x4*)(Kk + kr * 136 + kc * 8) = *(const u32x4*)(kg + kr * 128 + kc * 8);
    }
    __syncthreads();
    f32x16 z = {0.f, 0.f, 0.f, 0.f, 0.f, 0.f, 0.f, 0.f, 0.f, 0.f, 0.f, 0.f, 0.f, 0.f, 0.f, 0.f};
    f32x16 s00 = z, s01 = z, s10 = z, s11 = z;
    const h16* Qb = Q + (wm * 64 + (lane & 31)) * 136 + (lane >> 5) * 8;
    const h16* Kb = Kk + (wn * 64 + (lane & 31)) * 136 + (lane >> 5) * 8;
#pragma unroll
    for (int sidx = 0; sidx < 8; ++sidx) {
      half8 a0 = *(const half8*)(Qb + sidx * 16), a1 = *(const half8*)(Qb + 32 * 136 + sidx * 16);
      half8 b0 = *(const half8*)(Kb + sidx * 16), b1 = *(const half8*)(Kb + 32 * 136 + sidx * 16);
      s00 = __builtin_amdgcn_mfma_f32_32x32x16_f16(a0, b0, s00, 0, 0, 0);
      s01 = __builtin_amdgcn_mfma_f32_32x32x16_f16(a0, b1, s01, 0, 0, 0);
      s10 = __builtin_amdgcn_mfma_f32_32x32x16_f16(a1, b0, s10, 0, 0, 0);
      s11 = __builtin_amdgcn_mfma_f32_32x32x16_f16(a1, b1, s11, 0, 0, 0);
    }
    __syncthreads();
    float* SC = (float*)g_smem;
#define SST(ACC, I, J) _Pragma("unroll") for (int r = 0; r < 16; ++r) SC[(wm * 64 + (I) * 32 + (r & 3) + 8 * (r >> 2) + 4 * (lane >> 5)) * 129 + wn * 64 + (J) * 32 + (lane & 31)] = ACC[r];
    SST(s00, 0, 0) SST(s01, 0, 1) SST(s10, 1, 0) SST(s11, 1, 1)
#undef SST
    __syncthreads();
    const int row = tid >> 1, half = tid & 1;
    float ts[16]; int ti[16];
#pragma unroll
    for (int j = 0; j < 16; ++j) { ts[j] = -3.0e38f; ti[j] = 0; }
#pragma unroll 1
    for (int g = 0; g < 4; ++g) {
      float gs[16]; int gi[16];
#pragma unroll
      for (int j = 0; j < 16; ++j) { gs[j] = SC[row * 129 + half * 64 + g * 16 + j]; gi[j] = half * 64 + g * 16 + j; }
      bitonic_sort16_desc(gs, gi);
      merge_top16(ts, ti, gs, gi);
    }
    {
      float ps[16]; int pi[16];
#pragma unroll
      for (int j = 0; j < 16; ++j) { ps[j] = dppf<0xB1>(ts[j]); pi[j] = __builtin_amdgcn_update_dpp(0, ti[j], 0xB1, 0xF, 0xF, true); }
      merge_top16(ts, ti, ps, pi);
    }
    if (half == 0) {
      const long token = cm0 + row;
#pragma unroll
      for (int j = 0; j < 16; ++j) { p.tks[token * 256 + cnt * 16 + j] = ts[j]; p.tki[token * 256 + cnt * 16 + j] = ti[j]; }
    }
  }
#undef GEMM_EPI
  if (!has_next) break;
  GLD0(0)
  GLD1(64)
  w = w2;
  }
#undef GLD0
#undef GLD1
#undef LST0
#undef LST1
#undef GCOMP
#undef TILE_OF
}

__device__ void blk_mod(long w, const P& p) {
  float* sl = (float*)g_smem;
  const int tid = otid();
  const int cb = (int)(w % 24); const int r = (int)((w / 24) % NCOND); const int l = (int)(w / (24 * NCOND));
  const float* cond = r == 0 ? p.cctx : p.c + (long)(r - 1) * 1024;
  __syncthreads();
#pragma unroll
  for (int j = 0; j < 4; ++j) sl[tid + 256 * j] = siluf_(cond[tid + 256 * j]);
  __syncthreads();
  const int col = cb * 256 + tid;
  const float* wp = p.wmod + (long)l * 1024 * 6144 + col;
  float acc = p.bmod[l * 6144 + col];
#pragma unroll 8
  for (int k = 0; k < 1024; ++k) acc += sl[k] * wp[(long)k * 6144];
  p.mod[((long)l * NCOND + r) * 6144 + col] = acc;
}
__device__ __forceinline__ float sum64u(float x);
template <int WHICH>
__device__ void blk_norm(long w, const P& p, int l) {
  const int tid_ = otid(); const int lane = tid_ & 63; const long token = w * 4 + (tid_ >> 6);
  const float* src = (WHICH == 0 && l == 0) ? (token < NTC ? p.xp + token * 1024 : p.xs + (token - NTC) * 1024) : p.X + token * 1024;
  float4 v[4]; float ss = 0.f;
#pragma unroll
  for (int j = 0; j < 4; ++j) { v[j] = ((const float4*)src)[lane + 64 * j]; ss += v[j].x * v[j].x + v[j].y * v[j].y + v[j].z * v[j].z + v[j].w * v[j].w; }
  ss = sum64u(ss);
  const float rstd = 1.0f / sqrtf(ss * (1.0f / 1024) + 1e-6f);
  if (WHICH == 2) {
#pragma unroll
    for (int j = 0; j < 4; ++j) {
      float4 g = ((const float4*)p.fng)[lane + 64 * j];
      float4 o; o.x = v[j].x * rstd * g.x; o.y = v[j].y * rstd * g.y; o.z = v[j].z * rstd * g.z; o.w = v[j].w * rstd * g.w;
      ((float4*)(p.X + token * 1024))[lane + 64 * j] = o;
    }
    return;
  }
  const float* m = p.mod + ((long)l * NCOND + condrow(token)) * 6144 + (WHICH ? 3072 : 0);
  const float* g = (WHICH ? p.n2g : p.n1g) + l * 1024;
  float4 gga[4], sha[4], sca[4];
#pragma unroll
  for (int j = 0; j < 4; ++j) { const int c4 = lane + 64 * j; gga[j] = ((const float4*)g)[c4]; sha[j] = ((const float4*)m)[c4]; sca[j] = ((const float4*)(m + 1024))[c4]; }
#pragma unroll
  for (int j = 0; j < 4; ++j) {
    const int c4 = lane + 64 * j;
    const float4 gg = gga[j], sh = sha[j], sc = sca[j];
    half4 o;
    o[0] = (h16)((v[j].x * rstd * gg.x) * (1.0f + sc.x) + sh.x);
    o[1] = (h16)((v[j].y * rstd * gg.y) * (1.0f + sc.y) + sh.y);
    o[2] = (h16)((v[j].z * rstd * gg.z) * (1.0f + sc.z) + sh.z);
    o[3] = (h16)((v[j].w * rstd * gg.w) * (1.0f + sc.w) + sh.w);
    *(half4*)(p.act + token * 1024 + c4 * 4) = o;
    if (WHICH == 0 && l == 0) ((float4*)(p.X + token * 1024))[c4] = v[j];
  }
}


#define SC_CT 32
__device__ __forceinline__ float fsigmoid(float x) { return __frcp_rn(1.0f + __expf(-x)); }
__device__ __forceinline__ float fsilu(float x) { return x * fsigmoid(x); }
__device__ __forceinline__ float fsoftplus(float x) { return fmaxf(x, 0.0f) + __logf(1.0f + __expf(-fabsf(x))); }
__device__ __forceinline__ float ftanh(float x) { const float e = __expf(-2.0f * fabsf(x)); const float t = (1.0f - e) * __frcp_rn(1.0f + e); return x < 0.f ? -t : t; }
#define N_PREP_RW ((NT / 32) * 8)
#define N_PREP_DN ((NT / 32) * 4)
__device__ void blk_scanprep(long w, const P& p, int l, half8& bf0, half8& bf1, int& bkey) {
  h16* tw16 = (h16*)g_smem;
  h16* al16 = tw16 + 32 * 40;
  float* cbuf = (float*)(al16 + 32 * 40);
  const int tid = otid();
  const int ls = tid >> 3, part = tid & 7;
  if (w < N_PREP_RW) {
    const int d = (int)(w & 1), h = (int)((w >> 1) & 3); const long token = (w >> 3) * 32 + ls;
    int t, T; long base; seqinfo(token, t, T, base);
    const bool sv = d == 0 ? (t > 0) : (t < T - 1);
    const h16* pb = p.proj + token * INC + RW_OFF;
    const h16* ps = p.proj + (token + (d == 0 ? -1 : 1)) * INC + RW_OFF;
    const float* mu = p.rwmu + ((long)l * 2 + d) * 832;
    const int lane = tid & 63, wv = tid >> 6;
    const int mat = wv >> 1, ntile = wv & 1;
    const int c0 = h * 64 + part * 8;
    half8 rb = *(const half8*)(pb + c0), kb = *(const half8*)(pb + 256 + c0);
    half8 rs_ = rb, ks_ = kb;
    if (sv) { rs_ = *(const half8*)(ps + c0); ks_ = *(const half8*)(ps + 256 + c0); }
    if (bkey != (int)((l << 3) | (w & 7))) {
      bkey = (int)((l << 3) | (w & 7));
      const float* wsrc = (mat ? p.rwa2 : p.rww2) + ((long)l * 2 + d) * 32 * 256 + h * 64 + ntile * 32 + (lane & 31);
#pragma unroll
      for (int j = 0; j < 8; ++j) { bf0[j] = (h16)wsrc[(8 * (lane >> 5) + j) * 256]; bf1[j] = (h16)wsrc[(16 + 8 * (lane >> 5) + j) * 256]; }
    }
    __syncthreads();
#pragma unroll
    for (int e = 0; e < 4; ++e) {
      const int jj = part * 4 + e;
      float bw = (float)pb[768 + d * 32 + jj], sw = sv ? (float)ps[768 + d * 32 + jj] : 0.f;
      tw16[ls * 40 + jj] = (h16)ftanh(bw + (sw - bw) * mu[768 + jj]);
      float ba = (float)pb[832 + d * 32 + jj], sa_ = sv ? (float)ps[832 + d * 32 + jj] : 0.f;
      al16[ls * 40 + jj] = (h16)(ba + (sa_ - ba) * mu[800 + jj]);
    }
    __syncthreads();
    {
      const h16* X16 = (mat ? al16 : tw16) + (lane & 31) * 40 + 8 * (lane >> 5);
      const half8 a0 = *(const half8*)X16, a1 = *(const half8*)(X16 + 16);
      f32x16 acc = {0.f, 0.f, 0.f, 0.f, 0.f, 0.f, 0.f, 0.f, 0.f, 0.f, 0.f, 0.f, 0.f, 0.f, 0.f, 0.f};
      acc = __builtin_amdgcn_mfma_f32_32x32x16_f16(a0, bf0, acc, 0, 0, 0);
      acc = __builtin_amdgcn_mfma_f32_32x32x16_f16(a1, bf1, acc, 0, 0, 0);
      float* cb = cbuf + mat * (32 * 65) + ntile * 32 + (lane & 31);
#pragma unroll
      for (int r = 0; r < 16; ++r) cb[((r & 3) + 8 * (r >> 2) + 4 * (lane >> 5)) * 65] = acc[r];
    }
    __syncthreads();
    float accw[8], acca[8];
#pragma unroll
    for (int e = 0; e < 8; ++e) {
      accw[e] = p.rww0[(l * 2 + d) * 256 + c0 + e] + cbuf[ls * 65 + part * 8 + e];
      acca[e] = p.rwa0[(l * 2 + d) * 256 + c0 + e] + cbuf[32 * 65 + ls * 65 + part * 8 + e];
    }
    float ss = 0.f, bon = 0.f;
    half8 ewo, ago;
#pragma unroll
    for (int e = 0; e < 8; ++e) {
      const int c = c0 + e;
      float b_ = (float)rb[e], s_ = sv ? (float)rs_[e] : 0.f; const float rr = b_ + (s_ - b_) * mu[c];
      b_ = (float)kb[e]; s_ = sv ? (float)ks_[e] : 0.f; const float kr = b_ + (s_ - b_) * mu[256 + c];
      const float asg = fsigmoid(acca[e]);
      const float kkr = kr * p.rwkk[l * 256 + c];
      ss += kkr * kkr;
      const float keff = kr * (1.0f + (asg - 1.0f) * p.rwka[l * 256 + c]);
      bon += rr * keff * p.rwrk[l * 256 + c];
      ewo[e] = (h16)__expf(-fsoftplus(-accw[e]) - 0.5f);
      ago[e] = (h16)asg;
    }
    ss = sum8(ss); bon = sum8(bon);
    *(half8*)(p.rwaux + ((token * 2 + d) * 2 + 0) * 256 + c0) = ewo;
    *(half8*)(p.rwaux + ((token * 2 + d) * 2 + 1) * 256 + c0) = ago;
    if (part == 0) { float* sc = p.rwsc + ((token * 2 + d) * 4 + h) * 2; sc[0] = 1.0f / sqrtf(ss + 1e-6f); sc[1] = bon; }
  } else {
    const long w2 = w - N_PREP_RW;
    const int h = (int)(w2 & 3); const long token = (w2 >> 2) * 32 + ls;
    int t, T; long base; seqinfo(token, t, T, base);
    const int c0 = h * 64 + part * 8;
    float aq[8], ak[8], av[8];
#pragma unroll
    for (int e = 0; e < 8; ++e) { aq[e] = 0.f; ak[e] = 0.f; av[e] = 0.f; }
    half8 xq[5], xk[5], xv[5]; float tv[5];
#pragma unroll
    for (int tap = 0; tap < 5; ++tap) {
      const int tt = t + tap - 2;
      const bool ok = tt >= 0 && tt < T;
      const h16* pr = p.proj + (base + (ok ? tt : t)) * INC + DN_OFF + c0;
      xq[tap] = *(const half8*)pr; xk[tap] = *(const half8*)(pr + 256); xv[tap] = *(const half8*)(pr + 512);
      tv[tap] = ok ? 1.0f : 0.0f;
    }
    __builtin_amdgcn_sched_barrier(0);
#pragma unroll
    for (int tap = 0; tap < 5; ++tap) {
      const float* cw = p.dnconv + ((long)l * 5 + tap) * 768 + c0;
#pragma unroll
      for (int e = 0; e < 8; ++e) {
        aq[e] += (float)xq[tap][e] * (cw[e] * tv[tap]); ak[e] += (float)xk[tap][e] * (cw[256 + e] * tv[tap]); av[e] += (float)xv[tap][e] * (cw[512 + e] * tv[tap]);
      }
    }
    float ssq = 0.f, ssk = 0.f;
#pragma unroll
    for (int e = 0; e < 8; ++e) { aq[e] = fsilu(aq[e]); ak[e] = fsilu(ak[e]); av[e] = fsilu(av[e]); ssq += aq[e] * aq[e]; ssk += ak[e] * ak[e]; }
    ssq = sum8(ssq); ssk = sum8(ssk);
    const float rq = 0.125f / sqrtf(ssq + 1e-6f), rk = 1.0f / sqrtf(ssk + 1e-6f);
    half8 qo, ko, vo;
#pragma unroll
    for (int e = 0; e < 8; ++e) { qo[e] = (h16)(aq[e] * rq); ko[e] = (h16)(ak[e] * rk); vo[e] = (h16)av[e]; }
    h16* dp = p.dnp + token * 768 + c0;
    *(half8*)dp = qo; *(half8*)(dp + 256) = ko; *(half8*)(dp + 512) = vo;
    if (part < 2) {
      const int d = part;
      const h16* pr = p.proj + token * INC + DN_OFF;
      float* sc = p.dnsc + ((token * 2 + d) * 4 + h) * 2;
      sc[0] = sigmoidf_((float)pr[768 + d * 4 + h]);
      sc[1] = expf(-expf(p.dnalog[(l * 2 + d) * 4 + h]) * softplusf_((float)pr[776 + d * 4 + h] + p.dndt[(l * 2 + d) * 4 + h]));
    }
  }
}
__device__ void blk_scan2(int kind, int bi, int h, int d, int rq, const P& p, int l) {
  float* L = (float*)g_smem;
  float* LA = L; float* LW = L + 2048; float* LB = L + 4096; float* LK = L + 6144; float* LR = L + 8192; float* LV = L + 10240;
  const int tid = otid(), lane = tid & 63, wv = tid >> 6, g = lane >> 4, cl = lane & 15;
  const int i = rq * 32 + wv * 8 + g * 2, j0 = cl * 4;
  const bool ctx = bi < CFG_BATCH;
  const int T = ctx ? CFG_SEQ : CFG_DS;
  const long base = ctx ? (long)bi * CFG_SEQ : (long)NTC + (long)(bi - CFG_BATCH) * CFG_DS;
  const int ls = tid >> 3, part = tid & 7;
  f32x4 S = {0.f, 0.f, 0.f, 0.f}, S1 = {0.f, 0.f, 0.f, 0.f};
  if (!ctx) {
    const int b = bi - CFG_BATCH;
    if (kind == 0) {
      const float* s0 = p.srw + (((((long)b) * 2 + l) * 2 + d) * 4 + h) * 4096;
      S = *(const f32x4*)(s0 + i * 64 + j0); S1 = *(const f32x4*)(s0 + (i + 1) * 64 + j0);
    } else {
      const float* s0 = p.sdn + (((((long)b) * 2 + l) * 2 + d) * 4 + h) * 4096;
#pragma unroll
      for (int c = 0; c < 4; ++c) { S[c] = s0[(j0 + c) * 64 + i]; S1[c] = s0[(j0 + c) * 64 + i + 1]; }
    }
  }
  h16* obuf = (h16*)(L + 12288);
  h16* obase = (kind == 0 ? p.act + 256 + d * 512 + h * 64 : p.proj + DN_OFF + d * 256 + h * 64) + rq * 32 + (tid & 7) * 4;
  const long ostride = kind == 0 ? 1024 : INC;
#define SC_FLUSH(S0I)                                                                              \
  { const int sidx_ = (S0I) + (tid >> 3); const int t_ = d == 0 ? sidx_ : T - 1 - sidx_;             \
    *(half4*)(obase + (base + t_) * ostride) = *(const half4*)(obuf + (tid >> 3) * 32 + (tid & 7) * 4); }
  const int c0 = h * 64 + part * 8, jb = part * 8;
  float cmr[8], cmk[8], cmv[8], ckk[8], cka[8];
#pragma unroll
  for (int e = 0; e < 8; ++e) { cmr[e] = 0.f; cmk[e] = 0.f; cmv[e] = 0.f; ckk[e] = 0.f; cka[e] = 0.f; }
  if (kind == 0) {
    const float* mu = p.rwmu + ((long)l * 2 + d) * 832;
#pragma unroll
    for (int e = 0; e < 8; ++e) { cmr[e] = mu[c0 + e]; cmk[e] = mu[256 + c0 + e]; cmv[e] = mu[512 + c0 + e]; ckk[e] = p.rwkk[l * 256 + c0 + e]; cka[e] = p.rwka[l * 256 + c0 + e]; }
  }
  half8 g0, g1, g2, g3, g4, g5, g6, g7; float gf0 = 0.f, gf1 = 0.f; bool gsv = false;
  g0 = g1 = g2 = g3 = g4 = g5 = g6 = g7 = (half8){0, 0, 0, 0, 0, 0, 0, 0};
#define SC_LOADG(S0I)                                                                              \
  {                                                                                                \
    const int sidx_ = (S0I) + ls;                                                                  \
    const int t_ = d == 0 ? sidx_ : T - 1 - sidx_;                                                 \
    const long token_ = base + t_;                                                                 \
    if (kind == 0) {                                                                               \
      gsv = d == 0 ? (t_ > 0) : (t_ < T - 1);                                                      \
      const h16* pb_ = p.proj + token_ * INC + RW_OFF + c0;                                        \
      const h16* ps_ = gsv ? p.proj + (token_ + (d == 0 ? -1 : 1)) * INC + RW_OFF + c0 : pb_;      \
      g0 = *(const half8*)pb_; g1 = *(const half8*)(pb_ + 256); g2 = *(const half8*)(pb_ + 512);   \
      g3 = *(const half8*)ps_; g4 = *(const half8*)(ps_ + 256); g5 = *(const half8*)(ps_ + 512);   \
      g6 = *(const half8*)(p.rwaux + ((token_ * 2 + d) * 2 + 0) * 256 + c0);                       \
      g7 = *(const half8*)(p.rwaux + ((token_ * 2 + d) * 2 + 1) * 256 + c0);                       \
      gf0 = p.rwsc[((token_ * 2 + d) * 4 + h) * 2];                                                \
    } else {                                                                                       \
      const h16* dp_ = p.dnp + token_ * 768 + c0;                                                  \
      g0 = *(const half8*)dp_; g1 = *(const half8*)(dp_ + 256); g2 = *(const half8*)(dp_ + 512);   \
      const float* sc_ = p.dnsc + ((token_ * 2 + d) * 4 + h) * 2;                                  \
      gf0 = sc_[0]; gf1 = sc_[1];                                                                  \
    }                                                                                              \
  }
  SC_LOADG(0)
  for (int s0i = 0; s0i < T; s0i += SC_CT) {
    __syncthreads();
    if (s0i > 0) SC_FLUSH(s0i - SC_CT)
    {
      f32x4 va[2], vw[2], vb[2], vk[2], vr[2], vv_[2];
      if (kind == 0) {
#pragma unroll
        for (int e = 0; e < 8; ++e) {
          float b_ = (float)g0[e], s_ = gsv ? (float)g3[e] : 0.f; const float rr = b_ + (s_ - b_) * cmr[e];
          b_ = (float)g1[e]; s_ = gsv ? (float)g4[e] : 0.f; const float kr = b_ + (s_ - b_) * cmk[e];
          b_ = (float)g2[e]; s_ = gsv ? (float)g5[e] : 0.f; const float vl = b_ + (s_ - b_) * cmv[e];
          const float asg = (float)g7[e];
          const float kk = kr * ckk[e] * gf0;
          va[e >> 2][e & 3] = -kk; vw[e >> 2][e & 3] = __expf(-(float)g6[e]); vb[e >> 2][e & 3] = kk * asg;
          vk[e >> 2][e & 3] = kr * (1.0f + (asg - 1.0f) * cka[e]); vr[e >> 2][e & 3] = rr; vv_[e >> 2][e & 3] = vl;
        }
      } else {
        const float beta = gf0, alpha = gf1;
#pragma unroll
        for (int e = 0; e < 8; ++e) {
          const float k = (float)g1[e];
          va[e >> 2][e & 3] = k; vw[e >> 2][e & 3] = alpha; vb[e >> 2][e & 3] = -alpha * beta * k;
          vk[e >> 2][e & 3] = beta * k; vr[e >> 2][e & 3] = (float)g0[e]; vv_[e >> 2][e & 3] = (float)g2[e];
        }
      }
      const int lo_ = ls * 64 + jb;
      *(f32x4*)(LA + lo_) = va[0]; *(f32x4*)(LA + lo_ + 4) = va[1]; *(f32x4*)(LW + lo_) = vw[0]; *(f32x4*)(LW + lo_ + 4) = vw[1];
      *(f32x4*)(LB + lo_) = vb[0]; *(f32x4*)(LB + lo_ + 4) = vb[1]; *(f32x4*)(LK + lo_) = vk[0]; *(f32x4*)(LK + lo_ + 4) = vk[1];
      *(f32x4*)(LR + lo_) = vr[0]; *(f32x4*)(LR + lo_ + 4) = vr[1]; *(f32x4*)(LV + lo_) = vv_[0]; *(f32x4*)(LV + lo_ + 4) = vv_[1];
    }
    __syncthreads();
    if (s0i + SC_CT < T) SC_LOADG(s0i + SC_CT)
    __builtin_amdgcn_sched_barrier(0);
#define SC_LD(A4, W4, B4, K4, R4, VV, Q)                                                                    \
    { const int o_ = (Q) * 64; A4 = *(const f32x4*)(LA + o_ + j0); W4 = *(const f32x4*)(LW + o_ + j0); B4 = *(const f32x4*)(LB + o_ + j0); \
      K4 = *(const f32x4*)(LK + o_ + j0); R4 = *(const f32x4*)(LR + o_ + j0); VV = *(const f32x2*)(LV + o_ + i); }
#define SC_STEP(ca, cw, cb, ck, cr, cv, Q)                                                                  \
    {                                                                                                       \
      float sa = S[0] * ca[0] + S[1] * ca[1] + S[2] * ca[2] + S[3] * ca[3];                                 \
      float sb = S1[0] * ca[0] + S1[1] * ca[1] + S1[2] * ca[2] + S1[3] * ca[3];                             \
      sa = sum16(sa); sb = sum16(sb);                                                                       \
      _Pragma("unroll") for (int c = 0; c < 4; ++c) { S[c] = S[c] * cw[c] + sa * cb[c] + cv[0] * ck[c]; S1[c] = S1[c] * cw[c] + sb * cb[c] + cv[1] * ck[c]; } \
      float o = S[0] * cr[0] + S[1] * cr[1] + S[2] * cr[2] + S[3] * cr[3];                                  \
      float o1 = S1[0] * cr[0] + S1[1] * cr[1] + S1[2] * cr[2] + S1[3] * cr[3];                             \
      o = sum16(o); o1 = sum16(o1);                                                                         \
      if (cl == 0) { half2v ov; ov[0] = (h16)o; ov[1] = (h16)o1; *(half2v*)(obuf + (Q) * 32 + wv * 8 + g * 2) = ov; } \
    }
    f32x4 a4, w4, b4, k4, r4, a5, w5, b5, k5, r5; f32x2 vv, vv5;
    SC_LD(a4, w4, b4, k4, r4, vv, 0)
    for (int q = 0; q < SC_CT; q += 2) {
      SC_LD(a5, w5, b5, k5, r5, vv5, q + 1)
      SC_STEP(a4, w4, b4, k4, r4, vv, q)
      if (q + 2 < SC_CT) SC_LD(a4, w4, b4, k4, r4, vv, q + 2)
      SC_STEP(a5, w5, b5, k5, r5, vv5, q + 1)
    }
#undef SC_LD
#undef SC_STEP
  }
  __syncthreads();
  SC_FLUSH(T - SC_CT)
#undef SC_FLUSH
  if (ctx) {
    if (kind == 0) {
      float* so = p.orw + (((((long)bi) * 2 + l) * 2 + d) * 4 + h) * 4096;
      *(f32x4*)(so + i * 64 + j0) = S; *(f32x4*)(so + (i + 1) * 64 + j0) = S1;
    } else {
      float* so = p.odn + (((((long)bi) * 2 + l) * 2 + d) * 4 + h) * 4096;
#pragma unroll
      for (int c = 0; c < 4; ++c) { so[(j0 + c) * 64 + i] = S[c]; so[(j0 + c) * 64 + i + 1] = S1[c]; }
    }
  }
}
#undef SC_LOADG
__device__ void blk_fin(long w, const P& p, int l, const float* g2s, float* sgs) {
  const int tid_ = otid(); const int lane = tid_ & 63; const long token = w * 4 + (tid_ >> 6);
  float* sgw = sgs + (tid_ >> 6) * 64;
  const int c4 = lane * 4;
  const int hd = lane >> 4;
  const h16* pr = p.proj + token * INC;
  h16* ao = p.act + token * 1024;
  int t, T; long base; seqinfo(token, t, T, base);
  const bool sv0 = t > 0, sv1 = t < T - 1;
  const float bon0 = p.rwsc[((token * 2 + 0) * 4 + hd) * 2 + 1], bon1 = p.rwsc[((token * 2 + 1) * 4 + hd) * 2 + 1];
  const half4 vb = *(const half4*)(pr + RW_OFF + 512 + c4);
  half4 vm = vb, vp = vb;
  if (sv0) vm = *(const half4*)(pr - INC + RW_OFF + 512 + c4);
  if (sv1) vp = *(const half4*)(pr + INC + RW_OFF + 512 + c4);
  const half4 d_o0 = *(const half4*)(pr + DN_OFF + c4), d_o1 = *(const half4*)(pr + DN_OFF + 256 + c4);
  const half4 d_z = *(const half4*)(pr + DN_OFF + 784 + c4);
  const f32x4 mu0 = *(const f32x4*)(p.rwmu + ((long)l * 2 + 0) * 832 + 512 + c4), mu1 = *(const f32x4*)(p.rwmu + ((long)l * 2 + 1) * 832 + 512 + c4);
  const f32x4 lng = *(const f32x4*)(p.rwlng + l * 256 + c4), lnb = *(const f32x4*)(p.rwlnb + l * 256 + c4);
  const f32x4 dng = *(const f32x4*)(p.dnng + l * 64 + (c4 & 63));
  {
    half4 o0 = *(const half4*)(ao + 256 + c4), o1 = *(const half4*)(ao + 768 + c4);
    float o[4]; float mu = 0.f;
#pragma unroll
    for (int e = 0; e < 4; ++e) { o[e] = (float)o0[e] + (float)o1[e]; mu += o[e]; }
    mu = sum16(mu) * (1.0f / 64);
    float var = 0.f;
#pragma unroll
    for (int e = 0; e < 4; ++e) { float dl = o[e] - mu; var += dl * dl; }
    var = sum16(var) * (1.0f / 64);
    const float rs = 1.0f / sqrtf(var + 64e-5f);
    const float sg = sigmoidf_((float)pr[RW_OFF + 896 + lane]);
    float gate[4] = {0.f, 0.f, 0.f, 0.f};
    sgw[lane] = sg;
    __syncthreads();
#pragma unroll 8
    for (int j = 0; j < 64; ++j) {
      const float sj = sgw[j];
      const f32x4 g2 = *(const f32x4*)(g2s + j * 256 + c4);
#pragma unroll
      for (int e = 0; e < 4; ++e) gate[e] += sj * g2[e];
    }
    half4 out;
#pragma unroll
    for (int e = 0; e < 4; ++e) {
      const float b_ = (float)vb[e];
      const float v0 = b_ + ((sv0 ? (float)vm[e] : 0.f) - b_) * mu0[e];
      const float v1 = b_ + ((sv1 ? (float)vp[e] : 0.f) - b_) * mu1[e];
      float y = (o[e] - mu) * rs * lng[e] + lnb[e] + bon0 * v0 + bon1 * v1;
      out[e] = (h16)(y * gate[e]);
    }
    *(half4*)(ao + 256 + c4) = out;
  }
  {
    const half4 o0 = d_o0, o1 = d_o1, z = d_z;
    float o[4]; float ss = 0.f;
#pragma unroll
    for (int e = 0; e < 4; ++e) { o[e] = (float)o0[e] + (float)o1[e]; ss += o[e] * o[e]; }
    ss = sum16(ss);
    const float rs = 1.0f / sqrtf(ss * (1.0f / 64) + 1e-6f);
    half4 out;
#pragma unroll
    for (int e = 0; e < 4; ++e) out[e] = (h16)(o[e] * rs * dng[e] * siluf_((float)z[e]));
    *(half4*)(ao + 768 + c4) = out;
  }
}

__device__ __forceinline__ float dot8h(half8 u, half8 x, float d) {
#pragma unroll
  for (int e = 0; e < 8; ++e) d += (float)u[e] * (float)x[e];
  return d;
}
__device__ __forceinline__ void cvt8(const float* src, h16* dst, long i) {
  const f32x4 a = *(const f32x4*)(src + i * 8), b = *(const f32x4*)(src + i * 8 + 4);
  half8 o; o[0] = (h16)a[0]; o[1] = (h16)a[1]; o[2] = (h16)a[2]; o[3] = (h16)a[3]; o[4] = (h16)b[0]; o[5] = (h16)b[1]; o[6] = (h16)b[2]; o[7] = (h16)b[3];
  *(half8*)(dst + i * 8) = o;
}
__device__ __forceinline__ float sum64u(float x) {
  x = sum16(x);
  x += __builtin_bit_cast(float, __builtin_amdgcn_update_dpp(0, __builtin_bit_cast(int, x), 0x142, 0xA, 0xF, false));
  x += __builtin_bit_cast(float, __builtin_amdgcn_update_dpp(0, __builtin_bit_cast(int, x), 0x143, 0xC, 0xF, false));
  return __builtin_bit_cast(float, __builtin_amdgcn_readlane(__builtin_bit_cast(int, x), 63));
}
__device__ __forceinline__ float ferf(float x) {
  const float ax = fabsf(x);
  const float t = __frcp_rn(1.0f + 0.3275911f * ax);
  const float y = 1.0f - (((((1.061405429f * t - 1.453152027f) * t) + 1.421413741f) * t - 0.284496736f) * t + 0.254829592f) * t * __expf(-ax * ax);
  return x < 0.f ? -y : y;
}
__device__ __forceinline__ void cvt16_fp8(const float* src, unsigned char* dst, long i, float scale) {
  u32x4 o;
#pragma unroll
  for (int k = 0; k < 4; ++k) {
    const f32x4 a = *(const f32x4*)(src + i * 16 + k * 4);
    int w = __builtin_amdgcn_cvt_pk_fp8_f32(a[0] * scale, a[1] * scale, 0, false);
    w = __builtin_amdgcn_cvt_pk_fp8_f32(a[2] * scale, a[3] * scale, w, true);
    o[k] = (unsigned)w;
  }
  *(u32x4*)(dst + i * 16) = o;
}
__device__ void fin_phase(const P& p, int l) {
  float* g2s = (float*)g_smem;
  float* sgs = g2s + 64 * 256;
  const int tid = otid();
  __syncthreads();
  const f32x4* src = (const f32x4*)(p.rwg2 + (long)l * 64 * 256);
#pragma unroll
  for (int j = 0; j < 16; ++j) ((f32x4*)g2s)[tid + 256 * j] = src[tid + 256 * j];
  __syncthreads();
  for (long w = blockIdx.x; w < NT / 4; w += gridDim.x) blk_fin(w, p, l, g2s, sgs);
}
typedef unsigned u32x2 __attribute__((ext_vector_type(2)));
__device__ __forceinline__ void cvt16_fp4(const float* src, unsigned char* dst, long i, float scale) {
  u32x2 o;
#pragma unroll
  for (int k = 0; k < 2; ++k) {
    const f32x4 a = *(const f32x4*)(src + i * 16 + k * 8), b = *(const f32x4*)(src + i * 16 + k * 8 + 4);
    unsigned w = 0u;
    w = __builtin_amdgcn_cvt_scalef32_pk_fp4_f32(w, a[0] * scale, a[1] * scale, 1.0f, 0);
    w = __builtin_amdgcn_cvt_scalef32_pk_fp4_f32(w, a[2] * scale, a[3] * scale, 1.0f, 1);
    w = __builtin_amdgcn_cvt_scalef32_pk_fp4_f32(w, b[0] * scale, b[1] * scale, 1.0f, 2);
    w = __builtin_amdgcn_cvt_scalef32_pk_fp4_f32(w, b[2] * scale, b[3] * scale, 1.0f, 3);
    o[k] = w;
  }
  *(u32x2*)(dst + i * 8) = o;
}
#define PEER_USCALE 48.0f
#define PEER_VSCALE 16.0f
struct PairTab { int a[50]; int b[50]; };
__host__ __device__ constexpr PairTab make_pairs() {
  PairTab t{}; int n = 0;
  for (int a = 0; a < 16; ++a) for (int b = 0; b < 16; ++b) if ((a + 1) * (b + 1) <= 16) { t.a[n] = a; t.b[n] = b; ++n; }
  return t;
}
template <bool DRY>
__device__ void blk_peer(long w, const P& p, int l) {
  constexpr PairTab PT = make_pairs();
  const int tid_ = otid(); const int lane = tid_ & 63, wv = tid_ >> 6; const long token = w * 4 + wv;
  int* eidx = (int*)g_smem + wv * 256; float* egate = (float*)g_smem + wv * 256 + 128;
  const h16* xr = p.act + token * 1024 + lane * 16;
  const half8 x0 = *(const half8*)xr, x1 = *(const half8*)(xr + 8);
  int la = 0, lb = 0;
#pragma unroll
  for (int j = 0; j < 50; ++j) if (lane == j) { la = PT.a[j]; lb = PT.b[j]; }
  const int lc = la * 16 + lb;
  __syncthreads();
  float cs_[8]; int ce_[8];
#pragma unroll
  for (int hd = 0; hd < 8; ++hd) {
    const float* s1 = p.tks + token * 256 + hd * 32; const int* i1 = p.tki + token * 256 + hd * 32;
    const int la_ = lane < 50 ? la : 0, lb_ = lane < 50 ? lb : 0;
    cs_[hd] = s1[la_] + s1[16 + lb_]; ce_[hd] = i1[la_] * CFG_NKEYS + i1[16 + lb_];
  }
#pragma unroll
  for (int hd = 0; hd < 8; ++hd) {
    const float s = lane < 50 ? cs_[hd] : -3.0e38f;
    int rank = 0;
#pragma unroll
    for (int j = 0; j < 50; ++j) {
      const float sj = __builtin_bit_cast(float, __builtin_amdgcn_readlane(__builtin_bit_cast(int, s), j));
      rank += (sj > s) ? 1 : 0;
    }
    {
      int mk = (lane < 50 && rank < 16) ? (1 << rank) : 0;
      mk |= __builtin_amdgcn_update_dpp(0, mk, 0x128, 0xF, 0xF, true); mk |= __builtin_amdgcn_update_dpp(0, mk, 0x124, 0xF, 0xF, true);
      mk |= __builtin_amdgcn_update_dpp(0, mk, 0xB1, 0xF, 0xF, true);  mk |= __builtin_amdgcn_update_dpp(0, mk, 0x4E, 0xF, 0xF, true);
      const int mall = __builtin_amdgcn_readlane(mk, 0) | __builtin_amdgcn_readlane(mk, 16) | __builtin_amdgcn_readlane(mk, 32) | __builtin_amdgcn_readlane(mk, 48);
      const int nsel = __builtin_popcountll(__ballot(lane < 50 && rank < 16));
      if (mall != 0xFFFF || nsel != 16) {
        rank = 0;
#pragma unroll 1
        for (int j = 0; j < 50; ++j) {
          const float sj = __builtin_bit_cast(float, __builtin_amdgcn_readlane(__builtin_bit_cast(int, s), j));
          rank += (sj > s || (sj == s && j < lane)) ? 1 : 0;
        }
      }
    }
    const bool sel = lane < 50 && rank < 16;
    const float m = __builtin_bit_cast(float, __builtin_amdgcn_readlane(__builtin_bit_cast(int, s), 0));
    const float e = sel ? expf(s - m) : 0.f;
    const float sum = sum64(e);
    if (sel) { eidx[hd * 16 + rank] = ce_[hd]; egate[hd * 16 + rank] = e / sum; }
  }
  __syncthreads();
  f32x2 x2[8];
#pragma unroll
  for (int e = 0; e < 4; ++e) { x2[e][0] = (float)x0[2 * e]; x2[e][1] = (float)x0[2 * e + 1]; x2[4 + e][0] = (float)x1[2 * e]; x2[4 + e][1] = (float)x1[2 * e + 1]; }
  f32x2 acc2[8];
#pragma unroll
  for (int e = 0; e < 8; ++e) { acc2[e][0] = 0.f; acc2[e][1] = 0.f; }
  const unsigned char* u8 = (const unsigned char*)p.u16; const unsigned char* v8 = (const unsigned char*)p.v16;
#define PEER_LOAD(U, V, GT, EB)                                                                   \
  _Pragma("unroll") for (int q = 0; q < 8; ++q) {                                                 \
    const unsigned ro_ = (unsigned)eidx[(EB) + q] * 512u + (unsigned)lane * 8u; GT[q] = egate[(EB) + q];   \
    U[q] = *(const u32x2*)(u8 + ro_); V[q] = *(const u32x2*)(v8 + ro_);                           \
  }
#define PEER_COMP(U, V, GT)                                                                       \
  {                                                                                               \
    float dd_[8];                                                                                 \
    _Pragma("unroll") for (int q = 0; q < 8; ++q) {                                               \
      f32x2 d2 = {0.f, 0.f};                                                                      \
      _Pragma("unroll") for (int k = 0; k < 2; ++k) {                                             \
        d2 += __builtin_amdgcn_cvt_scalef32_pk_f32_fp4(U[q][k], 1.0f, 0) * x2[4 * k];             \
        d2 += __builtin_amdgcn_cvt_scalef32_pk_f32_fp4(U[q][k], 1.0f, 1) * x2[4 * k + 1];         \
        d2 += __builtin_amdgcn_cvt_scalef32_pk_f32_fp4(U[q][k], 1.0f, 2) * x2[4 * k + 2];         \
        d2 += __builtin_amdgcn_cvt_scalef32_pk_f32_fp4(U[q][k], 1.0f, 3) * x2[4 * k + 3];         \
      }                                                                                           \
      dd_[q] = sum64u(d2[0] + d2[1]) * (1.0f / PEER_USCALE);                                      \
    }                                                                                             \
      \
    float dv_ = dd_[7];                                                                           \
    _Pragma("unroll") for (int q = 6; q >= 0; --q) dv_ = lane == q ? dd_[q] : dv_;                \
    const float gv_ = 0.5f * dv_ * (1.0f + erff(dv_ * 0.70710678118654752f));                     \
    _Pragma("unroll") for (int q = 0; q < 8; ++q) {                                               \
      const float wgt = GT[q] * __builtin_bit_cast(float, __builtin_amdgcn_readlane(__builtin_bit_cast(int, gv_), q)) * (1.0f / PEER_VSCALE); \
      const f32x2 w2 = {wgt, wgt};                                                                \
      _Pragma("unroll") for (int k = 0; k < 2; ++k) {                                             \
        acc2[4 * k] += w2 * __builtin_amdgcn_cvt_scalef32_pk_f32_fp4(V[q][k], 1.0f, 0);           \
        acc2[4 * k + 1] += w2 * __builtin_amdgcn_cvt_scalef32_pk_f32_fp4(V[q][k], 1.0f, 1);       \
        acc2[4 * k + 2] += w2 * __builtin_amdgcn_cvt_scalef32_pk_f32_fp4(V[q][k], 1.0f, 2);       \
        acc2[4 * k + 3] += w2 * __builtin_amdgcn_cvt_scalef32_pk_f32_fp4(V[q][k], 1.0f, 3);       \
      }                                                                                           \
    }                                                                                             \
  }
  u32x2 au[8], av[8], bu[8], bv[8];
  float ag[8], bg[8];
  PEER_LOAD(au, av, ag, 0)
  for (int eb = 0; eb < 128; eb += 16) {
    PEER_LOAD(bu, bv, bg, eb + 8)
    __builtin_amdgcn_sched_barrier(0);
    PEER_COMP(au, av, ag)
    if (eb + 16 < 128) { PEER_LOAD(au, av, ag, eb + 16) }
    __builtin_amdgcn_sched_barrier(0);
    PEER_COMP(bu, bv, bg)
  }
#undef PEER_LOAD
#undef PEER_COMP
  const float* g2 = p.mod + ((long)l * NCOND + condrow(token)) * 6144 + 5120 + lane * 16;
  float* xo = p.X + token * 1024 + lane * 16;
  f32x4 xn[4]; float ssq = 0.f;
#pragma unroll
  for (int k = 0; k < 4; ++k) {
    xn[k] = *(f32x4*)(xo + 4 * k);
    const f32x4 ga = *(const f32x4*)(g2 + 4 * k);
#pragma unroll
    for (int e = 0; e < 4; ++e) { xn[k][e] += ga[e] * acc2[2 * k + (e >> 1)][e & 1]; ssq += xn[k][e] * xn[k][e]; }
  }
  if (DRY) { if (acc2[0][0] == 123456.789f) *(f32x4*)xo = xn[0]; return; }
  const float rstd = 1.0f / sqrtf(sum64u(ssq) * (1.0f / 1024) + 1e-6f);
  if (l == 0) {
    const float* m = p.mod + ((long)1 * NCOND + condrow(token)) * 6144 + lane * 16;
    const float* g = p.n1g + 1024 + lane * 16;
    half8 h0, h1;
    f32x4 gga[4], sha[4], sca[4];
#pragma unroll
    for (int k = 0; k < 4; ++k) { gga[k] = *(const f32x4*)(g + 4 * k); sha[k] = *(const f32x4*)(m + 4 * k); sca[k] = *(const f32x4*)(m + 1024 + 4 * k); }
#pragma unroll
    for (int k = 0; k < 4; ++k) {
      *(f32x4*)(xo + 4 * k) = xn[k];
      const f32x4 gg = gga[k], sh = sha[k], sc = sca[k];
#pragma unroll
      for (int e = 0; e < 4; ++e) {
        const h16 hv = (h16)((xn[k][e] * rstd * gg[e]) * (1.0f + sc[e]) + sh[e]);
        if (k < 2) h0[4 * k + e] = hv; else h1[4 * (k - 2) + e] = hv;
      }
    }
    h16* ho = p.act + token * 1024 + lane * 16;
    *(half8*)ho = h0; *(half8*)(ho + 8) = h1;
  } else {
    f32x4 fga[4];
#pragma unroll
    for (int k = 0; k < 4; ++k) fga[k] = *(const f32x4*)(p.fng + lane * 16 + 4 * k);
#pragma unroll
    for (int k = 0; k < 4; ++k) {
      const f32x4 gg = fga[k];
      f32x4 y;
#pragma unroll
      for (int e = 0; e < 4; ++e) y[e] = xn[k][e] * rstd * gg[e];
      *(f32x4*)(xo + 4 * k) = y;
    }
  }
}

__device__ void blk_attn(int type, int idx, const P& p, int l) {
  h16* Ks = (h16*)g_smem;
  h16* Vt = Ks + 64 * 72;
  float* Bt = (float*)(Vt + 64 * 72);
  const int tid = otid(), lane = tid & 63, wv = tid >> 6, ql = lane & 31, hh = lane >> 5;
  int b, hk, tb; long qtok; int qcol_off, kcol_off, vcol_off, outcol; float qscale; int ntl, ntc; long kbase_tok;
  const float *ck = nullptr, *cv = nullptr;
  int grow = 0, r0w = 0, krmin = 0;
  if (type == 0) {
    tb = idx & 3; hk = (idx >> 2) & 1; b = idx >> 3;
    const int head = hk * 2 + (wv & 1);
    kbase_tok = (long)b * CFG_SEQ; qtok = kbase_tok + tb * 64 + (wv >> 1) * 32 + ql;
    qcol_off = head * 64; kcol_off = 256 + hk * 64; vcol_off = 384 + hk * 64; outcol = head * 64; qscale = 1.0f; ntl = CFG_SEQ / 64; ntc = 0;
  } else if (type == 1) {
    tb = idx & 63; hk = (idx >> 6) & 1; b = idx >> 7;
    const int head = hk * 2 + (wv & 1);
    kbase_tok = (long)NTC + (long)b * CFG_DS; qtok = kbase_tok + tb * 64 + (wv >> 1) * 32 + ql;
    qcol_off = head * 64; kcol_off = 256 + hk * 64; vcol_off = 384 + hk * 64; outcol = head * 64; qscale = 1.0f; ntl = CFG_DS / 64; ntc = CFG_PAST / 64;
    ck = p.cgk + (((long)b * 2 + l) * 2 + hk) * CFG_PAST * 64; cv = p.cgv + (((long)b * 2 + l) * 2 + hk) * CFG_PAST * 64;
  } else if (type == 2) {
    tb = idx & 1; hk = (idx >> 1) & 3; b = idx >> 3;
    kbase_tok = (long)b * CFG_SEQ; qtok = kbase_tok + tb * 128 + wv * 32 + ql;
    qcol_off = NA_OFF + hk * 64; kcol_off = NA_OFF + 256 + hk * 64; vcol_off = NA_OFF + 512 + hk * 64; outcol = 512 + hk * 64; qscale = 0.125f; ntl = CFG_SEQ / 64; ntc = 0;
  } else {
    tb = idx & 31; hk = (idx >> 5) & 3; b = idx >> 7;
    kbase_tok = (long)NTC + (long)b * CFG_DS;
    grow = tb * 2 + (wv >> 1);
    qtok = kbase_tok + grow * 64 + (wv & 1) * 32 + ql;
    qcol_off = NA_OFF + hk * 64; kcol_off = NA_OFF + 256 + hk * 64; vcol_off = NA_OFF + 512 + hk * 64; outcol = 512 + hk * 64; qscale = 0.125f;
    r0w = grow - WR / 2; r0w = r0w < 0 ? 0 : (r0w > GROWS - WR ? GROWS - WR : r0w);
    int ra = tb * 2 - WR / 2; ra = ra < 0 ? 0 : (ra > GROWS - WR ? GROWS - WR : ra);
    int rb = tb * 2 + 1 - WR / 2; rb = rb < 0 ? 0 : (rb > GROWS - WR ? GROWS - WR : rb);
    krmin = ra; ntl = rb + WR - ra; ntc = CFG_PAST / 64;
    ck = p.cnk + (((long)b * 2 + l) * 4 + hk) * CFG_PAST * 64; cv = p.cnv + (((long)b * 2 + l) * 4 + hk) * CFG_PAST * 64;
  }
  const int nt = ntl + ntc;
  __syncthreads();
  if (type == 3) { for (int e = tid; e < 465; e += 256) Bt[e] = p.nabias[((long)l * 4 + hk) * 465 + e]; }
  half8 qf[4];
  {
    const h16* qp = p.proj + qtok * INC + qcol_off + hh * 8;
#pragma unroll
    for (int ds = 0; ds < 4; ++ds) qf[ds] = *(const half8*)(qp + ds * 16);
  }
  const int qc = (int)((qtok - kbase_tok) & 63);
  int cst = qc - 8; cst = cst < 0 ? 0 : (cst > 48 ? 48 : cst);
  f32x16 o0 = {0.f, 0.f, 0.f, 0.f, 0.f, 0.f, 0.f, 0.f, 0.f, 0.f, 0.f, 0.f, 0.f, 0.f, 0.f, 0.f};
  f32x16 o1 = o0;
  float m = -1.0e30f, lsum = 0.f;
  half8 kx0, kx1, vx0, vx1;
  const int skey0 = tid >> 3, sdc = tid & 7;
#define ATT_LOAD(TI)                                                                                       \
  {                                                                                                        \
    const int ti_ = (TI);                                                                                  \
    if (ti_ < ntc) {                                                                                       \
      const float* kk_ = ck + ((long)ti_ * 64 + skey0) * 64 + sdc * 8;                                     \
      const float* vv_ = cv + ((long)ti_ * 64 + skey0) * 64 + sdc * 8;                                     \
      f32x4 a_ = *(const f32x4*)kk_, b_ = *(const f32x4*)(kk_ + 4), c_ = *(const f32x4*)(kk_ + 2048), d_ = *(const f32x4*)(kk_ + 2052); \
      _Pragma("unroll") for (int e = 0; e < 4; ++e) { kx0[e] = (h16)a_[e]; kx0[4 + e] = (h16)b_[e]; kx1[e] = (h16)c_[e]; kx1[4 + e] = (h16)d_[e]; } \
      a_ = *(const f32x4*)vv_; b_ = *(const f32x4*)(vv_ + 4); c_ = *(const f32x4*)(vv_ + 2048); d_ = *(const f32x4*)(vv_ + 2052); \
      _Pragma("unroll") for (int e = 0; e < 4; ++e) { vx0[e] = (h16)a_[e]; vx0[4 + e] = (h16)b_[e]; vx1[e] = (h16)c_[e]; vx1[4 + e] = (h16)d_[e]; } \
    } else {                                                                                               \
      const long t0_ = kbase_tok + (long)((type == 3 ? krmin : 0) + (ti_ - ntc)) * 64;                     \
      const h16* r_ = p.proj + (t0_ + skey0) * INC + sdc * 8;                                              \
      kx0 = *(const half8*)(r_ + kcol_off); kx1 = *(const half8*)(r_ + 32 * INC + kcol_off);              \
      vx0 = *(const half8*)(r_ + vcol_off); vx1 = *(const half8*)(r_ + 32 * INC + vcol_off);              \
    }                                                                                                      \
  }
  ATT_LOAD(0)
  for (int ti = 0; ti < nt; ++ti) {
    __syncthreads();
    *(half8*)(Ks + skey0 * 72 + sdc * 8) = kx0; *(half8*)(Ks + (skey0 + 32) * 72 + sdc * 8) = kx1;
    *(half8*)(Vt + skey0 * 72 + sdc * 8) = vx0; *(half8*)(Vt + (skey0 + 32) * 72 + sdc * 8) = vx1;
    __syncthreads();
    if (ti + 1 < nt) ATT_LOAD(ti + 1)
    __builtin_amdgcn_sched_barrier(0);
    const bool local = type == 3 && ti >= ntc;
    const int kr = krmin + (ti - ntc);
    if (local && (kr < r0w || kr >= r0w + WR)) continue;
    f32x16 s0 = {0.f, 0.f, 0.f, 0.f, 0.f, 0.f, 0.f, 0.f, 0.f, 0.f, 0.f, 0.f, 0.f, 0.f, 0.f, 0.f};
    f32x16 s1 = s0;
#pragma unroll
    for (int ds = 0; ds < 4; ++ds) {
      const half8 a0 = *(const half8*)(Ks + ql * 72 + ds * 16 + hh * 8);
      const half8 a1 = *(const half8*)(Ks + (32 + ql) * 72 + ds * 16 + hh * 8);
      s0 = __builtin_amdgcn_mfma_f32_32x32x16_f16(a0, qf[ds], s0, 0, 0, 0);
      s1 = __builtin_amdgcn_mfma_f32_32x32x16_f16(a1, qf[ds], s1, 0, 0, 0);
    }
    float mx = -1.0e30f;
    if (local) {
      const float* brow = Bt + (kr - grow + 7) * 31 + 15 - qc;
#pragma unroll
      for (int i = 0; i < 16; ++i) {
        const int kc0 = (i & 3) + 8 * (i >> 2) + 4 * hh, kc1 = kc0 + 32;
        s0[i] = (kc0 >= cst && kc0 < cst + 16) ? s0[i] * 0.125f + brow[kc0] : -1.0e30f;
        s1[i] = (kc1 >= cst && kc1 < cst + 16) ? s1[i] * 0.125f + brow[kc1] : -1.0e30f;
      }
    } else if (qscale != 1.0f) {
#pragma unroll
      for (int i = 0; i < 16; ++i) { s0[i] *= qscale; s1[i] *= qscale; }
    }
#pragma unroll
    for (int i = 0; i < 16; ++i) mx = fmaxf(mx, fmaxf(s0[i], s1[i]));
    mx = fmaxf(mx, __shfl_xor(mx, 32));
    const float mn = fmaxf(m, mx);
    const float alpha = __expf(m - mn);
    m = mn; lsum *= alpha;
#pragma unroll
    for (int i = 0; i < 16; ++i) { o0[i] *= alpha; o1[i] *= alpha; }
    float ps = 0.f;
#pragma unroll
    for (int i = 0; i < 16; ++i) { s0[i] = __expf(s0[i] - mn); s1[i] = __expf(s1[i] - mn); ps += s0[i] + s1[i]; }
    lsum += ps;
    half8 pf0, pf1, pf2, pf3;
#pragma unroll
    for (int j = 0; j < 8; ++j) { pf0[j] = (h16)s0[j]; pf1[j] = (h16)s0[8 + j]; pf2[j] = (h16)s1[j]; pf3[j] = (h16)s1[8 + j]; }
#define TRD(ptr) __builtin_bit_cast(half4, __builtin_amdgcn_ds_read_tr16_b64_v4i16((__attribute__((address_space(3))) s16x4v*)(ptr)))
#define ATT_PV(KS, PF)                                                                              \
    {                                                                                               \
        \
      const h16* v0_ = Vt + (16 * (KS) + 4 * hh + ((lane & 15) >> 2)) * 72 + 16 * ((lane >> 4) & 1) + 4 * (lane & 3); \
      const half4 lo0 = TRD(v0_), hi0 = TRD(v0_ + 8 * 72);                                          \
      const half4 lo1 = TRD(v0_ + 32), hi1 = TRD(v0_ + 8 * 72 + 32);                                \
      const half8 a0_ = __builtin_shufflevector(lo0, hi0, 0, 1, 2, 3, 4, 5, 6, 7);                  \
      const half8 a1_ = __builtin_shufflevector(lo1, hi1, 0, 1, 2, 3, 4, 5, 6, 7);                  \
      o0 = __builtin_amdgcn_mfma_f32_32x32x16_f16(a0_, PF, o0, 0, 0, 0);                            \
      o1 = __builtin_amdgcn_mfma_f32_32x32x16_f16(a1_, PF, o1, 0, 0, 0);                            \
    }
    ATT_PV(0, pf0) ATT_PV(1, pf1) ATT_PV(2, pf2) ATT_PV(3, pf3)
#undef ATT_PV
#undef TRD
  }
#undef ATT_LOAD
  lsum += __shfl_xor(lsum, 32);
  const float inv = 1.0f / lsum;
  h16* op = p.act + qtok * 1024 + outcol;
#pragma unroll
  for (int g = 0; g < 4; ++g) {
    half4 a, c;
#pragma unroll
    for (int e = 0; e < 4; ++e) { a[e] = (h16)(o0[4 * g + e] * inv); c[e] = (h16)(o1[4 * g + e] * inv); }
    *(half4*)(op + 8 * g + 4 * hh) = a;
    *(half4*)(op + 32 + 8 * g + 4 * hh) = c;
  }
}
#define N_SCAN_LAT (2 * 2 * CFG_DB * 4 * 2)
#define N_SCAN_CTX (2 * 2 * CFG_BATCH * 4 * 2)
#define N_ATT1 (CFG_DB * 2 * (CFG_DS / 64))
#define N_ATT3 (CFG_DB * 4 * (CFG_DS / 128))
#define N_ATT0 (CFG_BATCH * 2 * (CFG_SEQ / 64))
#define N_ATT2 (CFG_BATCH * 4 * (CFG_SEQ / 128))
__device__ __forceinline__ void run_scan_item(int r, bool latent, const P& p, int l) {
  const int rq = r & 1; r >>= 1; const int kind = r & 1; r >>= 1; const int d = r & 1; r >>= 1; const int h = r & 3; r >>= 2;
  if (latent) __builtin_amdgcn_s_setprio(3);
  blk_scan2(kind, latent ? CFG_BATCH + r : r, h, d, rq, p, l);
  if (latent) __builtin_amdgcn_s_setprio(0);
}
__device__ void mixer_phase(const P& p, int lc, int mode = 0) {
  const int l = lc & 1;
  __shared__ long s_item;
  __shared__ unsigned s_slot;
  const long total = N_SCAN_CTX + N_ATT1 + N_ATT3 + N_ATT0 + N_ATT2;
  unsigned* lat_cnt = p.counters + 8 + lc;
  if (mode == 0) {
    __syncthreads();
    if (threadIdx.x == 0) {
      const unsigned hw = __builtin_amdgcn_s_getreg((31 << 11) | 4);
      const unsigned xcc = __builtin_amdgcn_s_getreg((3 << 11) | 20) & 0xFu;
      const unsigned key = (xcc << 8) | ((hw >> 8) & 0xFFu);
      const unsigned slot = atomicAdd(p.cucnt + lc * 4096 + key, 1u);
      s_slot = slot;
      s_item = slot == 0 ? (long)atomicAdd(lat_cnt, 1u) : (long)N_SCAN_LAT;
    }
    __syncthreads();
    const long w = s_item;
    if (w < N_SCAN_LAT) run_scan_item((int)w, true, p, l);
  }
  for (;;) {
    __syncthreads();
    if (threadIdx.x == 0) s_item = (long)atomicAdd(p.counters + lc, 1u);
    __syncthreads();
    long w = s_item;
    if (mode == 2) w += N_SCAN_CTX;
    if (w >= (mode == 1 ? (long)N_SCAN_CTX : total)) break;
    if (w < N_SCAN_CTX) {
      run_scan_item((int)w, false, p, l);
    } else {
      int a = (int)(w - N_SCAN_CTX);
      int ty;
      if (a < N_ATT1) ty = 1;
      else if ((a -= N_ATT1) < N_ATT3) ty = 3;
      else if ((a -= N_ATT3) < N_ATT0) ty = 0;
      else { a -= N_ATT0; ty = 2; }
      blk_attn(ty, a, p, l);
    }
  }
  if (mode != 2) {
    for (;;) {
      __syncthreads();
      if (threadIdx.x == 0) s_item = (long)atomicAdd(lat_cnt, 1u);
      __syncthreads();
      const long w = s_item;
      if (w >= N_SCAN_LAT) break;
      run_scan_item((int)w, true, p, l);
    }
  }
}


#define XB_TMO      128
#define XB_XCNT(j)  (256  + 64 * (j))
#define XB_XSUB(j)  (1280 + 64 * (j))
#define XB_XGEN(j)  (2304 + 64 * (j))
#define XB_TOP      3328
#define XB_TOPGEN   3392
#define XCD_BAR_WORDS 3456
#define XB_SPIN_CAP (1u << 22)
#define LAS __attribute__((address_space(3)))
__device__ __forceinline__ unsigned xb_ld(unsigned* p)              { return __hip_atomic_load(p, __ATOMIC_RELAXED, __HIP_MEMORY_SCOPE_AGENT); }
__device__ __forceinline__ unsigned xb_add(unsigned* p, unsigned v) { return __hip_atomic_fetch_add(p, v, __ATOMIC_RELAXED, __HIP_MEMORY_SCOPE_AGENT); }
__device__ __forceinline__ unsigned xb_xcc_id() { return (unsigned)__builtin_amdgcn_s_getreg((3 << 11) | 20) & 0xFu; }
#define XB_SPIN(cond, bar) do { unsigned _sp = 0; while (cond) { __builtin_amdgcn_s_sleep(1); \
    if ((++_sp & 255u) == 0u) { if (xb_ld(&(bar)[XB_TMO])) break; if (_sp > XB_SPIN_CAP) { atomicAdd(&(bar)[XB_TMO], 1u); break; } } } } while (0)
struct XcdBarrier { unsigned* bar; unsigned x; volatile LAS unsigned* st; };
__device__ __forceinline__ XcdBarrier xcd_barrier_post(unsigned* bar, volatile LAS unsigned* st) {
  XcdBarrier b; b.bar = bar; b.x = xb_xcc_id(); b.st = st;
  if (threadIdx.x == 0) (void)xb_add(&bar[XB_XCNT(b.x)], 1u);
  return b;
}
__device__ __forceinline__ void xcd_barrier_complete(unsigned* bar, unsigned x, unsigned& nloc, unsigned& nx) {
  const unsigned G = gridDim.x * gridDim.y * gridDim.z;
  unsigned sum, cnt, mine, sp = 0u;
  for (;;) {
    sum = 0u; cnt = 0u; mine = 0u;
#pragma unroll
    for (unsigned j = 0; j < 16; ++j) { const unsigned c = xb_ld(&bar[XB_XCNT(j)]); sum += c; cnt += (c > 0u) ? 1u : 0u; mine = (j == x) ? c : mine; }
    if (sum == G) break;
    __builtin_amdgcn_s_sleep(1);
    if ((++sp & 255u) == 0u) { if (xb_ld(&bar[XB_TMO])) break; if (sp > XB_SPIN_CAP) { atomicAdd(&bar[XB_TMO], 1u); break; } }
  }
  nloc = mine > 0u ? mine : 1u; nx = cnt > 0u ? cnt : 1u;
}
__device__ __forceinline__ void xcd_barrier(const XcdBarrier& b) {
  asm volatile("s_waitcnt vmcnt(0)" ::: "memory");
  __syncthreads();
  if (threadIdx.x == 0) {
    unsigned* bar = b.bar;
    __builtin_amdgcn_s_waitcnt(0);
    unsigned nloc = b.st[0], nx = b.st[1];
    if (nloc == 0u) { xcd_barrier_complete(bar, b.x, nloc, nx); b.st[0] = nloc; b.st[1] = nx; }
    const unsigned old = xb_add(&bar[XB_XSUB(b.x)], 1u);
    const unsigned gen = old / nloc;
    if (old + 1u == (gen + 1u) * nloc) {
      __builtin_amdgcn_fence(__ATOMIC_RELEASE, "agent");
      asm volatile("s_waitcnt vmcnt(0)" ::: "memory");
      const unsigned og = xb_add(&bar[XB_TOP], 1u);
      const unsigned tg = og / nx;
      if (og + 1u == (tg + 1u) * nx) xb_add(&bar[XB_TOPGEN], 1u);
      else XB_SPIN(xb_ld(&bar[XB_TOPGEN]) == tg, bar);
      __builtin_amdgcn_fence(__ATOMIC_ACQUIRE, "agent");
      xb_add(&bar[XB_XGEN(b.x)], 1u);
      asm volatile("s_waitcnt vmcnt(0)" ::: "memory");
    } else {
      XB_SPIN(xb_ld(&bar[XB_XGEN(b.x)]) == gen, bar);
      __builtin_amdgcn_fence(__ATOMIC_ACQUIRE, "agent");
      asm volatile("s_waitcnt vmcnt(0)" ::: "memory");
    }
  }
  __syncthreads();
}

#define STAGE(fn, n) for (long i_ = (long)blockIdx.x * 256 + otid(); i_ < (long)(n); i_ += (long)gridDim.x * 256) fn(i_, p, l);
#define BSTAGE(fn, n) for (long w_ = blockIdx.x; w_ < (long)(n); w_ += gridDim.x) fn(w_, p, l);
#define SYNC { XcdBarrier xb_; xb_.bar = p.xbar; xb_.x = xb_xcc_id(); xb_.st = (volatile LAS unsigned*)&xb_words; xcd_barrier(xb_); }
__global__ void __launch_bounds__(256, 2) mega(P p) {
  cg::grid_group grid = cg::this_grid();
  __shared__ uint4 xb_words;
  if (threadIdx.x == 0) xb_words = make_uint4(0u, 0u, 0u, 0u);
  __syncthreads();
  (void)xcd_barrier_post(p.xbar, (volatile LAS unsigned*)&xb_words);
#define gtid ((long)blockIdx.x * 256 + otid())
#define gstride ((long)gridDim.x * 256)
  { int l = 0;
    if (gtid < 16) p.counters[gtid] = 0u;
    for (long i_ = gtid; i_ < 4 * 4096; i_ += gstride) p.cucnt[i_] = 0u;
    for (int rep_ = 0; rep_ < REP_S0; ++rep_) {
    for (long w_ = blockIdx.x; w_ < 3200; w_ += gridDim.x) blk_convert(w_, p);
    for (long w_ = blockIdx.x; w_ < 2L * NCOND * 24; w_ += gridDim.x) blk_mod(w_, p);
    for (long i_ = gtid; i_ < 2L * 16 * CFG_NKEYS * 128 / 8; i_ += gstride) cvt8(p.pkeys, p.keys16, i_);
    }
  }
  grid.sync();
#pragma unroll 1
  for (int ph = 0; ph < 18; ++ph) {
    const int l = ph >= 9 ? 1 : 0; const int k = ph - 9 * l;
    if (k == 0 && l == 1) continue;
    switch (k) {
      case 0: { BSTAGE(blk_norm<0>, NT / 4) } break;
      case 1: gemm_phase<0>(p, l); break;
      case 2: {
        STAGE(b_prep_gqa, (long)NT * 6)
        STAGE(b_prep_cache, (long)NTC * 640)
        half8 bf0 = {0, 0, 0, 0, 0, 0, 0, 0}, bf1 = bf0; int bkey = -1;
        for (long w_ = blockIdx.x; w_ < (long)N_PREP_RW + N_PREP_DN; w_ += gridDim.x) blk_scanprep(w_, p, l, bf0, bf1, bkey);
      } break;
      case 3:
#ifdef PROBE_MIXER2
        mixer_phase(p, l + 2); SYNC
#endif
        mixer_phase(p, l); break;
      case 4: fin_phase(p, l); break;
      case 5: {
        gemm_phase<1>(p, l);
        for (long i_ = gtid; i_ < (long)NEXP * 1024 / 16; i_ += gstride) {
          cvt16_fp4(p.pu + (long)l * NEXP * 1024, (unsigned char*)p.u16, i_, PEER_USCALE);
          cvt16_fp4(p.pv + (long)l * NEXP * 1024, (unsigned char*)p.v16, i_, PEER_VSCALE);
        }
      } break;
      case 6: { BSTAGE(blk_norm<1>, NT / 4) } break;
      case 7: gemm_phase<2>(p, l); break;
      default: { BSTAGE(blk_peer<false>, NT / 4) } break;
    }
    if (ph != 17) SYNC
  }
}
#else
#define STAGE(fn, n) { _Pragma("omp parallel for schedule(dynamic, 64)") for (long i_ = 0; i_ < (long)(n); ++i_) fn(i_, p, l); }
#define SYNC
void mega(P p) {
  { int l = 0;
    STAGE(b_init, (long)NT * 1024)
    STAGE(b_mod, 2L * NCOND * 6144)
  }
  for (int l = 0; l < 2; ++l) {
    STAGE(b_norm<0>, NT)
    STAGE(b_inproj, (long)NT * INC)
    STAGE(b_prep_gqa, (long)NT * 6)
    STAGE(b_prep_cache, (long)NTC * 640)
    STAGE(b_rwaux, (long)NT * 512)
    STAGE(b_dnconv, (long)NT * 768)
    STAGE(b_dnnorm, (long)NT * 8)
    STAGE(b_rwscan, NSCAN)
    STAGE(b_dnscan, NSCAN)
    STAGE(b_attn_gqa, (long)NT * 4)
    STAGE(b_attn_na, (long)NT * 4)
    STAGE(b_rwfin, (long)NT * 4)
    STAGE(b_dnfin, (long)NT * 4)
    STAGE(b_outproj, (long)NT * 1024)
    STAGE(b_norm<1>, NT)
    STAGE(b_peerq, (long)NT * 2048)
    STAGE(b_topk1, (long)NT * 16)
    STAGE(b_topk2, (long)NT * 8)
    STAGE(b_peer_act, (long)NT * 128)
    STAGE(b_peer_out, (long)NT * 1024)
  }
  { int l = 0; STAGE(b_final, NT) }
}
#endif

static void fill_params(P& p, void* const* d_in, void* d_out, void* d_ws) {
  const float** f = (const float**)&p;
  for (int i = 0; i < 39; ++i) f[i] = (const float*)d_in[i];
  float* o = (float*)d_out;
  p.X = o; o += (long)NT * 1024;
  p.ogk = o; o += (long)CFG_BATCH * 2 * 2 * CFG_SEQ * 64;
  p.ogv = o; o += (long)CFG_BATCH * 2 * 2 * CFG_SEQ * 64;
  p.onk = o; o += (long)CFG_BATCH * 2 * 4 * CFG_SEQ * 64;
  p.onv = o; o += (long)CFG_BATCH * 2 * 4 * CFG_SEQ * 64;
  p.orw = o; o += (long)CFG_BATCH * 2 * 2 * 4 * 4096;
  p.odn = o;
  char* w = (char*)d_ws;
  auto take = [&](size_t bytes) { char* r = w; w += (bytes + 255) & ~(size_t)255; return r; };
  p.xbar = (unsigned*)take(16384);
  p.counters = (unsigned*)take(256);
  p.cucnt = (unsigned*)take(4 * 4096 * 4);
  p.mod = (float*)take(2L * NCOND * 6144 * 4);
  p.act = (h16*)take((size_t)NT * 1024 * sizeof(h16));
  p.rwaux = (h16*)take((size_t)NT * 1024 * sizeof(h16));
  p.dnp = (h16*)take((size_t)NT * 768 * sizeof(h16));
  p.proj = (h16*)take((size_t)NT * INC * sizeof(h16));
  p.wtin = (h16*)take((size_t)2 * NPAD_IN * 1024 * sizeof(h16));
  p.wtout = (h16*)take((size_t)2 * 1024 * 1024 * sizeof(h16));
  p.wtq = (h16*)take((size_t)2 * 2048 * 1024 * sizeof(h16));
  p.rwsc = (float*)take((size_t)NT * 16 * 4);
  p.dnsc = (float*)take((size_t)NT * 16 * 4);
  p.keys16 = (h16*)take((size_t)2 * 16 * CFG_NKEYS * 128 * sizeof(h16));
  char* a = (char*)p.proj;
#ifdef HOST_EMU
  p.pq = (h16*)a; a += (size_t)NT * 2048 * sizeof(h16);
#endif
  p.tks = (float*)a; a += (size_t)NT * 256 * 4;
  p.tki = (int*)a; a += (size_t)NT * 256 * 4;
  p.u16 = (h16*)a; a += (size_t)NEXP * 1024 * sizeof(h16);
  p.v16 = (h16*)a; a += (size_t)NEXP * 1024 * sizeof(h16);
  p.pidx = (int*)p.rwaux;
  p.pact = (float*)((char*)p.rwaux + (size_t)NT * 128 * 4);
}

#ifndef HOST_EMU
extern "C" void kernel_launch(void* const* d_in, const int* in_sizes, int n_in, void* d_out, int out_size, void* d_ws,
                              size_t ws_size, hipStream_t stream) {
  static int grid_blocks = 0;
  if (!grid_blocks) {
    int dev = 0, cus = 0, per_cu = 0;
    (void)hipGetDevice(&dev);
    (void)hipDeviceGetAttribute(&cus, hipDeviceAttributeMultiprocessorCount, dev);
    (void)hipOccupancyMaxActiveBlocksPerMultiprocessor(&per_cu, mega, 256, 0);
    grid_blocks = cus * per_cu;
  }
  P p;
  memset(&p, 0, sizeof(p));
  fill_params(p, d_in, d_out, d_ws);
  (void)hipMemsetAsync(p.xbar, 0, 16384, stream);
  void* args[] = {&p};
  hipError_t e = hipLaunchCooperativeKernel((void*)mega, dim3(grid_blocks), dim3(256), args, 0, stream);
  if (e != hipSuccess) fprintf(stderr, "cooperative launch failed: %s (grid %d)\n", hipGetErrorString(e), grid_blocks);
}
#endif
```

```cpp
#ifndef HOST_EMU
#include <hip/hip_runtime.h>
#include <hip/hip_cooperative_groups.h>
namespace cg = cooperative_groups;
#define HD __device__ __forceinline__
#define HDN __device__ __noinline__
typedef _Float16 h16;
#define CBAR asm volatile("" ::: "memory")
#define SMEM_BYTES 73728
__shared__ __attribute__((aligned(16))) char g_smem[SMEM_BYTES];
__device__ __forceinline__ int otid() { int t = threadIdx.x; asm volatile("" : "+v"(t)); return t; }
#define FSIN(x) __sinf(x)
#define FCOS(x) __cosf(x)
#else
#include <cmath>
#include <cstring>
#define HD static inline
#define HDN static
typedef float h16;
#define CBAR
#define FSIN(x) sinf(x)
#define FCOS(x) cosf(x)
#endif
#include <cstdio>
#include <cstring>

#ifndef CFG_BATCH
#define CFG_BATCH 32
#define CFG_SEQ 256
#define CFG_DB 8
#define CFG_DS 4096
#define CFG_PAST 512
#define CFG_NKEYS 128
#endif

#define NTC (CFG_BATCH * CFG_SEQ)
#define NTL (CFG_DB * CFG_DS)
#define NT (NTC + NTL)
#define NCOND (1 + CFG_DB)
#define GROWS (CFG_DS / 64)
#define WR (GROWS < 8 ? GROWS : 8)
#define NEXP (CFG_NKEYS * CFG_NKEYS)
#define INC 3280
#define RW_OFF 512
#define NA_OFF 1472
#define DN_OFF 2240

struct P {
  const float *xp, *xs, *c, *cgk, *cgv, *cnk, *cnv, *srw, *sdn, *cctx, *n1g, *n2g, *wmod, *bmod, *win, *wout,
      *gqn, *gkn, *rwmu, *rww0, *rww2, *rwa0, *rwa2, *rwg2, *rwkk, *rwka, *rwrk, *rwlng, *rwlnb, *nabias,
      *dnconv, *dnalog, *dndt, *dnng, *pwq, *pkeys, *pu, *pv, *fng;
  float *X, *ogk, *ogv, *onk, *onv, *orw, *odn;
  float* mod;
  h16* act;
  h16* proj;
  h16* rwaux;
  h16* dnp;
  h16* pq;
  float* tks;
  int* tki;
  int* pidx;
  float* pact;
  unsigned* counters;
  unsigned* xbar;
  unsigned* cucnt;
  h16 *keys16, *u16, *v16;
  float *rwsc, *dnsc;
  h16 *wtin, *wtout, *wtq;
};

HD float sigmoidf_(float x) { return 1.0f / (1.0f + expf(-x)); }
HD float siluf_(float x) { return x * sigmoidf_(x); }
HD float softplusf_(float x) { return fmaxf(x, 0.0f) + log1pf(expf(-fabsf(x))); }
HD int condrow(long token) { return token < NTC ? 0 : 1 + (int)((token - NTC) / CFG_DS); }
HD void seqinfo(long token, int& t, int& T, long& base) {
  if (token < NTC) { T = CFG_SEQ; t = (int)(token % CFG_SEQ); base = token - t; }
  else { long u = token - NTC; T = CFG_DS; t = (int)(u % CFG_DS); base = token - t; }
}

HD void b_init(long i, const P& p, int l) {
  p.X[i] = (i < (long)NTC * 1024) ? p.xp[i] : p.xs[i - (long)NTC * 1024];
}
HD void b_mod(long i, const P& p, int) {
  int col = (int)(i % 6144); int r = (int)((i / 6144) % NCOND); int l = (int)(i / (6144L * NCOND));
  const float* cond = r == 0 ? p.cctx : p.c + (long)(r - 1) * 1024;
  float acc = p.bmod[l * 6144 + col];
  for (int k = 0; k < 1024; ++k) acc += siluf_(cond[k]) * p.wmod[((long)l * 1024 + k) * 6144 + col];
  p.mod[i] = acc;
}
template <int WHICH>
HD void b_norm(long i, const P& p, int l) {
  const float* x = p.X + i * 1024;
  float ss = 0.f;
  for (int k = 0; k < 1024; ++k) ss += x[k] * x[k];
  float rstd = 1.0f / sqrtf(ss * (1.0f / 1024) + 1e-6f);
  const float* m = p.mod + ((long)l * NCOND + condrow(i)) * 6144 + (WHICH ? 3072 : 0);
  const float* g = (WHICH ? p.n2g : p.n1g) + l * 1024;
  for (int k = 0; k < 1024; ++k) p.act[i * 1024 + k] = (h16)((x[k] * rstd * g[k]) * (1.0f + m[1024 + k]) + m[k]);
}
HD void b_prep_gqa(long i, const P& p, int l) {
  long token = i / 6; int slot = (int)(i % 6);
  h16* x = p.proj + token * INC + slot * 64;
  float y[64]; float ss = 0.f;
#pragma unroll
  for (int d = 0; d < 64; ++d) { y[d] = (float)x[d]; ss += y[d] * y[d]; }
  float rstd = 1.0f / sqrtf(ss * (1.0f / 64) + 1e-6f);
  const float* g = (slot < 4 ? p.gqn : p.gkn) + l * 64;
#pragma unroll
  for (int d = 0; d < 64; ++d) y[d] = y[d] * rstd * g[d];
  if (token >= NTC) {
    int t = (int)((token - NTC) % CFG_DS); int row = t / 64, colp = t % 64;
#pragma unroll
    for (int j = 0; j < 32; ++j) {
      float inv = exp2f(-(float)(j % 16) * 0.83048202372184059f);
      float ang = (float)(j < 16 ? row : colp) * inv;
      float cs = FCOS(ang), sn = FSIN(ang);
      float a = y[j], b = y[j + 32];
      y[j] = a * cs - b * sn; y[j + 32] = b * cs + a * sn;
    }
  } else if (slot >= 4) {
    int b = (int)(token / CFG_SEQ), t = (int)(token % CFG_SEQ);
    float* o = p.ogk + ((((long)b * 2 + l) * 2 + (slot - 4)) * CFG_SEQ + t) * 64;
#pragma unroll
    for (int d = 0; d < 64; ++d) o[d] = y[d];
  }
  float sc = slot < 4 ? 0.125f : 1.0f;
#pragma unroll
  for (int d = 0; d < 64; ++d) x[d] = (h16)(y[d] * sc);
}
HD void b_prep_cache(long i, const P& p, int l) {
  long token = i / 640; int e = (int)(i % 640);
  int b = (int)(token / CFG_SEQ), t = (int)(token % CFG_SEQ);
  const h16* pr = p.proj + token * INC;
  if (e < 128) { int kvh = e / 64, d = e % 64; p.ogv[((((long)b * 2 + l) * 2 + kvh) * CFG_SEQ + t) * 64 + d] = (float)pr[384 + e]; }
  else if (e < 384) { int c = e - 128; int h = c / 64, d = c % 64; p.onk[((((long)b * 2 + l) * 4 + h) * CFG_SEQ + t) * 64 + d] = (float)pr[NA_OFF + 256 + c]; }
  else { int c = e - 384; int h = c / 64, d = c % 64; p.onv[((((long)b * 2 + l) * 4 + h) * CFG_SEQ + t) * 64 + d] = (float)pr[NA_OFF + 512 + c]; }
}
HD void b_rwaux(long i, const P& p, int l) {
  int col = (int)(i % 256); int d = (int)((i / 256) % 2); long token = i / 512;
  int t, T; long base; seqinfo(token, t, T, base);
  bool sv = d == 0 ? (t > 0) : (t < T - 1);
  const h16* pb = p.proj + token * INC + RW_OFF;
  const h16* ps = p.proj + (token + (d == 0 ? -1 : 1)) * INC + RW_OFF;
  const float* mu = p.rwmu + ((long)l * 2 + d) * 832;
  float accw = p.rww0[(l * 2 + d) * 256 + col], acca = p.rwa0[(l * 2 + d) * 256 + col];
  for (int j = 0; j < 32; ++j) {
    float bw = (float)pb[768 + d * 32 + j], sw = sv ? (float)ps[768 + d * 32 + j] : 0.f;
    float wl = bw + (sw - bw) * mu[768 + j];
    float ba = (float)pb[832 + d * 32 + j], sa = sv ? (float)ps[832 + d * 32 + j] : 0.f;
    float al = ba + (sa - ba) * mu[800 + j];
    accw += tanhf(wl) * p.rww2[(((long)l * 2 + d) * 32 + j) * 256 + col];
    acca += al * p.rwa2[(((long)l * 2 + d) * 32 + j) * 256 + col];
  }
  float w = -softplusf_(-accw) - 0.5f;
  p.rwaux[((token * 2 + d) * 2 + 0) * 256 + col] = (h16)expf(w);
  p.rwaux[((token * 2 + d) * 2 + 1) * 256 + col] = (h16)sigmoidf_(acca);
}
HD void b_dnconv(long i, const P& p, int l) {
  int c = (int)(i % 768); long token = i / 768;
  int t, T; long base; seqinfo(token, t, T, base);
  float acc = 0.f;
#pragma unroll
  for (int j = 0; j < 5; ++j) {
    int tt = t + j - 2;
    if (tt >= 0 && tt < T) acc += (float)p.proj[(base + tt) * INC + DN_OFF + c] * p.dnconv[((long)l * 5 + j) * 768 + c];
  }
  p.dnp[token * 768 + c] = (h16)siluf_(acc);
}
HD void b_dnnorm(long i, const P& p, int) {
  long token = i / 8; int slot = (int)(i % 8);
  h16* x = p.dnp + token * 768 + slot * 64;
  float ss = 0.f;
  for (int d = 0; d < 64; ++d) { float v = (float)x[d]; ss += v * v; }
  float rs = 1.0f / sqrtf(ss + 1e-6f) * (slot < 4 ? 0.125f : 1.0f);
  for (int d = 0; d < 64; ++d) x[d] = (h16)((float)x[d] * rs);
}

struct Softmax64 {
  float m, lsum, acc[64];
};
template <typename TK>
HD void attend_key(Softmax64& st, const float* q, const TK* k, const TK* v, float scale, float bias) {
  float s = 0.f;
#pragma unroll
  for (int d = 0; d < 64; ++d) s += q[d] * (float)k[d];
  s = s * scale + bias;
  if (s > st.m) {
    float f = expf(st.m - s);
    st.lsum *= f;
#pragma unroll
    for (int d = 0; d < 64; ++d) st.acc[d] *= f;
    st.m = s;
  }
  float pw = expf(s - st.m);
  st.lsum += pw;
#pragma unroll
  for (int d = 0; d < 64; ++d) st.acc[d] += pw * (float)v[d];
}
HD void b_attn_gqa(long i, const P& p, int l) {
  int h = (int)(i / NT); long token = i % NT; int kvh = h / 2;
  float q[64];
  const h16* qp = p.proj + token * INC + h * 64;
#pragma unroll
  for (int d = 0; d < 64; ++d) q[d] = (float)qp[d];
  Softmax64 st; st.m = -1e30f; st.lsum = 0.f;
#pragma unroll
  for (int d = 0; d < 64; ++d) st.acc[d] = 0.f;
  int t, T; long base; seqinfo(token, t, T, base);
  for (int tk = 0; tk < T; ++tk) {
    const h16* kp = p.proj + (base + tk) * INC + 256 + kvh * 64;
    attend_key<h16>(st, q, kp, kp + 128, 1.0f, 0.f);
  }
  if (token >= NTC) {
    int b = (int)((token - NTC) / CFG_DS);
    const float* ck = p.cgk + (((long)b * 2 + l) * 2 + kvh) * CFG_PAST * 64;
    const float* cv = p.cgv + (((long)b * 2 + l) * 2 + kvh) * CFG_PAST * 64;
    for (int pp = 0; pp < CFG_PAST; ++pp) attend_key<float>(st, q, ck + pp * 64, cv + pp * 64, 1.0f, 0.f);
  }
  float inv = 1.0f / st.lsum;
  h16* o = p.act + token * 1024 + h * 64;
#pragma unroll
  for (int d = 0; d < 64; ++d) o[d] = (h16)(st.acc[d] * inv);
}
HD void b_attn_na(long i, const P& p, int l) {
  int h = (int)(i / NT); long token = i % NT;
  float q[64];
  const h16* qp = p.proj + token * INC + NA_OFF + h * 64;
#pragma unroll
  for (int d = 0; d < 64; ++d) q[d] = (float)qp[d];
  Softmax64 st; st.m = -1e30f; st.lsum = 0.f;
#pragma unroll
  for (int d = 0; d < 64; ++d) st.acc[d] = 0.f;
  int t, T; long base; seqinfo(token, t, T, base);
  if (token < NTC) {
    for (int tk = 0; tk < T; ++tk) {
      const h16* kp = p.proj + (base + tk) * INC + NA_OFF + 256 + h * 64;
      attend_key<h16>(st, q, kp, kp + 256, 0.125f, 0.f);
    }
  } else {
    int r = t / 64, cq = t % 64;
    int r0 = r - WR / 2; r0 = r0 < 0 ? 0 : (r0 > GROWS - WR ? GROWS - WR : r0);
    int cs = cq - 8; cs = cs < 0 ? 0 : (cs > 48 ? 48 : cs);
    const float* bias = p.nabias + ((long)l * 4 + h) * 15 * 31;
    for (int w = 0; w < WR; ++w) {
      int kr = r0 + w;
      for (int cc = 0; cc < 16; ++cc) {
        int kc = cs + cc;
        const h16* kp = p.proj + (base + kr * 64 + kc) * INC + NA_OFF + 256 + h * 64;
        attend_key<h16>(st, q, kp, kp + 256, 0.125f, bias[(kr - r + 7) * 31 + (kc - cq + 15)]);
      }
    }
    int b = (int)((token - NTC) / CFG_DS);
    const float* ck = p.cnk + (((long)b * 2 + l) * 4 + h) * CFG_PAST * 64;
    const float* cv = p.cnv + (((long)b * 2 + l) * 4 + h) * CFG_PAST * 64;
    for (int pp = 0; pp < CFG_PAST; ++pp) attend_key<float>(st, q, ck + pp * 64, cv + pp * 64, 0.125f, 0.f);
  }
  float inv = 1.0f / st.lsum;
  h16* o = p.act + token * 1024 + 512 + h * 64;
#pragma unroll
  for (int d = 0; d < 64; ++d) o[d] = (h16)(st.acc[d] * inv);
}

HD float rw_lerp(const P& p, int l, long token, bool sv, int d, int c) {
  float b = (float)p.proj[token * INC + RW_OFF + c];
  float s = sv ? (float)p.proj[(token + (d == 0 ? -1 : 1)) * INC + RW_OFF + c] : 0.f;
  return b + (s - b) * p.rwmu[((long)l * 2 + d) * 832 + c];
}
HD void b_rwscan(long i, const P& p, int l) {
  int v = (int)(i % 64); int sb = (int)(i / 64); int h = sb % 4; int bi = sb / 4;
  bool ctx = bi < CFG_BATCH;
  int T = ctx ? CFG_SEQ : CFG_DS;
  long base = ctx ? (long)bi * CFG_SEQ : (long)NTC + (long)(bi - CFG_BATCH) * CFG_DS;
#ifndef HOST_EMU
  float* S = (float*)g_smem + threadIdx.x * 65;
#else
  float S[64];
#endif
  for (int d = 0; d < 2; ++d) {
    if (ctx) {
      for (int k = 0; k < 64; ++k) S[k] = 0.f;
    } else {
      const float* s0 = p.srw + (((((long)(bi - CFG_BATCH)) * 2 + l) * 2 + d) * 4 + h) * 4096 + v * 64;
      for (int k = 0; k < 64; ++k) S[k] = s0[k];
    }
    for (int step = 0; step < T; ++step) {
      int t = d == 0 ? step : T - 1 - step;
      long token = base + t;
      bool sv = d == 0 ? (t > 0) : (t < T - 1);
      const h16* aux = p.rwaux + (token * 2 + d) * 512;
      float ss = 0.f;
      for (int k = 0; k < 64; ++k) {
        float kv = rw_lerp(p, l, token, sv, d, 256 + h * 64 + k) * p.rwkk[l * 256 + h * 64 + k];
        ss += kv * kv;
      }
      float rs = 1.0f / sqrtf(ss + 1e-6f);
      float sa = 0.f;
      for (int k = 0; k < 64; ++k) {
        float kk = rw_lerp(p, l, token, sv, d, 256 + h * 64 + k) * p.rwkk[l * 256 + h * 64 + k] * rs;
        sa -= S[k] * kk;
      }
      float vv = rw_lerp(p, l, token, sv, d, 512 + h * 64 + v);
      float o = 0.f;
      for (int k = 0; k < 64; ++k) {
        int c = h * 64 + k;
        float kr = rw_lerp(p, l, token, sv, d, 256 + c);
        float kk = kr * p.rwkk[l * 256 + c] * rs;
        float a = (float)aux[256 + c];
        float dec = expf(-(float)aux[c]);
        float keff = kr * (1.0f + (a - 1.0f) * p.rwka[l * 256 + c]);
        float r = rw_lerp(p, l, token, sv, d, c);
        S[k] = S[k] * dec + sa * (kk * a) + vv * keff;
        o += S[k] * r;
      }
      h16* op = p.act + token * 1024 + 256 + h * 64 + v;
      if (d == 0) *op = (h16)o; else *op = (h16)((float)*op + o);
    }
    if (ctx) {
      float* so = p.orw + (((((long)bi) * 2 + l) * 2 + d) * 4 + h) * 4096 + v * 64;
      for (int k = 0; k < 64; ++k) so[k] = S[k];
    }
  }
}
HD void b_rwfin(long i, const P& p, int l) {
  long token = i / 4; int h = (int)(i % 4);
  int t, T; long base; seqinfo(token, t, T, base);
  h16* op = p.act + token * 1024 + 256 + h * 64;
  float mu = 0.f;
  for (int k = 0; k < 64; ++k) mu += (float)op[k];
  mu *= (1.0f / 64);
  float var = 0.f;
  for (int k = 0; k < 64; ++k) { float dlt = (float)op[k] - mu; var += dlt * dlt; }
  var *= (1.0f / 64);
  float rs = 1.0f / sqrtf(var + 64e-5f);
  float bon0 = 0.f, bon1 = 0.f;
  for (int d = 0; d < 2; ++d) {
    bool sv = d == 0 ? (t > 0) : (t < T - 1);
    const h16* aux = p.rwaux + (token * 2 + d) * 512;
    float s = 0.f;
    for (int k = 0; k < 64; ++k) {
      int c = h * 64 + k;
      float kr = rw_lerp(p, l, token, sv, d, 256 + c);
      float a = (float)aux[256 + c];
      float keff = kr * (1.0f + (a - 1.0f) * p.rwka[l * 256 + c]);
      s += rw_lerp(p, l, token, sv, d, c) * keff * p.rwrk[l * 256 + c];
    }
    if (d == 0) bon0 = s; else bon1 = s;
  }
  bool sv0 = t > 0, sv1 = t < T - 1;
  for (int k = 0; k < 64; ++k) {
    int c = h * 64 + k;
    float y = ((float)op[k] - mu) * rs * p.rwlng[l * 256 + c] + p.rwlnb[l * 256 + c];
    y += bon0 * rw_lerp(p, l, token, sv0, 0, 512 + c) + bon1 * rw_lerp(p, l, token, sv1, 1, 512 + c);
    float gate = 0.f;
    for (int j = 0; j < 64; ++j) gate += sigmoidf_((float)p.proj[token * INC + RW_OFF + 896 + j]) * p.rwg2[((long)l * 64 + j) * 256 + c];
    op[k] = (h16)(y * gate);
  }
}
HD void b_dnscan(long i, const P& p, int l) {
  int v = (int)(i % 64); int sb = (int)(i / 64); int h = sb % 4; int bi = sb / 4;
  bool ctx = bi < CFG_BATCH;
  int T = ctx ? CFG_SEQ : CFG_DS;
  long base = ctx ? (long)bi * CFG_SEQ : (long)NTC + (long)(bi - CFG_BATCH) * CFG_DS;
#ifndef HOST_EMU
  float* S = (float*)g_smem + threadIdx.x * 65;
#else
  float S[64];
#endif
  for (int d = 0; d < 2; ++d) {
    if (ctx) {
      for (int k = 0; k < 64; ++k) S[k] = 0.f;
    } else {
      const float* s0 = p.sdn + (((((long)(bi - CFG_BATCH)) * 2 + l) * 2 + d) * 4 + h) * 4096 + v;
      for (int k = 0; k < 64; ++k) S[k] = s0[k * 64];
    }
    float nalog = -expf(p.dnalog[(l * 2 + d) * 4 + h]);
    float dtb = p.dndt[(l * 2 + d) * 4 + h];
    for (int step = 0; step < T; ++step) {
      int t = d == 0 ? step : T - 1 - step;
      long token = base + t;
      const h16* dp = p.dnp + token * 768;
      const h16* pr = p.proj + token * INC + DN_OFF;
      float beta = sigmoidf_((float)pr[768 + d * 4 + h]);
      float g = nalog * softplusf_((float)pr[776 + d * 4 + h] + dtb);
      float a = expf(g);
      float sk = 0.f;
      for (int k = 0; k < 64; ++k) sk += (float)dp[256 + h * 64 + k] * S[k];
      float coef = beta * ((float)dp[512 + h * 64 + v] - a * sk);
      float o = 0.f;
      for (int k = 0; k < 64; ++k) {
        S[k] = a * S[k] + coef * (float)dp[256 + h * 64 + k];
        o += (float)dp[h * 64 + k] * S[k];
      }
      h16* op = p.act + token * 1024 + 768 + h * 64 + v;
      if (d == 0) *op = (h16)o; else *op = (h16)((float)*op + o);
    }
    if (ctx) {
      float* so = p.odn + (((((long)bi) * 2 + l) * 2 + d) * 4 + h) * 4096 + v;
      for (int k = 0; k < 64; ++k) so[k * 64] = S[k];
    }
  }
}
HD void b_dnfin(long i, const P& p, int l) {
  long token = i / 4; int h = (int)(i % 4);
  h16* op = p.act + token * 1024 + 768 + h * 64;
  float ss = 0.f;
  for (int k = 0; k < 64; ++k) { float o = (float)op[k]; ss += o * o; }
  float rs = 1.0f / sqrtf(ss * (1.0f / 64) + 1e-6f);
  for (int k = 0; k < 64; ++k) {
    float z = (float)p.proj[token * INC + DN_OFF + 784 + h * 64 + k];
    op[k] = (h16)((float)op[k] * rs * p.dnng[l * 64 + k] * siluf_(z));
  }
}
HD void top16_insert(float (&ts)[16], int (&ti)[16], float s, int id) {
#pragma unroll
  for (int j = 0; j < 16; ++j) {
    if (s > ts[j]) { float a = ts[j]; ts[j] = s; s = a; int b = ti[j]; ti[j] = id; id = b; }
  }
}
HD void b_topk1(long i, const P& p, int l) {
  long token = i / 16; int hp = (int)(i % 16);
  const h16* q = p.pq + token * 2048 + hp * 128;
  const float* keys = p.pkeys + ((long)l * 16 + hp) * CFG_NKEYS * 128;
  float ts[16]; int ti[16];
#pragma unroll
  for (int j = 0; j < 16; ++j) { ts[j] = -3.0e38f; ti[j] = 0; }
  for (int k = 0; k < CFG_NKEYS; ++k) {
    float s = 0.f;
    for (int d = 0; d < 128; ++d) s += (float)q[d] * keys[k * 128 + d];
    top16_insert(ts, ti, s, k);
  }
#pragma unroll
  for (int j = 0; j < 16; ++j) { p.tks[token * 256 + hp * 16 + j] = ts[j]; p.tki[token * 256 + hp * 16 + j] = ti[j]; }
}
HD void b_topk2(long i, const P& p, int l) {
  long token = i / 8; int hd = (int)(i % 8);
  const float* s1 = p.tks + token * 256 + hd * 32; const int* i1 = p.tki + token * 256 + hd * 32;
  float ts[16]; int ti[16];
#pragma unroll
  for (int j = 0; j < 16; ++j) { ts[j] = -3.0e38f; ti[j] = 0; }
  for (int a = 0; a < 16; ++a)
    for (int b = 0; b < 16; ++b) top16_insert(ts, ti, s1[a] + s1[16 + b], i1[a] * CFG_NKEYS + i1[16 + b]);
  float sum = 0.f;
#pragma unroll
  for (int j = 0; j < 16; ++j) sum += expf(ts[j] - ts[0]);
  float inv = 1.0f / sum;
#pragma unroll
  for (int j = 0; j < 16; ++j) { p.pidx[token * 128 + hd * 16 + j] = ti[j]; p.pact[token * 128 + hd * 16 + j] = expf(ts[j] - ts[0]) * inv; }
}
HD void b_peer_act(long i, const P& p, int l) {
  long token = i / 128;
  const float* u = p.pu + ((long)l * NEXP + p.pidx[i]) * 1024;
  const h16* x = p.act + token * 1024;
  float dot = 0.f;
  for (int k = 0; k < 1024; ++k) dot += (float)x[k] * u[k];
  float ge = 0.5f * dot * (1.0f + erff(dot * 0.70710678118654752f));
  p.pact[i] = p.pact[i] * ge;
}
HD void b_peer_out(long i, const P& p, int l) {
  long token = i / 1024; int col = (int)(i % 1024);
  float acc = 0.f;
  for (int e = 0; e < 128; ++e) acc += p.pact[token * 128 + e] * p.pv[((long)l * NEXP + p.pidx[token * 128 + e]) * 1024 + col];
  p.X[i] += p.mod[((long)l * NCOND + condrow(token)) * 6144 + 5120 + col] * acc;
}
HD void b_final(long i, const P& p, int) {
  float* x = p.X + i * 1024;
  float ss = 0.f;
  for (int k = 0; k < 1024; ++k) ss += x[k] * x[k];
  float rstd = 1.0f / sqrtf(ss * (1.0f / 1024) + 1e-6f);
  for (int k = 0; k < 1024; ++k) x[k] = x[k] * rstd * p.fng[k];
}
HD float gemm_elem(const h16* A, const float* B, int N, long token, int col) {
  float acc = 0.f;
  for (int k = 0; k < 1024; ++k) acc += (float)A[token * 1024 + k] * B[(long)k * N + col];
  return acc;
}
HD void b_inproj(long i, const P& p, int l) {
  long token = i / INC; int col = (int)(i % INC);
  p.proj[i] = (h16)gemm_elem(p.act, p.win + (long)l * 1024 * INC, INC, token, col);
}
HD void b_outproj(long i, const P& p, int l) {
  long token = i / 1024; int col = (int)(i % 1024);
  float acc = gemm_elem(p.act, p.wout + (long)l * 1024 * 1024, 1024, token, col);
  p.X[i] += p.mod[((long)l * NCOND + condrow(token)) * 6144 + 2048 + col] * acc;
}
HD void b_peerq(long i, const P& p, int l) {
  long token = i / 2048; int col = (int)(i % 2048);
  p.pq[i] = (h16)gemm_elem(p.act, p.pwq + (long)l * 1024 * 2048, 2048, token, col);
}

#ifndef PROBE_KMAX
#define PROBE_KMAX 16
#endif
#ifndef REP_S0
#define REP_S0 1
#endif
#ifndef REP_MISC
#define REP_MISC 1
#endif
#ifndef REP_G0
#define REP_G0 1
#endif
#ifndef REP_G2
#define REP_G2 1
#endif
#ifndef REP_SP
#define REP_SP 1
#endif
#define NSCAN ((long)(CFG_BATCH + CFG_DB) * 4 * 64)
#define NPAD_IN 3328

#ifndef HOST_EMU
typedef _Float16 half8 __attribute__((ext_vector_type(8)));
typedef _Float16 half4 __attribute__((ext_vector_type(4)));
typedef _Float16 half2v __attribute__((ext_vector_type(2)));
typedef float f32x2 __attribute__((ext_vector_type(2)));
typedef float f32x16 __attribute__((ext_vector_type(16)));
typedef float f32x4 __attribute__((ext_vector_type(4)));
typedef unsigned u32x4 __attribute__((ext_vector_type(4)));
typedef short s16x4v __attribute__((__vector_size__(4 * sizeof(short))));

template <int CTRL> __device__ __forceinline__ float dppf(float x) {
  return __builtin_bit_cast(float, __builtin_amdgcn_update_dpp(0, __builtin_bit_cast(int, x), CTRL, 0xF, 0xF, true));
}
__device__ __forceinline__ float sum16(float x) { x += dppf<0x128>(x); x += dppf<0x124>(x); x += dppf<0xB1>(x); x += dppf<0x4E>(x); return x; }
__device__ __forceinline__ float sum8(float x) { x += dppf<0xB1>(x); x += dppf<0x4E>(x); x += dppf<0x141>(x); return x; }
__device__ __forceinline__ float sum64(float x) { x = sum16(x); x += __shfl_xor(x, 16); x += __shfl_xor(x, 32); return x; }

#define CSWAP_DESC(S, ID, i, j) { const bool c_ = S[j] > S[i]; const float a_ = c_ ? S[j] : S[i]; const float b_ = c_ ? S[i] : S[j]; \
    const int ia_ = c_ ? ID[j] : ID[i]; const int ib_ = c_ ? ID[i] : ID[j]; S[i] = a_; S[j] = b_; ID[i] = ia_; ID[j] = ib_; }
__device__ __forceinline__ void bitonic_sort16_desc(float (&s)[16], int (&id)[16]) {
#pragma unroll
  for (int k = 2; k <= 16; k <<= 1) {
#pragma unroll
    for (int j = k >> 1; j > 0; j >>= 1) {
#pragma unroll
      for (int i = 0; i < 16; ++i) {
        const int l = i ^ j;
        if (l > i) {
          if ((i & k) == 0) CSWAP_DESC(s, id, i, l) else CSWAP_DESC(s, id, l, i)
        }
      }
    }
  }
}
__device__ __forceinline__ void merge_top16(float (&ts)[16], int (&ti)[16], const float (&gs)[16], const int (&gi)[16]) {
#pragma unroll
  for (int i = 0; i < 16; ++i) { if (gs[15 - i] > ts[i]) { ts[i] = gs[15 - i]; ti[i] = gi[15 - i]; } }
#pragma unroll
  for (int j = 8; j > 0; j >>= 1) {
#pragma unroll
    for (int i = 0; i < 16; ++i) { if ((i & j) == 0) CSWAP_DESC(ts, ti, i, i + j) }
  }
}
__device__ void blk_convert(long w, const P& p) {
  int l = (int)(w / 1600); int r = (int)(w % 1600);
  const float* src; h16* dst; int N, ntile;
  if (r < 832) { src = p.win + (long)l * 1024 * INC; dst = p.wtin + (long)l * NPAD_IN * 1024; N = INC; ntile = 52; }
  else if (r < 1088) { r -= 832; src = p.wout + (long)l * 1024 * 1024; dst = p.wtout + (long)l * 1024 * 1024; N = 1024; ntile = 16; }
  else { r -= 1088; src = p.pwq + (long)l * 1024 * 2048; dst = p.wtq + (long)l * 2048 * 1024; N = 2048; ntile = 32; }
  int kt = r / ntile, nt = r % ntile;
  int k0 = kt * 64, n0 = nt * 64;
  h16* tile = (h16*)g_smem;
  const int tid_ = otid(); int c = tid_ & 63, r4 = tid_ >> 6;
  __syncthreads();
#pragma unroll
  for (int j = 0; j < 16; ++j) {
    int rr = r4 + 4 * j;
    float v = (n0 + c < N) ? src[(long)(k0 + rr) * N + n0 + c] : 0.f;
    tile[rr * 66 + c] = (h16)v;
  }
  __syncthreads();
#pragma unroll
  for (int j = 0; j < 16; ++j) {
    int rr = r4 + 4 * j;
    dst[(long)(n0 + rr) * 1024 + k0 + c] = tile[c * 66 + rr];
  }
}

template <int EPI>
__device__ void gemm_phase(const P& p, int l, int kmax = 16) {
  constexpr int NTILES = EPI == 0 ? (NPAD_IN / 128) : (EPI == 1 ? 8 : 16);
  constexpr int NT8 = (NTILES + 7) / 8;
  const long nw = EPI == 0 ? (long)(NT / 128) * NTILES : (long)(NT / 128) * 8 * NT8;
#define TILE_OF(W, MT, NTV) { const int x_ = (int)((W) & 7); const int j_ = (int)((W) >> 3);                        \
    if (EPI == 0) { if (j_ < 960) { MT = j_ / 3; NTV = x_ + 8 * (j_ - 3 * MT); } else { NTV = 24 + (x_ >> 2); MT = 80 * (x_ & 3) + j_ - 960; } } \
    else { NTV = x_ + 8 * (j_ % NT8); MT = j_ / NT8; } }
  const h16* A = p.act;
  const h16* Bt = EPI == 0 ? p.wtin + (long)l * NPAD_IN * 1024 : (EPI == 1 ? p.wtout + (long)l * 1024 * 1024 : p.wtq + (long)l * 2048 * 1024);
  const int tid = otid(), lane = tid & 63, wv = tid >> 6, wm = wv >> 1, wn = wv & 1;
  h16* As = (h16*)g_smem;
  h16* Bs = As + 2 * 128 * 72;
  const int lrow = tid >> 3, lch = tid & 7;
  long w = blockIdx.x; int mt = 0, nt = 0;
  for (;;) { if (w >= nw) return; TILE_OF(w, mt, nt) if (nt < NTILES) break; w += gridDim.x; }
  int m0 = mt * 128, n0 = nt * 128;
  const h16* Ag = A + (long)(m0 + lrow) * 1024 + lch * 8;
  const h16* Bg = Bt + (long)(n0 + lrow) * 1024 + lch * 8;
  u32x4 ra0, ra1, ra2, ra3, rb0, rb1, rb2, rb3;
  u32x4 sa0, sa1, sa2, sa3, sb0, sb1, sb2, sb3;
  const f32x16 zero16 = {0.f, 0.f, 0.f, 0.f, 0.f, 0.f, 0.f, 0.f, 0.f, 0.f, 0.f, 0.f, 0.f, 0.f, 0.f, 0.f};
  f32x16 acc00, acc01, acc10, acc11;
#define GLD0(K0) \
  ra0 = *(const u32x4*)(Ag + (K0)); ra1 = *(const u32x4*)(Ag + 32 * 1024 + (K0)); ra2 = *(const u32x4*)(Ag + 64 * 1024 + (K0)); ra3 = *(const u32x4*)(Ag + 96 * 1024 + (K0)); \
  rb0 = *(const u32x4*)(Bg + (K0)); rb1 = *(const u32x4*)(Bg + 32 * 1024 + (K0)); rb2 = *(const u32x4*)(Bg + 64 * 1024 + (K0)); rb3 = *(const u32x4*)(Bg + 96 * 1024 + (K0));
#define GLD1(K0) \
  sa0 = *(const u32x4*)(Ag + (K0)); sa1 = *(const u32x4*)(Ag + 32 * 1024 + (K0)); sa2 = *(const u32x4*)(Ag + 64 * 1024 + (K0)); sa3 = *(const u32x4*)(Ag + 96 * 1024 + (K0)); \
  sb0 = *(const u32x4*)(Bg + (K0)); sb1 = *(const u32x4*)(Bg + 32 * 1024 + (K0)); sb2 = *(const u32x4*)(Bg + 64 * 1024 + (K0)); sb3 = *(const u32x4*)(Bg + 96 * 1024 + (K0));
#define LST0(AW, BW) \
  *(u32x4*)((AW) + (lrow) * 72 + lch * 8) = ra0; *(u32x4*)((AW) + (lrow + 32) * 72 + lch * 8) = ra1; *(u32x4*)((AW) + (lrow + 64) * 72 + lch * 8) = ra2; *(u32x4*)((AW) + (lrow + 96) * 72 + lch * 8) = ra3; \
  *(u32x4*)((BW) + (lrow) * 72 + lch * 8) = rb0; *(u32x4*)((BW) + (lrow + 32) * 72 + lch * 8) = rb1; *(u32x4*)((BW) + (lrow + 64) * 72 + lch * 8) = rb2; *(u32x4*)((BW) + (lrow + 96) * 72 + lch * 8) = rb3;
#define LST1(AW, BW) \
  *(u32x4*)((AW) + (lrow) * 72 + lch * 8) = sa0; *(u32x4*)((AW) + (lrow + 32) * 72 + lch * 8) = sa1; *(u32x4*)((AW) + (lrow + 64) * 72 + lch * 8) = sa2; *(u32x4*)((AW) + (lrow + 96) * 72 + lch * 8) = sa3; \
  *(u32x4*)((BW) + (lrow) * 72 + lch * 8) = sb0; *(u32x4*)((BW) + (lrow + 32) * 72 + lch * 8) = sb1; *(u32x4*)((BW) + (lrow + 64) * 72 + lch * 8) = sb2; *(u32x4*)((BW) + (lrow + 96) * 72 + lch * 8) = sb3;
#define GCOMP(BUF)                                                                                   \
  {                                                                                                  \
    const h16* Ab = As + (BUF) * 128 * 72 + (wm * 64 + (lane & 31)) * 72 + (lane >> 5) * 8;          \
    const h16* Bb = Bs + (BUF) * 128 * 72 + (wn * 64 + (lane & 31)) * 72 + (lane >> 5) * 8;          \
    _Pragma("unroll") for (int s = 0; s < 4; ++s) {                                                  \
      half8 a0 = *(const half8*)(Ab + s * 16), a1 = *(const half8*)(Ab + 32 * 72 + s * 16);          \
      half8 b0 = *(const half8*)(Bb + s * 16), b1 = *(const half8*)(Bb + 32 * 72 + s * 16);          \
      acc00 = __builtin_amdgcn_mfma_f32_32x32x16_f16(a0, b0, acc00, 0, 0, 0);                        \
      acc01 = __builtin_amdgcn_mfma_f32_32x32x16_f16(a0, b1, acc01, 0, 0, 0);                        \
      acc10 = __builtin_amdgcn_mfma_f32_32x32x16_f16(a1, b0, acc10, 0, 0, 0);                        \
      acc11 = __builtin_amdgcn_mfma_f32_32x32x16_f16(a1, b1, acc11, 0, 0, 0);                        \
    }                                                                                                \
  }
  GLD0(0)
  GLD1(64)
  for (;;) {
  acc00 = zero16; acc01 = zero16; acc10 = zero16; acc11 = zero16;
  __builtin_amdgcn_sched_barrier(0);
  __syncthreads();
  LST0(As, Bs)
  GLD0(128)
  __builtin_amdgcn_sched_barrier(0);
  __syncthreads();
  __builtin_amdgcn_s_setprio(2);
  for (int kt = 0; kt < kmax; kt += 2) {
    GCOMP(0)
    __builtin_amdgcn_sched_barrier(0);
    LST1(As + 128 * 72, Bs + 128 * 72)
    if (kt + 3 < 16) { GLD1((kt + 3) * 64) }
    __builtin_amdgcn_sched_barrier(0);
    __syncthreads();
    GCOMP(1)
    __builtin_amdgcn_sched_barrier(0);
    if (kt + 2 < 16) { LST0(As, Bs) }
    if (kt + 4 < 16) { GLD0((kt + 4) * 64) }
    __builtin_amdgcn_sched_barrier(0);
    __syncthreads();
  }
  __builtin_amdgcn_s_setprio(0);
  const int cm0 = m0, cn0 = n0, cnt = nt;
  long w2 = w + gridDim.x; int mt2 = 0, nt2 = 0; bool has_next = false;
  for (;;) { if (w2 >= nw) break; TILE_OF(w2, mt2, nt2) if (nt2 < NTILES) { has_next = true; break; } w2 += gridDim.x; }
  if (has_next) {
    m0 = mt2 * 128; n0 = nt2 * 128; nt = nt2;
    Ag = A + (long)(m0 + lrow) * 1024 + lch * 8; Bg = Bt + (long)(n0 + lrow) * 1024 + lch * 8;
  }
  __builtin_amdgcn_sched_barrier(0);
#define GEMM_EPI(ACC, I, J)                                                                         \
  _Pragma("unroll") for (int r = 0; r < 16; ++r) {                                                   \
    const long row = cm0 + wm * 64 + (I) * 32 + (r & 3) + 8 * (r >> 2) + 4 * (lane >> 5);             \
    const int col = cn0 + wn * 64 + (J) * 32 + (lane & 31);                                            \
    const float v = ACC[r];                                                                          \
    if (EPI == 0) { if (col < INC) p.proj[row * INC + col] = (h16)v; }                                \
    else if (EPI == 1) { p.X[row * 1024 + col] += p.mod[((long)l * NCOND + condrow(row)) * 6144 + 2048 + col] * v; } \
    else { p.pq[row * 2048 + col] = (h16)v; }                                                         \
  }
  if (EPI == 0) {
    h16* Ct = (h16*)g_smem;
#define CST(ACC, I, J) _Pragma("unroll") for (int r = 0; r < 16; ++r) Ct[(wm * 64 + (I) * 32 + (r & 3) + 8 * (r >> 2) + 4 * (lane >> 5)) * 136 + wn * 64 + (J) * 32 + (lane & 31)] = (h16)ACC[r];
    CST(acc00, 0, 0) CST(acc01, 0, 1) CST(acc10, 1, 0) CST(acc11, 1, 1)
#undef CST
    __syncthreads();
#pragma unroll
    for (int j = 0; j < 8; ++j) {
      const int idx = tid + 256 * j; const int rr = idx >> 4, cc = idx & 15;
      if (cn0 + cc * 8 < INC) *(u32x4*)(p.proj + (long)(cm0 + rr) * INC + cn0 + cc * 8) = *(const u32x4*)(Ct + rr * 136 + cc * 8);
    }
  } else if (EPI == 1) {
#define EPI1(ACC, I, J)                                                                              \
    {                                                                                                \
      float xv_[16], mv_[16];                                                                        \
      const int col = cn0 + wn * 64 + (J) * 32 + (lane & 31);                                         \
      _Pragma("unroll") for (int r = 0; r < 16; ++r) {                                               \
        const long row = cm0 + wm * 64 + (I) * 32 + (r & 3) + 8 * (r >> 2) + 4 * (lane >> 5);         \
        xv_[r] = p.X[row * 1024 + col]; mv_[r] = p.mod[((long)l * NCOND + condrow(row)) * 6144 + 2048 + col]; \
      }                                                                                              \
      _Pragma("unroll") for (int r = 0; r < 16; ++r) {                                               \
        const long row = cm0 + wm * 64 + (I) * 32 + (r & 3) + 8 * (r >> 2) + 4 * (lane >> 5);         \
        p.X[row * 1024 + col] = xv_[r] + mv_[r] * ACC[r];                                            \
      }                                                                                              \
    }
    EPI1(acc00, 0, 0) EPI1(acc01, 0, 1) EPI1(acc10, 1, 0) EPI1(acc11, 1, 1)
#undef EPI1
  } else {
    h16* Q = (h16*)g_smem;
    h16* Kk = Q + 128 * 136;
    const h16* kg = p.keys16 + ((long)l * 16 + cnt) * CFG_NKEYS * 128;
#define QST(ACC, I, J) _Pragma("unroll") for (int r = 0; r < 16; ++r) Q[(wm * 64 + (I) * 32 + (r & 3) + 8 * (r >> 2) + 4 * (lane >> 5)) * 136 + wn * 64 + (J) * 32 + (lane & 31)] = (h16)ACC[r];
    QST(acc00, 0, 0) QST(acc01, 0, 1) QST(acc10, 1, 0) QST(acc11, 1, 1)
#undef QST
#pragma unroll
    for (int j = 0; j < 8; ++j) {
      const int idx = tid + 256 * j; const int kr = idx >> 4, kc = idx & 15;
      *(u32x4*)(Kk + kr * 136 + kc * 8) = *(const u32x4*)(kg + kr * 128 + kc * 8);
    }
    __syncthreads();
    f32x16 z = {0.f, 0.f, 0.f, 0.f, 0.f, 0.f, 0.f, 0.f, 0.f, 0.f, 0.f, 0.f, 0.f, 0.f, 0.f, 0.f};
    f32x16 s00 = z, s01 = z, s10 = z, s11 = z;
    const h16* Qb = Q + (wm * 64 + (lane & 31)) * 136 + (lane >> 5) * 8;
    const h16* Kb = Kk + (wn * 64 + (lane & 31)) * 136 + (lane >> 5) * 8;
#pragma unroll
    for (int sidx = 0; sidx < 8; ++sidx) {
      half8 a0 = *(const half8*)(Qb + sidx * 16), a1 = *(const half8*)(Qb + 32 * 136 + sidx * 16);
      half8 b0 = *(const half8*)(Kb + sidx * 16), b1 = *(const half8*)(Kb + 32 * 136 + sidx * 16);
      s00 = __builtin_amdgcn_mfma_f32_32x32x16_f16(a0, b0, s00, 0, 0, 0);
      s01 = __builtin_amdgcn_mfma_f32_32x32x16_f16(a0, b1, s01, 0, 0, 0);
      s10 = __builtin_amdgcn_mfma_f32_32x32x16_f16(a1, b0, s10, 0, 0, 0);
      s11 = __builtin_amdgcn_mfma_f32_32x32x16_f16(a1, b1, s11, 0, 0, 0);
    }
    __syncthreads();
    float* SC = (float*)g_smem;
#define SST(ACC, I, J) _Pragma("unroll") for (int r = 0; r < 16; ++r) SC[(wm * 64 + (I) * 32 + (r & 3) + 8 * (r >> 2) + 4 * (lane >> 5)) * 129 + wn * 64 + (J) * 32 + (lane & 31)] = ACC[r];
    SST(s00, 0, 0) SST(s01, 0, 1) SST(s10, 1, 0) SST(s11, 1, 1)
#undef SST
    __syncthreads();
    const int row = tid >> 1, half = tid & 1;
    float ts[16]; int ti[16];
#pragma unroll
    for (int j = 0; j < 16; ++j) { ts[j] = -3.0e38f; ti[j] = 0; }
#pragma unroll 1
    for (int g = 0; g < 4; ++g) {
      float gs[16]; int gi[16];
#pragma unroll
      for (int j = 0; j < 16; ++j) { gs[j] = SC[row * 129 + half * 64 + g * 16 + j]; gi[j] = half * 64 + g * 16 + j; }
      bitonic_sort16_desc(gs, gi);
      merge_top16(ts, ti, gs, gi);
    }
    {
      float ps[16]; int pi[16];
#pragma unroll
      for (int j = 0; j < 16; ++j) { ps[j] = dppf<0xB1>(ts[j]); pi[j] = __builtin_amdgcn_update_dpp(0, ti[j], 0xB1, 0xF, 0xF, true); }
      merge_top16(ts, ti, ps, pi);
    }
    if (half == 0) {
      const long token = cm0 + row;
#pragma unroll
      for (int j = 0; j < 16; ++j) { p.tks[token * 256 + cnt * 16 + j] = ts[j]; p.tki[token * 256 + cnt * 16 + j] = ti[j]; }
    }
  }
#undef GEMM_EPI
  if (!has_next) break;
  GLD0(0)
  GLD1(64)
  w = w2;
  }
#undef GLD0
#undef GLD1
#undef LST0
#undef LST1
#undef GCOMP
#undef TILE_OF
}

__device__ void blk_mod(long w, const P& p) {
  float* sl = (float*)g_smem;
  const int tid = otid();
  const int cb = (int)(w % 24); const int r = (int)((w / 24) % NCOND); const int l = (int)(w / (24 * NCOND));
  const float* cond = r == 0 ? p.cctx : p.c + (long)(r - 1) * 1024;
  __syncthreads();
#pragma unroll
  for (int j = 0; j < 4; ++j) sl[tid + 256 * j] = siluf_(cond[tid + 256 * j]);
  __syncthreads();
  const int col = cb * 256 + tid;
  const float* wp = p.wmod + (long)l * 1024 * 6144 + col;
  float acc = p.bmod[l * 6144 + col];
#pragma unroll 8
  for (int k = 0; k < 1024; ++k) acc += sl[k] * wp[(long)k * 6144];
  p.mod[((long)l * NCOND + r) * 6144 + col] = acc;
}
__device__ __forceinline__ float sum64u(float x);
template <int WHICH>
__device__ void blk_norm(long w, const P& p, int l) {
  const int tid_ = otid(); const int lane = tid_ & 63; const long token = w * 4 + (tid_ >> 6);
  const float* src = (WHICH == 0 && l == 0) ? (token < NTC ? p.xp + token * 1024 : p.xs + (token - NTC) * 1024) : p.X + token * 1024;
  float4 v[4]; float ss = 0.f;
#pragma unroll
  for (int j = 0; j < 4; ++j) { v[j] = ((const float4*)src)[lane + 64 * j]; ss += v[j].x * v[j].x + v[j].y * v[j].y + v[j].z * v[j].z + v[j].w * v[j].w; }
  ss = sum64u(ss);
  const float rstd = 1.0f / sqrtf(ss * (1.0f / 1024) + 1e-6f);
  if (WHICH == 2) {
#pragma unroll
    for (int j = 0; j < 4; ++j) {
      float4 g = ((const float4*)p.fng)[lane + 64 * j];
      float4 o; o.x = v[j].x * rstd * g.x; o.y = v[j].y * rstd * g.y; o.z = v[j].z * rstd * g.z; o.w = v[j].w * rstd * g.w;
      ((float4*)(p.X + token * 1024))[lane + 64 * j] = o;
    }
    return;
  }
  const float* m = p.mod + ((long)l * NCOND + condrow(token)) * 6144 + (WHICH ? 3072 : 0);
  const float* g = (WHICH ? p.n2g : p.n1g) + l * 1024;
  float4 gga[4], sha[4], sca[4];
#pragma unroll
  for (int j = 0; j < 4; ++j) { const int c4 = lane + 64 * j; gga[j] = ((const float4*)g)[c4]; sha[j] = ((const float4*)m)[c4]; sca[j] = ((const float4*)(m + 1024))[c4]; }
#pragma unroll
  for (int j = 0; j < 4; ++j) {
    const int c4 = lane + 64 * j;
    const float4 gg = gga[j], sh = sha[j], sc = sca[j];
    half4 o;
    o[0] = (h16)((v[j].x * rstd * gg.x) * (1.0f + sc.x) + sh.x);
    o[1] = (h16)((v[j].y * rstd * gg.y) * (1.0f + sc.y) + sh.y);
    o[2] = (h16)((v[j].z * rstd * gg.z) * (1.0f + sc.z) + sh.z);
    o[3] = (h16)((v[j].w * rstd * gg.w) * (1.0f + sc.w) + sh.w);
    *(half4*)(p.act + token * 1024 + c4 * 4) = o;
    if (WHICH == 0 && l == 0) ((float4*)(p.X + token * 1024))[c4] = v[j];
  }
}


#define SC_CT 32
__device__ __forceinline__ float fsigmoid(float x) { return __frcp_rn(1.0f + __expf(-x)); }
__device__ __forceinline__ float fsilu(float x) { return x * fsigmoid(x); }
__device__ __forceinline__ float fsoftplus(float x) { return fmaxf(x, 0.0f) + __logf(1.0f + __expf(-fabsf(x))); }
__device__ __forceinline__ float ftanh(float x) { const float e = __expf(-2.0f * fabsf(x)); const float t = (1.0f - e) * __frcp_rn(1.0f + e); return x < 0.f ? -t : t; }
#define N_PREP_RW ((NT / 32) * 8)
#define N_PREP_DN ((NT / 32) * 4)
__device__ void blk_scanprep(long w, const P& p, int l, half8& bf0, half8& bf1, int& bkey) {
  h16* tw16 = (h16*)g_smem;
  h16* al16 = tw16 + 32 * 40;
  float* cbuf = (float*)(al16 + 32 * 40);
  const int tid = otid();
  const int ls = tid >> 3, part = tid & 7;
  if (w < N_PREP_RW) {
    const int d = (int)(w & 1), h = (int)((w >> 1) & 3); const long token = (w >> 3) * 32 + ls;
    int t, T; long base; seqinfo(token, t, T, base);
    const bool sv = d == 0 ? (t > 0) : (t < T - 1);
    const h16* pb = p.proj + token * INC + RW_OFF;
    const h16* ps = p.proj + (token + (d == 0 ? -1 : 1)) * INC + RW_OFF;
    const float* mu = p.rwmu + ((long)l * 2 + d) * 832;
    const int lane = tid & 63, wv = tid >> 6;
    const int mat = wv >> 1, ntile = wv & 1;
    const int c0 = h * 64 + part * 8;
    half8 rb = *(const half8*)(pb + c0), kb = *(const half8*)(pb + 256 + c0);
    half8 rs_ = rb, ks_ = kb;
    if (sv) { rs_ = *(const half8*)(ps + c0); ks_ = *(const half8*)(ps + 256 + c0); }
    if (bkey != (int)((l << 3) | (w & 7))) {
      bkey = (int)((l << 3) | (w & 7));
      const float* wsrc = (mat ? p.rwa2 : p.rww2) + ((long)l * 2 + d) * 32 * 256 + h * 64 + ntile * 32 + (lane & 31);
#pragma unroll
      for (int j = 0; j < 8; ++j) { bf0[j] = (h16)wsrc[(8 * (lane >> 5) + j) * 256]; bf1[j] = (h16)wsrc[(16 + 8 * (lane >> 5) + j) * 256]; }
    }
    __syncthreads();
#pragma unroll
    for (int e = 0; e < 4; ++e) {
      const int jj = part * 4 + e;
      float bw = (float)pb[768 + d * 32 + jj], sw = sv ? (float)ps[768 + d * 32 + jj] : 0.f;
      tw16[ls * 40 + jj] = (h16)ftanh(bw + (sw - bw) * mu[768 + jj]);
      float ba = (float)pb[832 + d * 32 + jj], sa_ = sv ? (float)ps[832 + d * 32 + jj] : 0.f;
      al16[ls * 40 + jj] = (h16)(ba + (sa_ - ba) * mu[800 + jj]);
    }
    __syncthreads();
    {
      const h16* X16 = (mat ? al16 : tw16) + (lane & 31) * 40 + 8 * (lane >> 5);
      const half8 a0 = *(const half8*)X16, a1 = *(const half8*)(X16 + 16);
      f32x16 acc = {0.f, 0.f, 0.f, 0.f, 0.f, 0.f, 0.f, 0.f, 0.f, 0.f, 0.f, 0.f, 0.f, 0.f, 0.f, 0.f};
      acc = __builtin_amdgcn_mfma_f32_32x32x16_f16(a0, bf0, acc, 0, 0, 0);
      acc = __builtin_amdgcn_mfma_f32_32x32x16_f16(a1, bf1, acc, 0, 0, 0);
      float* cb = cbuf + mat * (32 * 65) + ntile * 32 + (lane & 31);
#pragma unroll
      for (int r = 0; r < 16; ++r) cb[((r & 3) + 8 * (r >> 2) + 4 * (lane >> 5)) * 65] = acc[r];
    }
    __syncthreads();
    float accw[8], acca[8];
#pragma unroll
    for (int e = 0; e < 8; ++e) {
      accw[e] = p.rww0[(l * 2 + d) * 256 + c0 + e] + cbuf[ls * 65 + part * 8 + e];
      acca[e] = p.rwa0[(l * 2 + d) * 256 + c0 + e] + cbuf[32 * 65 + ls * 65 + part * 8 + e];
    }
    float ss = 0.f, bon = 0.f;
    half8 ewo, ago;
#pragma unroll
    for (int e = 0; e < 8; ++e) {
      const int c = c0 + e;
      float b_ = (float)rb[e], s_ = sv ? (float)rs_[e] : 0.f; const float rr = b_ + (s_ - b_) * mu[c];
      b_ = (float)kb[e]; s_ = sv ? (float)ks_[e] : 0.f; const float kr = b_ + (s_ - b_) * mu[256 + c];
      const float asg = fsigmoid(acca[e]);
      const float kkr = kr * p.rwkk[l * 256 + c];
      ss += kkr * kkr;
      const float keff = kr * (1.0f + (asg - 1.0f) * p.rwka[l * 256 + c]);
      bon += rr * keff * p.rwrk[l * 256 + c];
      ewo[e] = (h16)__expf(-fsoftplus(-accw[e]) - 0.5f);
      ago[e] = (h16)asg;
    }
    ss = sum8(ss); bon = sum8(bon);
    *(half8*)(p.rwaux + ((token * 2 + d) * 2 + 0) * 256 + c0) = ewo;
    *(half8*)(p.rwaux + ((token * 2 + d) * 2 + 1) * 256 + c0) = ago;
    if (part == 0) { float* sc = p.rwsc + ((token * 2 + d) * 4 + h) * 2; sc[0] = 1.0f / sqrtf(ss + 1e-6f); sc[1] = bon; }
  } else {
    const long w2 = w - N_PREP_RW;
    const int h = (int)(w2 & 3); const long token = (w2 >> 2) * 32 + ls;
    int t, T; long base; seqinfo(token, t, T, base);
    const int c0 = h * 64 + part * 8;
    float aq[8], ak[8], av[8];
#pragma unroll
    for (int e = 0; e < 8; ++e) { aq[e] = 0.f; ak[e] = 0.f; av[e] = 0.f; }
    half8 xq[5], xk[5], xv[5]; float tv[5];
#pragma unroll
    for (int tap = 0; tap < 5; ++tap) {
      const int tt = t + tap - 2;
      const bool ok = tt >= 0 && tt < T;
      const h16* pr = p.proj + (base + (ok ? tt : t)) * INC + DN_OFF + c0;
      xq[tap] = *(const half8*)pr; xk[tap] = *(const half8*)(pr + 256); xv[tap] = *(const half8*)(pr + 512);
      tv[tap] = ok ? 1.0f : 0.0f;
    }
    __builtin_amdgcn_sched_barrier(0);
#pragma unroll
    for (int tap = 0; tap < 5; ++tap) {
      const float* cw = p.dnconv + ((long)l * 5 + tap) * 768 + c0;
#pragma unroll
      for (int e = 0; e < 8; ++e) {
        aq[e] += (float)xq[tap][e] * (cw[e] * tv[tap]); ak[e] += (float)xk[tap][e] * (cw[256 + e] * tv[tap]); av[e] += (float)xv[tap][e] * (cw[512 + e] * tv[tap]);
      }
    }
    float ssq = 0.f, ssk = 0.f;
#pragma unroll
    for (int e = 0; e < 8; ++e) { aq[e] = fsilu(aq[e]); ak[e] = fsilu(ak[e]); av[e] = fsilu(av[e]); ssq += aq[e] * aq[e]; ssk += ak[e] * ak[e]; }
    ssq = sum8(ssq); ssk = sum8(ssk);
    const float rq = 0.125f / sqrtf(ssq + 1e-6f), rk = 1.0f / sqrtf(ssk + 1e-6f);
    half8 qo, ko, vo;
#pragma unroll
    for (int e = 0; e < 8; ++e) { qo[e] = (h16)(aq[e] * rq); ko[e] = (h16)(ak[e] * rk); vo[e] = (h16)av[e]; }
    h16* dp = p.dnp + token * 768 + c0;
    *(half8*)dp = qo; *(half8*)(dp + 256) = ko; *(half8*)(dp + 512) = vo;
    if (part < 2) {
      const int d = part;
      const h16* pr = p.proj + token * INC + DN_OFF;
      float* sc = p.dnsc + ((token * 2 + d) * 4 + h) * 2;
      sc[0] = sigmoidf_((float)pr[768 + d * 4 + h]);
      sc[1] = expf(-expf(p.dnalog[(l * 2 + d) * 4 + h]) * softplusf_((float)pr[776 + d * 4 + h] + p.dndt[(l * 2 + d) * 4 + h]));
    }
  }
}
__device__ void blk_scan2(int kind, int bi, int h, int d, int rq, const P& p, int l) {
  float* L = (float*)g_smem;
  float* LA = L; float* LW = L + 2048; float* LB = L + 4096; float* LK = L + 6144; float* LR = L + 8192; float* LV = L + 10240;
  const int tid = otid(), lane = tid & 63, wv = tid >> 6, g = lane >> 4, cl = lane & 15;
  const int i = rq * 32 + wv * 8 + g * 2, j0 = cl * 4;
  const bool ctx = bi < CFG_BATCH;
  const int T = ctx ? CFG_SEQ : CFG_DS;
  const long base = ctx ? (long)bi * CFG_SEQ : (long)NTC + (long)(bi - CFG_BATCH) * CFG_DS;
  const int ls = tid >> 3, part = tid & 7;
  f32x4 S = {0.f, 0.f, 0.f, 0.f}, S1 = {0.f, 0.f, 0.f, 0.f};
  if (!ctx) {
    const int b = bi - CFG_BATCH;
    if (kind == 0) {
      const float* s0 = p.srw + (((((long)b) * 2 + l) * 2 + d) * 4 + h) * 4096;
      S = *(const f32x4*)(s0 + i * 64 + j0); S1 = *(const f32x4*)(s0 + (i + 1) * 64 + j0);
    } else {
      const float* s0 = p.sdn + (((((long)b) * 2 + l) * 2 + d) * 4 + h) * 4096;
#pragma unroll
      for (int c = 0; c < 4; ++c) { S[c] = s0[(j0 + c) * 64 + i]; S1[c] = s0[(j0 + c) * 64 + i + 1]; }
    }
  }
  h16* obuf = (h16*)(L + 12288);
  h16* obase = (kind == 0 ? p.act + 256 + d * 512 + h * 64 : p.proj + DN_OFF + d * 256 + h * 64) + rq * 32 + (tid & 7) * 4;
  const long ostride = kind == 0 ? 1024 : INC;
#define SC_FLUSH(S0I)                                                                              \
  { const int sidx_ = (S0I) + (tid >> 3); const int t_ = d == 0 ? sidx_ : T - 1 - sidx_;             \
    *(half4*)(obase + (base + t_) * ostride) = *(const half4*)(obuf + (tid >> 3) * 32 + (tid & 7) * 4); }
  const int c0 = h * 64 + part * 8, jb = part * 8;
  float cmr[8], cmk[8], cmv[8], ckk[8], cka[8];
#pragma unroll
  for (int e = 0; e < 8; ++e) { cmr[e] = 0.f; cmk[e] = 0.f; cmv[e] = 0.f; ckk[e] = 0.f; cka[e] = 0.f; }
  if (kind == 0) {
    const float* mu = p.rwmu + ((long)l * 2 + d) * 832;
#pragma unroll
    for (int e = 0; e < 8; ++e) { cmr[e] = mu[c0 + e]; cmk[e] = mu[256 + c0 + e]; cmv[e] = mu[512 + c0 + e]; ckk[e] = p.rwkk[l * 256 + c0 + e]; cka[e] = p.rwka[l * 256 + c0 + e]; }
  }
  half8 g0, g1, g2, g3, g4, g5, g6, g7; float gf0 = 0.f, gf1 = 0.f; bool gsv = false;
  g0 = g1 = g2 = g3 = g4 = g5 = g6 = g7 = (half8){0, 0, 0, 0, 0, 0, 0, 0};
#define SC_LOADG(S0I)                                                                              \
  {                                                                                                \
    const int sidx_ = (S0I) + ls;                                                                  \
    const int t_ = d == 0 ? sidx_ : T - 1 - sidx_;                                                 \
    const long token_ = base + t_;                                                                 \
    if (kind == 0) {                                                                               \
      gsv = d == 0 ? (t_ > 0) : (t_ < T - 1);                                                      \
      const h16* pb_ = p.proj + token_ * INC + RW_OFF + c0;                                        \
      const h16* ps_ = gsv ? p.proj + (token_ + (d == 0 ? -1 : 1)) * INC + RW_OFF + c0 : pb_;      \
      g0 = *(const half8*)pb_; g1 = *(const half8*)(pb_ + 256); g2 = *(const half8*)(pb_ + 512);   \
      g3 = *(const half8*)ps_; g4 = *(const half8*)(ps_ + 256); g5 = *(const half8*)(ps_ + 512);   \
      g6 = *(const half8*)(p.rwaux + ((token_ * 2 + d) * 2 + 0) * 256 + c0);                       \
      g7 = *(const half8*)(p.rwaux + ((token_ * 2 + d) * 2 + 1) * 256 + c0);                       \
      gf0 = p.rwsc[((token_ * 2 + d) * 4 + h) * 2];                                                \
    } else {                                                                                       \
      const h16* dp_ = p.dnp + token_ * 768 + c0;                                                  \
      g0 = *(const half8*)dp_; g1 = *(const half8*)(dp_ + 256); g2 = *(const half8*)(dp_ + 512);   \
      const float* sc_ = p.dnsc + ((token_ * 2 + d) * 4 + h) * 2;                                  \
      gf0 = sc_[0]; gf1 = sc_[1];                                                                  \
    }                                                                                              \
  }
  SC_LOADG(0)
  for (int s0i = 0; s0i < T; s0i += SC_CT) {
    __syncthreads();
    if (s0i > 0) SC_FLUSH(s0i - SC_CT)
    {
      f32x4 va[2], vw[2], vb[2], vk[2], vr[2], vv_[2];
      if (kind == 0) {
#pragma unroll
        for (int e = 0; e < 8; ++e) {
          float b_ = (float)g0[e], s_ = gsv ? (float)g3[e] : 0.f; const float rr = b_ + (s_ - b_) * cmr[e];
          b_ = (float)g1[e]; s_ = gsv ? (float)g4[e] : 0.f; const float kr = b_ + (s_ - b_) * cmk[e];
          b_ = (float)g2[e]; s_ = gsv ? (float)g5[e] : 0.f; const float vl = b_ + (s_ - b_) * cmv[e];
          const float asg = (float)g7[e];
          const float kk = kr * ckk[e] * gf0;
          va[e >> 2][e & 3] = -kk; vw[e >> 2][e & 3] = __expf(-(float)g6[e]); vb[e >> 2][e & 3] = kk * asg;
          vk[e >> 2][e & 3] = kr * (1.0f + (asg - 1.0f) * cka[e]); vr[e >> 2][e & 3] = rr; vv_[e >> 2][e & 3] = vl;
        }
      } else {
        const float beta = gf0, alpha = gf1;
#pragma unroll
        for (int e = 0; e < 8; ++e) {
          const float k = (float)g1[e];
          va[e >> 2][e & 3] = k; vw[e >> 2][e & 3] = alpha; vb[e >> 2][e & 3] = -alpha * beta * k;
          vk[e >> 2][e & 3] = beta * k; vr[e >> 2][e & 3] = (float)g0[e]; vv_[e >> 2][e & 3] = (float)g2[e];
        }
      }
      const int lo_ = ls * 64 + jb;
      *(f32x4*)(LA + lo_) = va[0]; *(f32x4*)(LA + lo_ + 4) = va[1]; *(f32x4*)(LW + lo_) = vw[0]; *(f32x4*)(LW + lo_ + 4) = vw[1];
      *(f32x4*)(LB + lo_) = vb[0]; *(f32x4*)(LB + lo_ + 4) = vb[1]; *(f32x4*)(LK + lo_) = vk[0]; *(f32x4*)(LK + lo_ + 4) = vk[1];
      *(f32x4*)(LR + lo_) = vr[0]; *(f32x4*)(LR + lo_ + 4) = vr[1]; *(f32x4*)(LV + lo_) = vv_[0]; *(f32x4*)(LV + lo_ + 4) = vv_[1];
    }
    __syncthreads();
    if (s0i + SC_CT < T) SC_LOADG(s0i + SC_CT)
    __builtin_amdgcn_sched_barrier(0);
#define SC_LD(A4, W4, B4, K4, R4, VV, Q)                                                                    \
    { const int o_ = (Q) * 64; A4 = *(const f32x4*)(LA + o_ + j0); W4 = *(const f32x4*)(LW + o_ + j0); B4 = *(const f32x4*)(LB + o_ + j0); \
      K4 = *(const f32x4*)(LK + o_ + j0); R4 = *(const f32x4*)(LR + o_ + j0); VV = *(const f32x2*)(LV + o_ + i); }
#define SC_STEP(ca, cw, cb, ck, cr, cv, Q)                                                                  \
    {                                                                                                       \
      float sa = S[0] * ca[0] + S[1] * ca[1] + S[2] * ca[2] + S[3] * ca[3];                                 \
      float sb = S1[0] * ca[0] + S1[1] * ca[1] + S1[2] * ca[2] + S1[3] * ca[3];                             \
      sa = sum16(sa); sb = sum16(sb);                                                                       \
      _Pragma("unroll") for (int c = 0; c < 4; ++c) { S[c] = S[c] * cw[c] + sa * cb[c] + cv[0] * ck[c]; S1[c] = S1[c] * cw[c] + sb * cb[c] + cv[1] * ck[c]; } \
      float o = S[0] * cr[0] + S[1] * cr[1] + S[2] * cr[2] + S[3] * cr[3];                                  \
      float o1 = S1[0] * cr[0] + S1[1] * cr[1] + S1[2] * cr[2] + S1[3] * cr[3];                             \
      o = sum16(o); o1 = sum16(o1);                                                                         \
      if (cl == 0) { half2v ov; ov[0] = (h16)o; ov[1] = (h16)o1; *(half2v*)(obuf + (Q) * 32 + wv * 8 + g * 2) = ov; } \
    }
    f32x4 a4, w4, b4, k4, r4, a5, w5, b5, k5, r5; f32x2 vv, vv5;
    SC_LD(a4, w4, b4, k4, r4, vv, 0)
    for (int q = 0; q < SC_CT; q += 2) {
      SC_LD(a5, w5, b5, k5, r5, vv5, q + 1)
      SC_STEP(a4, w4, b4, k4, r4, vv, q)
      if (q + 2 < SC_CT) SC_LD(a4, w4, b4, k4, r4, vv, q + 2)
      SC_STEP(a5, w5, b5, k5, r5, vv5, q + 1)
    }
#undef SC_LD
#undef SC_STEP
  }
  __syncthreads();
  SC_FLUSH(T - SC_CT)
#undef SC_FLUSH
  if (ctx) {
    if (kind == 0) {
      float* so = p.orw + (((((long)bi) * 2 + l) * 2 + d) * 4 + h) * 4096;
      *(f32x4*)(so + i * 64 + j0) = S; *(f32x4*)(so + (i + 1) * 64 + j0) = S1;
    } else {
      float* so = p.odn + (((((long)bi) * 2 + l) * 2 + d) * 4 + h) * 4096;
#pragma unroll
      for (int c = 0; c < 4; ++c) { so[(j0 + c) * 64 + i] = S[c]; so[(j0 + c) * 64 + i + 1] = S1[c]; }
    }
  }
}
#undef SC_LOADG
__device__ void blk_fin(long w, const P& p, int l, const float* g2s, float* sgs) {
  const int tid_ = otid(); const int lane = tid_ & 63; const long token = w * 4 + (tid_ >> 6);
  float* sgw = sgs + (tid_ >> 6) * 64;
  const int c4 = lane * 4;
  const int hd = lane >> 4;
  const h16* pr = p.proj + token * INC;
  h16* ao = p.act + token * 1024;
  int t, T; long base; seqinfo(token, t, T, base);
  const bool sv0 = t > 0, sv1 = t < T - 1;
  const float bon0 = p.rwsc[((token * 2 + 0) * 4 + hd) * 2 + 1], bon1 = p.rwsc[((token * 2 + 1) * 4 + hd) * 2 + 1];
  const half4 vb = *(const half4*)(pr + RW_OFF + 512 + c4);
  half4 vm = vb, vp = vb;
  if (sv0) vm = *(const half4*)(pr - INC + RW_OFF + 512 + c4);
  if (sv1) vp = *(const half4*)(pr + INC + RW_OFF + 512 + c4);
  const half4 d_o0 = *(const half4*)(pr + DN_OFF + c4), d_o1 = *(const half4*)(pr + DN_OFF + 256 + c4);
  const half4 d_z = *(const half4*)(pr + DN_OFF + 784 + c4);
  const f32x4 mu0 = *(const f32x4*)(p.rwmu + ((long)l * 2 + 0) * 832 + 512 + c4), mu1 = *(const f32x4*)(p.rwmu + ((long)l * 2 + 1) * 832 + 512 + c4);
  const f32x4 lng = *(const f32x4*)(p.rwlng + l * 256 + c4), lnb = *(const f32x4*)(p.rwlnb + l * 256 + c4);
  const f32x4 dng = *(const f32x4*)(p.dnng + l * 64 + (c4 & 63));
  {
    half4 o0 = *(const half4*)(ao + 256 + c4), o1 = *(const half4*)(ao + 768 + c4);
    float o[4]; float mu = 0.f;
#pragma unroll
    for (int e = 0; e < 4; ++e) { o[e] = (float)o0[e] + (float)o1[e]; mu += o[e]; }
    mu = sum16(mu) * (1.0f / 64);
    float var = 0.f;
#pragma unroll
    for (int e = 0; e < 4; ++e) { float dl = o[e] - mu; var += dl * dl; }
    var = sum16(var) * (1.0f / 64);
    const float rs = 1.0f / sqrtf(var + 64e-5f);
    const float sg = sigmoidf_((float)pr[RW_OFF + 896 + lane]);
    float gate[4] = {0.f, 0.f, 0.f, 0.f};
    sgw[lane] = sg;
    __syncthreads();
#pragma unroll 8
    for (int j = 0; j < 64; ++j) {
      const float sj = sgw[j];
      const f32x4 g2 = *(const f32x4*)(g2s + j * 256 + c4);
#pragma unroll
      for (int e = 0; e < 4; ++e) gate[e] += sj * g2[e];
    }
    half4 out;
#pragma unroll
    for (int e = 0; e < 4; ++e) {
      const float b_ = (float)vb[e];
      const float v0 = b_ + ((sv0 ? (float)vm[e] : 0.f) - b_) * mu0[e];
      const float v1 = b_ + ((sv1 ? (float)vp[e] : 0.f) - b_) * mu1[e];
      float y = (o[e] - mu) * rs * lng[e] + lnb[e] + bon0 * v0 + bon1 * v1;
      out[e] = (h16)(y * gate[e]);
    }
    *(half4*)(ao + 256 + c4) = out;
  }
  {
    const half4 o0 = d_o0, o1 = d_o1, z = d_z;
    float o[4]; float ss = 0.f;
#pragma unroll
    for (int e = 0; e < 4; ++e) { o[e] = (float)o0[e] + (float)o1[e]; ss += o[e] * o[e]; }
    ss = sum16(ss);
    const float rs = 1.0f / sqrtf(ss * (1.0f / 64) + 1e-6f);
    half4 out;
#pragma unroll
    for (int e = 0; e < 4; ++e) out[e] = (h16)(o[e] * rs * dng[e] * siluf_((float)z[e]));
    *(half4*)(ao + 768 + c4) = out;
  }
}

__device__ __forceinline__ float dot8h(half8 u, half8 x, float d) {
#pragma unroll
  for (int e = 0; e < 8; ++e) d += (float)u[e] * (float)x[e];
  return d;
}
__device__ __forceinline__ void cvt8(const float* src, h16* dst, long i) {
  const f32x4 a = *(const f32x4*)(src + i * 8), b = *(const f32x4*)(src + i * 8 + 4);
  half8 o; o[0] = (h16)a[0]; o[1] = (h16)a[1]; o[2] = (h16)a[2]; o[3] = (h16)a[3]; o[4] = (h16)b[0]; o[5] = (h16)b[1]; o[6] = (h16)b[2]; o[7] = (h16)b[3];
  *(half8*)(dst + i * 8) = o;
}
__device__ __forceinline__ float sum64u(float x) {
  x = sum16(x);
  x += __builtin_bit_cast(float, __builtin_amdgcn_update_dpp(0, __builtin_bit_cast(int, x), 0x142, 0xA, 0xF, false));
  x += __builtin_bit_cast(float, __builtin_amdgcn_update_dpp(0, __builtin_bit_cast(int, x), 0x143, 0xC, 0xF, false));
  return __builtin_bit_cast(float, __builtin_amdgcn_readlane(__builtin_bit_cast(int, x), 63));
}
__device__ __forceinline__ float ferf(float x) {
  const float ax = fabsf(x);
  const float t = __frcp_rn(1.0f + 0.3275911f * ax);
  const float y = 1.0f - (((((1.061405429f * t - 1.453152027f) * t) + 1.421413741f) * t - 0.284496736f) * t + 0.254829592f) * t * __expf(-ax * ax);
  return x < 0.f ? -y : y;
}
__device__ __forceinline__ void cvt16_fp8(const float* src, unsigned char* dst, long i, float scale) {
  u32x4 o;
#pragma unroll
  for (int k = 0; k < 4; ++k) {
    const f32x4 a = *(const f32x4*)(src + i * 16 + k * 4);
    int w = __builtin_amdgcn_cvt_pk_fp8_f32(a[0] * scale, a[1] * scale, 0, false);
    w = __builtin_amdgcn_cvt_pk_fp8_f32(a[2] * scale, a[3] * scale, w, true);
    o[k] = (unsigned)w;
  }
  *(u32x4*)(dst + i * 16) = o;
}
__device__ void fin_phase(const P& p, int l) {
  float* g2s = (float*)g_smem;
  float* sgs = g2s + 64 * 256;
  const int tid = otid();
  __syncthreads();
  const f32x4* src = (const f32x4*)(p.rwg2 + (long)l * 64 * 256);
#pragma unroll
  for (int j = 0; j < 16; ++j) ((f32x4*)g2s)[tid + 256 * j] = src[tid + 256 * j];
  __syncthreads();
  for (long w = blockIdx.x; w < NT / 4; w += gridDim.x) blk_fin(w, p, l, g2s, sgs);
}
typedef unsigned u32x2 __attribute__((ext_vector_type(2)));
__device__ __forceinline__ void cvt16_fp4(const float* src, unsigned char* dst, long i, float scale) {
  u32x2 o;
#pragma unroll
  for (int k = 0; k < 2; ++k) {
    const f32x4 a = *(const f32x4*)(src + i * 16 + k * 8), b = *(const f32x4*)(src + i * 16 + k * 8 + 4);
    unsigned w = 0u;
    w = __builtin_amdgcn_cvt_scalef32_pk_fp4_f32(w, a[0] * scale, a[1] * scale, 1.0f, 0);
    w = __builtin_amdgcn_cvt_scalef32_pk_fp4_f32(w, a[2] * scale, a[3] * scale, 1.0f, 1);
    w = __builtin_amdgcn_cvt_scalef32_pk_fp4_f32(w, b[0] * scale, b[1] * scale, 1.0f, 2);
    w = __builtin_amdgcn_cvt_scalef32_pk_fp4_f32(w, b[2] * scale, b[3] * scale, 1.0f, 3);
    o[k] = w;
  }
  *(u32x2*)(dst + i * 8) = o;
}
#define PEER_USCALE 48.0f
#define PEER_VSCALE 16.0f
struct PairTab { int a[50]; int b[50]; };
__host__ __device__ constexpr PairTab make_pairs() {
  PairTab t{}; int n = 0;
  for (int a = 0; a < 16; ++a) for (int b = 0; b < 16; ++b) if ((a + 1) * (b + 1) <= 16) { t.a[n] = a; t.b[n] = b; ++n; }
  return t;
}
template <bool DRY>
__device__ void blk_peer(long w, const P& p, int l) {
  constexpr PairTab PT = make_pairs();
  const int tid_ = otid(); const int lane = tid_ & 63, wv = tid_ >> 6; const long token = w * 4 + wv;
  int* eidx = (int*)g_smem + wv * 256; float* egate = (float*)g_smem + wv * 256 + 128;
  const h16* xr = p.act + token * 1024 + lane * 16;
  const half8 x0 = *(const half8*)xr, x1 = *(const half8*)(xr + 8);
  int la = 0, lb = 0;
#pragma unroll
  for (int j = 0; j < 50; ++j) if (lane == j) { la = PT.a[j]; lb = PT.b[j]; }
  const int lc = la * 16 + lb;
  __syncthreads();
  float cs_[8]; int ce_[8];
#pragma unroll
  for (int hd = 0; hd < 8; ++hd) {
    const float* s1 = p.tks + token * 256 + hd * 32; const int* i1 = p.tki + token * 256 + hd * 32;
    const int la_ = lane < 50 ? la : 0, lb_ = lane < 50 ? lb : 0;
    cs_[hd] = s1[la_] + s1[16 + lb_]; ce_[hd] = i1[la_] * CFG_NKEYS + i1[16 + lb_];
  }
#pragma unroll
  for (int hd = 0; hd < 8; ++hd) {
    const float s = lane < 50 ? cs_[hd] : -3.0e38f;
    int rank = 0;
#pragma unroll
    for (int j = 0; j < 50; ++j) {
      const float sj = __builtin_bit_cast(float, __builtin_amdgcn_readlane(__builtin_bit_cast(int, s), j));
      rank += (sj > s) ? 1 : 0;
    }
    {
      int mk = (lane < 50 && rank < 16) ? (1 << rank) : 0;
      mk |= __builtin_amdgcn_update_dpp(0, mk, 0x128, 0xF, 0xF, true); mk |= __builtin_amdgcn_update_dpp(0, mk, 0x124, 0xF, 0xF, true);
      mk |= __builtin_amdgcn_update_dpp(0, mk, 0xB1, 0xF, 0xF, true);  mk |= __builtin_amdgcn_update_dpp(0, mk, 0x4E, 0xF, 0xF, true);
      const int mall = __builtin_amdgcn_readlane(mk, 0) | __builtin_amdgcn_readlane(mk, 16) | __builtin_amdgcn_readlane(mk, 32) | __builtin_amdgcn_readlane(mk, 48);
      const int nsel = __builtin_popcountll(__ballot(lane < 50 && rank < 16));
      if (mall != 0xFFFF || nsel != 16) {
        rank = 0;
#pragma unroll 1
        for (int j = 0; j < 50; ++j) {
          const float sj = __builtin_bit_cast(float, __builtin_amdgcn_readlane(__builtin_bit_cast(int, s), j));
          rank += (sj > s || (sj == s && j < lane)) ? 1 : 0;
        }
      }
    }
    const bool sel = lane < 50 && rank < 16;
    const float m = __builtin_bit_cast(float, __builtin_amdgcn_readlane(__builtin_bit_cast(int, s), 0));
    const float e = sel ? expf(s - m) : 0.f;
    const float sum = sum64(e);
    if (sel) { eidx[hd * 16 + rank] = ce_[hd]; egate[hd * 16 + rank] = e / sum; }
  }
  __syncthreads();
  f32x2 x2[8];
#pragma unroll
  for (int e = 0; e < 4; ++e) { x2[e][0] = (float)x0[2 * e]; x2[e][1] = (float)x0[2 * e + 1]; x2[4 + e][0] = (float)x1[2 * e]; x2[4 + e][1] = (float)x1[2 * e + 1]; }
  f32x2 acc2[8];
#pragma unroll
  for (int e = 0; e < 8; ++e) { acc2[e][0] = 0.f; acc2[e][1] = 0.f; }
  const unsigned char* u8 = (const unsigned char*)p.u16; const unsigned char* v8 = (const unsigned char*)p.v16;
#define PEER_LOAD(U, V, GT, EB)                                                                   \
  _Pragma("unroll") for (int q = 0; q < 8; ++q) {                                                 \
    const unsigned ro_ = (unsigned)eidx[(EB) + q] * 512u + (unsigned)lane * 8u; GT[q] = egate[(EB) + q];   \
    U[q] = *(const u32x2*)(u8 + ro_); V[q] = *(const u32x2*)(v8 + ro_);                           \
  }
#define PEER_COMP(U, V, GT)                                                                       \
  {                                                                                               \
    float dd_[8];                                                                                 \
    _Pragma("unroll") for (int q = 0; q < 8; ++q) {                                               \
      f32x2 d2 = {0.f, 0.f};                                                                      \
      _Pragma("unroll") for (int k = 0; k < 2; ++k) {                                             \
        d2 += __builtin_amdgcn_cvt_scalef32_pk_f32_fp4(U[q][k], 1.0f, 0) * x2[4 * k];             \
        d2 += __builtin_amdgcn_cvt_scalef32_pk_f32_fp4(U[q][k], 1.0f, 1) * x2[4 * k + 1];         \
        d2 += __builtin_amdgcn_cvt_scalef32_pk_f32_fp4(U[q][k], 1.0f, 2) * x2[4 * k + 2];         \
        d2 += __builtin_amdgcn_cvt_scalef32_pk_f32_fp4(U[q][k], 1.0f, 3) * x2[4 * k + 3];         \
      }                                                                                           \
      dd_[q] = sum64u(d2[0] + d2[1]) * (1.0f / PEER_USCALE);                                      \
    }                                                                                             \
      \
    float dv_ = dd_[7];                                                                           \
    _Pragma("unroll") for (int q = 6; q >= 0; --q) dv_ = lane == q ? dd_[q] : dv_;                \
    const float gv_ = 0.5f * dv_ * (1.0f + erff(dv_ * 0.70710678118654752f));                     \
    _Pragma("unroll") for (int q = 0; q < 8; ++q) {                                               \
      const float wgt = GT[q] * __builtin_bit_cast(float, __builtin_amdgcn_readlane(__builtin_bit_cast(int, gv_), q)) * (1.0f / PEER_VSCALE); \
      const f32x2 w2 = {wgt, wgt};                                                                \
      _Pragma("unroll") for (int k = 0; k < 2; ++k) {                                             \
        acc2[4 * k] += w2 * __builtin_amdgcn_cvt_scalef32_pk_f32_fp4(V[q][k], 1.0f, 0);           \
        acc2[4 * k + 1] += w2 * __builtin_amdgcn_cvt_scalef32_pk_f32_fp4(V[q][k], 1.0f, 1);       \
        acc2[4 * k + 2] += w2 * __builtin_amdgcn_cvt_scalef32_pk_f32_fp4(V[q][k], 1.0f, 2);       \
        acc2[4 * k + 3] += w2 * __builtin_amdgcn_cvt_scalef32_pk_f32_fp4(V[q][k], 1.0f, 3);       \
      }                                                                                           \
    }                                                                                             \
  }
  u32x2 au[8], av[8], bu[8], bv[8];
  float ag[8], bg[8];
  PEER_LOAD(au, av, ag, 0)
  for (int eb = 0; eb < 128; eb += 16) {
    PEER_LOAD(bu, bv, bg, eb + 8)
    __builtin_amdgcn_sched_barrier(0);
    PEER_COMP(au, av, ag)
    if (eb + 16 < 128) { PEER_LOAD(au, av, ag, eb + 16) }
    __builtin_amdgcn_sched_barrier(0);
    PEER_COMP(bu, bv, bg)
  }
#undef PEER_LOAD
#undef PEER_COMP
  const float* g2 = p.mod + ((long)l * NCOND + condrow(token)) * 6144 + 5120 + lane * 16;
  float* xo = p.X + token * 1024 + lane * 16;
  f32x4 xn[4]; float ssq = 0.f;
#pragma unroll
  for (int k = 0; k < 4; ++k) {
    xn[k] = *(f32x4*)(xo + 4 * k);
    const f32x4 ga = *(const f32x4*)(g2 + 4 * k);
#pragma unroll
    for (int e = 0; e < 4; ++e) { xn[k][e] += ga[e] * acc2[2 * k + (e >> 1)][e & 1]; ssq += xn[k][e] * xn[k][e]; }
  }
  if (DRY) { if (acc2[0][0] == 123456.789f) *(f32x4*)xo = xn[0]; return; }
  const float rstd = 1.0f / sqrtf(sum64u(ssq) * (1.0f / 1024) + 1e-6f);
  if (l == 0) {
    const float* m = p.mod + ((long)1 * NCOND + condrow(token)) * 6144 + lane * 16;
    const float* g = p.n1g + 1024 + lane * 16;
    half8 h0, h1;
    f32x4 gga[4], sha[4], sca[4];
#pragma unroll
    for (int k = 0; k < 4; ++k) { gga[k] = *(const f32x4*)(g + 4 * k); sha[k] = *(const f32x4*)(m + 4 * k); sca[k] = *(const f32x4*)(m + 1024 + 4 * k); }
#pragma unroll
    for (int k = 0; k < 4; ++k) {
      *(f32x4*)(xo + 4 * k) = xn[k];
      const f32x4 gg = gga[k], sh = sha[k], sc = sca[k];
#pragma unroll
      for (int e = 0; e < 4; ++e) {
        const h16 hv = (h16)((xn[k][e] * rstd * gg[e]) * (1.0f + sc[e]) + sh[e]);
        if (k < 2) h0[4 * k + e] = hv; else h1[4 * (k - 2) + e] = hv;
      }
    }
    h16* ho = p.act + token * 1024 + lane * 16;
    *(half8*)ho = h0; *(half8*)(ho + 8) = h1;
  } else {
    f32x4 fga[4];
#pragma unroll
    for (int k = 0; k < 4; ++k) fga[k] = *(const f32x4*)(p.fng + lane * 16 + 4 * k);
#pragma unroll
    for (int k = 0; k < 4; ++k) {
      const f32x4 gg = fga[k];
      f32x4 y;
#pragma unroll
      for (int e = 0; e < 4; ++e) y[e] = xn[k][e] * rstd * gg[e];
      *(f32x4*)(xo + 4 * k) = y;
    }
  }
}

__device__ void blk_attn(int type, int idx, const P& p, int l) {
  h16* Ks = (h16*)g_smem;
  h16* Vt = Ks + 64 * 72;
  float* Bt = (float*)(Vt + 64 * 72);
  const int tid = otid(), lane = tid & 63, wv = tid >> 6, ql = lane & 31, hh = lane >> 5;
  int b, hk, tb; long qtok; int qcol_off, kcol_off, vcol_off, outcol; float qscale; int ntl, ntc; long kbase_tok;
  const float *ck = nullptr, *cv = nullptr;
  int grow = 0, r0w = 0, krmin = 0;
  if (type == 0) {
    tb = idx & 3; hk = (idx >> 2) & 1; b = idx >> 3;
    const int head = hk * 2 + (wv & 1);
    kbase_tok = (long)b * CFG_SEQ; qtok = kbase_tok + tb * 64 + (wv >> 1) * 32 + ql;
    qcol_off = head * 64; kcol_off = 256 + hk * 64; vcol_off = 384 + hk * 64; outcol = head * 64; qscale = 1.0f; ntl = CFG_SEQ / 64; ntc = 0;
  } else if (type == 1) {
    tb = idx & 63; hk = (idx >> 6) & 1; b = idx >> 7;
    const int head = hk * 2 + (wv & 1);
    kbase_tok = (long)NTC + (long)b * CFG_DS; qtok = kbase_tok + tb * 64 + (wv >> 1) * 32 + ql;
    qcol_off = head * 64; kcol_off = 256 + hk * 64; vcol_off = 384 + hk * 64; outcol = head * 64; qscale = 1.0f; ntl = CFG_DS / 64; ntc = CFG_PAST / 64;
    ck = p.cgk + (((long)b * 2 + l) * 2 + hk) * CFG_PAST * 64; cv = p.cgv + (((long)b * 2 + l) * 2 + hk) * CFG_PAST * 64;
  } else if (type == 2) {
    tb = idx & 1; hk = (idx >> 1) & 3; b = idx >> 3;
    kbase_tok = (long)b * CFG_SEQ; qtok = kbase_tok + tb * 128 + wv * 32 + ql;
    qcol_off = NA_OFF + hk * 64; kcol_off = NA_OFF + 256 + hk * 64; vcol_off = NA_OFF + 512 + hk * 64; outcol = 512 + hk * 64; qscale = 0.125f; ntl = CFG_SEQ / 64; ntc = 0;
  } else {
    tb = idx & 31; hk = (idx >> 5) & 3; b = idx >> 7;
    kbase_tok = (long)NTC + (long)b * CFG_DS;
    grow = tb * 2 + (wv >> 1);
    qtok = kbase_tok + grow * 64 + (wv & 1) * 32 + ql;
    qcol_off = NA_OFF + hk * 64; kcol_off = NA_OFF + 256 + hk * 64; vcol_off = NA_OFF + 512 + hk * 64; outcol = 512 + hk * 64; qscale = 0.125f;
    r0w = grow - WR / 2; r0w = r0w < 0 ? 0 : (r0w > GROWS - WR ? GROWS - WR : r0w);
    int ra = tb * 2 - WR / 2; ra = ra < 0 ? 0 : (ra > GROWS - WR ? GROWS - WR : ra);
    int rb = tb * 2 + 1 - WR / 2; rb = rb < 0 ? 0 : (rb > GROWS - WR ? GROWS - WR : rb);
    krmin = ra; ntl = rb + WR - ra; ntc = CFG_PAST / 64;
    ck = p.cnk + (((long)b * 2 + l) * 4 + hk) * CFG_PAST * 64; cv = p.cnv + (((long)b * 2 + l) * 4 + hk) * CFG_PAST * 64;
  }
  const int nt = ntl + ntc;
  __syncthreads();
  if (type == 3) { for (int e = tid; e < 465; e += 256) Bt[e] = p.nabias[((long)l * 4 + hk) * 465 + e]; }
  half8 qf[4];
  {
    const h16* qp = p.proj + qtok * INC + qcol_off + hh * 8;
#pragma unroll
    for (int ds = 0; ds < 4; ++ds) qf[ds] = *(const half8*)(qp + ds * 16);
  }
  const int qc = (int)((qtok - kbase_tok) & 63);
  int cst = qc - 8; cst = cst < 0 ? 0 : (cst > 48 ? 48 : cst);
  f32x16 o0 = {0.f, 0.f, 0.f, 0.f, 0.f, 0.f, 0.f, 0.f, 0.f, 0.f, 0.f, 0.f, 0.f, 0.f, 0.f, 0.f};
  f32x16 o1 = o0;
  float m = -1.0e30f, lsum = 0.f;
  half8 kx0, kx1, vx0, vx1;
  const int skey0 = tid >> 3, sdc = tid & 7;
#define ATT_LOAD(TI)                                                                                       \
  {                                                                                                        \
    const int ti_ = (TI);                                                                                  \
    if (ti_ < ntc) {                                                                                       \
      const float* kk_ = ck + ((long)ti_ * 64 + skey0) * 64 + sdc * 8;                                     \
      const float* vv_ = cv + ((long)ti_ * 64 + skey0) * 64 + sdc * 8;                                     \
      f32x4 a_ = *(const f32x4*)kk_, b_ = *(const f32x4*)(kk_ + 4), c_ = *(const f32x4*)(kk_ + 2048), d_ = *(const f32x4*)(kk_ + 2052); \
      _Pragma("unroll") for (int e = 0; e < 4; ++e) { kx0[e] = (h16)a_[e]; kx0[4 + e] = (h16)b_[e]; kx1[e] = (h16)c_[e]; kx1[4 + e] = (h16)d_[e]; } \
      a_ = *(const f32x4*)vv_; b_ = *(const f32x4*)(vv_ + 4); c_ = *(const f32x4*)(vv_ + 2048); d_ = *(const f32x4*)(vv_ + 2052); \
      _Pragma("unroll") for (int e = 0; e < 4; ++e) { vx0[e] = (h16)a_[e]; vx0[4 + e] = (h16)b_[e]; vx1[e] = (h16)c_[e]; vx1[4 + e] = (h16)d_[e]; } \
    } else {                                                                                               \
      const long t0_ = kbase_tok + (long)((type == 3 ? krmin : 0) + (ti_ - ntc)) * 64;                     \
      const h16* r_ = p.proj + (t0_ + skey0) * INC + sdc * 8;                                              \
      kx0 = *(const half8*)(r_ + kcol_off); kx1 = *(const half8*)(r_ + 32 * INC + kcol_off);              \
      vx0 = *(const half8*)(r_ + vcol_off); vx1 = *(const half8*)(r_ + 32 * INC + vcol_off);              \
    }                                                                                                      \
  }
  ATT_LOAD(0)
  for (int ti = 0; ti < nt; ++ti) {
    __syncthreads();
    *(half8*)(Ks + skey0 * 72 + sdc * 8) = kx0; *(half8*)(Ks + (skey0 + 32) * 72 + sdc * 8) = kx1;
    *(half8*)(Vt + skey0 * 72 + sdc * 8) = vx0; *(half8*)(Vt + (skey0 + 32) * 72 + sdc * 8) = vx1;
    __syncthreads();
    if (ti + 1 < nt) ATT_LOAD(ti + 1)
    __builtin_amdgcn_sched_barrier(0);
    const bool local = type == 3 && ti >= ntc;
    const int kr = krmin + (ti - ntc);
    if (local && (kr < r0w || kr >= r0w + WR)) continue;
    f32x16 s0 = {0.f, 0.f, 0.f, 0.f, 0.f, 0.f, 0.f, 0.f, 0.f, 0.f, 0.f, 0.f, 0.f, 0.f, 0.f, 0.f};
    f32x16 s1 = s0;
#pragma unroll
    for (int ds = 0; ds < 4; ++ds) {
      const half8 a0 = *(const half8*)(Ks + ql * 72 + ds * 16 + hh * 8);
      const half8 a1 = *(const half8*)(Ks + (32 + ql) * 72 + ds * 16 + hh * 8);
      s0 = __builtin_amdgcn_mfma_f32_32x32x16_f16(a0, qf[ds], s0, 0, 0, 0);
      s1 = __builtin_amdgcn_mfma_f32_32x32x16_f16(a1, qf[ds], s1, 0, 0, 0);
    }
    float mx = -1.0e30f;
    if (local) {
      const float* brow = Bt + (kr - grow + 7) * 31 + 15 - qc;
#pragma unroll
      for (int i = 0; i < 16; ++i) {
        const int kc0 = (i & 3) + 8 * (i >> 2) + 4 * hh, kc1 = kc0 + 32;
        s0[i] = (kc0 >= cst && kc0 < cst + 16) ? s0[i] * 0.125f + brow[kc0] : -1.0e30f;
        s1[i] = (kc1 >= cst && kc1 < cst + 16) ? s1[i] * 0.125f + brow[kc1] : -1.0e30f;
      }
    } else if (qscale != 1.0f) {
#pragma unroll
      for (int i = 0; i < 16; ++i) { s0[i] *= qscale; s1[i] *= qscale; }
    }
#pragma unroll
    for (int i = 0; i < 16; ++i) mx = fmaxf(mx, fmaxf(s0[i], s1[i]));
    mx = fmaxf(mx, __shfl_xor(mx, 32));
    const float mn = fmaxf(m, mx);
    const float alpha = __expf(m - mn);
    m = mn; lsum *= alpha;
#pragma unroll
    for (int i = 0; i < 16; ++i) { o0[i] *= alpha; o1[i] *= alpha; }
    float ps = 0.f;
#pragma unroll
    for (int i = 0; i < 16; ++i) { s0[i] = __expf(s0[i] - mn); s1[i] = __expf(s1[i] - mn); ps += s0[i] + s1[i]; }
    lsum += ps;
    half8 pf0, pf1, pf2, pf3;
#pragma unroll
    for (int j = 0; j < 8; ++j) { pf0[j] = (h16)s0[j]; pf1[j] = (h16)s0[8 + j]; pf2[j] = (h16)s1[j]; pf3[j] = (h16)s1[8 + j]; }
#define TRD(ptr) __builtin_bit_cast(half4, __builtin_amdgcn_ds_read_tr16_b64_v4i16((__attribute__((address_space(3))) s16x4v*)(ptr)))
#define ATT_PV(KS, PF)                                                                              \
    {                                                                                               \
        \
      const h16* v0_ = Vt + (16 * (KS) + 4 * hh + ((lane & 15) >> 2)) * 72 + 16 * ((lane >> 4) & 1) + 4 * (lane & 3); \
      const half4 lo0 = TRD(v0_), hi0 = TRD(v0_ + 8 * 72);                                          \
      const half4 lo1 = TRD(v0_ + 32), hi1 = TRD(v0_ + 8 * 72 + 32);                                \
      const half8 a0_ = __builtin_shufflevector(lo0, hi0, 0, 1, 2, 3, 4, 5, 6, 7);                  \
      const half8 a1_ = __builtin_shufflevector(lo1, hi1, 0, 1, 2, 3, 4, 5, 6, 7);                  \
      o0 = __builtin_amdgcn_mfma_f32_32x32x16_f16(a0_, PF, o0, 0, 0, 0);                            \
      o1 = __builtin_amdgcn_mfma_f32_32x32x16_f16(a1_, PF, o1, 0, 0, 0);                            \
    }
    ATT_PV(0, pf0) ATT_PV(1, pf1) ATT_PV(2, pf2) ATT_PV(3, pf3)
#undef ATT_PV
#undef TRD
  }
#undef ATT_LOAD
  lsum += __shfl_xor(lsum, 32);
  const float inv = 1.0f / lsum;
  h16* op = p.act + qtok * 1024 + outcol;
#pragma unroll
  for (int g = 0; g < 4; ++g) {
    half4 a, c;
#pragma unroll
    for (int e = 0; e < 4; ++e) { a[e] = (h16)(o0[4 * g + e] * inv); c[e] = (h16)(o1[4 * g + e] * inv); }
    *(half4*)(op + 8 * g + 4 * hh) = a;
    *(half4*)(op + 32 + 8 * g + 4 * hh) = c;
  }
}
#define N_SCAN_LAT (2 * 2 * CFG_DB * 4 * 2)
#define N_SCAN_CTX (2 * 2 * CFG_BATCH * 4 * 2)
#define N_ATT1 (CFG_DB * 2 * (CFG_DS / 64))
#define N_ATT3 (CFG_DB * 4 * (CFG_DS / 128))
#define N_ATT0 (CFG_BATCH * 2 * (CFG_SEQ / 64))
#define N_ATT2 (CFG_BATCH * 4 * (CFG_SEQ / 128))
__device__ __forceinline__ void run_scan_item(int r, bool latent, const P& p, int l) {
  const int rq = r & 1; r >>= 1; const int kind = r & 1; r >>= 1; const int d = r & 1; r >>= 1; const int h = r & 3; r >>= 2;
  if (latent) __builtin_amdgcn_s_setprio(3);
  blk_scan2(kind, latent ? CFG_BATCH + r : r, h, d, rq, p, l);
  if (latent) __builtin_amdgcn_s_setprio(0);
}
__device__ void mixer_phase(const P& p, int lc, int mode = 0) {
  const int l = lc & 1;
  __shared__ long s_item;
  __shared__ unsigned s_slot;
  const long total = N_SCAN_CTX + N_ATT1 + N_ATT3 + N_ATT0 + N_ATT2;
  unsigned* lat_cnt = p.counters + 8 + lc;
  if (mode == 0) {
    __syncthreads();
    if (threadIdx.x == 0) {
      const unsigned hw = __builtin_amdgcn_s_getreg((31 << 11) | 4);
      const unsigned xcc = __builtin_amdgcn_s_getreg((3 << 11) | 20) & 0xFu;
      const unsigned key = (xcc << 8) | ((hw >> 8) & 0xFFu);
      const unsigned slot = atomicAdd(p.cucnt + lc * 4096 + key, 1u);
      s_slot = slot;
      s_item = slot == 0 ? (long)atomicAdd(lat_cnt, 1u) : (long)N_SCAN_LAT;
    }
    __syncthreads();
    const long w = s_item;
    if (w < N_SCAN_LAT) run_scan_item((int)w, true, p, l);
  }
  for (;;) {
    __syncthreads();
    if (threadIdx.x == 0) s_item = (long)atomicAdd(p.counters + lc, 1u);
    __syncthreads();
    long w = s_item;
    if (mode == 2) w += N_SCAN_CTX;
    if (w >= (mode == 1 ? (long)N_SCAN_CTX : total)) break;
    if (w < N_SCAN_CTX) {
      run_scan_item((int)w, false, p, l);
    } else {
      int a = (int)(w - N_SCAN_CTX);
      int ty;
      if (a < N_ATT1) ty = 1;
      else if ((a -= N_ATT1) < N_ATT3) ty = 3;
      else if ((a -= N_ATT3) < N_ATT0) ty = 0;
      else { a -= N_ATT0; ty = 2; }
      blk_attn(ty, a, p, l);
    }
  }
  if (mode != 2) {
    for (;;) {
      __syncthreads();
      if (threadIdx.x == 0) s_item = (long)atomicAdd(lat_cnt, 1u);
      __syncthreads();
      const long w = s_item;
      if (w >= N_SCAN_LAT) break;
      run_scan_item((int)w, true, p, l);
    }
  }
}


#define XB_TMO      128
#define XB_XCNT(j)  (256  + 64 * (j))
#define XB_XSUB(j)  (1280 + 64 * (j))
#define XB_XGEN(j)  (2304 + 64 * (j))
#define XB_TOP      3328
#define XB_TOPGEN   3392
#define XCD_BAR_WORDS 3456
#define XB_SPIN_CAP (1u << 22)
#define LAS __attribute__((address_space(3)))
__device__ __forceinline__ unsigned xb_ld(unsigned* p)              { return __hip_atomic_load(p, __ATOMIC_RELAXED, __HIP_MEMORY_SCOPE_AGENT); }
__device__ __forceinline__ unsigned xb_add(unsigned* p, unsigned v) { return __hip_atomic_fetch_add(p, v, __ATOMIC_RELAXED, __HIP_MEMORY_SCOPE_AGENT); }
__device__ __forceinline__ unsigned xb_xcc_id() { return (unsigned)__builtin_amdgcn_s_getreg((3 << 11) | 20) & 0xFu; }
#define XB_SPIN(cond, bar) do { unsigned _sp = 0; while (cond) { __builtin_amdgcn_s_sleep(1); \
    if ((++_sp & 255u) == 0u) { if (xb_ld(&(bar)[XB_TMO])) break; if (_sp > XB_SPIN_CAP) { atomicAdd(&(bar)[XB_TMO], 1u); break; } } } } while (0)
struct XcdBarrier { unsigned* bar; unsigned x; volatile LAS unsigned* st; };
__device__ __forceinline__ XcdBarrier xcd_barrier_post(unsigned* bar, volatile LAS unsigned* st) {
  XcdBarrier b; b.bar = bar; b.x = xb_xcc_id(); b.st = st;
  if (threadIdx.x == 0) (void)xb_add(&bar[XB_XCNT(b.x)], 1u);
  return b;
}
__device__ __forceinline__ void xcd_barrier_complete(unsigned* bar, unsigned x, unsigned& nloc, unsigned& nx) {
  const unsigned G = gridDim.x * gridDim.y * gridDim.z;
  unsigned sum, cnt, mine, sp = 0u;
  for (;;) {
    sum = 0u; cnt = 0u; mine = 0u;
#pragma unroll
    for (unsigned j = 0; j < 16; ++j) { const unsigned c = xb_ld(&bar[XB_XCNT(j)]); sum += c; cnt += (c > 0u) ? 1u : 0u; mine = (j == x) ? c : mine; }
    if (sum == G) break;
    __builtin_amdgcn_s_sleep(1);
    if ((++sp & 255u) == 0u) { if (xb_ld(&bar[XB_TMO])) break; if (sp > XB_SPIN_CAP) { atomicAdd(&bar[XB_TMO], 1u); break; } }
  }
  nloc = mine > 0u ? mine : 1u; nx = cnt > 0u ? cnt : 1u;
}
__device__ __forceinline__ void xcd_barrier(const XcdBarrier& b) {
  asm volatile("s_waitcnt vmcnt(0)" ::: "memory");
  __syncthreads();
  if (threadIdx.x == 0) {
    unsigned* bar = b.bar;
    __builtin_amdgcn_s_waitcnt(0);
    unsigned nloc = b.st[0], nx = b.st[1];
    if (nloc == 0u) { xcd_barrier_complete(bar, b.x, nloc, nx); b.st[0] = nloc; b.st[1] = nx; }
    const unsigned old = xb_add(&bar[XB_XSUB(b.x)], 1u);
    const unsigned gen = old / nloc;
    if (old + 1u == (gen + 1u) * nloc) {
      __builtin_amdgcn_fence(__ATOMIC_RELEASE, "agent");
      asm volatile("s_waitcnt vmcnt(0)" ::: "memory");
      const unsigned og = xb_add(&bar[XB_TOP], 1u);
      const unsigned tg = og / nx;
      if (og + 1u == (tg + 1u) * nx) xb_add(&bar[XB_TOPGEN], 1u);
      else XB_SPIN(xb_ld(&bar[XB_TOPGEN]) == tg, bar);
      __builtin_amdgcn_fence(__ATOMIC_ACQUIRE, "agent");
      xb_add(&bar[XB_XGEN(b.x)], 1u);
      asm volatile("s_waitcnt vmcnt(0)" ::: "memory");
    } else {
      XB_SPIN(xb_ld(&bar[XB_XGEN(b.x)]) == gen, bar);
      __builtin_amdgcn_fence(__ATOMIC_ACQUIRE, "agent");
      asm volatile("s_waitcnt vmcnt(0)" ::: "memory");
    }
  }
  __syncthreads();
}

#define STAGE(fn, n) for (long i_ = (long)blockIdx.x * 256 + otid(); i_ < (long)(n); i_ += (long)gridDim.x * 256) fn(i_, p, l);
#define BSTAGE(fn, n) for (long w_ = blockIdx.x; w_ < (long)(n); w_ += gridDim.x) fn(w_, p, l);
#define SYNC { XcdBarrier xb_; xb_.bar = p.xbar; xb_.x = xb_xcc_id(); xb_.st = (volatile LAS unsigned*)&xb_words; xcd_barrier(xb_); }
__global__ void __launch_bounds__(256, 2) mega(P p) {
  cg::grid_group grid = cg::this_grid();
  __shared__ uint4 xb_words;
  if (threadIdx.x == 0) xb_words = make_uint4(0u, 0u, 0u, 0u);
  __syncthreads();
  (void)xcd_barrier_post(p.xbar, (volatile LAS unsigned*)&xb_words);
#define gtid ((long)blockIdx.x * 256 + otid())
#define gstride ((long)gridDim.x * 256)
  { int l = 0;
    if (gtid < 16) p.counters[gtid] = 0u;
    for (long i_ = gtid; i_ < 4 * 4096; i_ += gstride) p.cucnt[i_] = 0u;
    for (int rep_ = 0; rep_ < REP_S0; ++rep_) {
    for (long w_ = blockIdx.x; w_ < 3200; w_ += gridDim.x) blk_convert(w_, p);
    for (long w_ = blockIdx.x; w_ < 2L * NCOND * 24; w_ += gridDim.x) blk_mod(w_, p);
    for (long i_ = gtid; i_ < 2L * 16 * CFG_NKEYS * 128 / 8; i_ += gstride) cvt8(p.pkeys, p.keys16, i_);
    }
  }
  grid.sync();
#pragma unroll 1
  for (int ph = 0; ph < 18; ++ph) {
    const int l = ph >= 9 ? 1 : 0; const int k = ph - 9 * l;
    if (k == 0 && l == 1) continue;
    switch (k) {
      case 0: { BSTAGE(blk_norm<0>, NT / 4) } break;
      case 1: gemm_phase<0>(p, l); break;
      case 2: {
        STAGE(b_prep_gqa, (long)NT * 6)
        STAGE(b_prep_cache, (long)NTC * 640)
        half8 bf0 = {0, 0, 0, 0, 0, 0, 0, 0}, bf1 = bf0; int bkey = -1;
        for (long w_ = blockIdx.x; w_ < (long)N_PREP_RW + N_PREP_DN; w_ += gridDim.x) blk_scanprep(w_, p, l, bf0, bf1, bkey);
      } break;
      case 3:
#ifdef PROBE_MIXER2
        mixer_phase(p, l + 2); SYNC
#endif
        mixer_phase(p, l); break;
      case 4: fin_phase(p, l); break;
      case 5: {
        gemm_phase<1>(p, l);
        for (long i_ = gtid; i_ < (long)NEXP * 1024 / 16; i_ += gstride) {
          cvt16_fp4(p.pu + (long)l * NEXP * 1024, (unsigned char*)p.u16, i_, PEER_USCALE);
          cvt16_fp4(p.pv + (long)l * NEXP * 1024, (unsigned char*)p.v16, i_, PEER_VSCALE);
        }
      } break;
      case 6: { BSTAGE(blk_norm<1>, NT / 4) } break;
      case 7: gemm_phase<2>(p, l); break;
      default: { BSTAGE(blk_peer<false>, NT / 4) } break;
    }
    if (ph != 17) SYNC
  }
}
#else
#define STAGE(fn, n) { _Pragma("omp parallel for schedule(dynamic, 64)") for (long i_ = 0; i_ < (long)(n); ++i_) fn(i_, p, l); }
#define SYNC
void mega(P p) {
  { int l = 0;
    STAGE(b_init, (long)NT * 1024)
    STAGE(b_mod, 2L * NCOND * 6144)
  }
  for (int l = 0; l < 2; ++l) {
    STAGE(b_norm<0>, NT)
    STAGE(b_inproj, (long)NT * INC)
    STAGE(b_prep_gqa, (long)NT * 6)
    STAGE(b_prep_cache, (long)NTC * 640)
    STAGE(b_rwaux, (long)NT * 512)
    STAGE(b_dnconv, (long)NT * 768)
    STAGE(b_dnnorm, (long)NT * 8)
    STAGE(b_rwscan, NSCAN)
    STAGE(b_dnscan, NSCAN)
    STAGE(b_attn_gqa, (long)NT * 4)
    STAGE(b_attn_na, (long)NT * 4)
    STAGE(b_rwfin, (long)NT * 4)
    STAGE(b_dnfin, (long)NT * 4)
    STAGE(b_outproj, (long)NT * 1024)
    STAGE(b_norm<1>, NT)
    STAGE(b_peerq, (long)NT * 2048)
    STAGE(b_topk1, (long)NT * 16)
    STAGE(b_topk2, (long)NT * 8)
    STAGE(b_peer_act, (long)NT * 128)
    STAGE(b_peer_out, (long)NT * 1024)
  }
  { int l = 0; STAGE(b_final, NT) }
}
#endif

static void fill_params(P& p, void* const* d_in, void* d_out, void* d_ws) {
  const float** f = (const float**)&p;
  for (int i = 0; i < 39; ++i) f[i] = (const float*)d_in[i];
  float* o = (float*)d_out;
  p.X = o; o += (long)NT * 1024;
  p.ogk = o; o += (long)CFG_BATCH * 2 * 2 * CFG_SEQ * 64;
  p.ogv = o; o += (long)CFG_BATCH * 2 * 2 * CFG_SEQ * 64;
  p.onk = o; o += (long)CFG_BATCH * 2 * 4 * CFG_SEQ * 64;
  p.onv = o; o += (long)CFG_BATCH * 2 * 4 * CFG_SEQ * 64;
  p.orw = o; o += (long)CFG_BATCH * 2 * 2 * 4 * 4096;
  p.odn = o;
  char* w = (char*)d_ws;
  auto take = [&](size_t bytes) { char* r = w; w += (bytes + 255) & ~(size_t)255; return r; };
  p.xbar = (unsigned*)take(16384);
  p.counters = (unsigned*)take(256);
  p.cucnt = (unsigned*)take(4 * 4096 * 4);
  p.mod = (float*)take(2L * NCOND * 6144 * 4);
  p.act = (h16*)take((size_t)NT * 1024 * sizeof(h16));
  p.rwaux = (h16*)take((size_t)NT * 1024 * sizeof(h16));
  p.dnp = (h16*)take((size_t)NT * 768 * sizeof(h16));
  p.proj = (h16*)take((size_t)NT * INC * sizeof(h16));
  p.wtin = (h16*)take((size_t)2 * NPAD_IN * 1024 * sizeof(h16));
  p.wtout = (h16*)take((size_t)2 * 1024 * 1024 * sizeof(h16));
  p.wtq = (h16*)take((size_t)2 * 2048 * 1024 * sizeof(h16));
  p.rwsc = (float*)take((size_t)NT * 16 * 4);
  p.dnsc = (float*)take((size_t)NT * 16 * 4);
  p.keys16 = (h16*)take((size_t)2 * 16 * CFG_NKEYS * 128 * sizeof(h16));
  char* a = (char*)p.proj;
#ifdef HOST_EMU
  p.pq = (h16*)a; a += (size_t)NT * 2048 * sizeof(h16);
#endif
  p.tks = (float*)a; a += (size_t)NT * 256 * 4;
  p.tki = (int*)a; a += (size_t)NT * 256 * 4;
  p.u16 = (h16*)a; a += (size_t)NEXP * 1024 * sizeof(h16);
  p.v16 = (h16*)a; a += (size_t)NEXP * 1024 * sizeof(h16);
  p.pidx = (int*)p.rwaux;
  p.pact = (float*)((char*)p.rwaux + (size_t)NT * 128 * 4);
}

#ifndef HOST_EMU
extern "C" void kernel_launch(void* const* d_in, const int* in_sizes, int n_in, void* d_out, int out_size, void* d_ws,
                              size_t ws_size, hipStream_t stream) {
  static int grid_blocks = 0;
  if (!grid_blocks) {
    int dev = 0, cus = 0, per_cu = 0;
    (void)hipGetDevice(&dev);
    (void)hipDeviceGetAttribute(&cus, hipDeviceAttributeMultiprocessorCount, dev);
    (void)hipOccupancyMaxActiveBlocksPerMultiprocessor(&per_cu, mega, 256, 0);
    grid_blocks = cus * per_cu;
  }
  P p;
  memset(&p, 0, sizeof(p));
  fill_params(p, d_in, d_out, d_ws);
  (void)hipMemsetAsync(p.xbar, 0, 16384, stream);
  void* args[] = {&p};
  hipError_t e = hipLaunchCooperativeKernel((void*)mega, dim3(grid_blocks), dim3(256), args, 0, stream);
  if (e != hipSuccess) fprintf(stderr, "cooperative launch failed: %s (grid %d)\n", hipGetErrorString(e), grid_blocks);
}
#endif
```

```cpp
#ifndef HOST_EMU
#include <hip/hip_runtime.h>
#include <hip/hip_cooperative_groups.h>
namespace cg = cooperative_groups;
#define HD __device__ __forceinline__
#define HDN __device__ __noinline__
typedef _Float16 h16;
#define CBAR asm volatile("" ::: "memory")
#define SMEM_BYTES 73728
__shared__ __attribute__((aligned(16))) char g_smem[SMEM_BYTES];
__device__ __forceinline__ int otid() { int t = threadIdx.x; asm volatile("" : "+v"(t)); return t; }
#define FSIN(x) __sinf(x)
#define FCOS(x) __cosf(x)
#else
#include <cmath>
#include <cstring>
#define HD static inline
#define HDN static
typedef float h16;
#define CBAR
#define FSIN(x) sinf(x)
#define FCOS(x) cosf(x)
#endif
#include <cstdio>
#include <cstring>

#ifndef CFG_BATCH
#define CFG_BATCH 32
#define CFG_SEQ 256
#define CFG_DB 8
#define CFG_DS 4096
#define CFG_PAST 512
#define CFG_NKEYS 128
#endif

#define NTC (CFG_BATCH * CFG_SEQ)
#define NTL (CFG_DB * CFG_DS)
#define NT (NTC + NTL)
#define NCOND (1 + CFG_DB)
#define GROWS (CFG_DS / 64)
#define WR (GROWS < 8 ? GROWS : 8)
#define NEXP (CFG_NKEYS * CFG_NKEYS)
#define INC 3280
#define RW_OFF 512
#define NA_OFF 1472
#define DN_OFF 2240

struct P {
  const float *xp, *xs, *c, *cgk, *cgv, *cnk, *cnv, *srw, *sdn, *cctx, *n1g, *n2g, *wmod, *bmod, *win, *wout,
      *gqn, *gkn, *rwmu, *rww0, *rww2, *rwa0, *rwa2, *rwg2, *rwkk, *rwka, *rwrk, *rwlng, *rwlnb, *nabias,
      *dnconv, *dnalog, *dndt, *dnng, *pwq, *pkeys, *pu, *pv, *fng;
  float *X, *ogk, *ogv, *onk, *onv, *orw, *odn;
  float* mod;
  h16* act;
  h16* proj;
  h16* rwaux;
  h16* dnp;
  h16* pq;
  float* tks;
  int* tki;
  int* pidx;
  float* pact;
  unsigned* counters;
  unsigned* xbar;
  unsigned* cucnt;
  h16 *keys16, *u16, *v16;
  float *rwsc, *dnsc;
  h16 *wtin, *wtout, *wtq;
};

HD float sigmoidf_(float x) { return 1.0f / (1.0f + expf(-x)); }
HD float siluf_(float x) { return x * sigmoidf_(x); }
HD float softplusf_(float x) { return fmaxf(x, 0.0f) + log1pf(expf(-fabsf(x))); }
HD int condrow(long token) { return token < NTC ? 0 : 1 + (int)((token - NTC) / CFG_DS); }
HD void seqinfo(long token, int& t, int& T, long& base) {
  if (token < NTC) { T = CFG_SEQ; t = (int)(token % CFG_SEQ); base = token - t; }
  else { long u = token - NTC; T = CFG_DS; t = (int)(u % CFG_DS); base = token - t; }
}

HD void b_init(long i, const P& p, int l) {
  p.X[i] = (i < (long)NTC * 1024) ? p.xp[i] : p.xs[i - (long)NTC * 1024];
}
HD void b_mod(long i, const P& p, int) {
  int col = (int)(i % 6144); int r = (int)((i / 6144) % NCOND); int l = (int)(i / (6144L * NCOND));
  const float* cond = r == 0 ? p.cctx : p.c + (long)(r - 1) * 1024;
  float acc = p.bmod[l * 6144 + col];
  for (int k = 0; k < 1024; ++k) acc += siluf_(cond[k]) * p.wmod[((long)l * 1024 + k) * 6144 + col];
  p.mod[i] = acc;
}
template <int WHICH>
HD void b_norm(long i, const P& p, int l) {
  const float* x = p.X + i * 1024;
  float ss = 0.f;
  for (int k = 0; k < 1024; ++k) ss += x[k] * x[k];
  float rstd = 1.0f / sqrtf(ss * (1.0f / 1024) + 1e-6f);
  const float* m = p.mod + ((long)l * NCOND + condrow(i)) * 6144 + (WHICH ? 3072 : 0);
  const float* g = (WHICH ? p.n2g : p.n1g) + l * 1024;
  for (int k = 0; k < 1024; ++k) p.act[i * 1024 + k] = (h16)((x[k] * rstd * g[k]) * (1.0f + m[1024 + k]) + m[k]);
}
HD void b_prep_gqa(long i, const P& p, int l) {
  long token = i / 6; int slot = (int)(i % 6);
  h16* x = p.proj + token * INC + slot * 64;
  float y[64]; float ss = 0.f;
#pragma unroll
  for (int d = 0; d < 64; ++d) { y[d] = (float)x[d]; ss += y[d] * y[d]; }
  float rstd = 1.0f / sqrtf(ss * (1.0f / 64) + 1e-6f);
  const float* g = (slot < 4 ? p.gqn : p.gkn) + l * 64;
#pragma unroll
  for (int d = 0; d < 64; ++d) y[d] = y[d] * rstd * g[d];
  if (token >= NTC) {
    int t = (int)((token - NTC) % CFG_DS); int row = t / 64, colp = t % 64;
#pragma unroll
    for (int j = 0; j < 32; ++j) {
      float inv = exp2f(-(float)(j % 16) * 0.83048202372184059f);
      float ang = (float)(j < 16 ? row : colp) * inv;
      float cs = FCOS(ang), sn = FSIN(ang);
      float a = y[j], b = y[j + 32];
      y[j] = a * cs - b * sn; y[j + 32] = b * cs + a * sn;
    }
  } else if (slot >= 4) {
    int b = (int)(token / CFG_SEQ), t = (int)(token % CFG_SEQ);
    float* o = p.ogk + ((((long)b * 2 + l) * 2 + (slot - 4)) * CFG_SEQ + t) * 64;
#pragma unroll
    for (int d = 0; d < 64; ++d) o[d] = y[d];
  }
  float sc = slot < 4 ? 0.125f : 1.0f;
#pragma unroll
  for (int d = 0; d < 64; ++d) x[d] = (h16)(y[d] * sc);
}
HD void b_prep_cache(long i, const P& p, int l) {
  long token = i / 640; int e = (int)(i % 640);
  int b = (int)(token / CFG_SEQ), t = (int)(token % CFG_SEQ);
  const h16* pr = p.proj + token * INC;
  if (e < 128) { int kvh = e / 64, d = e % 64; p.ogv[((((long)b * 2 + l) * 2 + kvh) * CFG_SEQ + t) * 64 + d] = (float)pr[384 + e]; }
  else if (e < 384) { int c = e - 128; int h = c / 64, d = c % 64; p.onk[((((long)b * 2 + l) * 4 + h) * CFG_SEQ + t) * 64 + d] = (float)pr[NA_OFF + 256 + c]; }
  else { int c = e - 384; int h = c / 64, d = c % 64; p.onv[((((long)b * 2 + l) * 4 + h) * CFG_SEQ + t) * 64 + d] = (float)pr[NA_OFF + 512 + c]; }
}
HD void b_rwaux(long i, const P& p, int l) {
  int col = (int)(i % 256); int d = (int)((i / 256) % 2); long token = i / 512;
  int t, T; long base; seqinfo(token, t, T, base);
  bool sv = d == 0 ? (t > 0) : (t < T - 1);
  const h16* pb = p.proj + token * INC + RW_OFF;
  const h16* ps = p.proj + (token + (d == 0 ? -1 : 1)) * INC + RW_OFF;
  const float* mu = p.rwmu + ((long)l * 2 + d) * 832;
  float accw = p.rww0[(l * 2 + d) * 256 + col], acca = p.rwa0[(l * 2 + d) * 256 + col];
  for (int j = 0; j < 32; ++j) {
    float bw = (float)pb[768 + d * 32 + j], sw = sv ? (float)ps[768 + d * 32 + j] : 0.f;
    float wl = bw + (sw - bw) * mu[768 + j];
    float ba = (float)pb[832 + d * 32 + j], sa = sv ? (float)ps[832 + d * 32 + j] : 0.f;
    float al = ba + (sa - ba) * mu[800 + j];
    accw += tanhf(wl) * p.rww2[(((long)l * 2 + d) * 32 + j) * 256 + col];
    acca += al * p.rwa2[(((long)l * 2 + d) * 32 + j) * 256 + col];
  }
  float w = -softplusf_(-accw) - 0.5f;
  p.rwaux[((token * 2 + d) * 2 + 0) * 256 + col] = (h16)expf(w);
  p.rwaux[((token * 2 + d) * 2 + 1) * 256 + col] = (h16)sigmoidf_(acca);
}
HD void b_dnconv(long i, const P& p, int l) {
  int c = (int)(i % 768); long token = i / 768;
  int t, T; long base; seqinfo(token, t, T, base);
  float acc = 0.f;
#pragma unroll
  for (int j = 0; j < 5; ++j) {
    int tt = t + j - 2;
    if (tt >= 0 && tt < T) acc += (float)p.proj[(base + tt) * INC + DN_OFF + c] * p.dnconv[((long)l * 5 + j) * 768 + c];
  }
  p.dnp[token * 768 + c] = (h16)siluf_(acc);
}
HD void b_dnnorm(long i, const P& p, int) {
  long token = i / 8; int slot = (int)(i % 8);
  h16* x = p.dnp + token * 768 + slot * 64;
  float ss = 0.f;
  for (int d = 0; d < 64; ++d) { float v = (float)x[d]; ss += v * v; }
  float rs = 1.0f / sqrtf(ss + 1e-6f) * (slot < 4 ? 0.125f : 1.0f);
  for (int d = 0; d < 64; ++d) x[d] = (h16)((float)x[d] * rs);
}

struct Softmax64 {
  float m, lsum, acc[64];
};
template <typename TK>
HD void attend_key(Softmax64& st, const float* q, const TK* k, const TK* v, float scale, float bias) {
  float s = 0.f;
#pragma unroll
  for (int d = 0; d < 64; ++d) s += q[d] * (float)k[d];
  s = s * scale + bias;
  if (s > st.m) {
    float f = expf(st.m - s);
    st.lsum *= f;
#pragma unroll
    for (int d = 0; d < 64; ++d) st.acc[d] *= f;
    st.m = s;
  }
  float pw = expf(s - st.m);
  st.lsum += pw;
#pragma unroll
  for (int d = 0; d < 64; ++d) st.acc[d] += pw * (float)v[d];
}
HD void b_attn_gqa(long i, const P& p, int l) {
  int h = (int)(i / NT); long token = i % NT; int kvh = h / 2;
  float q[64];
  const h16* qp = p.proj + token * INC + h * 64;
#pragma unroll
  for (int d = 0; d < 64; ++d) q[d] = (float)qp[d];
  Softmax64 st; st.m = -1e30f; st.lsum = 0.f;
#pragma unroll
  for (int d = 0; d < 64; ++d) st.acc[d] = 0.f;
  int t, T; long base; seqinfo(token, t, T, base);
  for (int tk = 0; tk < T; ++tk) {
    const h16* kp = p.proj + (base + tk) * INC + 256 + kvh * 64;
    attend_key<h16>(st, q, kp, kp + 128, 1.0f, 0.f);
  }
  if (token >= NTC) {
    int b = (int)((token - NTC) / CFG_DS);
    const float* ck = p.cgk + (((long)b * 2 + l) * 2 + kvh) * CFG_PAST * 64;
    const float* cv = p.cgv + (((long)b * 2 + l) * 2 + kvh) * CFG_PAST * 64;
    for (int pp = 0; pp < CFG_PAST; ++pp) attend_key<float>(st, q, ck + pp * 64, cv + pp * 64, 1.0f, 0.f);
  }
  float inv = 1.0f / st.lsum;
  h16* o = p.act + token * 1024 + h * 64;
#pragma unroll
  for (int d = 0; d < 64; ++d) o[d] = (h16)(st.acc[d] * inv);
}
HD void b_attn_na(long i, const P& p, int l) {
  int h = (int)(i / NT); long token = i % NT;
  float q[64];
  const h16* qp = p.proj + token * INC + NA_OFF + h * 64;
#pragma unroll
  for (int d = 0; d < 64; ++d) q[d] = (float)qp[d];
  Softmax64 st; st.m = -1e30f; st.lsum = 0.f;
#pragma unroll
  for (int d = 0; d < 64; ++d) st.acc[d] = 0.f;
  int t, T; long base; seqinfo(token, t, T, base);
  if (token < NTC) {
    for (int tk = 0; tk < T; ++tk) {
      const h16* kp = p.proj + (base + tk) * INC + NA_OFF + 256 + h * 64;
      attend_key<h16>(st, q, kp, kp + 256, 0.125f, 0.f);
    }
  } else {
    int r = t / 64, cq = t % 64;
    int r0 = r - WR / 2; r0 = r0 < 0 ? 0 : (r0 > GROWS - WR ? GROWS - WR : r0);
    int cs = cq - 8; cs = cs < 0 ? 0 : (cs > 48 ? 48 : cs);
    const float* bias = p.nabias + ((long)l * 4 + h) * 15 * 31;
    for (int w = 0; w < WR; ++w) {
      int kr = r0 + w;
      for (int cc = 0; cc < 16; ++cc) {
        int kc = cs + cc;
        const h16* kp = p.proj + (base + kr * 64 + kc) * INC + NA_OFF + 256 + h * 64;
        attend_key<h16>(st, q, kp, kp + 256, 0.125f, bias[(kr - r + 7) * 31 + (kc - cq + 15)]);
      }
    }
    int b = (int)((token - NTC) / CFG_DS);
    const float* ck = p.cnk + (((long)b * 2 + l) * 4 + h) * CFG_PAST * 64;
    const float* cv = p.cnv + (((long)b * 2 + l) * 4 + h) * CFG_PAST * 64;
    for (int pp = 0; pp < CFG_PAST; ++pp) attend_key<float>(st, q, ck + pp * 64, cv + pp * 64, 0.125f, 0.f);
  }
  float inv = 1.0f / st.lsum;
  h16* o = p.act + token * 1024 + 512 + h * 64;
#pragma unroll
  for (int d = 0; d < 64; ++d) o[d] = (h16)(st.acc[d] * inv);
}

HD float rw_lerp(const P& p, int l, long token, bool sv, int d, int c) {
  float b = (float)p.proj[token * INC + RW_OFF + c];
  float s = sv ? (float)p.proj[(token + (d == 0 ? -1 : 1)) * INC + RW_OFF + c] : 0.f;
  return b + (s - b) * p.rwmu[((long)l * 2 + d) * 832 + c];
}
HD void b_rwscan(long i, const P& p, int l) {
  int v = (int)(i % 64); int sb = (int)(i / 64); int h = sb % 4; int bi = sb / 4;
  bool ctx = bi < CFG_BATCH;
  int T = ctx ? CFG_SEQ : CFG_DS;
  long base = ctx ? (long)bi * CFG_SEQ : (long)NTC + (long)(bi - CFG_BATCH) * CFG_DS;
#ifndef HOST_EMU
  float* S = (float*)g_smem + threadIdx.x * 65;
#else
  float S[64];
#endif
  for (int d = 0; d < 2; ++d) {
    if (ctx) {
      for (int k = 0; k < 64; ++k) S[k] = 0.f;
    } else {
      const float* s0 = p.srw + (((((long)(bi - CFG_BATCH)) * 2 + l) * 2 + d) * 4 + h) * 4096 + v * 64;
      for (int k = 0; k < 64; ++k) S[k] = s0[k];
    }
    for (int step = 0; step < T; ++step) {
      int t = d == 0 ? step : T - 1 - step;
      long token = base + t;
      bool sv = d == 0 ? (t > 0) : (t < T - 1);
      const h16* aux = p.rwaux + (token * 2 + d) * 512;
      float ss = 0.f;
      for (int k = 0; k < 64; ++k) {
        float kv = rw_lerp(p, l, token, sv, d, 256 + h * 64 + k) * p.rwkk[l * 256 + h * 64 + k];
        ss += kv * kv;
      }
      float rs = 1.0f / sqrtf(ss + 1e-6f);
      float sa = 0.f;
      for (int k = 0; k < 64; ++k) {
        float kk = rw_lerp(p, l, token, sv, d, 256 + h * 64 + k) * p.rwkk[l * 256 + h * 64 + k] * rs;
        sa -= S[k] * kk;
      }
      float vv = rw_lerp(p, l, token, sv, d, 512 + h * 64 + v);
      float o = 0.f;
      for (int k = 0; k < 64; ++k) {
        int c = h * 64 + k;
        float kr = rw_lerp(p, l, token, sv, d, 256 + c);
        float kk = kr * p.rwkk[l * 256 + c] * rs;
        float a = (float)aux[256 + c];
        float dec = expf(-(float)aux[c]);
        float keff = kr * (1.0f + (a - 1.0f) * p.rwka[l * 256 + c]);
        float r = rw_lerp(p, l, token, sv, d, c);
        S[k] = S[k] * dec + sa * (kk * a) + vv * keff;
        o += S[k] * r;
      }
      h16* op = p.act + token * 1024 + 256 + h * 64 + v;
      if (d == 0) *op = (h16)o; else *op = (h16)((float)*op + o);
    }
    if (ctx) {
      float* so = p.orw + (((((long)bi) * 2 + l) * 2 + d) * 4 + h) * 4096 + v * 64;
      for (int k = 0; k < 64; ++k) so[k] = S[k];
    }
  }
}
HD void b_rwfin(long i, const P& p, int l) {
  long token = i / 4; int h = (int)(i % 4);
  int t, T; long base; seqinfo(token, t, T, base);
  h16* op = p.act + token * 1024 + 256 + h * 64;
  float mu = 0.f;
  for (int k = 0; k < 64; ++k) mu += (float)op[k];
  mu *= (1.0f / 64);
  float var = 0.f;
  for (int k = 0; k < 64; ++k) { float dlt = (float)op[k] - mu; var += dlt * dlt; }
  var *= (1.0f / 64);
  float rs = 1.0f / sqrtf(var + 64e-5f);
  float bon0 = 0.f, bon1 = 0.f;
  for (int d = 0; d < 2; ++d) {
    bool sv = d == 0 ? (t > 0) : (t < T - 1);
    const h16* aux = p.rwaux + (token * 2 + d) * 512;
    float s = 0.f;
    for (int k = 0; k < 64; ++k) {
      int c = h * 64 + k;
      float kr = rw_lerp(p, l, token, sv, d, 256 + c);
      float a = (float)aux[256 + c];
      float keff = kr * (1.0f + (a - 1.0f) * p.rwka[l * 256 + c]);
      s += rw_lerp(p, l, token, sv, d, c) * keff * p.rwrk[l * 256 + c];
    }
    if (d == 0) bon0 = s; else bon1 = s;
  }
  bool sv0 = t > 0, sv1 = t < T - 1;
  for (int k = 0; k < 64; ++k) {
    int c = h * 64 + k;
    float y = ((float)op[k] - mu) * rs * p.rwlng[l * 256 + c] + p.rwlnb[l * 256 + c];
    y += bon0 * rw_lerp(p, l, token, sv0, 0, 512 + c) + bon1 * rw_lerp(p, l, token, sv1, 1, 512 + c);
    float gate = 0.f;
    for (int j = 0; j < 64; ++j) gate += sigmoidf_((float)p.proj[token * INC + RW_OFF + 896 + j]) * p.rwg2[((long)l * 64 + j) * 256 + c];
    op[k] = (h16)(y * gate);
  }
}
HD void b_dnscan(long i, const P& p, int l) {
  int v = (int)(i % 64); int sb = (int)(i / 64); int h = sb % 4; int bi = sb / 4;
  bool ctx = bi < CFG_BATCH;
  int T = ctx ? CFG_SEQ : CFG_DS;
  long base = ctx ? (long)bi * CFG_SEQ : (long)NTC + (long)(bi - CFG_BATCH) * CFG_DS;
#ifndef HOST_EMU
  float* S = (float*)g_smem + threadIdx.x * 65;
#else
  float S[64];
#endif
  for (int d = 0; d < 2; ++d) {
    if (ctx) {
      for (int k = 0; k < 64; ++k) S[k] = 0.f;
    } else {
      const float* s0 = p.sdn + (((((long)(bi - CFG_BATCH)) * 2 + l) * 2 + d) * 4 + h) * 4096 + v;
      for (int k = 0; k < 64; ++k) S[k] = s0[k * 64];
    }
    float nalog = -expf(p.dnalog[(l * 2 + d) * 4 + h]);
    float dtb = p.dndt[(l * 2 + d) * 4 + h];
    for (int step = 0; step < T; ++step) {
      int t = d == 0 ? step : T - 1 - step;
      long token = base + t;
      const h16* dp = p.dnp + token * 768;
      const h16* pr = p.proj + token * INC + DN_OFF;
      float beta = sigmoidf_((float)pr[768 + d * 4 + h]);
      float g = nalog * softplusf_((float)pr[776 + d * 4 + h] + dtb);
      float a = expf(g);
      float sk = 0.f;
      for (int k = 0; k < 64; ++k) sk += (float)dp[256 + h * 64 + k] * S[k];
      float coef = beta * ((float)dp[512 + h * 64 + v] - a * sk);
      float o = 0.f;
      for (int k = 0; k < 64; ++k) {
        S[k] = a * S[k] + coef * (float)dp[256 + h * 64 + k];
        o += (float)dp[h * 64 + k] * S[k];
      }
      h16* op = p.act + token * 1024 + 768 + h * 64 + v;
      if (d == 0) *op = (h16)o; else *op = (h16)((float)*op + o);
    }
    if (ctx) {
      float* so = p.odn + (((((long)bi) * 2 + l) * 2 + d) * 4 + h) * 4096 + v;
      for (int k = 0; k < 64; ++k) so[k * 64] = S[k];
    }
  }
}
HD void b_dnfin(long i, const P& p, int l) {
  long token = i / 4; int h = (int)(i % 4);
  h16* op = p.act + token * 1024 + 768 + h * 64;
  float ss = 0.f;
  for (int k = 0; k < 64; ++k) { float o = (float)op[k]; ss += o * o; }
  float rs = 1.0f / sqrtf(ss * (1.0f / 64) + 1e-6f);
  for (int k = 0; k < 64; ++k) {
    float z = (float)p.proj[token * INC + DN_OFF + 784 + h * 64 + k];
    op[k] = (h16)((float)op[k] * rs * p.dnng[l * 64 + k] * siluf_(z));
  }
}
HD void top16_insert(float (&ts)[16], int (&ti)[16], float s, int id) {
#pragma unroll
  for (int j = 0; j < 16; ++j) {
    if (s > ts[j]) { float a = ts[j]; ts[j] = s; s = a; int b = ti[j]; ti[j] = id; id = b; }
  }
}
HD void b_topk1(long i, const P& p, int l) {
  long token = i / 16; int hp = (int)(i % 16);
  const h16* q = p.pq + token * 2048 + hp * 128;
  const float* keys = p.pkeys + ((long)l * 16 + hp) * CFG_NKEYS * 128;
  float ts[16]; int ti[16];
#pragma unroll
  for (int j = 0; j < 16; ++j) { ts[j] = -3.0e38f; ti[j] = 0; }
  for (int k = 0; k < CFG_NKEYS; ++k) {
    float s = 0.f;
    for (int d = 0; d < 128; ++d) s += (float)q[d] * keys[k * 128 + d];
    top16_insert(ts, ti, s, k);
  }
#pragma unroll
  for (int j = 0; j < 16; ++j) { p.tks[token * 256 + hp * 16 + j] = ts[j]; p.tki[token * 256 + hp * 16 + j] = ti[j]; }
}
HD void b_topk2(long i, const P& p, int l) {
  long token = i / 8; int hd = (int)(i % 8);
  const float* s1 = p.tks + token * 256 + hd * 32; const int* i1 = p.tki + token * 256 + hd * 32;
  float ts[16]; int ti[16];
#pragma unroll
  for (int j = 0; j < 16; ++j) { ts[j] = -3.0e38f; ti[j] = 0; }
  for (int a = 0; a < 16; ++a)
    for (int b = 0; b < 16; ++b) top16_insert(ts, ti, s1[a] + s1[16 + b], i1[a] * CFG_NKEYS + i1[16 + b]);
  float sum = 0.f;
#pragma unroll
  for (int j = 0; j < 16; ++j) sum += expf(ts[j] - ts[0]);
  float inv = 1.0f / sum;
#pragma unroll
  for (int j = 0; j < 16; ++j) { p.pidx[token * 128 + hd * 16 + j] = ti[j]; p.pact[token * 128 + hd * 16 + j] = expf(ts[j] - ts[0]) * inv; }
}
HD void b_peer_act(long i, const P& p, int l) {
  long token = i / 128;
  const float* u = p.pu + ((long)l * NEXP + p.pidx[i]) * 1024;
  const h16* x = p.act + token * 1024;
  float dot = 0.f;
  for (int k = 0; k < 1024; ++k) dot += (float)x[k] * u[k];
  float ge = 0.5f * dot * (1.0f + erff(dot * 0.70710678118654752f));
  p.pact[i] = p.pact[i] * ge;
}
HD void b_peer_out(long i, const P& p, int l) {
  long token = i / 1024; int col = (int)(i % 1024);
  float acc = 0.f;
  for (int e = 0; e < 128; ++e) acc += p.pact[token * 128 + e] * p.pv[((long)l * NEXP + p.pidx[token * 128 + e]) * 1024 + col];
  p.X[i] += p.mod[((long)l * NCOND + condrow(token)) * 6144 + 5120 + col] * acc;
}
HD void b_final(long i, const P& p, int) {
  float* x = p.X + i * 1024;
  float ss = 0.f;
  for (int k = 0; k < 1024; ++k) ss += x[k] * x[k];
  float rstd = 1.0f / sqrtf(ss * (1.0f / 1024) + 1e-6f);
  for (int k = 0; k < 1024; ++k) x[k] = x[k] * rstd * p.fng[k];
}
HD float gemm_elem(const h16* A, const float* B, int N, long token, int col) {
  float acc = 0.f;
  for (int k = 0; k < 1024; ++k) acc += (float)A[token * 1024 + k] * B[(long)k * N + col];
  return acc;
}
HD void b_inproj(long i, const P& p, int l) {
  long token = i / INC; int col = (int)(i % INC);
  p.proj[i] = (h16)gemm_elem(p.act, p.win + (long)l * 1024 * INC, INC, token, col);
}
HD void b_outproj(long i, const P& p, int l) {
  long token = i / 1024; int col = (int)(i % 1024);
  float acc = gemm_elem(p.act, p.wout + (long)l * 1024 * 1024, 1024, token, col);
  p.X[i] += p.mod[((long)l * NCOND + condrow(token)) * 6144 + 2048 + col] * acc;
}
HD void b_peerq(long i, const P& p, int l) {
  long token = i / 2048; int col = (int)(i % 2048);
  p.pq[i] = (h16)gemm_elem(p.act, p.pwq + (long)l * 1024 * 2048, 2048, token, col);
}

#ifndef PROBE_KMAX
#define PROBE_KMAX 16
#endif
#ifndef REP_S0
#define REP_S0 1
#endif
#ifndef REP_MISC
#define REP_MISC 1
#endif
#ifndef REP_G0
#define REP_G0 1
#endif
#ifndef REP_G2
#define REP_G2 1
#endif
#ifndef REP_SP
#define REP_SP 1
#endif
#define NSCAN ((long)(CFG_BATCH + CFG_DB) * 4 * 64)
#define NPAD_IN 3328

#ifndef HOST_EMU
typedef _Float16 half8 __attribute__((ext_vector_type(8)));
typedef _Float16 half4 __attribute__((ext_vector_type(4)));
typedef _Float16 half2v __attribute__((ext_vector_type(2)));
typedef float f32x2 __attribute__((ext_vector_type(2)));
typedef float f32x16 __attribute__((ext_vector_type(16)));
typedef float f32x4 __attribute__((ext_vector_type(4)));
typedef unsigned u32x4 __attribute__((ext_vector_type(4)));
typedef short s16x4v __attribute__((__vector_size__(4 * sizeof(short))));

template <int CTRL> __device__ __forceinline__ float dppf(float x) {
  return __builtin_bit_cast(float, __builtin_amdgcn_update_dpp(0, __builtin_bit_cast(int, x), CTRL, 0xF, 0xF, true));
}
__device__ __forceinline__ float sum16(float x) { x += dppf<0x128>(x); x += dppf<0x124>(x); x += dppf<0xB1>(x); x += dppf<0x4E>(x); return x; }
__device__ __forceinline__ float sum8(float x) { x += dppf<0xB1>(x); x += dppf<0x4E>(x); x += dppf<0x141>(x); return x; }
__device__ __forceinline__ float sum64(float x) { x = sum16(x); x += __shfl_xor(x, 16); x += __shfl_xor(x, 32); return x; }

#define CSWAP_DESC(S, ID, i, j) { const bool c_ = S[j] > S[i]; const float a_ = c_ ? S[j] : S[i]; const float b_ = c_ ? S[i] : S[j]; \
    const int ia_ = c_ ? ID[j] : ID[i]; const int ib_ = c_ ? ID[i] : ID[j]; S[i] = a_; S[j] = b_; ID[i] = ia_; ID[j] = ib_; }
__device__ __forceinline__ void bitonic_sort16_desc(float (&s)[16], int (&id)[16]) {
#pragma unroll
  for (int k = 2; k <= 16; k <<= 1) {
#pragma unroll
    for (int j = k >> 1; j > 0; j >>= 1) {
#pragma unroll
      for (int i = 0; i < 16; ++i) {
        const int l = i ^ j;
        if (l > i) {
          if ((i & k) == 0) CSWAP_DESC(s, id, i, l) else CSWAP_DESC(s, id, l, i)
        }
      }
    }
  }
}
__device__ __forceinline__ void merge_top16(float (&ts)[16], int (&ti)[16], const float (&gs)[16], const int (&gi)[16]) {
#pragma unroll
  for (int i = 0; i < 16; ++i) { if (gs[15 - i] > ts[i]) { ts[i] = gs[15 - i]; ti[i] = gi[15 - i]; } }
#pragma unroll
  for (int j = 8; j > 0; j >>= 1) {
#pragma unroll
    for (int i = 0; i < 16; ++i) { if ((i & j) == 0) CSWAP_DESC(ts, ti, i, i + j) }
  }
}
__device__ void blk_convert(long w, const P& p) {
  int l = (int)(w / 1600); int r = (int)(w % 1600);
  const float* src; h16* dst; int N, ntile;
  if (r < 832) { src = p.win + (long)l * 1024 * INC; dst = p.wtin + (long)l * NPAD_IN * 1024; N = INC; ntile = 52; }
  else if (r < 1088) { r -= 832; src = p.wout + (long)l * 1024 * 1024; dst = p.wtout + (long)l * 1024 * 1024; N = 1024; ntile = 16; }
  else { r -= 1088; src = p.pwq + (long)l * 1024 * 2048; dst = p.wtq + (long)l * 2048 * 1024; N = 2048; ntile = 32; }
  int kt = r / ntile, nt = r % ntile;
  int k0 = kt * 64, n0 = nt * 64;
  h16* tile = (h16*)g_smem;
  const int tid_ = otid(); int c = tid_ & 63, r4 = tid_ >> 6;
  __syncthreads();
#pragma unroll
  for (int j = 0; j < 16; ++j) {
    int rr = r4 + 4 * j;
    float v = (n0 + c < N) ? src[(long)(k0 + rr) * N + n0 + c] : 0.f;
    tile[rr * 66 + c] = (h16)v;
  }
  __syncthreads();
#pragma unroll
  for (int j = 0; j < 16; ++j) {
    int rr = r4 + 4 * j;
    dst[(long)(n0 + rr) * 1024 + k0 + c] = tile[c * 66 + rr];
  }
}

template <int EPI>
__device__ void gemm_phase(const P& p, int l, int kmax = 16) {
  constexpr int NTILES = EPI == 0 ? (NPAD_IN / 128) : (EPI == 1 ? 8 : 16);
  constexpr int NT8 = (NTILES + 7) / 8;
  const long nw = EPI == 0 ? (long)(NT / 128) * NTILES : (long)(NT / 128) * 8 * NT8;
#define TILE_OF(W, MT, NTV) { const int x_ = (int)((W) & 7); const int j_ = (int)((W) >> 3);                        \
    if (EPI == 0) { if (j_ < 960) { MT = j_ / 3; NTV = x_ + 8 * (j_ - 3 * MT); } else { NTV = 24 + (x_ >> 2); MT = 80 * (x_ & 3) + j_ - 960; } } \
    else { NTV = x_ + 8 * (j_ % NT8); MT = j_ / NT8; } }
  const h16* A = p.act;
  const h16* Bt = EPI == 0 ? p.wtin + (long)l * NPAD_IN * 1024 : (EPI == 1 ? p.wtout + (long)l * 1024 * 1024 : p.wtq + (long)l * 2048 * 1024);
  const int tid = otid(), lane = tid & 63, wv = tid >> 6, wm = wv >> 1, wn = wv & 1;
  h16* As = (h16*)g_smem;
  h16* Bs = As + 2 * 128 * 72;
  const int lrow = tid >> 3, lch = tid & 7;
  long w = blockIdx.x; int mt = 0, nt = 0;
  for (;;) { if (w >= nw) return; TILE_OF(w, mt, nt) if (nt < NTILES) break; w += gridDim.x; }
  int m0 = mt * 128, n0 = nt * 128;
  const h16* Ag = A + (long)(m0 + lrow) * 1024 + lch * 8;
  const h16* Bg = Bt + (long)(n0 + lrow) * 1024 + lch * 8;
  u32x4 ra0, ra1, ra2, ra3, rb0, rb1, rb2, rb3;
  u32x4 sa0, sa1, sa2, sa3, sb0, sb1, sb2, sb3;
  const f32x16 zero16 = {0.f, 0.f, 0.f, 0.f, 0.f, 0.f, 0.f, 0.f, 0.f, 0.f, 0.f, 0.f, 0.f, 0.f, 0.f, 0.f};
  f32x16 acc00, acc01, acc10, acc11;
#define GLD0(K0) \
  ra0 = *(const u32x4*)(Ag + (K0)); ra1 = *(const u32x4*)(Ag + 32 * 1024 + (K0)); ra2 = *(const u32x4*)(Ag + 64 * 1024 + (K0)); ra3 = *(const u32x4*)(Ag + 96 * 1024 + (K0)); \
  rb0 = *(const u32x4*)(Bg + (K0)); rb1 = *(const u32x4*)(Bg + 32 * 1024 + (K0)); rb2 = *(const u32x4*)(Bg + 64 * 1024 + (K0)); rb3 = *(const u32x4*)(Bg + 96 * 1024 + (K0));
#define GLD1(K0) \
  sa0 = *(const u32x4*)(Ag + (K0)); sa1 = *(const u32x4*)(Ag + 32 * 1024 + (K0)); sa2 = *(const u32x4*)(Ag + 64 * 1024 + (K0)); sa3 = *(const u32x4*)(Ag + 96 * 1024 + (K0)); \
  sb0 = *(const u32x4*)(Bg + (K0)); sb1 = *(const u32x4*)(Bg + 32 * 1024 + (K0)); sb2 = *(const u32x4*)(Bg + 64 * 1024 + (K0)); sb3 = *(const u32x4*)(Bg + 96 * 1024 + (K0));
#define LST0(AW, BW) \
  *(u32x4*)((AW) + (lrow) * 72 + lch * 8) = ra0; *(u32x4*)((AW) + (lrow + 32) * 72 + lch * 8) = ra1; *(u32x4*)((AW) + (lrow + 64) * 72 + lch * 8) = ra2; *(u32x4*)((AW) + (lrow + 96) * 72 + lch * 8) = ra3; \
  *(u32x4*)((BW) + (lrow) * 72 + lch * 8) = rb0; *(u32x4*)((BW) + (lrow + 32) * 72 + lch * 8) = rb1; *(u32x4*)((BW) + (lrow + 64) * 72 + lch * 8) = rb2; *(u32x4*)((BW) + (lrow + 96) * 72 + lch * 8) = rb3;
#define LST1(AW, BW) \
  *(u32x4*)((AW) + (lrow) * 72 + lch * 8) = sa0; *(u32x4*)((AW) + (lrow + 32) * 72 + lch * 8) = sa1; *(u32x4*)((AW) + (lrow + 64) * 72 + lch * 8) = sa2; *(u32x4*)((AW) + (lrow + 96) * 72 + lch * 8) = sa3; \
  *(u32x4*)((BW) + (lrow) * 72 + lch * 8) = sb0; *(u32x4*)((BW) + (lrow + 32) * 72 + lch * 8) = sb1; *(u32x4*)((BW) + (lrow + 64) * 72 + lch * 8) = sb2; *(u32x4*)((BW) + (lrow + 96) * 72 + lch * 8) = sb3;
#define GCOMP(BUF)                                                                                   \
  {                                                                                                  \
    const h16* Ab = As + (BUF) * 128 * 72 + (wm * 64 + (lane & 31)) * 72 + (lane >> 5) * 8;          \
    const h16* Bb = Bs + (BUF) * 128 * 72 + (wn * 64 + (lane & 31)) * 72 + (lane >> 5) * 8;          \
    _Pragma("unroll") for (int s = 0; s < 4; ++s) {                                                  \
      half8 a0 = *(const half8*)(Ab + s * 16), a1 = *(const half8*)(Ab + 32 * 72 + s * 16);          \
      half8 b0 = *(const half8*)(Bb + s * 16), b1 = *(const half8*)(Bb + 32 * 72 + s * 16);          \
      acc00 = __builtin_amdgcn_mfma_f32_32x32x16_f16(a0, b0, acc00, 0, 0, 0);                        \
      acc01 = __builtin_amdgcn_mfma_f32_32x32x16_f16(a0, b1, acc01, 0, 0, 0);                        \
      acc10 = __builtin_amdgcn_mfma_f32_32x32x16_f16(a1, b0, acc10, 0, 0, 0);                        \
      acc11 = __builtin_amdgcn_mfma_f32_32x32x16_f16(a1, b1, acc11, 0, 0, 0);                        \
    }                                                                                                \
  }
  GLD0(0)
  GLD1(64)
  for (;;) {
  acc00 = zero16; acc01 = zero16; acc10 = zero16; acc11 = zero16;
  __builtin_amdgcn_sched_barrier(0);
  __syncthreads();
  LST0(As, Bs)
  GLD0(128)
  __builtin_amdgcn_sched_barrier(0);
  __syncthreads();
  __builtin_amdgcn_s_setprio(2);
  for (int kt = 0; kt < kmax; kt += 2) {
    GCOMP(0)
    __builtin_amdgcn_sched_barrier(0);
    LST1(As + 128 * 72, Bs + 128 * 72)
    if (kt + 3 < 16) { GLD1((kt + 3) * 64) }
    __builtin_amdgcn_sched_barrier(0);
    __syncthreads();
    GCOMP(1)
    __builtin_amdgcn_sched_barrier(0);
    if (kt + 2 < 16) { LST0(As, Bs) }
    if (kt + 4 < 16) { GLD0((kt + 4) * 64) }
    __builtin_amdgcn_sched_barrier(0);
    __syncthreads();
  }
  __builtin_amdgcn_s_setprio(0);
  const int cm0 = m0, cn0 = n0, cnt = nt;
  long w2 = w + gridDim.x; int mt2 = 0, nt2 = 0; bool has_next = false;
  for (;;) { if (w2 >= nw) break; TILE_OF(w2, mt2, nt2) if (nt2 < NTILES) { has_next = true; break; } w2 += gridDim.x; }
  if (has_next) {
    m0 = mt2 * 128; n0 = nt2 * 128; nt = nt2;
    Ag = A + (long)(m0 + lrow) * 1024 + lch * 8; Bg = Bt + (long)(n0 + lrow) * 1024 + lch * 8;
  }
  __builtin_amdgcn_sched_barrier(0);
#define GEMM_EPI(ACC, I, J)                                                                         \
  _Pragma("unroll") for (int r = 0; r < 16; ++r) {                                                   \
    const long row = cm0 + wm * 64 + (I) * 32 + (r & 3) + 8 * (r >> 2) + 4 * (lane >> 5);             \
    const int col = cn0 + wn * 64 + (J) * 32 + (lane & 31);                                            \
    const float v = ACC[r];                                                                          \
    if (EPI == 0) { if (col < INC) p.proj[row * INC + col] = (h16)v; }                                \
    else if (EPI == 1) { p.X[row * 1024 + col] += p.mod[((long)l * NCOND + condrow(row)) * 6144 + 2048 + col] * v; } \
    else { p.pq[row * 2048 + col] = (h16)v; }                                                         \
  }
  if (EPI == 0) {
    h16* Ct = (h16*)g_smem;
#define CST(ACC, I, J) _Pragma("unroll") for (int r = 0; r < 16; ++r) Ct[(wm * 64 + (I) * 32 + (r & 3) + 8 * (r >> 2) + 4 * (lane >> 5)) * 136 + wn * 64 + (J) * 32 + (lane & 31)] = (h16)ACC[r];
    CST(acc00, 0, 0) CST(acc01, 0, 1) CST(acc10, 1, 0) CST(acc11, 1, 1)
#undef CST
    __syncthreads();
#pragma unroll
    for (int j = 0; j < 8; ++j) {
      const int idx = tid + 256 * j; const int rr = idx >> 4, cc = idx & 15;
      if (cn0 + cc * 8 < INC) *(u32x4*)(p.proj + (long)(cm0 + rr) * INC + cn0 + cc * 8) = *(const u32x4*)(Ct + rr * 136 + cc * 8);
    }
  } else if (EPI == 1) {
#define EPI1(ACC, I, J)                                                                              \
    {                                                                                                \
      float xv_[16], mv_[16];                                                                        \
      const int col = cn0 + wn * 64 + (J) * 32 + (lane & 31);                                         \
      _Pragma("unroll") for (int r = 0; r < 16; ++r) {                                               \
        const long row = cm0 + wm * 64 + (I) * 32 + (r & 3) + 8 * (r >> 2) + 4 * (lane >> 5);         \
        xv_[r] = p.X[row * 1024 + col]; mv_[r] = p.mod[((long)l * NCOND + condrow(row)) * 6144 + 2048 + col]; \
      }                                                                                              \
      _Pragma("unroll") for (int r = 0; r < 16; ++r) {                                               \
        const long row = cm0 + wm * 64 + (I) * 32 + (r & 3) + 8 * (r >> 2) + 4 * (lane >> 5);         \
        p.X[row * 1024 + col] = xv_[r] + mv_[r] * ACC[r];                                            \
      }                                                                                              \
    }
    EPI1(acc00, 0, 0) EPI1(acc01, 0, 1) EPI1(acc10, 1, 0) EPI1(acc11, 1, 1)
#undef EPI1
  } else {
    h16* Q = (h16*)g_smem;
    h16* Kk = Q + 128 * 136;
    const h16* kg = p.keys16 + ((long)l * 16 + cnt) * CFG_NKEYS * 128;
#define QST(ACC, I, J) _Pragma("unroll") for (int r = 0; r < 16; ++r) Q[(wm * 64 + (I) * 32 + (r & 3) + 8 * (r >> 2) + 4 * (lane >> 5)) * 136 + wn * 64 + (J) * 32 + (lane & 31)] = (h16)ACC[r];
    QST(acc00, 0, 0) QST(acc01, 0, 1) QST(acc10, 1, 0) QST(acc11, 1, 1)
#undef QST
#pragma unroll
    for (int j = 0; j < 8; ++j) {
      const int idx = tid + 256 * j; const int kr = idx >> 4, kc = idx & 15;
      *(u32x4*)(Kk + kr * 136 + kc * 8) = *(const u32x4*)(kg + kr * 128 + kc * 8);
    }
    __syncthreads();
    f32x16 z = {0.f, 0.f, 0.f, 0.f, 0.f, 0.f, 0.f, 0.f, 0.f, 0.f, 0.f, 0.f, 0.f, 0.f, 0.f, 0.f};
    f32x16 s00 = z, s01 = z, s10 = z, s11 = z;
    const h16* Qb = Q + (wm * 64 + (lane & 31)) * 136 + (lane >> 5) * 8;
    const h16* Kb = Kk + (wn * 64 + (lane & 31)) * 136 + (lane >> 5) * 8;
#pragma unroll
    for (int sidx = 0; sidx < 8; ++sidx) {
      half8 a0 = *(const half8*)(Qb + sidx * 16), a1 = *(const half8*)(Qb + 32 * 136 + sidx * 16);
      half8 b0 = *(const half8*)(Kb + sidx * 16), b1 = *(const half8*)(Kb + 32 * 136 + sidx * 16);
      s00 = __builtin_amdgcn_mfma_f32_32x32x16_f16(a0, b0, s00, 0, 0, 0);
      s01 = __builtin_amdgcn_mfma_f32_32x32x16_f16(a0, b1, s01, 0, 0, 0);
      s10 = __builtin_amdgcn_mfma_f32_32x32x16_f16(a1, b0, s10, 0, 0, 0);
      s11 = __builtin_amdgcn_mfma_f32_32x32x16_f16(a1, b1, s11, 0, 0, 0);
    }
    __syncthreads();
    float* SC = (float*)g_smem;
#define SST(ACC, I, J) _Pragma("unroll") for (int r = 0; r < 16; ++r) SC[(wm * 64 + (I) * 32 + (r & 3) + 8 * (r >> 2) + 4 * (lane >> 5)) * 129 + wn * 64 + (J) * 32 + (lane & 31)] = ACC[r];
    SST(s00, 0, 0) SST(s01, 0, 1) SST(s10, 1, 0) SST(s11, 1, 1)
#undef SST
    __syncthreads();
    const int row = tid >> 1, half = tid & 1;
    float ts[16]; int ti[16];
#pragma unroll
    for (int j = 0; j < 16; ++j) { ts[j] = -3.0e38f; ti[j] = 0; }
#pragma unroll 1
    for (int g = 0; g < 4; ++g) {
      float gs[16]; int gi[16];
#pragma unroll
      for (int j = 0; j < 16; ++j) { gs[j] = SC[row * 129 + half * 64 + g * 16 + j]; gi[j] = half * 64 + g * 16 + j; }
      bitonic_sort16_desc(gs, gi);
      merge_top16(ts, ti, gs, gi);
    }
    {
      float ps[16]; int pi[16];
#pragma unroll
      for (int j = 0; j < 16; ++j) { ps[j] = dppf<0xB1>(ts[j]); pi[j] = __builtin_amdgcn_update_dpp(0, ti[j], 0xB1, 0xF, 0xF, true); }
      merge_top16(ts, ti, ps, pi);
    }
    if (half == 0) {
      const long token = cm0 + row;
#pragma unroll
      for (int j = 0; j < 16; ++j) { p.tks[token * 256 + cnt * 16 + j] = ts[j]; p.tki[token * 256 + cnt * 16 + j] = ti[j]; }
    }
  }
#undef GEMM_EPI
  if (!has_next) break;
  GLD0(0)
  GLD1(64)
  w = w2;
  }
#undef GLD0
#undef GLD1
#undef LST0
#undef LST1
#undef GCOMP
#undef TILE_OF
}

__device__ void blk_mod(long w, const P& p) {
  float* sl = (float*)g_smem;
  const int tid = otid();
  const int cb = (int)(w % 24); const int r = (int)((w / 24) % NCOND); const int l = (int)(w / (24 * NCOND));
  const float* cond = r == 0 ? p.cctx : p.c + (long)(r - 1) * 1024;
  __syncthreads();
#pragma unroll
  for (int j = 0; j < 4; ++j) sl[tid + 256 * j] = siluf_(cond[tid + 256 * j]);
  __syncthreads();
  const int col = cb * 256 + tid;
  const float* wp = p.wmod + (long)l * 1024 * 6144 + col;
  float acc = p.bmod[l * 6144 + col];
#pragma unroll 8
  for (int k = 0; k < 1024; ++k) acc += sl[k] * wp[(long)k * 6144];
  p.mod[((long)l * NCOND + r) * 6144 + col] = acc;
}
__device__ __forceinline__ float sum64u(float x);
template <int WHICH>
__device__ void blk_norm(long w, const P& p, int l) {
  const int tid_ = otid(); const int lane = tid_ & 63; const long token = w * 4 + (tid_ >> 6);
  const float* src = (WHICH == 0 && l == 0) ? (token < NTC ? p.xp + token * 1024 : p.xs + (token - NTC) * 1024) : p.X + token * 1024;
  float4 v[4]; float ss = 0.f;
#pragma unroll
  for (int j = 0; j < 4; ++j) { v[j] = ((const float4*)src)[lane + 64 * j]; ss += v[j].x * v[j].x + v[j].y * v[j].y + v[j].z * v[j].z + v[j].w * v[j].w; }
  ss = sum64u(ss);
  const float rstd = 1.0f / sqrtf(ss * (1.0f / 1024) + 1e-6f);
  if (WHICH == 2) {
#pragma unroll
    for (int j = 0; j < 4; ++j) {
      float4 g = ((const float4*)p.fng)[lane + 64 * j];
      float4 o; o.x = v[j].x * rstd * g.x; o.y = v[j].y * rstd * g.y; o.z = v[j].z * rstd * g.z; o.w = v[j].w * rstd * g.w;
      ((float4*)(p.X + token * 1024))[lane + 64 * j] = o;
    }
    return;
  }
  const float* m = p.mod + ((long)l * NCOND + condrow(token)) * 6144 + (WHICH ? 3072 : 0);
  const float* g = (WHICH ? p.n2g : p.n1g) + l * 1024;
  float4 gga[4], sha[4], sca[4];
#pragma unroll
  for (int j = 0; j < 4; ++j) { const int c4 = lane + 64 * j; gga[j] = ((const float4*)g)[c4]; sha[j] = ((const float4*)m)[c4]; sca[j] = ((const float4*)(m + 1024))[c4]; }
#pragma unroll
  for (int j = 0; j < 4; ++j) {
    const int c4 = lane + 64 * j;
    const float4 gg = gga[j], sh = sha[j], sc = sca[j];
    half4 o;
    o[0] = (h16)((v[j].x * rstd * gg.x) * (1.0f + sc.x) + sh.x);
    o[1] = (h16)((v[j].y * rstd * gg.y) * (1.0f + sc.y) + sh.y);
    o[2] = (h16)((v[j].z * rstd * gg.z) * (1.0f + sc.z) + sh.z);
    o[3] = (h16)((v[j].w * rstd * gg.w) * (1.0f + sc.w) + sh.w);
    *(half4*)(p.act + token * 1024 + c4 * 4) = o;
    if (WHICH == 0 && l == 0) ((float4*)(p.X + token * 1024))[c4] = v[j];
  }
}


#define SC_CT 32
__device__ __forceinline__ float fsigmoid(float x) { return __frcp_rn(1.0f + __expf(-x)); }
__device__ __forceinline__ float fsilu(float x) { return x * fsigmoid(x); }
__device__ __forceinline__ float fsoftplus(float x) { return fmaxf(x, 0.0f) + __logf(1.0f + __expf(-fabsf(x))); }
__device__ __forceinline__ float ftanh(float x) { const float e = __expf(-2.0f * fabsf(x)); const float t = (1.0f - e) * __frcp_rn(1.0f + e); return x < 0.f ? -t : t; }
#define N_PREP_RW ((NT / 32) * 8)
#define N_PREP_DN ((NT / 32) * 4)
__device__ void blk_scanprep(long w, const P& p, int l, half8& bf0, half8& bf1, int& bkey) {
  h16* tw16 = (h16*)g_smem;
  h16* al16 = tw16 + 32 * 40;
  float* cbuf = (float*)(al16 + 32 * 40);
  const int tid = otid();
  const int ls = tid >> 3, part = tid & 7;
  if (w < N_PREP_RW) {
    const int d = (int)(w & 1), h = (int)((w >> 1) & 3); const long token = (w >> 3) * 32 + ls;
    int t, T; long base; seqinfo(token, t, T, base);
    const bool sv = d == 0 ? (t > 0) : (t < T - 1);
    const h16* pb = p.proj + token * INC + RW_OFF;
    const h16* ps = p.proj + (token + (d == 0 ? -1 : 1)) * INC + RW_OFF;
    const float* mu = p.rwmu + ((long)l * 2 + d) * 832;
    const int lane = tid & 63, wv = tid >> 6;
    const int mat = wv >> 1, ntile = wv & 1;
    const int c0 = h * 64 + part * 8;
    half8 rb = *(const half8*)(pb + c0), kb = *(const half8*)(pb + 256 + c0);
    half8 rs_ = rb, ks_ = kb;
    if (sv) { rs_ = *(const half8*)(ps + c0); ks_ = *(const half8*)(ps + 256 + c0); }
    if (bkey != (int)((l << 3) | (w & 7))) {
      bkey = (int)((l << 3) | (w & 7));
      const float* wsrc = (mat ? p.rwa2 : p.rww2) + ((long)l * 2 + d) * 32 * 256 + h * 64 + ntile * 32 + (lane & 31);
#pragma unroll
      for (int j = 0; j < 8; ++j) { bf0[j] = (h16)wsrc[(8 * (lane >> 5) + j) * 256]; bf1[j] = (h16)wsrc[(16 + 8 * (lane >> 5) + j) * 256]; }
    }
    __syncthreads();
#pragma unroll
    for (int e = 0; e < 4; ++e) {
      const int jj = part * 4 + e;
      float bw = (float)pb[768 + d * 32 + jj], sw = sv ? (float)ps[768 + d * 32 + jj] : 0.f;
      tw16[ls * 40 + jj] = (h16)ftanh(bw + (sw - bw) * mu[768 + jj]);
      float ba = (float)pb[832 + d * 32 + jj], sa_ = sv ? (float)ps[832 + d * 32 + jj] : 0.f;
      al16[ls * 40 + jj] = (h16)(ba + (sa_ - ba) * mu[800 + jj]);
    }
    __syncthreads();
    {
      const h16* X16 = (mat ? al16 : tw16) + (lane & 31) * 40 + 8 * (lane >> 5);
      const half8 a0 = *(const half8*)X16, a1 = *(const half8*)(X16 + 16);
      f32x16 acc = {0.f, 0.f, 0.f, 0.f, 0.f, 0.f, 0.f, 0.f, 0.f, 0.f, 0.f, 0.f, 0.f, 0.f, 0.f, 0.f};
      acc = __builtin_amdgcn_mfma_f32_32x32x16_f16(a0, bf0, acc, 0, 0, 0);
      acc = __builtin_amdgcn_mfma_f32_32x32x16_f16(a1, bf1, acc, 0, 0, 0);
      float* cb = cbuf + mat * (32 * 65) + ntile * 32 + (lane & 31);
#pragma unroll
      for (int r = 0; r < 16; ++r) cb[((r & 3) + 8 * (r >> 2) + 4 * (lane >> 5)) * 65] = acc[r];
    }
    __syncthreads();
    float accw[8], acca[8];
#pragma unroll
    for (int e = 0; e < 8; ++e) {
      accw[e] = p.rww0[(l * 2 + d) * 256 + c0 + e] + cbuf[ls * 65 + part * 8 + e];
      acca[e] = p.rwa0[(l * 2 + d) * 256 + c0 + e] + cbuf[32 * 65 + ls * 65 + part * 8 + e];
    }
    float ss = 0.f, bon = 0.f;
    half8 ewo, ago;
#pragma unroll
    for (int e = 0; e < 8; ++e) {
      const int c = c0 + e;
      float b_ = (float)rb[e], s_ = sv ? (float)rs_[e] : 0.f; const float rr = b_ + (s_ - b_) * mu[c];
      b_ = (float)kb[e]; s_ = sv ? (float)ks_[e] : 0.f; const float kr = b_ + (s_ - b_) * mu[256 + c];
      const float asg = fsigmoid(acca[e]);
      const float kkr = kr * p.rwkk[l * 256 + c];
      ss += kkr * kkr;
      const float keff = kr * (1.0f + (asg - 1.0f) * p.rwka[l * 256 + c]);
      bon += rr * keff * p.rwrk[l * 256 + c];
      ewo[e] = (h16)__expf(-fsoftplus(-accw[e]) - 0.5f);
      ago[e] = (h16)asg;
    }
    ss = sum8(ss); bon = sum8(bon);
    *(half8*)(p.rwaux + ((token * 2 + d) * 2 + 0) * 256 + c0) = ewo;
    *(half8*)(p.rwaux + ((token * 2 + d) * 2 + 1) * 256 + c0) = ago;
    if (part == 0) { float* sc = p.rwsc + ((token * 2 + d) * 4 + h) * 2; sc[0] = 1.0f / sqrtf(ss + 1e-6f); sc[1] = bon; }
  } else {
    const long w2 = w - N_PREP_RW;
    const int h = (int)(w2 & 3); const long token = (w2 >> 2) * 32 + ls;
    int t, T; long base; seqinfo(token, t, T, base);
    const int c0 = h * 64 + part * 8;
    float aq[8], ak[8], av[8];
#pragma unroll
    for (int e = 0; e < 8; ++e) { aq[e] = 0.f; ak[e] = 0.f; av[e] = 0.f; }
    half8 xq[5], xk[5], xv[5]; float tv[5];
#pragma unroll
    for (int tap = 0; tap < 5; ++tap) {
      const int tt = t + tap - 2;
      const bool ok = tt >= 0 && tt < T;
      const h16* pr = p.proj + (base + (ok ? tt : t)) * INC + DN_OFF + c0;
      xq[tap] = *(const half8*)pr; xk[tap] = *(const half8*)(pr + 256); xv[tap] = *(const half8*)(pr + 512);
      tv[tap] = ok ? 1.0f : 0.0f;
    }
    __builtin_amdgcn_sched_barrier(0);
#pragma unroll
    for (int tap = 0; tap < 5; ++tap) {
      const float* cw = p.dnconv + ((long)l * 5 + tap) * 768 + c0;
#pragma unroll
      for (int e = 0; e < 8; ++e) {
        aq[e] += (float)xq[tap][e] * (cw[e] * tv[tap]); ak[e] += (float)xk[tap][e] * (cw[256 + e] * tv[tap]); av[e] += (float)xv[tap][e] * (cw[512 + e] * tv[tap]);
      }
    }
    float ssq = 0.f, ssk = 0.f;
#pragma unroll
    for (int e = 0; e < 8; ++e) { aq[e] = fsilu(aq[e]); ak[e] = fsilu(ak[e]); av[e] = fsilu(av[e]); ssq += aq[e] * aq[e]; ssk += ak[e] * ak[e]; }
    ssq = sum8(ssq); ssk = sum8(ssk);
    const float rq = 0.125f / sqrtf(ssq + 1e-6f), rk = 1.0f / sqrtf(ssk + 1e-6f);
    half8 qo, ko, vo;
#pragma unroll
    for (int e = 0; e < 8; ++e) { qo[e] = (h16)(aq[e] * rq); ko[e] = (h16)(ak[e] * rk); vo[e] = (h16)av[e]; }
    h16* dp = p.dnp + token * 768 + c0;
    *(half8*)dp = qo; *(half8*)(dp + 256) = ko; *(half8*)(dp + 512) = vo;
    if (part < 2) {
      const int d = part;
      const h16* pr = p.proj + token * INC + DN_OFF;
      float* sc = p.dnsc + ((token * 2 + d) * 4 + h) * 2;
      sc[0] = sigmoidf_((float)pr[768 + d * 4 + h]);
      sc[1] = expf(-expf(p.dnalog[(l * 2 + d) * 4 + h]) * softplusf_((float)pr[776 + d * 4 + h] + p.dndt[(l * 2 + d) * 4 + h]));
    }
  }
}
__device__ void blk_scan2(int kind, int bi, int h, int d, int rq, const P& p, int l) {
  float* L = (float*)g_smem;
  float* LA = L; float* LW = L + 2048; float* LB = L + 4096; float* LK = L + 6144; float* LR = L + 8192; float* LV = L + 10240;
  const int tid = otid(), lane = tid & 63, wv = tid >> 6, g = lane >> 4, cl = lane & 15;
  const int i = rq * 32 + wv * 8 + g * 2, j0 = cl * 4;
  const bool ctx = bi < CFG_BATCH;
  const int T = ctx ? CFG_SEQ : CFG_DS;
  const long base = ctx ? (long)bi * CFG_SEQ : (long)NTC + (long)(bi - CFG_BATCH) * CFG_DS;
  const int ls = tid >> 3, part = tid & 7;
  f32x4 S = {0.f, 0.f, 0.f, 0.f}, S1 = {0.f, 0.f, 0.f, 0.f};
  if (!ctx) {
    const int b = bi - CFG_BATCH;
    if (kind == 0) {
      const float* s0 = p.srw + (((((long)b) * 2 + l) * 2 + d) * 4 + h) * 4096;
      S = *(const f32x4*)(s0 + i * 64 + j0); S1 = *(const f32x4*)(s0 + (i + 1) * 64 + j0);
    } else {
      const float* s0 = p.sdn + (((((long)b) * 2 + l) * 2 + d) * 4 + h) * 4096;
#pragma unroll
      for (int c = 0; c < 4; ++c) { S[c] = s0[(j0 + c) * 64 + i]; S1[c] = s0[(j0 + c) * 64 + i + 1]; }
    }
  }
  h16* obuf = (h16*)(L + 12288);
  h16* obase = (kind == 0 ? p.act + 256 + d * 512 + h * 64 : p.proj + DN_OFF + d * 256 + h * 64) + rq * 32 + (tid & 7) * 4;
  const long ostride = kind == 0 ? 1024 : INC;
#define SC_FLUSH(S0I)                                                                              \
  { const int sidx_ = (S0I) + (tid >> 3); const int t_ = d == 0 ? sidx_ : T - 1 - sidx_;             \
    *(half4*)(obase + (base + t_) * ostride) = *(const half4*)(obuf + (tid >> 3) * 32 + (tid & 7) * 4); }
  const int c0 = h * 64 + part * 8, jb = part * 8;
  float cmr[8], cmk[8], cmv[8], ckk[8], cka[8];
#pragma unroll
  for (int e = 0; e < 8; ++e) { cmr[e] = 0.f; cmk[e] = 0.f; cmv[e] = 0.f; ckk[e] = 0.f; cka[e] = 0.f; }
  if (kind == 0) {
    const float* mu = p.rwmu + ((long)l * 2 + d) * 832;
#pragma unroll
    for (int e = 0; e < 8; ++e) { cmr[e] = mu[c0 + e]; cmk[e] = mu[256 + c0 + e]; cmv[e] = mu[512 + c0 + e]; ckk[e] = p.rwkk[l * 256 + c0 + e]; cka[e] = p.rwka[l * 256 + c0 + e]; }
  }
  half8 g0, g1, g2, g3, g4, g5, g6, g7; float gf0 = 0.f, gf1 = 0.f; bool gsv = false;
  g0 = g1 = g2 = g3 = g4 = g5 = g6 = g7 = (half8){0, 0, 0, 0, 0, 0, 0, 0};
#define SC_LOADG(S0I)                                                                              \
  {                                                                                                \
    const int sidx_ = (S0I) + ls;                                                                  \
    const int t_ = d == 0 ? sidx_ : T - 1 - sidx_;                                                 \
    const long token_ = base + t_;                                                                 \
    if (kind == 0) {                                                                               \
      gsv = d == 0 ? (t_ > 0) : (t_ < T - 1);                                                      \
      const h16* pb_ = p.proj + token_ * INC + RW_OFF + c0;                                        \
      const h16* ps_ = gsv ? p.proj + (token_ + (d == 0 ? -1 : 1)) * INC + RW_OFF + c0 : pb_;      \
      g0 = *(const half8*)pb_; g1 = *(const half8*)(pb_ + 256); g2 = *(const half8*)(pb_ + 512);   \
      g3 = *(const half8*)ps_; g4 = *(const half8*)(ps_ + 256); g5 = *(const half8*)(ps_ + 512);   \
      g6 = *(const half8*)(p.rwaux + ((token_ * 2 + d) * 2 + 0) * 256 + c0);                       \
      g7 = *(const half8*)(p.rwaux + ((token_ * 2 + d) * 2 + 1) * 256 + c0);                       \
      gf0 = p.rwsc[((token_ * 2 + d) * 4 + h) * 2];                                                \
    } else {                                                                                       \
      const h16* dp_ = p.dnp + token_ * 768 + c0;                                                  \
      g0 = *(const half8*)dp_; g1 = *(const half8*)(dp_ + 256); g2 = *(const half8*)(dp_ + 512);   \
      const float* sc_ = p.dnsc + ((token_ * 2 + d) * 4 + h) * 2;                                  \
      gf0 = sc_[0]; gf1 = sc_[1];                                                                  \
    }                                                                                              \
  }
  SC_LOADG(0)
  for (int s0i = 0; s0i < T; s0i += SC_CT) {
    __syncthreads();
    if (s0i > 0) SC_FLUSH(s0i - SC_CT)
    {
      f32x4 va[2], vw[2], vb[2], vk[2], vr[2], vv_[2];
      if (kind == 0) {
#pragma unroll
        for (int e = 0; e < 8; ++e) {
          float b_ = (float)g0[e], s_ = gsv ? (float)g3[e] : 0.f; const float rr = b_ + (s_ - b_) * cmr[e];
          b_ = (float)g1[e]; s_ = gsv ? (float)g4[e] : 0.f; const float kr = b_ + (s_ - b_) * cmk[e];
          b_ = (float)g2[e]; s_ = gsv ? (float)g5[e] : 0.f; const float vl = b_ + (s_ - b_) * cmv[e];
          const float asg = (float)g7[e];
          const float kk = kr * ckk[e] * gf0;
          va[e >> 2][e & 3] = -kk; vw[e >> 2][e & 3] = __expf(-(float)g6[e]); vb[e >> 2][e & 3] = kk * asg;
          vk[e >> 2][e & 3] = kr * (1.0f + (asg - 1.0f) * cka[e]); vr[e >> 2][e & 3] = rr; vv_[e >> 2][e & 3] = vl;
        }
      } else {
        const float beta = gf0, alpha = gf1;
#pragma unroll
        for (int e = 0; e < 8; ++e) {
          const float k = (float)g1[e];
          va[e >> 2][e & 3] = k; vw[e >> 2][e & 3] = alpha; vb[e >> 2][e & 3] = -alpha * beta * k;
          vk[e >> 2][e & 3] = beta * k; vr[e >> 2][e & 3] = (float)g0[e]; vv_[e >> 2][e & 3] = (float)g2[e];
        }
      }
      const int lo_ = ls * 64 + jb;
      *(f32x4*)(LA + lo_) = va[0]; *(f32x4*)(LA + lo_ + 4) = va[1]; *(f32x4*)(LW + lo_) = vw[0]; *(f32x4*)(LW + lo_ + 4) = vw[1];
      *(f32x4*)(LB + lo_) = vb[0]; *(f32x4*)(LB + lo_ + 4) = vb[1]; *(f32x4*)(LK + lo_) = vk[0]; *(f32x4*)(LK + lo_ + 4) = vk[1];
      *(f32x4*)(LR + lo_) = vr[0]; *(f32x4*)(LR + lo_ + 4) = vr[1]; *(f32x4*)(LV + lo_) = vv_[0]; *(f32x4*)(LV + lo_ + 4) = vv_[1];
    }
    __syncthreads();
    if (s0i + SC_CT < T) SC_LOADG(s0i + SC_CT)
    __builtin_amdgcn_sched_barrier(0);
#define SC_LD(A4, W4, B4, K4, R4, VV, Q)                                                                    \
    { const int o_ = (Q) * 64; A4 = *(const f32x4*)(LA + o_ + j0); W4 = *(const f32x4*)(LW + o_ + j0); B4 = *(const f32x4*)(LB + o_ + j0); \
      K4 = *(const f32x4*)(LK + o_ + j0); R4 = *(const f32x4*)(LR + o_ + j0); VV = *(const f32x2*)(LV + o_ + i); }
#define SC_STEP(ca, cw, cb, ck, cr, cv, Q)                                                                  \
    {                                                                                                       \
      float sa = S[0] * ca[0] + S[1] * ca[1] + S[2] * ca[2] + S[3] * ca[3];                                 \
      float sb = S1[0] * ca[0] + S1[1] * ca[1] + S1[2] * ca[2] + S1[3] * ca[3];                             \
      sa = sum16(sa); sb = sum16(sb);                                                                       \
      _Pragma("unroll") for (int c = 0; c < 4; ++c) { S[c] = S[c] * cw[c] + sa * cb[c] + cv[0] * ck[c]; S1[c] = S1[c] * cw[c] + sb * cb[c] + cv[1] * ck[c]; } \
      float o = S[0] * cr[0] + S[1] * cr[1] + S[2] * cr[2] + S[3] * cr[3];                                  \
      float o1 = S1[0] * cr[0] + S1[1] * cr[1] + S1[2] * cr[2] + S1[3] * cr[3];                             \
      o = sum16(o); o1 = sum16(o1);                                                                         \
      { half2v ov; ov[0] = (h16)o; ov[1] = (h16)o1; *(half2v*)(obuf + (Q) * 32 + wv * 8 + g * 2) = ov; }   \
    }
    f32x4 a4, w4, b4, k4, r4, a5, w5, b5, k5, r5; f32x2 vv, vv5;
    SC_LD(a4, w4, b4, k4, r4, vv, 0)
    for (int q = 0; q < SC_CT; q += 2) {
      SC_LD(a5, w5, b5, k5, r5, vv5, q + 1)
      SC_STEP(a4, w4, b4, k4, r4, vv, q)
      if (q + 2 < SC_CT) SC_LD(a4, w4, b4, k4, r4, vv, q + 2)
      SC_STEP(a5, w5, b5, k5, r5, vv5, q + 1)
    }
#undef SC_LD
#undef SC_STEP
  }
  __syncthreads();
  SC_FLUSH(T - SC_CT)
#undef SC_FLUSH
  if (ctx) {
    if (kind == 0) {
      float* so = p.orw + (((((long)bi) * 2 + l) * 2 + d) * 4 + h) * 4096;
      *(f32x4*)(so + i * 64 + j0) = S; *(f32x4*)(so + (i + 1) * 64 + j0) = S1;
    } else {
      float* so = p.odn + (((((long)bi) * 2 + l) * 2 + d) * 4 + h) * 4096;
#pragma unroll
      for (int c = 0; c < 4; ++c) { so[(j0 + c) * 64 + i] = S[c]; so[(j0 + c) * 64 + i + 1] = S1[c]; }
    }
  }
}
#undef SC_LOADG
__device__ void blk_fin(long w, const P& p, int l, const float* g2s, float* sgs) {
  const int tid_ = otid(); const int lane = tid_ & 63; const long token = w * 4 + (tid_ >> 6);
  float* sgw = sgs + (tid_ >> 6) * 64;
  const int c4 = lane * 4;
  const int hd = lane >> 4;
  const h16* pr = p.proj + token * INC;
  h16* ao = p.act + token * 1024;
  int t, T; long base; seqinfo(token, t, T, base);
  const bool sv0 = t > 0, sv1 = t < T - 1;
  const float bon0 = p.rwsc[((token * 2 + 0) * 4 + hd) * 2 + 1], bon1 = p.rwsc[((token * 2 + 1) * 4 + hd) * 2 + 1];
  const half4 vb = *(const half4*)(pr + RW_OFF + 512 + c4);
  half4 vm = vb, vp = vb;
  if (sv0) vm = *(const half4*)(pr - INC + RW_OFF + 512 + c4);
  if (sv1) vp = *(const half4*)(pr + INC + RW_OFF + 512 + c4);
  const half4 d_o0 = *(const half4*)(pr + DN_OFF + c4), d_o1 = *(const half4*)(pr + DN_OFF + 256 + c4);
  const half4 d_z = *(const half4*)(pr + DN_OFF + 784 + c4);
  const f32x4 mu0 = *(const f32x4*)(p.rwmu + ((long)l * 2 + 0) * 832 + 512 + c4), mu1 = *(const f32x4*)(p.rwmu + ((long)l * 2 + 1) * 832 + 512 + c4);
  const f32x4 lng = *(const f32x4*)(p.rwlng + l * 256 + c4), lnb = *(const f32x4*)(p.rwlnb + l * 256 + c4);
  const f32x4 dng = *(const f32x4*)(p.dnng + l * 64 + (c4 & 63));
  {
    half4 o0 = *(const half4*)(ao + 256 + c4), o1 = *(const half4*)(ao + 768 + c4);
    float o[4]; float mu = 0.f;
#pragma unroll
    for (int e = 0; e < 4; ++e) { o[e] = (float)o0[e] + (float)o1[e]; mu += o[e]; }
    mu = sum16(mu) * (1.0f / 64);
    float var = 0.f;
#pragma unroll
    for (int e = 0; e < 4; ++e) { float dl = o[e] - mu; var += dl * dl; }
    var = sum16(var) * (1.0f / 64);
    const float rs = 1.0f / sqrtf(var + 64e-5f);
    const float sg = sigmoidf_((float)pr[RW_OFF + 896 + lane]);
    float gate[4] = {0.f, 0.f, 0.f, 0.f};
    sgw[lane] = sg;
    __syncthreads();
#pragma unroll 8
    for (int j = 0; j < 64; ++j) {
      const float sj = sgw[j];
      const f32x4 g2 = *(const f32x4*)(g2s + j * 256 + c4);
#pragma unroll
      for (int e = 0; e < 4; ++e) gate[e] += sj * g2[e];
    }
    half4 out;
#pragma unroll
    for (int e = 0; e < 4; ++e) {
      const float b_ = (float)vb[e];
      const float v0 = b_ + ((sv0 ? (float)vm[e] : 0.f) - b_) * mu0[e];
      const float v1 = b_ + ((sv1 ? (float)vp[e] : 0.f) - b_) * mu1[e];
      float y = (o[e] - mu) * rs * lng[e] + lnb[e] + bon0 * v0 + bon1 * v1;
      out[e] = (h16)(y * gate[e]);
    }
    *(half4*)(ao + 256 + c4) = out;
  }
  {
    const half4 o0 = d_o0, o1 = d_o1, z = d_z;
    float o[4]; float ss = 0.f;
#pragma unroll
    for (int e = 0; e < 4; ++e) { o[e] = (float)o0[e] + (float)o1[e]; ss += o[e] * o[e]; }
    ss = sum16(ss);
    const float rs = 1.0f / sqrtf(ss * (1.0f / 64) + 1e-6f);
    half4 out;
#pragma unroll
    for (int e = 0; e < 4; ++e) out[e] = (h16)(o[e] * rs * dng[e] * siluf_((float)z[e]));
    *(half4*)(ao + 768 + c4) = out;
  }
}

__device__ __forceinline__ float dot8h(half8 u, half8 x, float d) {
#pragma unroll
  for (int e = 0; e < 8; ++e) d += (float)u[e] * (float)x[e];
  return d;
}
__device__ __forceinline__ void cvt8(const float* src, h16* dst, long i) {
  const f32x4 a = *(const f32x4*)(src + i * 8), b = *(const f32x4*)(src + i * 8 + 4);
  half8 o; o[0] = (h16)a[0]; o[1] = (h16)a[1]; o[2] = (h16)a[2]; o[3] = (h16)a[3]; o[4] = (h16)b[0]; o[5] = (h16)b[1]; o[6] = (h16)b[2]; o[7] = (h16)b[3];
  *(half8*)(dst + i * 8) = o;
}
__device__ __forceinline__ float sum64u(float x) {
  x = sum16(x);
  x += __builtin_bit_cast(float, __builtin_amdgcn_update_dpp(0, __builtin_bit_cast(int, x), 0x142, 0xA, 0xF, false));
  x += __builtin_bit_cast(float, __builtin_amdgcn_update_dpp(0, __builtin_bit_cast(int, x), 0x143, 0xC, 0xF, false));
  return __builtin_bit_cast(float, __builtin_amdgcn_readlane(__builtin_bit_cast(int, x), 63));
}
__device__ __forceinline__ float ferf(float x) {
  const float ax = fabsf(x);
  const float t = __frcp_rn(1.0f + 0.3275911f * ax);
  const float y = 1.0f - (((((1.061405429f * t - 1.453152027f) * t) + 1.421413741f) * t - 0.284496736f) * t + 0.254829592f) * t * __expf(-ax * ax);
  return x < 0.f ? -y : y;
}
__device__ __forceinline__ void cvt16_fp8(const float* src, unsigned char* dst, long i, float scale) {
  u32x4 o;
#pragma unroll
  for (int k = 0; k < 4; ++k) {
    const f32x4 a = *(const f32x4*)(src + i * 16 + k * 4);
    int w = __builtin_amdgcn_cvt_pk_fp8_f32(a[0] * scale, a[1] * scale, 0, false);
    w = __builtin_amdgcn_cvt_pk_fp8_f32(a[2] * scale, a[3] * scale, w, true);
    o[k] = (unsigned)w;
  }
  *(u32x4*)(dst + i * 16) = o;
}
__device__ void fin_phase(const P& p, int l) {
  float* g2s = (float*)g_smem;
  float* sgs = g2s + 64 * 256;
  const int tid = otid();
  __syncthreads();
  const f32x4* src = (const f32x4*)(p.rwg2 + (long)l * 64 * 256);
#pragma unroll
  for (int j = 0; j < 16; ++j) ((f32x4*)g2s)[tid + 256 * j] = src[tid + 256 * j];
  __syncthreads();
  for (long w = blockIdx.x; w < NT / 4; w += gridDim.x) blk_fin(w, p, l, g2s, sgs);
}
typedef unsigned u32x2 __attribute__((ext_vector_type(2)));
__device__ __forceinline__ void cvt16_fp4(const float* src, unsigned char* dst, long i, float scale) {
  u32x2 o;
#pragma unroll
  for (int k = 0; k < 2; ++k) {
    const f32x4 a = *(const f32x4*)(src + i * 16 + k * 8), b = *(const f32x4*)(src + i * 16 + k * 8 + 4);
    unsigned w = 0u;
    w = __builtin_amdgcn_cvt_scalef32_pk_fp4_f32(w, a[0] * scale, a[1] * scale, 1.0f, 0);
    w = __builtin_amdgcn_cvt_scalef32_pk_fp4_f32(w, a[2] * scale, a[3] * scale, 1.0f, 1);
    w = __builtin_amdgcn_cvt_scalef32_pk_fp4_f32(w, b[0] * scale, b[1] * scale, 1.0f, 2);
    w = __builtin_amdgcn_cvt_scalef32_pk_fp4_f32(w, b[2] * scale, b[3] * scale, 1.0f, 3);
    o[k] = w;
  }
  *(u32x2*)(dst + i * 8) = o;
}
#define PEER_USCALE 48.0f
#define PEER_VSCALE 16.0f
struct PairTab { int a[50]; int b[50]; };
__host__ __device__ constexpr PairTab make_pairs() {
  PairTab t{}; int n = 0;
  for (int a = 0; a < 16; ++a) for (int b = 0; b < 16; ++b) if ((a + 1) * (b + 1) <= 16) { t.a[n] = a; t.b[n] = b; ++n; }
  return t;
}
template <bool DRY>
__device__ void blk_peer(long w, const P& p, int l) {
  constexpr PairTab PT = make_pairs();
  const int tid_ = otid(); const int lane = tid_ & 63, wv = tid_ >> 6; const long token = w * 4 + wv;
  int* eidx = (int*)g_smem + wv * 256; float* egate = (float*)g_smem + wv * 256 + 128;
  const h16* xr = p.act + token * 1024 + lane * 16;
  const half8 x0 = *(const half8*)xr, x1 = *(const half8*)(xr + 8);
  int la = 0, lb = 0;
#pragma unroll
  for (int j = 0; j < 50; ++j) if (lane == j) { la = PT.a[j]; lb = PT.b[j]; }
  const int lc = la * 16 + lb;
  __syncthreads();
  float cs_[8]; int ce_[8];
#pragma unroll
  for (int hd = 0; hd < 8; ++hd) {
    const float* s1 = p.tks + token * 256 + hd * 32; const int* i1 = p.tki + token * 256 + hd * 32;
    const int la_ = lane < 50 ? la : 0, lb_ = lane < 50 ? lb : 0;
    cs_[hd] = s1[la_] + s1[16 + lb_]; ce_[hd] = i1[la_] * CFG_NKEYS + i1[16 + lb_];
  }
#pragma unroll
  for (int hd = 0; hd < 8; ++hd) {
    const float s = lane < 50 ? cs_[hd] : -3.0e38f;
    int rank = 0;
#pragma unroll
    for (int j = 0; j < 50; ++j) {
      const float sj = __builtin_bit_cast(float, __builtin_amdgcn_readlane(__builtin_bit_cast(int, s), j));
      rank += (sj > s) ? 1 : 0;
    }
    {
      int mk = (lane < 50 && rank < 16) ? (1 << rank) : 0;
      mk |= __builtin_amdgcn_update_dpp(0, mk, 0x128, 0xF, 0xF, true); mk |= __builtin_amdgcn_update_dpp(0, mk, 0x124, 0xF, 0xF, true);
      mk |= __builtin_amdgcn_update_dpp(0, mk, 0xB1, 0xF, 0xF, true);  mk |= __builtin_amdgcn_update_dpp(0, mk, 0x4E, 0xF, 0xF, true);
      const int mall = __builtin_amdgcn_readlane(mk, 0) | __builtin_amdgcn_readlane(mk, 16) | __builtin_amdgcn_readlane(mk, 32) | __builtin_amdgcn_readlane(mk, 48);
      const int nsel = __builtin_popcountll(__ballot(lane < 50 && rank < 16));
      if (mall != 0xFFFF || nsel != 16) {
        rank = 0;
#pragma unroll 1
        for (int j = 0; j < 50; ++j) {
          const float sj = __builtin_bit_cast(float, __builtin_amdgcn_readlane(__builtin_bit_cast(int, s), j));
          rank += (sj > s || (sj == s && j < lane)) ? 1 : 0;
        }
      }
    }
    const bool sel = lane < 50 && rank < 16;
    const float m = __builtin_bit_cast(float, __builtin_amdgcn_readlane(__builtin_bit_cast(int, s), 0));
    const float e = sel ? expf(s - m) : 0.f;
    const float sum = sum64(e);
    if (sel) { eidx[hd * 16 + rank] = ce_[hd]; egate[hd * 16 + rank] = e / sum; }
  }
  __syncthreads();
  f32x2 x2[8];
#pragma unroll
  for (int e = 0; e < 4; ++e) { x2[e][0] = (float)x0[2 * e]; x2[e][1] = (float)x0[2 * e + 1]; x2[4 + e][0] = (float)x1[2 * e]; x2[4 + e][1] = (float)x1[2 * e + 1]; }
  f32x2 acc2[8];
#pragma unroll
  for (int e = 0; e < 8; ++e) { acc2[e][0] = 0.f; acc2[e][1] = 0.f; }
  const unsigned char* u8 = (const unsigned char*)p.u16; const unsigned char* v8 = (const unsigned char*)p.v16;
#define PEER_LOAD(U, V, GT, EB)                                                                   \
  _Pragma("unroll") for (int q = 0; q < 8; ++q) {                                                 \
    const unsigned ro_ = (unsigned)eidx[(EB) + q] * 512u + (unsigned)lane * 8u; GT[q] = egate[(EB) + q];   \
    U[q] = *(const u32x2*)(u8 + ro_); V[q] = *(const u32x2*)(v8 + ro_);                           \
  }
#define PEER_COMP(U, V, GT)                                                                       \
  {                                                                                               \
    float dd_[8];                                                                                 \
    _Pragma("unroll") for (int q = 0; q < 8; ++q) {                                               \
      f32x2 d2 = {0.f, 0.f};                                                                      \
      _Pragma("unroll") for (int k = 0; k < 2; ++k) {                                             \
        d2 += __builtin_amdgcn_cvt_scalef32_pk_f32_fp4(U[q][k], 1.0f, 0) * x2[4 * k];             \
        d2 += __builtin_amdgcn_cvt_scalef32_pk_f32_fp4(U[q][k], 1.0f, 1) * x2[4 * k + 1];         \
        d2 += __builtin_amdgcn_cvt_scalef32_pk_f32_fp4(U[q][k], 1.0f, 2) * x2[4 * k + 2];         \
        d2 += __builtin_amdgcn_cvt_scalef32_pk_f32_fp4(U[q][k], 1.0f, 3) * x2[4 * k + 3];         \
      }                                                                                           \
      dd_[q] = sum64u(d2[0] + d2[1]) * (1.0f / PEER_USCALE);                                      \
    }                                                                                             \
      \
    float dv_ = dd_[7];                                                                           \
    _Pragma("unroll") for (int q = 6; q >= 0; --q) dv_ = lane == q ? dd_[q] : dv_;                \
    const float gv_ = 0.5f * dv_ * (1.0f + erff(dv_ * 0.70710678118654752f));                     \
    _Pragma("unroll") for (int q = 0; q < 8; ++q) {                                               \
      const float wgt = GT[q] * __builtin_bit_cast(float, __builtin_amdgcn_readlane(__builtin_bit_cast(int, gv_), q)) * (1.0f / PEER_VSCALE); \
      const f32x2 w2 = {wgt, wgt};                                                                \
      _Pragma("unroll") for (int k = 0; k < 2; ++k) {                                             \
        acc2[4 * k] += w2 * __builtin_amdgcn_cvt_scalef32_pk_f32_fp4(V[q][k], 1.0f, 0);           \
        acc2[4 * k + 1] += w2 * __builtin_amdgcn_cvt_scalef32_pk_f32_fp4(V[q][k], 1.0f, 1);       \
        acc2[4 * k + 2] += w2 * __builtin_amdgcn_cvt_scalef32_pk_f32_fp4(V[q][k], 1.0f, 2);       \
        acc2[4 * k + 3] += w2 * __builtin_amdgcn_cvt_scalef32_pk_f32_fp4(V[q][k], 1.0f, 3);       \
      }                                                                                           \
    }                                                                                             \
  }
  u32x2 au[8], av[8], bu[8], bv[8];
  float ag[8], bg[8];
  PEER_LOAD(au, av, ag, 0)
  for (int eb = 0; eb < 128; eb += 16) {
    PEER_LOAD(bu, bv, bg, eb + 8)
    __builtin_amdgcn_sched_barrier(0);
    PEER_COMP(au, av, ag)
    if (eb + 16 < 128) { PEER_LOAD(au, av, ag, eb + 16) }
    __builtin_amdgcn_sched_barrier(0);
    PEER_COMP(bu, bv, bg)
  }
#undef PEER_LOAD
#undef PEER_COMP
  const float* g2 = p.mod + ((long)l * NCOND + condrow(token)) * 6144 + 5120 + lane * 16;
  float* xo = p.X + token * 1024 + lane * 16;
  f32x4 xn[4]; float ssq = 0.f;
#pragma unroll
  for (int k = 0; k < 4; ++k) {
    xn[k] = *(f32x4*)(xo + 4 * k);
    const f32x4 ga = *(const f32x4*)(g2 + 4 * k);
#pragma unroll
    for (int e = 0; e < 4; ++e) { xn[k][e] += ga[e] * acc2[2 * k + (e >> 1)][e & 1]; ssq += xn[k][e] * xn[k][e]; }
  }
  if (DRY) { if (acc2[0][0] == 123456.789f) *(f32x4*)xo = xn[0]; return; }
  const float rstd = 1.0f / sqrtf(sum64u(ssq) * (1.0f / 1024) + 1e-6f);
  if (l == 0) {
    const float* m = p.mod + ((long)1 * NCOND + condrow(token)) * 6144 + lane * 16;
    const float* g = p.n1g + 1024 + lane * 16;
    half8 h0, h1;
    f32x4 gga[4], sha[4], sca[4];
#pragma unroll
    for (int k = 0; k < 4; ++k) { gga[k] = *(const f32x4*)(g + 4 * k); sha[k] = *(const f32x4*)(m + 4 * k); sca[k] = *(const f32x4*)(m + 1024 + 4 * k); }
#pragma unroll
    for (int k = 0; k < 4; ++k) {
      *(f32x4*)(xo + 4 * k) = xn[k];
      const f32x4 gg = gga[k], sh = sha[k], sc = sca[k];
#pragma unroll
      for (int e = 0; e < 4; ++e) {
        const h16 hv = (h16)((xn[k][e] * rstd * gg[e]) * (1.0f + sc[e]) + sh[e]);
        if (k < 2) h0[4 * k + e] = hv; else h1[4 * (k - 2) + e] = hv;
      }
    }
    h16* ho = p.act + token * 1024 + lane * 16;
    *(half8*)ho = h0; *(half8*)(ho + 8) = h1;
  } else {
    f32x4 fga[4];
#pragma unroll
    for (int k = 0; k < 4; ++k) fga[k] = *(const f32x4*)(p.fng + lane * 16 + 4 * k);
#pragma unroll
    for (int k = 0; k < 4; ++k) {
      const f32x4 gg = fga[k];
      f32x4 y;
#pragma unroll
      for (int e = 0; e < 4; ++e) y[e] = xn[k][e] * rstd * gg[e];
      *(f32x4*)(xo + 4 * k) = y;
    }
  }
}

__device__ void blk_attn(int type, int idx, const P& p, int l) {
  h16* Ks = (h16*)g_smem;
  h16* Vt = Ks + 64 * 72;
  float* Bt = (float*)(Vt + 64 * 72);
  const int tid = otid(), lane = tid & 63, wv = tid >> 6, ql = lane & 31, hh = lane >> 5;
  int b, hk, tb; long qtok; int qcol_off, kcol_off, vcol_off, outcol; float qscale; int ntl, ntc; long kbase_tok;
  const float *ck = nullptr, *cv = nullptr;
  int grow = 0, r0w = 0, krmin = 0;
  if (type == 0) {
    tb = idx & 3; hk = (idx >> 2) & 1; b = idx >> 3;
    const int head = hk * 2 + (wv & 1);
    kbase_tok = (long)b * CFG_SEQ; qtok = kbase_tok + tb * 64 + (wv >> 1) * 32 + ql;
    qcol_off = head * 64; kcol_off = 256 + hk * 64; vcol_off = 384 + hk * 64; outcol = head * 64; qscale = 1.0f; ntl = CFG_SEQ / 64; ntc = 0;
  } else if (type == 1) {
    tb = idx & 63; hk = (idx >> 6) & 1; b = idx >> 7;
    const int head = hk * 2 + (wv & 1);
    kbase_tok = (long)NTC + (long)b * CFG_DS; qtok = kbase_tok + tb * 64 + (wv >> 1) * 32 + ql;
    qcol_off = head * 64; kcol_off = 256 + hk * 64; vcol_off = 384 + hk * 64; outcol = head * 64; qscale = 1.0f; ntl = CFG_DS / 64; ntc = CFG_PAST / 64;
    ck = p.cgk + (((long)b * 2 + l) * 2 + hk) * CFG_PAST * 64; cv = p.cgv + (((long)b * 2 + l) * 2 + hk) * CFG_PAST * 64;
  } else if (type == 2) {
    tb = idx & 1; hk = (idx >> 1) & 3; b = idx >> 3;
    kbase_tok = (long)b * CFG_SEQ; qtok = kbase_tok + tb * 128 + wv * 32 + ql;
    qcol_off = NA_OFF + hk * 64; kcol_off = NA_OFF + 256 + hk * 64; vcol_off = NA_OFF + 512 + hk * 64; outcol = 512 + hk * 64; qscale = 0.125f; ntl = CFG_SEQ / 64; ntc = 0;
  } else {
    tb = idx & 31; hk = (idx >> 5) & 3; b = idx >> 7;
    kbase_tok = (long)NTC + (long)b * CFG_DS;
    grow = tb * 2 + (wv >> 1);
    qtok = kbase_tok + grow * 64 + (wv & 1) * 32 + ql;
    qcol_off = NA_OFF + hk * 64; kcol_off = NA_OFF + 256 + hk * 64; vcol_off = NA_OFF + 512 + hk * 64; outcol = 512 + hk * 64; qscale = 0.125f;
    r0w = grow - WR / 2; r0w = r0w < 0 ? 0 : (r0w > GROWS - WR ? GROWS - WR : r0w);
    int ra = tb * 2 - WR / 2; ra = ra < 0 ? 0 : (ra > GROWS - WR ? GROWS - WR : ra);
    int rb = tb * 2 + 1 - WR / 2; rb = rb < 0 ? 0 : (rb > GROWS - WR ? GROWS - WR : rb);
    krmin = ra; ntl = rb + WR - ra; ntc = CFG_PAST / 64;
    ck = p.cnk + (((long)b * 2 + l) * 4 + hk) * CFG_PAST * 64; cv = p.cnv + (((long)b * 2 + l) * 4 + hk) * CFG_PAST * 64;
  }
  const int nt = ntl + ntc;
  __syncthreads();
  if (type == 3) { for (int e = tid; e < 465; e += 256) Bt[e] = p.nabias[((long)l * 4 + hk) * 465 + e]; }
  half8 qf[4];
  {
    const h16* qp = p.proj + qtok * INC + qcol_off + hh * 8;
#pragma unroll
    for (int ds = 0; ds < 4; ++ds) qf[ds] = *(const half8*)(qp + ds * 16);
  }
  const int qc = (int)((qtok - kbase_tok) & 63);
  int cst = qc - 8; cst = cst < 0 ? 0 : (cst > 48 ? 48 : cst);
  f32x16 o0 = {0.f, 0.f, 0.f, 0.f, 0.f, 0.f, 0.f, 0.f, 0.f, 0.f, 0.f, 0.f, 0.f, 0.f, 0.f, 0.f};
  f32x16 o1 = o0;
  float m = -1.0e30f, lsum = 0.f;
  half8 kx0, kx1, vx0, vx1;
  const int skey0 = tid >> 3, sdc = tid & 7;
#define ATT_LOAD(TI)                                                                                       \
  {                                                                                                        \
    const int ti_ = (TI);                                                                                  \
    if (ti_ < ntc) {                                                                                       \
      const float* kk_ = ck + ((long)ti_ * 64 + skey0) * 64 + sdc * 8;                                     \
      const float* vv_ = cv + ((long)ti_ * 64 + skey0) * 64 + sdc * 8;                                     \
      f32x4 a_ = *(const f32x4*)kk_, b_ = *(const f32x4*)(kk_ + 4), c_ = *(const f32x4*)(kk_ + 2048), d_ = *(const f32x4*)(kk_ + 2052); \
      _Pragma("unroll") for (int e = 0; e < 4; ++e) { kx0[e] = (h16)a_[e]; kx0[4 + e] = (h16)b_[e]; kx1[e] = (h16)c_[e]; kx1[4 + e] = (h16)d_[e]; } \
      a_ = *(const f32x4*)vv_; b_ = *(const f32x4*)(vv_ + 4); c_ = *(const f32x4*)(vv_ + 2048); d_ = *(const f32x4*)(vv_ + 2052); \
      _Pragma("unroll") for (int e = 0; e < 4; ++e) { vx0[e] = (h16)a_[e]; vx0[4 + e] = (h16)b_[e]; vx1[e] = (h16)c_[e]; vx1[4 + e] = (h16)d_[e]; } \
    } else {                                                                                               \
      const long t0_ = kbase_tok + (long)((type == 3 ? krmin : 0) + (ti_ - ntc)) * 64;                     \
      const h16* r_ = p.proj + (t0_ + skey0) * INC + sdc * 8;                                              \
      kx0 = *(const half8*)(r_ + kcol_off); kx1 = *(const half8*)(r_ + 32 * INC + kcol_off);              \
      vx0 = *(const half8*)(r_ + vcol_off); vx1 = *(const half8*)(r_ + 32 * INC + vcol_off);              \
    }                                                                                                      \
  }
  ATT_LOAD(0)
  for (int ti = 0; ti < nt; ++ti) {
    __syncthreads();
    *(half8*)(Ks + skey0 * 72 + sdc * 8) = kx0; *(half8*)(Ks + (skey0 + 32) * 72 + sdc * 8) = kx1;
    *(half8*)(Vt + skey0 * 72 + sdc * 8) = vx0; *(half8*)(Vt + (skey0 + 32) * 72 + sdc * 8) = vx1;
    __syncthreads();
    if (ti + 1 < nt) ATT_LOAD(ti + 1)
    __builtin_amdgcn_sched_barrier(0);
    const bool local = type == 3 && ti >= ntc;
    const int kr = krmin + (ti - ntc);
    if (local && (kr < r0w || kr >= r0w + WR)) continue;
    f32x16 s0 = {0.f, 0.f, 0.f, 0.f, 0.f, 0.f, 0.f, 0.f, 0.f, 0.f, 0.f, 0.f, 0.f, 0.f, 0.f, 0.f};
    f32x16 s1 = s0;
#pragma unroll
    for (int ds = 0; ds < 4; ++ds) {
      const half8 a0 = *(const half8*)(Ks + ql * 72 + ds * 16 + hh * 8);
      const half8 a1 = *(const half8*)(Ks + (32 + ql) * 72 + ds * 16 + hh * 8);
      s0 = __builtin_amdgcn_mfma_f32_32x32x16_f16(a0, qf[ds], s0, 0, 0, 0);
      s1 = __builtin_amdgcn_mfma_f32_32x32x16_f16(a1, qf[ds], s1, 0, 0, 0);
    }
    float mx = -1.0e30f;
    if (local) {
      const float* brow = Bt + (kr - grow + 7) * 31 + 15 - qc;
#pragma unroll
      for (int i = 0; i < 16; ++i) {
        const int kc0 = (i & 3) + 8 * (i >> 2) + 4 * hh, kc1 = kc0 + 32;
        s0[i] = (kc0 >= cst && kc0 < cst + 16) ? s0[i] * 0.125f + brow[kc0] : -1.0e30f;
        s1[i] = (kc1 >= cst && kc1 < cst + 16) ? s1[i] * 0.125f + brow[kc1] : -1.0e30f;
      }
    } else if (qscale != 1.0f) {
#pragma unroll
      for (int i = 0; i < 16; ++i) { s0[i] *= qscale; s1[i] *= qscale; }
    }
#pragma unroll
    for (int i = 0; i < 16; ++i) mx = fmaxf(mx, fmaxf(s0[i], s1[i]));
    mx = fmaxf(mx, __shfl_xor(mx, 32));
    const float mn = fmaxf(m, mx);
    const float alpha = __expf(m - mn);
    m = mn; lsum *= alpha;
#pragma unroll
    for (int i = 0; i < 16; ++i) { o0[i] *= alpha; o1[i] *= alpha; }
    float ps = 0.f;
#pragma unroll
    for (int i = 0; i < 16; ++i) { s0[i] = __expf(s0[i] - mn); s1[i] = __expf(s1[i] - mn); ps += s0[i] + s1[i]; }
    lsum += ps;
    half8 pf0, pf1, pf2, pf3;
#pragma unroll
    for (int j = 0; j < 8; ++j) { pf0[j] = (h16)s0[j]; pf1[j] = (h16)s0[8 + j]; pf2[j] = (h16)s1[j]; pf3[j] = (h16)s1[8 + j]; }
#define TRD(ptr) __builtin_bit_cast(half4, __builtin_amdgcn_ds_read_tr16_b64_v4i16((__attribute__((address_space(3))) s16x4v*)(ptr)))
#define ATT_PV(KS, PF)                                                                              \
    {                                                                                               \
        \
      const h16* v0_ = Vt + (16 * (KS) + 4 * hh + ((lane & 15) >> 2)) * 72 + 16 * ((lane >> 4) & 1) + 4 * (lane & 3); \
      const half4 lo0 = TRD(v0_), hi0 = TRD(v0_ + 8 * 72);                                          \
      const half4 lo1 = TRD(v0_ + 32), hi1 = TRD(v0_ + 8 * 72 + 32);                                \
      const half8 a0_ = __builtin_shufflevector(lo0, hi0, 0, 1, 2, 3, 4, 5, 6, 7);                  \
      const half8 a1_ = __builtin_shufflevector(lo1, hi1, 0, 1, 2, 3, 4, 5, 6, 7);                  \
      o0 = __builtin_amdgcn_mfma_f32_32x32x16_f16(a0_, PF, o0, 0, 0, 0);                            \
      o1 = __builtin_amdgcn_mfma_f32_32x32x16_f16(a1_, PF, o1, 0, 0, 0);                            \
    }
    ATT_PV(0, pf0) ATT_PV(1, pf1) ATT_PV(2, pf2) ATT_PV(3, pf3)
#undef ATT_PV
#undef TRD
  }
#undef ATT_LOAD
  lsum += __shfl_xor(lsum, 32);
  const float inv = 1.0f / lsum;
  h16* op = p.act + qtok * 1024 + outcol;
#pragma unroll
  for (int g = 0; g < 4; ++g) {
    half4 a, c;
#pragma unroll
    for (int e = 0; e < 4; ++e) { a[e] = (h16)(o0[4 * g + e] * inv); c[e] = (h16)(o1[4 * g + e] * inv); }
    *(half4*)(op + 8 * g + 4 * hh) = a;
    *(half4*)(op + 32 + 8 * g + 4 * hh) = c;
  }
}
#define N_SCAN_LAT (2 * 2 * CFG_DB * 4 * 2)
#define N_SCAN_CTX (2 * 2 * CFG_BATCH * 4 * 2)
#define N_ATT1 (CFG_DB * 2 * (CFG_DS / 64))
#define N_ATT3 (CFG_DB * 4 * (CFG_DS / 128))
#define N_ATT0 (CFG_BATCH * 2 * (CFG_SEQ / 64))
#define N_ATT2 (CFG_BATCH * 4 * (CFG_SEQ / 128))
__device__ __forceinline__ void run_scan_item(int r, bool latent, const P& p, int l) {
  const int rq = r & 1; r >>= 1; const int kind = r & 1; r >>= 1; const int d = r & 1; r >>= 1; const int h = r & 3; r >>= 2;
  if (latent) __builtin_amdgcn_s_setprio(3);
  blk_scan2(kind, latent ? CFG_BATCH + r : r, h, d, rq, p, l);
  if (latent) __builtin_amdgcn_s_setprio(0);
}
__device__ void mixer_phase(const P& p, int lc, int mode = 0) {
  const int l = lc & 1;
  __shared__ long s_item;
  __shared__ unsigned s_slot;
  const long total = N_SCAN_CTX + N_ATT1 + N_ATT3 + N_ATT0 + N_ATT2;
  unsigned* lat_cnt = p.counters + 8 + lc;
  if (mode == 0) {
    __syncthreads();
    if (threadIdx.x == 0) {
      const unsigned hw = __builtin_amdgcn_s_getreg((31 << 11) | 4);
      const unsigned xcc = __builtin_amdgcn_s_getreg((3 << 11) | 20) & 0xFu;
      const unsigned key = (xcc << 8) | ((hw >> 8) & 0xFFu);
      const unsigned slot = atomicAdd(p.cucnt + lc * 4096 + key, 1u);
      s_slot = slot;
      s_item = slot == 0 ? (long)atomicAdd(lat_cnt, 1u) : (long)N_SCAN_LAT;
    }
    __syncthreads();
    const long w = s_item;
    if (w < N_SCAN_LAT) run_scan_item((int)w, true, p, l);
  }
  for (;;) {
    __syncthreads();
    if (threadIdx.x == 0) s_item = (long)atomicAdd(p.counters + lc, 1u);
    __syncthreads();
    long w = s_item;
    if (mode == 2) w += N_SCAN_CTX;
    if (w >= (mode == 1 ? (long)N_SCAN_CTX : total)) break;
    if (w < N_SCAN_CTX) {
      run_scan_item((int)w, false, p, l);
    } else {
      int a = (int)(w - N_SCAN_CTX);
      int ty;
      if (a < N_ATT1) ty = 1;
      else if ((a -= N_ATT1) < N_ATT3) ty = 3;
      else if ((a -= N_ATT3) < N_ATT0) ty = 0;
      else { a -= N_ATT0; ty = 2; }
      blk_attn(ty, a, p, l);
    }
  }
  if (mode != 2) {
    for (;;) {
      __syncthreads();
      if (threadIdx.x == 0) s_item = (long)atomicAdd(lat_cnt, 1u);
      __syncthreads();
      const long w = s_item;
      if (w >= N_SCAN_LAT) break;
      run_scan_item((int)w, true, p, l);
    }
  }
}


#define XB_TMO      128
#define XB_XCNT(j)  (256  + 64 * (j))
#define XB_XSUB(j)  (1280 + 64 * (j))
#define XB_XGEN(j)  (2304 + 64 * (j))
#define XB_TOP      3328
#define XB_TOPGEN   3392
#define XCD_BAR_WORDS 3456
#define XB_SPIN_CAP (1u << 22)
#define LAS __attribute__((address_space(3)))
__device__ __forceinline__ unsigned xb_ld(unsigned* p)              { return __hip_atomic_load(p, __ATOMIC_RELAXED, __HIP_MEMORY_SCOPE_AGENT); }
__device__ __forceinline__ unsigned xb_add(unsigned* p, unsigned v) { return __hip_atomic_fetch_add(p, v, __ATOMIC_RELAXED, __HIP_MEMORY_SCOPE_AGENT); }
__device__ __forceinline__ unsigned xb_xcc_id() { return (unsigned)__builtin_amdgcn_s_getreg((3 << 11) | 20) & 0xFu; }
#define XB_SPIN(cond, bar) do { unsigned _sp = 0; while (cond) { __builtin_amdgcn_s_sleep(1); \
    if ((++_sp & 255u) == 0u) { if (xb_ld(&(bar)[XB_TMO])) break; if (_sp > XB_SPIN_CAP) { atomicAdd(&(bar)[XB_TMO], 1u); break; } } } } while (0)
struct XcdBarrier { unsigned* bar; unsigned x; volatile LAS unsigned* st; };
__device__ __forceinline__ XcdBarrier xcd_barrier_post(unsigned* bar, volatile LAS unsigned* st) {
  XcdBarrier b; b.bar = bar; b.x = xb_xcc_id(); b.st = st;
  if (threadIdx.x == 0) (void)xb_add(&bar[XB_XCNT(b.x)], 1u);
  return b;
}
__device__ __forceinline__ void xcd_barrier_complete(unsigned* bar, unsigned x, unsigned& nloc, unsigned& nx) {
  const unsigned G = gridDim.x * gridDim.y * gridDim.z;
  unsigned sum, cnt, mine, sp = 0u;
  for (;;) {
    sum = 0u; cnt = 0u; mine = 0u;
#pragma unroll
    for (unsigned j = 0; j < 16; ++j) { const unsigned c = xb_ld(&bar[XB_XCNT(j)]); sum += c; cnt += (c > 0u) ? 1u : 0u; mine = (j == x) ? c : mine; }
    if (sum == G) break;
    __builtin_amdgcn_s_sleep(1);
    if ((++sp & 255u) == 0u) { if (xb_ld(&bar[XB_TMO])) break; if (sp > XB_SPIN_CAP) { atomicAdd(&bar[XB_TMO], 1u); break; } }
  }
  nloc = mine > 0u ? mine : 1u; nx = cnt > 0u ? cnt : 1u;
}
__device__ __forceinline__ void xcd_barrier(const XcdBarrier& b) {
  asm volatile("s_waitcnt vmcnt(0)" ::: "memory");
  __syncthreads();
  if (threadIdx.x == 0) {
    unsigned* bar = b.bar;
    __builtin_amdgcn_s_waitcnt(0);
    unsigned nloc = b.st[0], nx = b.st[1];
    if (nloc == 0u) { xcd_barrier_complete(bar, b.x, nloc, nx); b.st[0] = nloc; b.st[1] = nx; }
    const unsigned old = xb_add(&bar[XB_XSUB(b.x)], 1u);
    const unsigned gen = old / nloc;
    if (old + 1u == (gen + 1u) * nloc) {
      __builtin_amdgcn_fence(__ATOMIC_RELEASE, "agent");
      asm volatile("s_waitcnt vmcnt(0)" ::: "memory");
      const unsigned og = xb_add(&bar[XB_TOP], 1u);
      const unsigned tg = og / nx;
      if (og + 1u == (tg + 1u) * nx) xb_add(&bar[XB_TOPGEN], 1u);
      else XB_SPIN(xb_ld(&bar[XB_TOPGEN]) == tg, bar);
      __builtin_amdgcn_fence(__ATOMIC_ACQUIRE, "agent");
      xb_add(&bar[XB_XGEN(b.x)], 1u);
      asm volatile("s_waitcnt vmcnt(0)" ::: "memory");
    } else {
      XB_SPIN(xb_ld(&bar[XB_XGEN(b.x)]) == gen, bar);
      __builtin_amdgcn_fence(__ATOMIC_ACQUIRE, "agent");
      asm volatile("s_waitcnt vmcnt(0)" ::: "memory");
    }
  }
  __syncthreads();
}

#define STAGE(fn, n) for (long i_ = (long)blockIdx.x * 256 + otid(); i_ < (long)(n); i_ += (long)gridDim.x * 256) fn(i_, p, l);
#define BSTAGE(fn, n) for (long w_ = blockIdx.x; w_ < (long)(n); w_ += gridDim.x) fn(w_, p, l);
#define SYNC { XcdBarrier xb_; xb_.bar = p.xbar; xb_.x = xb_xcc_id(); xb_.st = (volatile LAS unsigned*)&xb_words; xcd_barrier(xb_); }
__global__ void __launch_bounds__(256, 2) mega(P p) {
  cg::grid_group grid = cg::this_grid();
  __shared__ uint4 xb_words;
  if (threadIdx.x == 0) xb_words = make_uint4(0u, 0u, 0u, 0u);
  __syncthreads();
  (void)xcd_barrier_post(p.xbar, (volatile LAS unsigned*)&xb_words);
#define gtid ((long)blockIdx.x * 256 + otid())
#define gstride ((long)gridDim.x * 256)
  { int l = 0;
    if (gtid < 16) p.counters[gtid] = 0u;
    for (long i_ = gtid; i_ < 4 * 4096; i_ += gstride) p.cucnt[i_] = 0u;
    for (int rep_ = 0; rep_ < REP_S0; ++rep_) {
    for (long w_ = blockIdx.x; w_ < 3200; w_ += gridDim.x) blk_convert(w_, p);
    for (long w_ = blockIdx.x; w_ < 2L * NCOND * 24; w_ += gridDim.x) blk_mod(w_, p);
    for (long i_ = gtid; i_ < 2L * 16 * CFG_NKEYS * 128 / 8; i_ += gstride) cvt8(p.pkeys, p.keys16, i_);
    }
  }
  grid.sync();
#pragma unroll 1
  for (int ph = 0; ph < 18; ++ph) {
    const int l = ph >= 9 ? 1 : 0; const int k = ph - 9 * l;
    if (k == 0 && l == 1) continue;
    switch (k) {
      case 0: { BSTAGE(blk_norm<0>, NT / 4) } break;
      case 1: gemm_phase<0>(p, l); break;
      case 2: {
        STAGE(b_prep_gqa, (long)NT * 6)
        STAGE(b_prep_cache, (long)NTC * 640)
        half8 bf0 = {0, 0, 0, 0, 0, 0, 0, 0}, bf1 = bf0; int bkey = -1;
        for (long w_ = blockIdx.x; w_ < (long)N_PREP_RW + N_PREP_DN; w_ += gridDim.x) blk_scanprep(w_, p, l, bf0, bf1, bkey);
      } break;
      case 3:
#ifdef PROBE_MIXER2
        mixer_phase(p, l + 2); SYNC
#endif
        mixer_phase(p, l); break;
      case 4: fin_phase(p, l); break;
      case 5: {
        gemm_phase<1>(p, l);
        for (long i_ = gtid; i_ < (long)NEXP * 1024 / 16; i_ += gstride) {
          cvt16_fp4(p.pu + (long)l * NEXP * 1024, (unsigned char*)p.u16, i_, PEER_USCALE);
          cvt16_fp4(p.pv + (long)l * NEXP * 1024, (unsigned char*)p.v16, i_, PEER_VSCALE);
        }
      } break;
      case 6: { BSTAGE(blk_norm<1>, NT / 4) } break;
      case 7: gemm_phase<2>(p, l); break;
      default: { BSTAGE(blk_peer<false>, NT / 4) } break;
    }
    if (ph != 17) SYNC
  }
}
#else
#define STAGE(fn, n) { _Pragma("omp parallel for schedule(dynamic, 64)") for (long i_ = 0; i_ < (long)(n); ++i_) fn(i_, p, l); }
#define SYNC
void mega(P p) {
  { int l = 0;
    STAGE(b_init, (long)NT * 1024)
    STAGE(b_mod, 2L * NCOND * 6144)
  }
  for (int l = 0; l < 2; ++l) {
    STAGE(b_norm<0>, NT)
    STAGE(b_inproj, (long)NT * INC)
    STAGE(b_prep_gqa, (long)NT * 6)
    STAGE(b_prep_cache, (long)NTC * 640)
    STAGE(b_rwaux, (long)NT * 512)
    STAGE(b_dnconv, (long)NT * 768)
    STAGE(b_dnnorm, (long)NT * 8)
    STAGE(b_rwscan, NSCAN)
    STAGE(b_dnscan, NSCAN)
    STAGE(b_attn_gqa, (long)NT * 4)
    STAGE(b_attn_na, (long)NT * 4)
    STAGE(b_rwfin, (long)NT * 4)
    STAGE(b_dnfin, (long)NT * 4)
    STAGE(b_outproj, (long)NT * 1024)
    STAGE(b_norm<1>, NT)
    STAGE(b_peerq, (long)NT * 2048)
    STAGE(b_topk1, (long)NT * 16)
    STAGE(b_topk2, (long)NT * 8)
    STAGE(b_peer_act, (long)NT * 128)
    STAGE(b_peer_out, (long)NT * 1024)
  }
  { int l = 0; STAGE(b_final, NT) }
}
#endif

static void fill_params(P& p, void* const* d_in, void* d_out, void* d_ws) {
  const float** f = (const float**)&p;
  for (int i = 0; i < 39; ++i) f[i] = (const float*)d_in[i];
  float* o = (float*)d_out;
  p.X = o; o += (long)NT * 1024;
  p.ogk = o; o += (long)CFG_BATCH * 2 * 2 * CFG_SEQ * 64;
  p.ogv = o; o += (long)CFG_BATCH * 2 * 2 * CFG_SEQ * 64;
  p.onk = o; o += (long)CFG_BATCH * 2 * 4 * CFG_SEQ * 64;
  p.onv = o; o += (long)CFG_BATCH * 2 * 4 * CFG_SEQ * 64;
  p.orw = o; o += (long)CFG_BATCH * 2 * 2 * 4 * 4096;
  p.odn = o;
  char* w = (char*)d_ws;
  auto take = [&](size_t bytes) { char* r = w; w += (bytes + 255) & ~(size_t)255; return r; };
  p.xbar = (unsigned*)take(16384);
  p.counters = (unsigned*)take(256);
  p.cucnt = (unsigned*)take(4 * 4096 * 4);
  p.mod = (float*)take(2L * NCOND * 6144 * 4);
  p.act = (h16*)take((size_t)NT * 1024 * sizeof(h16));
  p.rwaux = (h16*)take((size_t)NT * 1024 * sizeof(h16));
  p.dnp = (h16*)take((size_t)NT * 768 * sizeof(h16));
  p.proj = (h16*)take((size_t)NT * INC * sizeof(h16));
  p.wtin = (h16*)take((size_t)2 * NPAD_IN * 1024 * sizeof(h16));
  p.wtout = (h16*)take((size_t)2 * 1024 * 1024 * sizeof(h16));
  p.wtq = (h16*)take((size_t)2 * 2048 * 1024 * sizeof(h16));
  p.rwsc = (float*)take((size_t)NT * 16 * 4);
  p.dnsc = (float*)take((size_t)NT * 16 * 4);
  p.keys16 = (h16*)take((size_t)2 * 16 * CFG_NKEYS * 128 * sizeof(h16));
  char* a = (char*)p.proj;
#ifdef HOST_EMU
  p.pq = (h16*)a; a += (size_t)NT * 2048 * sizeof(h16);
#endif
  p.tks = (float*)a; a += (size_t)NT * 256 * 4;
  p.tki = (int*)a; a += (size_t)NT * 256 * 4;
  p.u16 = (h16*)a; a += (size_t)NEXP * 1024 * sizeof(h16);
  p.v16 = (h16*)a; a += (size_t)NEXP * 1024 * sizeof(h16);
  p.pidx = (int*)p.rwaux;
  p.pact = (float*)((char*)p.rwaux + (size_t)NT * 128 * 4);
}

#ifndef HOST_EMU
extern "C" void kernel_launch(void* const* d_in, const int* in_sizes, int n_in, void* d_out, int out_size, void* d_ws,
                              size_t ws_size, hipStream_t stream) {
  static int grid_blocks = 0;
  if (!grid_blocks) {
    int dev = 0, cus = 0, per_cu = 0;
    (void)hipGetDevice(&dev);
    (void)hipDeviceGetAttribute(&cus, hipDeviceAttributeMultiprocessorCount, dev);
    (void)hipOccupancyMaxActiveBlocksPerMultiprocessor(&per_cu, mega, 256, 0);
    grid_blocks = cus * per_cu;
  }
  P p;
  memset(&p, 0, sizeof(p));
  fill_params(p, d_in, d_out, d_ws);
  (void)hipMemsetAsync(p.xbar, 0, 16384, stream);
  void* args[] = {&p};
  hipError_t e = hipLaunchCooperativeKernel((void*)mega, dim3(grid_blocks), dim3(256), args, 0, stream);
  if (e != hipSuccess) fprintf(stderr, "cooperative launch failed: %s (grid %d)\n", hipGetErrorString(e), grid_blocks);
}
#endif
```

```cpp
#ifndef HOST_EMU
#include <hip/hip_runtime.h>
#include <hip/hip_cooperative_groups.h>
namespace cg = cooperative_groups;
#define HD __device__ __forceinline__
#define HDN __device__ __noinline__
typedef _Float16 h16;
#define CBAR asm volatile("" ::: "memory")
#define SMEM_BYTES 73728
__shared__ __attribute__((aligned(16))) char g_smem[SMEM_BYTES];
__device__ __forceinline__ int otid() { int t = threadIdx.x; asm volatile("" : "+v"(t)); return t; }
#define FSIN(x) __sinf(x)
#define FCOS(x) __cosf(x)
#else
#include <cmath>
#include <cstring>
#define HD static inline
#define HDN static
typedef float h16;
#define CBAR
#define FSIN(x) sinf(x)
#define FCOS(x) cosf(x)
#endif
#include <cstdio>
#include <cstring>

#ifndef CFG_BATCH
#define CFG_BATCH 32
#define CFG_SEQ 256
#define CFG_DB 8
#define CFG_DS 4096
#define CFG_PAST 512
#define CFG_NKEYS 128
#endif

#define NTC (CFG_BATCH * CFG_SEQ)
#define NTL (CFG_DB * CFG_DS)
#define NT (NTC + NTL)
#define NCOND (1 + CFG_DB)
#define GROWS (CFG_DS / 64)
#define WR (GROWS < 8 ? GROWS : 8)
#define NEXP (CFG_NKEYS * CFG_NKEYS)
#define INC 3280
#define RW_OFF 512
#define NA_OFF 1472
#define DN_OFF 2240

struct P {
  const float *xp, *xs, *c, *cgk, *cgv, *cnk, *cnv, *srw, *sdn, *cctx, *n1g, *n2g, *wmod, *bmod, *win, *wout,
      *gqn, *gkn, *rwmu, *rww0, *rww2, *rwa0, *rwa2, *rwg2, *rwkk, *rwka, *rwrk, *rwlng, *rwlnb, *nabias,
      *dnconv, *dnalog, *dndt, *dnng, *pwq, *pkeys, *pu, *pv, *fng;
  float *X, *ogk, *ogv, *onk, *onv, *orw, *odn;
  float* mod;
  h16* act;
  h16* proj;
  h16* rwaux;
  h16* dnp;
  h16* pq;
  float* tks;
  int* tki;
  int* pidx;
  float* pact;
  unsigned* counters;
  unsigned* xbar;
  unsigned* cucnt;
  h16 *keys16, *u16, *v16;
  float *rwsc, *dnsc;
  h16 *wtin, *wtout, *wtq;
};

HD float sigmoidf_(float x) { return 1.0f / (1.0f + expf(-x)); }
HD float siluf_(float x) { return x * sigmoidf_(x); }
HD float softplusf_(float x) { return fmaxf(x, 0.0f) + log1pf(expf(-fabsf(x))); }
HD int condrow(long token) { return token < NTC ? 0 : 1 + (int)((token - NTC) / CFG_DS); }
HD void seqinfo(long token, int& t, int& T, long& base) {
  if (token < NTC) { T = CFG_SEQ; t = (int)(token % CFG_SEQ); base = token - t; }
  else { long u = token - NTC; T = CFG_DS; t = (int)(u % CFG_DS); base = token - t; }
}

HD void b_init(long i, const P& p, int l) {
  p.X[i] = (i < (long)NTC * 1024) ? p.xp[i] : p.xs[i - (long)NTC * 1024];
}
HD void b_mod(long i, const P& p, int) {
  int col = (int)(i % 6144); int r = (int)((i / 6144) % NCOND); int l = (int)(i / (6144L * NCOND));
  const float* cond = r == 0 ? p.cctx : p.c + (long)(r - 1) * 1024;
  float acc = p.bmod[l * 6144 + col];
  for (int k = 0; k < 1024; ++k) acc += siluf_(cond[k]) * p.wmod[((long)l * 1024 + k) * 6144 + col];
  p.mod[i] = acc;
}
template <int WHICH>
HD void b_norm(long i, const P& p, int l) {
  const float* x = p.X + i * 1024;
  float ss = 0.f;
  for (int k = 0; k < 1024; ++k) ss += x[k] * x[k];
  float rstd = 1.0f / sqrtf(ss * (1.0f / 1024) + 1e-6f);
  const float* m = p.mod + ((long)l * NCOND + condrow(i)) * 6144 + (WHICH ? 3072 : 0);
  const float* g = (WHICH ? p.n2g : p.n1g) + l * 1024;
  for (int k = 0; k < 1024; ++k) p.act[i * 1024 + k] = (h16)((x[k] * rstd * g[k]) * (1.0f + m[1024 + k]) + m[k]);
}
HD void b_prep_gqa(long i, const P& p, int l) {
  long token = i / 6; int slot = (int)(i % 6);
  h16* x = p.proj + token * INC + slot * 64;
  float y[64]; float ss = 0.f;
#pragma unroll
  for (int d = 0; d < 64; ++d) { y[d] = (float)x[d]; ss += y[d] * y[d]; }
  float rstd = 1.0f / sqrtf(ss * (1.0f / 64) + 1e-6f);
  const float* g = (slot < 4 ? p.gqn : p.gkn) + l * 64;
#pragma unroll
  for (int d = 0; d < 64; ++d) y[d] = y[d] * rstd * g[d];
  if (token >= NTC) {
    int t = (int)((token - NTC) % CFG_DS); int row = t / 64, colp = t % 64;
#pragma unroll
    for (int j = 0; j < 32; ++j) {
      float inv = exp2f(-(float)(j % 16) * 0.83048202372184059f);
      float ang = (float)(j < 16 ? row : colp) * inv;
      float cs = FCOS(ang), sn = FSIN(ang);
      float a = y[j], b = y[j + 32];
      y[j] = a * cs - b * sn; y[j + 32] = b * cs + a * sn;
    }
  } else if (slot >= 4) {
    int b = (int)(token / CFG_SEQ), t = (int)(token % CFG_SEQ);
    float* o = p.ogk + ((((long)b * 2 + l) * 2 + (slot - 4)) * CFG_SEQ + t) * 64;
#pragma unroll
    for (int d = 0; d < 64; ++d) o[d] = y[d];
  }
  float sc = slot < 4 ? 0.125f : 1.0f;
#pragma unroll
  for (int d = 0; d < 64; ++d) x[d] = (h16)(y[d] * sc);
}
HD void b_prep_cache(long i, const P& p, int l) {
  long token = i / 640; int e = (int)(i % 640);
  int b = (int)(token / CFG_SEQ), t = (int)(token % CFG_SEQ);
  const h16* pr = p.proj + token * INC;
  if (e < 128) { int kvh = e / 64, d = e % 64; p.ogv[((((long)b * 2 + l) * 2 + kvh) * CFG_SEQ + t) * 64 + d] = (float)pr[384 + e]; }
  else if (e < 384) { int c = e - 128; int h = c / 64, d = c % 64; p.onk[((((long)b * 2 + l) * 4 + h) * CFG_SEQ + t) * 64 + d] = (float)pr[NA_OFF + 256 + c]; }
  else { int c = e - 384; int h = c / 64, d = c % 64; p.onv[((((long)b * 2 + l) * 4 + h) * CFG_SEQ + t) * 64 + d] = (float)pr[NA_OFF + 512 + c]; }
}
HD void b_rwaux(long i, const P& p, int l) {
  int col = (int)(i % 256); int d = (int)((i / 256) % 2); long token = i / 512;
  int t, T; long base; seqinfo(token, t, T, base);
  bool sv = d == 0 ? (t > 0) : (t < T - 1);
  const h16* pb = p.proj + token * INC + RW_OFF;
  const h16* ps = p.proj + (token + (d == 0 ? -1 : 1)) * INC + RW_OFF;
  const float* mu = p.rwmu + ((long)l * 2 + d) * 832;
  float accw = p.rww0[(l * 2 + d) * 256 + col], acca = p.rwa0[(l * 2 + d) * 256 + col];
  for (int j = 0; j < 32; ++j) {
    float bw = (float)pb[768 + d * 32 + j], sw = sv ? (float)ps[768 + d * 32 + j] : 0.f;
    float wl = bw + (sw - bw) * mu[768 + j];
    float ba = (float)pb[832 + d * 32 + j], sa = sv ? (float)ps[832 + d * 32 + j] : 0.f;
    float al = ba + (sa - ba) * mu[800 + j];
    accw += tanhf(wl) * p.rww2[(((long)l * 2 + d) * 32 + j) * 256 + col];
    acca += al * p.rwa2[(((long)l * 2 + d) * 32 + j) * 256 + col];
  }
  float w = -softplusf_(-accw) - 0.5f;
  p.rwaux[((token * 2 + d) * 2 + 0) * 256 + col] = (h16)expf(w);
  p.rwaux[((token * 2 + d) * 2 + 1) * 256 + col] = (h16)sigmoidf_(acca);
}
HD void b_dnconv(long i, const P& p, int l) {
  int c = (int)(i % 768); long token = i / 768;
  int t, T; long base; seqinfo(token, t, T, base);
  float acc = 0.f;
#pragma unroll
  for (int j = 0; j < 5; ++j) {
    int tt = t + j - 2;
    if (tt >= 0 && tt < T) acc += (float)p.proj[(base + tt) * INC + DN_OFF + c] * p.dnconv[((long)l * 5 + j) * 768 + c];
  }
  p.dnp[token * 768 + c] = (h16)siluf_(acc);
}
HD void b_dnnorm(long i, const P& p, int) {
  long token = i / 8; int slot = (int)(i % 8);
  h16* x = p.dnp + token * 768 + slot * 64;
  float ss = 0.f;
  for (int d = 0; d < 64; ++d) { float v = (float)x[d]; ss += v * v; }
  float rs = 1.0f / sqrtf(ss + 1e-6f) * (slot < 4 ? 0.125f : 1.0f);
  for (int d = 0; d < 64; ++d) x[d] = (h16)((float)x[d] * rs);
}

struct Softmax64 {
  float m, lsum, acc[64];
};
template <typename TK>
HD void attend_key(Softmax64& st, const float* q, const TK* k, const TK* v, float scale, float bias) {
  float s = 0.f;
#pragma unroll
  for (int d = 0; d < 64; ++d) s += q[d] * (float)k[d];
  s = s * scale + bias;
  if (s > st.m) {
    float f = expf(st.m - s);
    st.lsum *= f;
#pragma unroll
    for (int d = 0; d < 64; ++d) st.acc[d] *= f;
    st.m = s;
  }
  float pw = expf(s - st.m);
  st.lsum += pw;
#pragma unroll
  for (int d = 0; d < 64; ++d) st.acc[d] += pw * (float)v[d];
}
HD void b_attn_gqa(long i, const P& p, int l) {
  int h = (int)(i / NT); long token = i % NT; int kvh = h / 2;
  float q[64];
  const h16* qp = p.proj + token * INC + h * 64;
#pragma unroll
  for (int d = 0; d < 64; ++d) q[d] = (float)qp[d];
  Softmax64 st; st.m = -1e30f; st.lsum = 0.f;
#pragma unroll
  for (int d = 0; d < 64; ++d) st.acc[d] = 0.f;
  int t, T; long base; seqinfo(token, t, T, base);
  for (int tk = 0; tk < T; ++tk) {
    const h16* kp = p.proj + (base + tk) * INC + 256 + kvh * 64;
    attend_key<h16>(st, q, kp, kp + 128, 1.0f, 0.f);
  }
  if (token >= NTC) {
    int b = (int)((token - NTC) / CFG_DS);
    const float* ck = p.cgk + (((long)b * 2 + l) * 2 + kvh) * CFG_PAST * 64;
    const float* cv = p.cgv + (((long)b * 2 + l) * 2 + kvh) * CFG_PAST * 64;
    for (int pp = 0; pp < CFG_PAST; ++pp) attend_key<float>(st, q, ck + pp * 64, cv + pp * 64, 1.0f, 0.f);
  }
  float inv = 1.0f / st.lsum;
  h16* o = p.act + token * 1024 + h * 64;
#pragma unroll
  for (int d = 0; d < 64; ++d) o[d] = (h16)(st.acc[d] * inv);
}
HD void b_attn_na(long i, const P& p, int l) {
  int h = (int)(i / NT); long token = i % NT;
  float q[64];
  const h16* qp = p.proj + token * INC + NA_OFF + h * 64;
#pragma unroll
  for (int d = 0; d < 64; ++d) q[d] = (float)qp[d];
  Softmax64 st; st.m = -1e30f; st.lsum = 0.f;
#pragma unroll
  for (int d = 0; d < 64; ++d) st.acc[d] = 0.f;
  int t, T; long base; seqinfo(token, t, T, base);
  if (token < NTC) {
    for (int tk = 0; tk < T; ++tk) {
      const h16* kp = p.proj + (base + tk) * INC + NA_OFF + 256 + h * 64;
      attend_key<h16>(st, q, kp, kp + 256, 0.125f, 0.f);
    }
  } else {
    int r = t / 64, cq = t % 64;
    int r0 = r - WR / 2; r0 = r0 < 0 ? 0 : (r0 > GROWS - WR ? GROWS - WR : r0);
    int cs = cq - 8; cs = cs < 0 ? 0 : (cs > 48 ? 48 : cs);
    const float* bias = p.nabias + ((long)l * 4 + h) * 15 * 31;
    for (int w = 0; w < WR; ++w) {
      int kr = r0 + w;
      for (int cc = 0; cc < 16; ++cc) {
        int kc = cs + cc;
        const h16* kp = p.proj + (base + kr * 64 + kc) * INC + NA_OFF + 256 + h * 64;
        attend_key<h16>(st, q, kp, kp + 256, 0.125f, bias[(kr - r + 7) * 31 + (kc - cq + 15)]);
      }
    }
    int b = (int)((token - NTC) / CFG_DS);
    const float* ck = p.cnk + (((long)b * 2 + l) * 4 + h) * CFG_PAST * 64;
    const float* cv = p.cnv + (((long)b * 2 + l) * 4 + h) * CFG_PAST * 64;
    for (int pp = 0; pp < CFG_PAST; ++pp) attend_key<float>(st, q, ck + pp * 64, cv + pp * 64, 0.125f, 0.f);
  }
  float inv = 1.0f / st.lsum;
  h16* o = p.act + token * 1024 + 512 + h * 64;
#pragma unroll
  for (int d = 0; d < 64; ++d) o[d] = (h16)(st.acc[d] * inv);
}

HD float rw_lerp(const P& p, int l, long token, bool sv, int d, int c) {
  float b = (float)p.proj[token * INC + RW_OFF + c];
  float s = sv ? (float)p.proj[(token + (d == 0 ? -1 : 1)) * INC + RW_OFF + c] : 0.f;
  return b + (s - b) * p.rwmu[((long)l * 2 + d) * 832 + c];
}
HD void b_rwscan(long i, const P& p, int l) {
  int v = (int)(i % 64); int sb = (int)(i / 64); int h = sb % 4; int bi = sb / 4;
  bool ctx = bi < CFG_BATCH;
  int T = ctx ? CFG_SEQ : CFG_DS;
  long base = ctx ? (long)bi * CFG_SEQ : (long)NTC + (long)(bi - CFG_BATCH) * CFG_DS;
#ifndef HOST_EMU
  float* S = (float*)g_smem + threadIdx.x * 65;
#else
  float S[64];
#endif
  for (int d = 0; d < 2; ++d) {
    if (ctx) {
      for (int k = 0; k < 64; ++k) S[k] = 0.f;
    } else {
      const float* s0 = p.srw + (((((long)(bi - CFG_BATCH)) * 2 + l) * 2 + d) * 4 + h) * 4096 + v * 64;
      for (int k = 0; k < 64; ++k) S[k] = s0[k];
    }
    for (int step = 0; step < T; ++step) {
      int t = d == 0 ? step : T - 1 - step;
      long token = base + t;
      bool sv = d == 0 ? (t > 0) : (t < T - 1);
      const h16* aux = p.rwaux + (token * 2 + d) * 512;
      float ss = 0.f;
      for (int k = 0; k < 64; ++k) {
        float kv = rw_lerp(p, l, token, sv, d, 256 + h * 64 + k) * p.rwkk[l * 256 + h * 64 + k];
        ss += kv * kv;
      }
      float rs = 1.0f / sqrtf(ss + 1e-6f);
      float sa = 0.f;
      for (int k = 0; k < 64; ++k) {
        float kk = rw_lerp(p, l, token, sv, d, 256 + h * 64 + k) * p.rwkk[l * 256 + h * 64 + k] * rs;
        sa -= S[k] * kk;
      }
      float vv = rw_lerp(p, l, token, sv, d, 512 + h * 64 + v);
      float o = 0.f;
      for (int k = 0; k < 64; ++k) {
        int c = h * 64 + k;
        float kr = rw_lerp(p, l, token, sv, d, 256 + c);
        float kk = kr * p.rwkk[l * 256 + c] * rs;
        float a = (float)aux[256 + c];
        float dec = expf(-(float)aux[c]);
        float keff = kr * (1.0f + (a - 1.0f) * p.rwka[l * 256 + c]);
        float r = rw_lerp(p, l, token, sv, d, c);
        S[k] = S[k] * dec + sa * (kk * a) + vv * keff;
        o += S[k] * r;
      }
      h16* op = p.act + token * 1024 + 256 + h * 64 + v;
      if (d == 0) *op = (h16)o; else *op = (h16)((float)*op + o);
    }
    if (ctx) {
      float* so = p.orw + (((((long)bi) * 2 + l) * 2 + d) * 4 + h) * 4096 + v * 64;
      for (int k = 0; k < 64; ++k) so[k] = S[k];
    }
  }
}
HD void b_rwfin(long i, const P& p, int l) {
  long token = i / 4; int h = (int)(i % 4);
  int t, T; long base; seqinfo(token, t, T, base);
  h16* op = p.act + token * 1024 + 256 + h * 64;
  float mu = 0.f;
  for (int k = 0; k < 64; ++k) mu += (float)op[k];
  mu *= (1.0f / 64);
  float var = 0.f;
  for (int k = 0; k < 64; ++k) { float dlt = (float)op[k] - mu; var += dlt * dlt; }
  var *= (1.0f / 64);
  float rs = 1.0f / sqrtf(var + 64e-5f);
  float bon0 = 0.f, bon1 = 0.f;
  for (int d = 0; d < 2; ++d) {
    bool sv = d == 0 ? (t > 0) : (t < T - 1);
    const h16* aux = p.rwaux + (token * 2 + d) * 512;
    float s = 0.f;
    for (int k = 0; k < 64; ++k) {
      int c = h * 64 + k;
      float kr = rw_lerp(p, l, token, sv, d, 256 + c);
      float a = (float)aux[256 + c];
      float keff = kr * (1.0f + (a - 1.0f) * p.rwka[l * 256 + c]);
      s += rw_lerp(p, l, token, sv, d, c) * keff * p.rwrk[l * 256 + c];
    }
    if (d == 0) bon0 = s; else bon1 = s;
  }
  bool sv0 = t > 0, sv1 = t < T - 1;
  for (int k = 0; k < 64; ++k) {
    int c = h * 64 + k;
    float y = ((float)op[k] - mu) * rs * p.rwlng[l * 256 + c] + p.rwlnb[l * 256 + c];
    y += bon0 * rw_lerp(p, l, token, sv0, 0, 512 + c) + bon1 * rw_lerp(p, l, token, sv1, 1, 512 + c);
    float gate = 0.f;
    for (int j = 0; j < 64; ++j) gate += sigmoidf_((float)p.proj[token * INC + RW_OFF + 896 + j]) * p.rwg2[((long)l * 64 + j) * 256 + c];
    op[k] = (h16)(y * gate);
  }
}
HD void b_dnscan(long i, const P& p, int l) {
  int v = (int)(i % 64); int sb = (int)(i / 64); int h = sb % 4; int bi = sb / 4;
  bool ctx = bi < CFG_BATCH;
  int T = ctx ? CFG_SEQ : CFG_DS;
  long base = ctx ? (long)bi * CFG_SEQ : (long)NTC + (long)(bi - CFG_BATCH) * CFG_DS;
#ifndef HOST_EMU
  float* S = (float*)g_smem + threadIdx.x * 65;
#else
  float S[64];
#endif
  for (int d = 0; d < 2; ++d) {
    if (ctx) {
      for (int k = 0; k < 64; ++k) S[k] = 0.f;
    } else {
      const float* s0 = p.sdn + (((((long)(bi - CFG_BATCH)) * 2 + l) * 2 + d) * 4 + h) * 4096 + v;
      for (int k = 0; k < 64; ++k) S[k] = s0[k * 64];
    }
    float nalog = -expf(p.dnalog[(l * 2 + d) * 4 + h]);
    float dtb = p.dndt[(l * 2 + d) * 4 + h];
    for (int step = 0; step < T; ++step) {
      int t = d == 0 ? step : T - 1 - step;
      long token = base + t;
      const h16* dp = p.dnp + token * 768;
      const h16* pr = p.proj + token * INC + DN_OFF;
      float beta = sigmoidf_((float)pr[768 + d * 4 + h]);
      float g = nalog * softplusf_((float)pr[776 + d * 4 + h] + dtb);
      float a = expf(g);
      float sk = 0.f;
      for (int k = 0; k < 64; ++k) sk += (float)dp[256 + h * 64 + k] * S[k];
      float coef = beta * ((float)dp[512 + h * 64 + v] - a * sk);
      float o = 0.f;
      for (int k = 0; k < 64; ++k) {
        S[k] = a * S[k] + coef * (float)dp[256 + h * 64 + k];
        o += (float)dp[h * 64 + k] * S[k];
      }
      h16* op = p.act + token * 1024 + 768 + h * 64 + v;
      if (d == 0) *op = (h16)o; else *op = (h16)((float)*op + o);
    }
    if (ctx) {
      float* so = p.odn + (((((long)bi) * 2 + l) * 2 + d) * 4 + h) * 4096 + v;
      for (int k = 0; k < 64; ++k) so[k * 64] = S[k];
    }
  }
}
HD void b_dnfin(long i, const P& p, int l) {
  long token = i / 4; int h = (int)(i % 4);
  h16* op = p.act + token * 1024 + 768 + h * 64;
  float ss = 0.f;
  for (int k = 0; k < 64; ++k) { float o = (float)op[k]; ss += o * o; }
  float rs = 1.0f / sqrtf(ss * (1.0f / 64) + 1e-6f);
  for (int k = 0; k < 64; ++k) {
    float z = (float)p.proj[token * INC + DN_OFF + 784 + h * 64 + k];
    op[k] = (h16)((float)op[k] * rs * p.dnng[l * 64 + k] * siluf_(z));
  }
}
HD void top16_insert(float (&ts)[16], int (&ti)[16], float s, int id) {
#pragma unroll
  for (int j = 0; j < 16; ++j) {
    if (s > ts[j]) { float a = ts[j]; ts[j] = s; s = a; int b = ti[j]; ti[j] = id; id = b; }
  }
}
HD void b_topk1(long i, const P& p, int l) {
  long token = i / 16; int hp = (int)(i % 16);
  const h16* q = p.pq + token * 2048 + hp * 128;
  const float* keys = p.pkeys + ((long)l * 16 + hp) * CFG_NKEYS * 128;
  float ts[16]; int ti[16];
#pragma unroll
  for (int j = 0; j < 16; ++j) { ts[j] = -3.0e38f; ti[j] = 0; }
  for (int k = 0; k < CFG_NKEYS; ++k) {
    float s = 0.f;
    for (int d = 0; d < 128; ++d) s += (float)q[d] * keys[k * 128 + d];
    top16_insert(ts, ti, s, k);
  }
#pragma unroll
  for (int j = 0; j < 16; ++j) { p.tks[token * 256 + hp * 16 + j] = ts[j]; p.tki[token * 256 + hp * 16 + j] = ti[j]; }
}
HD void b_topk2(long i, const P& p, int l) {
  long token = i / 8; int hd = (int)(i % 8);
  const float* s1 = p.tks + token * 256 + hd * 32; const int* i1 = p.tki + token * 256 + hd * 32;
  float ts[16]; int ti[16];
#pragma unroll
  for (int j = 0; j < 16; ++j) { ts[j] = -3.0e38f; ti[j] = 0; }
  for (int a = 0; a < 16; ++a)
    for (int b = 0; b < 16; ++b) top16_insert(ts, ti, s1[a] + s1[16 + b], i1[a] * CFG_NKEYS + i1[16 + b]);
  float sum = 0.f;
#pragma unroll
  for (int j = 0; j < 16; ++j) sum += expf(ts[j] - ts[0]);
  float inv = 1.0f / sum;
#pragma unroll
  for (int j = 0; j < 16; ++j) { p.pidx[token * 128 + hd * 16 + j] = ti[j]; p.pact[token * 128 + hd * 16 + j] = expf(ts[j] - ts[0]) * inv; }
}
HD void b_peer_act(long i, const P& p, int l) {
  long token = i / 128;
  const float* u = p.pu + ((long)l * NEXP + p.pidx[i]) * 1024;
  const h16* x = p.act + token * 1024;
  float dot = 0.f;
  for (int k = 0; k < 1024; ++k) dot += (float)x[k] * u[k];
  float ge = 0.5f * dot * (1.0f + erff(dot * 0.70710678118654752f));
  p.pact[i] = p.pact[i] * ge;
}
HD void b_peer_out(long i, const P& p, int l) {
  long token = i / 1024; int col = (int)(i % 1024);
  float acc = 0.f;
  for (int e = 0; e < 128; ++e) acc += p.pact[token * 128 + e] * p.pv[((long)l * NEXP + p.pidx[token * 128 + e]) * 1024 + col];
  p.X[i] += p.mod[((long)l * NCOND + condrow(token)) * 6144 + 5120 + col] * acc;
}
HD void b_final(long i, const P& p, int) {
  float* x = p.X + i * 1024;
  float ss = 0.f;
  for (int k = 0; k < 1024; ++k) ss += x[k] * x[k];
  float rstd = 1.0f / sqrtf(ss * (1.0f / 1024) + 1e-6f);
  for (int k = 0; k < 1024; ++k) x[k] = x[k] * rstd * p.fng[k];
}
HD float gemm_elem(const h16* A, const float* B, int N, long token, int col) {
  float acc = 0.f;
  for (int k = 0; k < 1024; ++k) acc += (float)A[token * 1024 + k] * B[(long)k * N + col];
  return acc;
}
HD void b_inproj(long i, const P& p, int l) {
  long token = i / INC; int col = (int)(i % INC);
  p.proj[i] = (h16)gemm_elem(p.act, p.win + (long)l * 1024 * INC, INC, token, col);
}
HD void b_outproj(long i, const P& p, int l) {
  long token = i / 1024; int col = (int)(i % 1024);
  float acc = gemm_elem(p.act, p.wout + (long)l * 1024 * 1024, 1024, token, col);
  p.X[i] += p.mod[((long)l * NCOND + condrow(token)) * 6144 + 2048 + col] * acc;
}
HD void b_peerq(long i, const P& p, int l) {
  long token = i / 2048; int col = (int)(i % 2048);
  p.pq[i] = (h16)gemm_elem(p.act, p.pwq + (long)l * 1024 * 2048, 2048, token, col);
}

#ifndef PROBE_KMAX
#define PROBE_KMAX 16
#endif
#ifndef REP_S0
#define REP_S0 1
#endif
#ifndef REP_MISC
#define REP_MISC 1
#endif
#ifndef REP_G0
#define REP_G0 1
#endif
#ifndef REP_G2
#define REP_G2 1
#endif
#ifndef REP_SP
#define REP_SP 1
#endif
#define NSCAN ((long)(CFG_BATCH + CFG_DB) * 4 * 64)
#define NPAD_IN 3328

#ifndef HOST_EMU
typedef _Float16 half8 __attribute__((ext_vector_type(8)));
typedef _Float16 half4 __attribute__((ext_vector_type(4)));
typedef _Float16 half2v __attribute__((ext_vector_type(2)));
typedef float f32x2 __attribute__((ext_vector_type(2)));
typedef float f32x16 __attribute__((ext_vector_type(16)));
typedef float f32x4 __attribute__((ext_vector_type(4)));
typedef unsigned u32x4 __attribute__((ext_vector_type(4)));
typedef short s16x4v __attribute__((__vector_size__(4 * sizeof(short))));

template <int CTRL> __device__ __forceinline__ float dppf(float x) {
  return __builtin_bit_cast(float, __builtin_amdgcn_update_dpp(0, __builtin_bit_cast(int, x), CTRL, 0xF, 0xF, true));
}
__device__ __forceinline__ float sum16(float x) { x += dppf<0x128>(x); x += dppf<0x124>(x); x += dppf<0xB1>(x); x += dppf<0x4E>(x); return x; }
__device__ __forceinline__ float sum8(float x) { x += dppf<0xB1>(x); x += dppf<0x4E>(x); x += dppf<0x141>(x); return x; }
__device__ __forceinline__ float sum64(float x) { x = sum16(x); x += __shfl_xor(x, 16); x += __shfl_xor(x, 32); return x; }

#define CSWAP_DESC(S, ID, i, j) { const bool c_ = S[j] > S[i]; const float a_ = c_ ? S[j] : S[i]; const float b_ = c_ ? S[i] : S[j]; \
    const int ia_ = c_ ? ID[j] : ID[i]; const int ib_ = c_ ? ID[i] : ID[j]; S[i] = a_; S[j] = b_; ID[i] = ia_; ID[j] = ib_; }
__device__ __forceinline__ void bitonic_sort16_desc(float (&s)[16], int (&id)[16]) {
#pragma unroll
  for (int k = 2; k <= 16; k <<= 1) {
#pragma unroll
    for (int j = k >> 1; j > 0; j >>= 1) {
#pragma unroll
      for (int i = 0; i < 16; ++i) {
        const int l = i ^ j;
        if (l > i) {
          if ((i & k) == 0) CSWAP_DESC(s, id, i, l) else CSWAP_DESC(s, id, l, i)
        }
      }
    }
  }
}
__device__ __forceinline__ void merge_top16(float (&ts)[16], int (&ti)[16], const float (&gs)[16], const int (&gi)[16]) {
#pragma unroll
  for (int i = 0; i < 16; ++i) { if (gs[15 - i] > ts[i]) { ts[i] = gs[15 - i]; ti[i] = gi[15 - i]; } }
#pragma unroll
  for (int j = 8; j > 0; j >>= 1) {
#pragma unroll
    for (int i = 0; i < 16; ++i) { if ((i & j) == 0) CSWAP_DESC(ts, ti, i, i + j) }
  }
}
__device__ void blk_convert(long w, const P& p) {
  int l = (int)(w / 1600); int r = (int)(w % 1600);
  const float* src; h16* dst; int N, ntile;
  if (r < 832) { src = p.win + (long)l * 1024 * INC; dst = p.wtin + (long)l * NPAD_IN * 1024; N = INC; ntile = 52; }
  else if (r < 1088) { r -= 832; src = p.wout + (long)l * 1024 * 1024; dst = p.wtout + (long)l * 1024 * 1024; N = 1024; ntile = 16; }
  else { r -= 1088; src = p.pwq + (long)l * 1024 * 2048; dst = p.wtq + (long)l * 2048 * 1024; N = 2048; ntile = 32; }
  int kt = r / ntile, nt = r % ntile;
  int k0 = kt * 64, n0 = nt * 64;
  h16* tile = (h16*)g_smem;
  const int tid_ = otid(); int c = tid_ & 63, r4 = tid_ >> 6;
  __syncthreads();
#pragma unroll
  for (int j = 0; j < 16; ++j) {
    int rr = r4 + 4 * j;
    float v = (n0 + c < N) ? src[(long)(k0 + rr) * N + n0 + c] : 0.f;
    tile[rr * 66 + c] = (h16)v;
  }
  __syncthreads();
#pragma unroll
  for (int j = 0; j < 16; ++j) {
    int rr = r4 + 4 * j;
    dst[(long)(n0 + rr) * 1024 + k0 + c] = tile[c * 66 + rr];
  }
}

template <int EPI>
__device__ void gemm_phase(const P& p, int l, int kmax = 16) {
  constexpr int NTILES = EPI == 0 ? (NPAD_IN / 128) : (EPI == 1 ? 8 : 16);
  constexpr int NT8 = (NTILES + 7) / 8;
  const long nw = EPI == 0 ? (long)(NT / 128) * NTILES : (long)(NT / 128) * 8 * NT8;
#define TILE_OF(W, MT, NTV) { const int x_ = (int)((W) & 7); const int j_ = (int)((W) >> 3);                        \
    if (EPI == 0) { if (j_ < 960) { MT = j_ / 3; NTV = x_ + 8 * (j_ - 3 * MT); } else { NTV = 24 + (x_ >> 2); MT = 80 * (x_ & 3) + j_ - 960; } } \
    else { NTV = x_ + 8 * (j_ % NT8); MT = j_ / NT8; } }
  const h16* A = p.act;
  const h16* Bt = EPI == 0 ? p.wtin + (long)l * NPAD_IN * 1024 : (EPI == 1 ? p.wtout + (long)l * 1024 * 1024 : p.wtq + (long)l * 2048 * 1024);
  const int tid = otid(), lane = tid & 63, wv = tid >> 6, wm = wv >> 1, wn = wv & 1;
  h16* As = (h16*)g_smem;
  h16* Bs = As + 2 * 128 * 72;
  const int lrow = tid >> 3, lch = tid & 7;
  long w = blockIdx.x; int mt = 0, nt = 0;
  for (;;) { if (w >= nw) return; TILE_OF(w, mt, nt) if (nt < NTILES) break; w += gridDim.x; }
  int m0 = mt * 128, n0 = nt * 128;
  const h16* Ag = A + (long)(m0 + lrow) * 1024 + lch * 8;
  const h16* Bg = Bt + (long)(n0 + lrow) * 1024 + lch * 8;
  u32x4 ra0, ra1, ra2, ra3, rb0, rb1, rb2, rb3;
  u32x4 sa0, sa1, sa2, sa3, sb0, sb1, sb2, sb3;
  const f32x16 zero16 = {0.f, 0.f, 0.f, 0.f, 0.f, 0.f, 0.f, 0.f, 0.f, 0.f, 0.f, 0.f, 0.f, 0.f, 0.f, 0.f};
  f32x16 acc00, acc01, acc10, acc11;
#define GLD0(K0) \
  ra0 = *(const u32x4*)(Ag + (K0)); ra1 = *(const u32x4*)(Ag + 32 * 1024 + (K0)); ra2 = *(const u32x4*)(Ag + 64 * 1024 + (K0)); ra3 = *(const u32x4*)(Ag + 96 * 1024 + (K0)); \
  rb0 = *(const u32x4*)(Bg + (K0)); rb1 = *(const u32x4*)(Bg + 32 * 1024 + (K0)); rb2 = *(const u32x4*)(Bg + 64 * 1024 + (K0)); rb3 = *(const u32x4*)(Bg + 96 * 1024 + (K0));
#define GLD1(K0) \
  sa0 = *(const u32x4*)(Ag + (K0)); sa1 = *(const u32x4*)(Ag + 32 * 1024 + (K0)); sa2 = *(const u32x4*)(Ag + 64 * 1024 + (K0)); sa3 = *(const u32x4*)(Ag + 96 * 1024 + (K0)); \
  sb0 = *(const u32x4*)(Bg + (K0)); sb1 = *(const u32x4*)(Bg + 32 * 1024 + (K0)); sb2 = *(const u32x4*)(Bg + 64 * 1024 + (K0)); sb3 = *(const u32x4*)(Bg + 96 * 1024 + (K0));
#define LST0(AW, BW) \
  *(u32x4*)((AW) + (lrow) * 72 + lch * 8) = ra0; *(u32x4*)((AW) + (lrow + 32) * 72 + lch * 8) = ra1; *(u32x4*)((AW) + (lrow + 64) * 72 + lch * 8) = ra2; *(u32x4*)((AW) + (lrow + 96) * 72 + lch * 8) = ra3; \
  *(u32x4*)((BW) + (lrow) * 72 + lch * 8) = rb0; *(u32x4*)((BW) + (lrow + 32) * 72 + lch * 8) = rb1; *(u32x4*)((BW) + (lrow + 64) * 72 + lch * 8) = rb2; *(u32x4*)((BW) + (lrow + 96) * 72 + lch * 8) = rb3;
#define LST1(AW, BW) \
  *(u32x4*)((AW) + (lrow) * 72 + lch * 8) = sa0; *(u32x4*)((AW) + (lrow + 32) * 72 + lch * 8) = sa1; *(u32x4*)((AW) + (lrow + 64) * 72 + lch * 8) = sa2; *(u32x4*)((AW) + (lrow + 96) * 72 + lch * 8) = sa3; \
  *(u32x4*)((BW) + (lrow) * 72 + lch * 8) = sb0; *(u32x4*)((BW) + (lrow + 32) * 72 + lch * 8) = sb1; *(u32x4*)((BW) + (lrow + 64) * 72 + lch * 8) = sb2; *(u32x4*)((BW) + (lrow + 96) * 72 + lch * 8) = sb3;
#define GCOMP(BUF)                                                                                   \
  {                                                                                                  \
    const h16* Ab = As + (BUF) * 128 * 72 + (wm * 64 + (lane & 31)) * 72 + (lane >> 5) * 8;          \
    const h16* Bb = Bs + (BUF) * 128 * 72 + (wn * 64 + (lane & 31)) * 72 + (lane >> 5) * 8;          \
    _Pragma("unroll") for (int s = 0; s < 4; ++s) {                                                  \
      half8 a0 = *(const half8*)(Ab + s * 16), a1 = *(const half8*)(Ab + 32 * 72 + s * 16);          \
      half8 b0 = *(const half8*)(Bb + s * 16), b1 = *(const half8*)(Bb + 32 * 72 + s * 16);          \
      acc00 = __builtin_amdgcn_mfma_f32_32x32x16_f16(a0, b0, acc00, 0, 0, 0);                        \
      acc01 = __builtin_amdgcn_mfma_f32_32x32x16_f16(a0, b1, acc01, 0, 0, 0);                        \
      acc10 = __builtin_amdgcn_mfma_f32_32x32x16_f16(a1, b0, acc10, 0, 0, 0);                        \
      acc11 = __builtin_amdgcn_mfma_f32_32x32x16_f16(a1, b1, acc11, 0, 0, 0);                        \
    }                                                                                                \
  }
  GLD0(0)
  GLD1(64)
  for (;;) {
  acc00 = zero16; acc01 = zero16; acc10 = zero16; acc11 = zero16;
  __builtin_amdgcn_sched_barrier(0);
  __syncthreads();
  LST0(As, Bs)
  GLD0(128)
  __builtin_amdgcn_sched_barrier(0);
  __syncthreads();
  __builtin_amdgcn_s_setprio(2);
  for (int kt = 0; kt < kmax; kt += 2) {
    GCOMP(0)
    __builtin_amdgcn_sched_barrier(0);
    LST1(As + 128 * 72, Bs + 128 * 72)
    if (kt + 3 < 16) { GLD1((kt + 3) * 64) }
    __builtin_amdgcn_sched_barrier(0);
    __syncthreads();
    GCOMP(1)
    __builtin_amdgcn_sched_barrier(0);
    if (kt + 2 < 16) { LST0(As, Bs) }
    if (kt + 4 < 16) { GLD0((kt + 4) * 64) }
    __builtin_amdgcn_sched_barrier(0);
    __syncthreads();
  }
  __builtin_amdgcn_s_setprio(0);
  const int cm0 = m0, cn0 = n0, cnt = nt;
  long w2 = w + gridDim.x; int mt2 = 0, nt2 = 0; bool has_next = false;
  for (;;) { if (w2 >= nw) break; TILE_OF(w2, mt2, nt2) if (nt2 < NTILES) { has_next = true; break; } w2 += gridDim.x; }
  if (has_next) {
    m0 = mt2 * 128; n0 = nt2 * 128; nt = nt2;
    Ag = A + (long)(m0 + lrow) * 1024 + lch * 8; Bg = Bt + (long)(n0 + lrow) * 1024 + lch * 8;
  }
  __builtin_amdgcn_sched_barrier(0);
#define GEMM_EPI(ACC, I, J)                                                                         \
  _Pragma("unroll") for (int r = 0; r < 16; ++r) {                                                   \
    const long row = cm0 + wm * 64 + (I) * 32 + (r & 3) + 8 * (r >> 2) + 4 * (lane >> 5);             \
    const int col = cn0 + wn * 64 + (J) * 32 + (lane & 31);                                            \
    const float v = ACC[r];                                                                          \
    if (EPI == 0) { if (col < INC) p.proj[row * INC + col] = (h16)v; }                                \
    else if (EPI == 1) { p.X[row * 1024 + col] += p.mod[((long)l * NCOND + condrow(row)) * 6144 + 2048 + col] * v; } \
    else { p.pq[row * 2048 + col] = (h16)v; }                                                         \
  }
  if (EPI == 0) {
    h16* Ct = (h16*)g_smem;
#define CST(ACC, I, J) _Pragma("unroll") for (int r = 0; r < 16; ++r) Ct[(wm * 64 + (I) * 32 + (r & 3) + 8 * (r >> 2) + 4 * (lane >> 5)) * 136 + wn * 64 + (J) * 32 + (lane & 31)] = (h16)ACC[r];
    CST(acc00, 0, 0) CST(acc01, 0, 1) CST(acc10, 1, 0) CST(acc11, 1, 1)
#undef CST
    __syncthreads();
#pragma unroll
    for (int j = 0; j < 8; ++j) {
      const int idx = tid + 256 * j; const int rr = idx >> 4, cc = idx & 15;
      if (cn0 + cc * 8 < INC) *(u32x4*)(p.proj + (long)(cm0 + rr) * INC + cn0 + cc * 8) = *(const u32x4*)(Ct + rr * 136 + cc * 8);
    }
  } else if (EPI == 1) {
#define EPI1(ACC, I, J)                                                                              \
    {                                                                                                \
      float xv_[16], mv_[16];                                                                        \
      const int col = cn0 + wn * 64 + (J) * 32 + (lane & 31);                                         \
      _Pragma("unroll") for (int r = 0; r < 16; ++r) {                                               \
        const long row = cm0 + wm * 64 + (I) * 32 + (r & 3) + 8 * (r >> 2) + 4 * (lane >> 5);         \
        xv_[r] = p.X[row * 1024 + col]; mv_[r] = p.mod[((long)l * NCOND + condrow(row)) * 6144 + 2048 + col]; \
      }                                                                                              \
      _Pragma("unroll") for (int r = 0; r < 16; ++r) {                                               \
        const long row = cm0 + wm * 64 + (I) * 32 + (r & 3) + 8 * (r >> 2) + 4 * (lane >> 5);         \
        p.X[row * 1024 + col] = xv_[r] + mv_[r] * ACC[r];                                            \
      }                                                                                              \
    }
    EPI1(acc00, 0, 0) EPI1(acc01, 0, 1) EPI1(acc10, 1, 0) EPI1(acc11, 1, 1)
#undef EPI1
  } else {
    h16* Q = (h16*)g_smem;
    h16* Kk = Q + 128 * 136;
    const h16* kg = p.keys16 + ((long)l * 16 + cnt) * CFG_NKEYS * 128;
#define QST(ACC, I, J) _Pragma("unroll") for (int r = 0; r < 16; ++r) Q[(wm * 64 + (I) * 32 + (r & 3) + 8 * (r >> 2) + 4 * (lane >> 5)) * 136 + wn * 64 + (J) * 32 + (lane & 31)] = (h16)ACC[r];
    QST(acc00, 0, 0) QST(acc01, 0, 1) QST(acc10, 1, 0) QST(acc11, 1, 1)
#undef QST
#pragma unroll
    for (int j = 0; j < 8; ++j) {
      const int idx = tid + 256 * j; const int kr = idx >> 4, kc = idx & 15;
      *(u32x4*)(Kk + kr * 136 + kc * 8) = *(const u32x4*)(kg + kr * 128 + kc * 8);
    }
    __syncthreads();
    f32x16 z = {0.f, 0.f, 0.f, 0.f, 0.f, 0.f, 0.f, 0.f, 0.f, 0.f, 0.f, 0.f, 0.f, 0.f, 0.f, 0.f};
    f32x16 s00 = z, s01 = z, s10 = z, s11 = z;
    const h16* Qb = Q + (wm * 64 + (lane & 31)) * 136 + (lane >> 5) * 8;
    const h16* Kb = Kk + (wn * 64 + (lane & 31)) * 136 + (lane >> 5) * 8;
#pragma unroll
    for (int sidx = 0; sidx < 8; ++sidx) {
      half8 a0 = *(const half8*)(Qb + sidx * 16), a1 = *(const half8*)(Qb + 32 * 136 + sidx * 16);
      half8 b0 = *(const half8*)(Kb + sidx * 16), b1 = *(const half8*)(Kb + 32 * 136 + sidx * 16);
      s00 = __builtin_amdgcn_mfma_f32_32x32x16_f16(a0, b0, s00, 0, 0, 0);
      s01 = __builtin_amdgcn_mfma_f32_32x32x16_f16(a0, b1, s01, 0, 0, 0);
      s10 = __builtin_amdgcn_mfma_f32_32x32x16_f16(a1, b0, s10, 0, 0, 0);
      s11 = __builtin_amdgcn_mfma_f32_32x32x16_f16(a1, b1, s11, 0, 0, 0);
    }
    __syncthreads();
    float* SC = (float*)g_smem;
#define SST(ACC, I, J) _Pragma("unroll") for (int r = 0; r < 16; ++r) SC[(wm * 64 + (I) * 32 + (r & 3) + 8 * (r >> 2) + 4 * (lane >> 5)) * 129 + wn * 64 + (J) * 32 + (lane & 31)] = ACC[r];
    SST(s00, 0, 0) SST(s01, 0, 1) SST(s10, 1, 0) SST(s11, 1, 1)
#undef SST
    __syncthreads();
    const int row = tid >> 1, half = tid & 1;
    float ts[16]; int ti[16];
#pragma unroll
    for (int j = 0; j < 16; ++j) { ts[j] = -3.0e38f; ti[j] = 0; }
#pragma unroll 1
    for (int g = 0; g < 4; ++g) {
      float gs[16]; int gi[16];
#pragma unroll
      for (int j = 0; j < 16; ++j) { gs[j] = SC[row * 129 + half * 64 + g * 16 + j]; gi[j] = half * 64 + g * 16 + j; }
      bitonic_sort16_desc(gs, gi);
      merge_top16(ts, ti, gs, gi);
    }
    {
      float ps[16]; int pi[16];
#pragma unroll
      for (int j = 0; j < 16; ++j) { ps[j] = dppf<0xB1>(ts[j]); pi[j] = __builtin_amdgcn_update_dpp(0, ti[j], 0xB1, 0xF, 0xF, true); }
      merge_top16(ts, ti, ps, pi);
    }
    if (half == 0) {
      const long token = cm0 + row;
#pragma unroll
      for (int j = 0; j < 16; ++j) { p.tks[token * 256 + cnt * 16 + j] = ts[j]; p.tki[token * 256 + cnt * 16 + j] = ti[j]; }
    }
  }
#undef GEMM_EPI
  if (!has_next) break;
  GLD0(0)
  GLD1(64)
  w = w2;
  }
#undef GLD0
#undef GLD1
#undef LST0
#undef LST1
#undef GCOMP
#undef TILE_OF
}

__device__ void blk_mod(long w, const P& p) {
  float* sl = (float*)g_smem;
  const int tid = otid();
  const int cb = (int)(w % 24); const int r = (int)((w / 24) % NCOND); const int l = (int)(w / (24 * NCOND));
  const float* cond = r == 0 ? p.cctx : p.c + (long)(r - 1) * 1024;
  __syncthreads();
#pragma unroll
  for (int j = 0; j < 4; ++j) sl[tid + 256 * j] = siluf_(cond[tid + 256 * j]);
  __syncthreads();
  const int col = cb * 256 + tid;
  const float* wp = p.wmod + (long)l * 1024 * 6144 + col;
  float acc = p.bmod[l * 6144 + col];
#pragma unroll 8
  for (int k = 0; k < 1024; ++k) acc += sl[k] * wp[(long)k * 6144];
  p.mod[((long)l * NCOND + r) * 6144 + col] = acc;
}
__device__ __forceinline__ float sum64u(float x);
template <int WHICH>
__device__ void blk_norm(long w, const P& p, int l) {
  const int tid_ = otid(); const int lane = tid_ & 63; const long token = w * 4 + (tid_ >> 6);
  const float* src = (WHICH == 0 && l == 0) ? (token < NTC ? p.xp + token * 1024 : p.xs + (token - NTC) * 1024) : p.X + token * 1024;
  float4 v[4]; float ss = 0.f;
#pragma unroll
  for (int j = 0; j < 4; ++j) { v[j] = ((const float4*)src)[lane + 64 * j]; ss += v[j].x * v[j].x + v[j].y * v[j].y + v[j].z * v[j].z + v[j].w * v[j].w; }
  ss = sum64u(ss);
  const float rstd = 1.0f / sqrtf(ss * (1.0f / 1024) + 1e-6f);
  if (WHICH == 2) {
#pragma unroll
    for (int j = 0; j < 4; ++j) {
      float4 g = ((const float4*)p.fng)[lane + 64 * j];
      float4 o; o.x = v[j].x * rstd * g.x; o.y = v[j].y * rstd * g.y; o.z = v[j].z * rstd * g.z; o.w = v[j].w * rstd * g.w;
      ((float4*)(p.X + token * 1024))[lane + 64 * j] = o;
    }
    return;
  }
  const float* m = p.mod + ((long)l * NCOND + condrow(token)) * 6144 + (WHICH ? 3072 : 0);
  const float* g = (WHICH ? p.n2g : p.n1g) + l * 1024;
  float4 gga[4], sha[4], sca[4];
#pragma unroll
  for (int j = 0; j < 4; ++j) { const int c4 = lane + 64 * j; gga[j] = ((const float4*)g)[c4]; sha[j] = ((const float4*)m)[c4]; sca[j] = ((const float4*)(m + 1024))[c4]; }
#pragma unroll
  for (int j = 0; j < 4; ++j) {
    const int c4 = lane + 64 * j;
    const float4 gg = gga[j], sh = sha[j], sc = sca[j];
    half4 o;
    o[0] = (h16)((v[j].x * rstd * gg.x) * (1.0f + sc.x) + sh.x);
    o[1] = (h16)((v[j].y * rstd * gg.y) * (1.0f + sc.y) + sh.y);
    o[2] = (h16)((v[j].z * rstd * gg.z) * (1.0f + sc.z) + sh.z);
    o[3] = (h16)((v[j].w * rstd * gg.w) * (1.0f + sc.w) + sh.w);
    *(half4*)(p.act + token * 1024 + c4 * 4) = o;
    if (WHICH == 0 && l == 0) ((float4*)(p.X + token * 1024))[c4] = v[j];
  }
}


#define SC_CT 32
__device__ __forceinline__ float fsigmoid(float x) { return __frcp_rn(1.0f + __expf(-x)); }
__device__ __forceinline__ float fsilu(float x) { return x * fsigmoid(x); }
__device__ __forceinline__ float fsoftplus(float x) { return fmaxf(x, 0.0f) + __logf(1.0f + __expf(-fabsf(x))); }
__device__ __forceinline__ float ftanh(float x) { const float e = __expf(-2.0f * fabsf(x)); const float t = (1.0f - e) * __frcp_rn(1.0f + e); return x < 0.f ? -t : t; }
#define N_PREP_RW ((NT / 32) * 8)
#define N_PREP_DN ((NT / 32) * 4)
__device__ void blk_scanprep(long w, const P& p, int l, half8& bf0, half8& bf1, int& bkey) {
  h16* tw16 = (h16*)g_smem;
  h16* al16 = tw16 + 32 * 40;
  float* cbuf = (float*)(al16 + 32 * 40);
  const int tid = otid();
  const int ls = tid >> 3, part = tid & 7;
  if (w < N_PREP_RW) {
    const int d = (int)(w & 1), h = (int)((w >> 1) & 3); const long token = (w >> 3) * 32 + ls;
    int t, T; long base; seqinfo(token, t, T, base);
    const bool sv = d == 0 ? (t > 0) : (t < T - 1);
    const h16* pb = p.proj + token * INC + RW_OFF;
    const h16* ps = p.proj + (token + (d == 0 ? -1 : 1)) * INC + RW_OFF;
    const float* mu = p.rwmu + ((long)l * 2 + d) * 832;
    const int lane = tid & 63, wv = tid >> 6;
    const int mat = wv >> 1, ntile = wv & 1;
    const int c0 = h * 64 + part * 8;
    half8 rb = *(const half8*)(pb + c0), kb = *(const half8*)(pb + 256 + c0);
    half8 rs_ = rb, ks_ = kb;
    if (sv) { rs_ = *(const half8*)(ps + c0); ks_ = *(const half8*)(ps + 256 + c0); }
    if (bkey != (int)((l << 3) | (w & 7))) {
      bkey = (int)((l << 3) | (w & 7));
      const float* wsrc = (mat ? p.rwa2 : p.rww2) + ((long)l * 2 + d) * 32 * 256 + h * 64 + ntile * 32 + (lane & 31);
#pragma unroll
      for (int j = 0; j < 8; ++j) { bf0[j] = (h16)wsrc[(8 * (lane >> 5) + j) * 256]; bf1[j] = (h16)wsrc[(16 + 8 * (lane >> 5) + j) * 256]; }
    }
    __syncthreads();
#pragma unroll
    for (int e = 0; e < 4; ++e) {
      const int jj = part * 4 + e;
      float bw = (float)pb[768 + d * 32 + jj], sw = sv ? (float)ps[768 + d * 32 + jj] : 0.f;
      tw16[ls * 40 + jj] = (h16)ftanh(bw + (sw - bw) * mu[768 + jj]);
      float ba = (float)pb[832 + d * 32 + jj], sa_ = sv ? (float)ps[832 + d * 32 + jj] : 0.f;
      al16[ls * 40 + jj] = (h16)(ba + (sa_ - ba) * mu[800 + jj]);
    }
    __syncthreads();
    {
      const h16* X16 = (mat ? al16 : tw16) + (lane & 31) * 40 + 8 * (lane >> 5);
      const half8 a0 = *(const half8*)X16, a1 = *(const half8*)(X16 + 16);
      f32x16 acc = {0.f, 0.f, 0.f, 0.f, 0.f, 0.f, 0.f, 0.f, 0.f, 0.f, 0.f, 0.f, 0.f, 0.f, 0.f, 0.f};
      acc = __builtin_amdgcn_mfma_f32_32x32x16_f16(a0, bf0, acc, 0, 0, 0);
      acc = __builtin_amdgcn_mfma_f32_32x32x16_f16(a1, bf1, acc, 0, 0, 0);
      float* cb = cbuf + mat * (32 * 65) + ntile * 32 + (lane & 31);
#pragma unroll
      for (int r = 0; r < 16; ++r) cb[((r & 3) + 8 * (r >> 2) + 4 * (lane >> 5)) * 65] = acc[r];
    }
    __syncthreads();
    float accw[8], acca[8];
#pragma unroll
    for (int e = 0; e < 8; ++e) {
      accw[e] = p.rww0[(l * 2 + d) * 256 + c0 + e] + cbuf[ls * 65 + part * 8 + e];
      acca[e] = p.rwa0[(l * 2 + d) * 256 + c0 + e] + cbuf[32 * 65 + ls * 65 + part * 8 + e];
    }
    float ss = 0.f, bon = 0.f;
    half8 ewo, ago;
#pragma unroll
    for (int e = 0; e < 8; ++e) {
      const int c = c0 + e;
      float b_ = (float)rb[e], s_ = sv ? (float)rs_[e] : 0.f; const float rr = b_ + (s_ - b_) * mu[c];
      b_ = (float)kb[e]; s_ = sv ? (float)ks_[e] : 0.f; const float kr = b_ + (s_ - b_) * mu[256 + c];
      const float asg = fsigmoid(acca[e]);
      const float kkr = kr * p.rwkk[l * 256 + c];
      ss += kkr * kkr;
      const float keff = kr * (1.0f + (asg - 1.0f) * p.rwka[l * 256 + c]);
      bon += rr * keff * p.rwrk[l * 256 + c];
      ewo[e] = (h16)__expf(-fsoftplus(-accw[e]) - 0.5f);
      ago[e] = (h16)asg;
    }
    ss = sum8(ss); bon = sum8(bon);
    *(half8*)(p.rwaux + ((token * 2 + d) * 2 + 0) * 256 + c0) = ewo;
    *(half8*)(p.rwaux + ((token * 2 + d) * 2 + 1) * 256 + c0) = ago;
    if (part == 0) { float* sc = p.rwsc + ((token * 2 + d) * 4 + h) * 2; sc[0] = 1.0f / sqrtf(ss + 1e-6f); sc[1] = bon; }
  } else {
    const long w2 = w - N_PREP_RW;
    const int h = (int)(w2 & 3); const long token = (w2 >> 2) * 32 + ls;
    int t, T; long base; seqinfo(token, t, T, base);
    const int c0 = h * 64 + part * 8;
    float aq[8], ak[8], av[8];
#pragma unroll
    for (int e = 0; e < 8; ++e) { aq[e] = 0.f; ak[e] = 0.f; av[e] = 0.f; }
    half8 xq[5], xk[5], xv[5]; float tv[5];
#pragma unroll
    for (int tap = 0; tap < 5; ++tap) {
      const int tt = t + tap - 2;
      const bool ok = tt >= 0 && tt < T;
      const h16* pr = p.proj + (base + (ok ? tt : t)) * INC + DN_OFF + c0;
      xq[tap] = *(const half8*)pr; xk[tap] = *(const half8*)(pr + 256); xv[tap] = *(const half8*)(pr + 512);
      tv[tap] = ok ? 1.0f : 0.0f;
    }
    __builtin_amdgcn_sched_barrier(0);
#pragma unroll
    for (int tap = 0; tap < 5; ++tap) {
      const float* cw = p.dnconv + ((long)l * 5 + tap) * 768 + c0;
#pragma unroll
      for (int e = 0; e < 8; ++e) {
        aq[e] += (float)xq[tap][e] * (cw[e] * tv[tap]); ak[e] += (float)xk[tap][e] * (cw[256 + e] * tv[tap]); av[e] += (float)xv[tap][e] * (cw[512 + e] * tv[tap]);
      }
    }
    float ssq = 0.f, ssk = 0.f;
#pragma unroll
    for (int e = 0; e < 8; ++e) { aq[e] = fsilu(aq[e]); ak[e] = fsilu(ak[e]); av[e] = fsilu(av[e]); ssq += aq[e] * aq[e]; ssk += ak[e] * ak[e]; }
    ssq = sum8(ssq); ssk = sum8(ssk);
    const float rq = 0.125f / sqrtf(ssq + 1e-6f), rk = 1.0f / sqrtf(ssk + 1e-6f);
    half8 qo, ko, vo;
#pragma unroll
    for (int e = 0; e < 8; ++e) { qo[e] = (h16)(aq[e] * rq); ko[e] = (h16)(ak[e] * rk); vo[e] = (h16)av[e]; }
    h16* dp = p.dnp + token * 768 + c0;
    *(half8*)dp = qo; *(half8*)(dp + 256) = ko; *(half8*)(dp + 512) = vo;
    if (part < 2) {
      const int d = part;
      const h16* pr = p.proj + token * INC + DN_OFF;
      float* sc = p.dnsc + ((token * 2 + d) * 4 + h) * 2;
      sc[0] = sigmoidf_((float)pr[768 + d * 4 + h]);
      sc[1] = expf(-expf(p.dnalog[(l * 2 + d) * 4 + h]) * softplusf_((float)pr[776 + d * 4 + h] + p.dndt[(l * 2 + d) * 4 + h]));
    }
  }
}
__device__ void blk_scan2(int kind, int bi, int h, int d, int rq, const P& p, int l) {
  float* L = (float*)g_smem;
  float* LA = L; float* LW = L + 2048; float* LB = L + 4096; float* LK = L + 6144; float* LR = L + 8192; float* LV = L + 10240;
  const int tid = otid(), lane = tid & 63, wv = tid >> 6, g = lane >> 4, cl = lane & 15;
  const int i = rq * 32 + wv * 8 + g * 2, j0 = cl * 4;
  const bool ctx = bi < CFG_BATCH;
  const int T = ctx ? CFG_SEQ : CFG_DS;
  const long base = ctx ? (long)bi * CFG_SEQ : (long)NTC + (long)(bi - CFG_BATCH) * CFG_DS;
  const int ls = tid >> 3, part = tid & 7;
  f32x4 S = {0.f, 0.f, 0.f, 0.f}, S1 = {0.f, 0.f, 0.f, 0.f};
  if (!ctx) {
    const int b = bi - CFG_BATCH;
    if (kind == 0) {
      const float* s0 = p.srw + (((((long)b) * 2 + l) * 2 + d) * 4 + h) * 4096;
      S = *(const f32x4*)(s0 + i * 64 + j0); S1 = *(const f32x4*)(s0 + (i + 1) * 64 + j0);
    } else {
      const float* s0 = p.sdn + (((((long)b) * 2 + l) * 2 + d) * 4 + h) * 4096;
#pragma unroll
      for (int c = 0; c < 4; ++c) { S[c] = s0[(j0 + c) * 64 + i]; S1[c] = s0[(j0 + c) * 64 + i + 1]; }
    }
  }
  h16* obuf = (h16*)(L + 12288);
  h16* obase = (kind == 0 ? p.act + 256 + d * 512 + h * 64 : p.proj + DN_OFF + d * 256 + h * 64) + rq * 32 + (tid & 7) * 4;
  const long ostride = kind == 0 ? 1024 : INC;
#define SC_FLUSH(S0I)                                                                              \
  { const int sidx_ = (S0I) + (tid >> 3); const int t_ = d == 0 ? sidx_ : T - 1 - sidx_;             \
    *(half4*)(obase + (base + t_) * ostride) = *(const half4*)(obuf + (tid >> 3) * 32 + (tid & 7) * 4); }
  const int c0 = h * 64 + part * 8, jb = part * 8;
  float cmr[8], cmk[8], cmv[8], ckk[8], cka[8];
#pragma unroll
  for (int e = 0; e < 8; ++e) { cmr[e] = 0.f; cmk[e] = 0.f; cmv[e] = 0.f; ckk[e] = 0.f; cka[e] = 0.f; }
  if (kind == 0) {
    const float* mu = p.rwmu + ((long)l * 2 + d) * 832;
#pragma unroll
    for (int e = 0; e < 8; ++e) { cmr[e] = mu[c0 + e]; cmk[e] = mu[256 + c0 + e]; cmv[e] = mu[512 + c0 + e]; ckk[e] = p.rwkk[l * 256 + c0 + e]; cka[e] = p.rwka[l * 256 + c0 + e]; }
  }
  half8 g0, g1, g2, g3, g4, g5, g6, g7; float gf0 = 0.f, gf1 = 0.f; bool gsv = false;
  g0 = g1 = g2 = g3 = g4 = g5 = g6 = g7 = (half8){0, 0, 0, 0, 0, 0, 0, 0};
#define SC_LOADG(S0I)                                                                              \
  {                                                                                                \
    const int sidx_ = (S0I) + ls;                                                                  \
    const int t_ = d == 0 ? sidx_ : T - 1 - sidx_;                                                 \
    const long token_ = base + t_;                                                                 \
    if (kind == 0) {                                                                               \
      gsv = d == 0 ? (t_ > 0) : (t_ < T - 1);                                                      \
      const h16* pb_ = p.proj + token_ * INC + RW_OFF + c0;                                        \
      const h16* ps_ = gsv ? p.proj + (token_ + (d == 0 ? -1 : 1)) * INC + RW_OFF + c0 : pb_;      \
      g0 = *(const half8*)pb_; g1 = *(const half8*)(pb_ + 256); g2 = *(const half8*)(pb_ + 512);   \
      g3 = *(const half8*)ps_; g4 = *(const half8*)(ps_ + 256); g5 = *(const half8*)(ps_ + 512);   \
      g6 = *(const half8*)(p.rwaux + ((token_ * 2 + d) * 2 + 0) * 256 + c0);                       \
      g7 = *(const half8*)(p.rwaux + ((token_ * 2 + d) * 2 + 1) * 256 + c0);                       \
      gf0 = p.rwsc[((token_ * 2 + d) * 4 + h) * 2];                                                \
    } else {                                                                                       \
      const h16* dp_ = p.dnp + token_ * 768 + c0;                                                  \
      g0 = *(const half8*)dp_; g1 = *(const half8*)(dp_ + 256); g2 = *(const half8*)(dp_ + 512);   \
      const float* sc_ = p.dnsc + ((token_ * 2 + d) * 4 + h) * 2;                                  \
      gf0 = sc_[0]; gf1 = sc_[1];                                                                  \
    }                                                                                              \
  }
  SC_LOADG(0)
  for (int s0i = 0; s0i < T; s0i += SC_CT) {
    __syncthreads();
    if (s0i > 0) SC_FLUSH(s0i - SC_CT)
    {
      f32x4 va[2], vw[2], vb[2], vk[2], vr[2], vv_[2];
      if (kind == 0) {
#pragma unroll
        for (int e = 0; e < 8; ++e) {
          float b_ = (float)g0[e], s_ = gsv ? (float)g3[e] : 0.f; const float rr = b_ + (s_ - b_) * cmr[e];
          b_ = (float)g1[e]; s_ = gsv ? (float)g4[e] : 0.f; const float kr = b_ + (s_ - b_) * cmk[e];
          b_ = (float)g2[e]; s_ = gsv ? (float)g5[e] : 0.f; const float vl = b_ + (s_ - b_) * cmv[e];
          const float asg = (float)g7[e];
          const float kk = kr * ckk[e] * gf0;
          va[e >> 2][e & 3] = -kk; vw[e >> 2][e & 3] = __expf(-(float)g6[e]); vb[e >> 2][e & 3] = kk * asg;
          vk[e >> 2][e & 3] = kr * (1.0f + (asg - 1.0f) * cka[e]); vr[e >> 2][e & 3] = rr; vv_[e >> 2][e & 3] = vl;
        }
      } else {
        const float beta = gf0, alpha = gf1;
#pragma unroll
        for (int e = 0; e < 8; ++e) {
          const float k = (float)g1[e];
          va[e >> 2][e & 3] = k; vw[e >> 2][e & 3] = alpha; vb[e >> 2][e & 3] = -alpha * beta * k;
          vk[e >> 2][e & 3] = beta * k; vr[e >> 2][e & 3] = (float)g0[e]; vv_[e >> 2][e & 3] = (float)g2[e];
        }
      }
      const int lo_ = ls * 64 + jb;
      *(f32x4*)(LA + lo_) = va[0]; *(f32x4*)(LA + lo_ + 4) = va[1]; *(f32x4*)(LW + lo_) = vw[0]; *(f32x4*)(LW + lo_ + 4) = vw[1];
      *(f32x4*)(LB + lo_) = vb[0]; *(f32x4*)(LB + lo_ + 4) = vb[1]; *(f32x4*)(LK + lo_) = vk[0]; *(f32x4*)(LK + lo_ + 4) = vk[1];
      *(f32x4*)(LR + lo_) = vr[0]; *(f32x4*)(LR + lo_ + 4) = vr[1]; *(f32x4*)(LV + lo_) = vv_[0]; *(f32x4*)(LV + lo_ + 4) = vv_[1];
    }
    __syncthreads();
    if (s0i + SC_CT < T) SC_LOADG(s0i + SC_CT)
    __builtin_amdgcn_sched_barrier(0);
#define SC_LD(A4, W4, B4, K4, R4, VV, Q)                                                                    \
    { const int o_ = (Q) * 64; A4 = *(const f32x4*)(LA + o_ + j0); W4 = *(const f32x4*)(LW + o_ + j0); B4 = *(const f32x4*)(LB + o_ + j0); \
      K4 = *(const f32x4*)(LK + o_ + j0); R4 = *(const f32x4*)(LR + o_ + j0); VV = *(const f32x2*)(LV + o_ + i); }
#define SC_STEP(ca, cw, cb, ck, cr, cv, Q)                                                                  \
    {                                                                                                       \
      float sa = S[0] * ca[0] + S[1] * ca[1] + S[2] * ca[2] + S[3] * ca[3];                                 \
      float sb = S1[0] * ca[0] + S1[1] * ca[1] + S1[2] * ca[2] + S1[3] * ca[3];                             \
      sa = sum16(sa); sb = sum16(sb);                                                                       \
      _Pragma("unroll") for (int c = 0; c < 4; ++c) { S[c] = S[c] * cw[c] + sa * cb[c] + cv[0] * ck[c]; S1[c] = S1[c] * cw[c] + sb * cb[c] + cv[1] * ck[c]; } \
      float o = S[0] * cr[0] + S[1] * cr[1] + S[2] * cr[2] + S[3] * cr[3];                                  \
      float o1 = S1[0] * cr[0] + S1[1] * cr[1] + S1[2] * cr[2] + S1[3] * cr[3];                             \
      o = sum16(o); o1 = sum16(o1);                                                                         \
      { half2v ov; ov[0] = (h16)o; ov[1] = (h16)o1; *(half2v*)(obuf + (Q) * 32 + wv * 8 + g * 2) = ov; }   \
    }
    f32x4 a4, w4, b4, k4, r4, a5, w5, b5, k5, r5; f32x2 vv, vv5;
    SC_LD(a4, w4, b4, k4, r4, vv, 0)
    for (int q = 0; q < SC_CT; q += 2) {
      SC_LD(a5, w5, b5, k5, r5, vv5, q + 1)
      SC_STEP(a4, w4, b4, k4, r4, vv, q)
      SC_LD(a4, w4, b4, k4, r4, vv, q + 2)
      SC_STEP(a5, w5, b5, k5, r5, vv5, q + 1)
    }
#undef SC_LD
#undef SC_STEP
  }
  __syncthreads();
  SC_FLUSH(T - SC_CT)
#undef SC_FLUSH
  if (ctx) {
    if (kind == 0) {
      float* so = p.orw + (((((long)bi) * 2 + l) * 2 + d) * 4 + h) * 4096;
      *(f32x4*)(so + i * 64 + j0) = S; *(f32x4*)(so + (i + 1) * 64 + j0) = S1;
    } else {
      float* so = p.odn + (((((long)bi) * 2 + l) * 2 + d) * 4 + h) * 4096;
#pragma unroll
      for (int c = 0; c < 4; ++c) { so[(j0 + c) * 64 + i] = S[c]; so[(j0 + c) * 64 + i + 1] = S1[c]; }
    }
  }
}
#undef SC_LOADG
__device__ void blk_fin(long w, const P& p, int l, const float* g2s, float* sgs) {
  const int tid_ = otid(); const int lane = tid_ & 63; const long token = w * 4 + (tid_ >> 6);
  float* sgw = sgs + (tid_ >> 6) * 64;
  const int c4 = lane * 4;
  const int hd = lane >> 4;
  const h16* pr = p.proj + token * INC;
  h16* ao = p.act + token * 1024;
  int t, T; long base; seqinfo(token, t, T, base);
  const bool sv0 = t > 0, sv1 = t < T - 1;
  const float bon0 = p.rwsc[((token * 2 + 0) * 4 + hd) * 2 + 1], bon1 = p.rwsc[((token * 2 + 1) * 4 + hd) * 2 + 1];
  const half4 vb = *(const half4*)(pr + RW_OFF + 512 + c4);
  half4 vm = vb, vp = vb;
  if (sv0) vm = *(const half4*)(pr - INC + RW_OFF + 512 + c4);
  if (sv1) vp = *(const half4*)(pr + INC + RW_OFF + 512 + c4);
  const half4 d_o0 = *(const half4*)(pr + DN_OFF + c4), d_o1 = *(const half4*)(pr + DN_OFF + 256 + c4);
  const half4 d_z = *(const half4*)(pr + DN_OFF + 784 + c4);
  const f32x4 mu0 = *(const f32x4*)(p.rwmu + ((long)l * 2 + 0) * 832 + 512 + c4), mu1 = *(const f32x4*)(p.rwmu + ((long)l * 2 + 1) * 832 + 512 + c4);
  const f32x4 lng = *(const f32x4*)(p.rwlng + l * 256 + c4), lnb = *(const f32x4*)(p.rwlnb + l * 256 + c4);
  const f32x4 dng = *(const f32x4*)(p.dnng + l * 64 + (c4 & 63));
  {
    half4 o0 = *(const half4*)(ao + 256 + c4), o1 = *(const half4*)(ao + 768 + c4);
    float o[4]; float mu = 0.f;
#pragma unroll
    for (int e = 0; e < 4; ++e) { o[e] = (float)o0[e] + (float)o1[e]; mu += o[e]; }
    mu = sum16(mu) * (1.0f / 64);
    float var = 0.f;
#pragma unroll
    for (int e = 0; e < 4; ++e) { float dl = o[e] - mu; var += dl * dl; }
    var = sum16(var) * (1.0f / 64);
    const float rs = 1.0f / sqrtf(var + 64e-5f);
    const float sg = sigmoidf_((float)pr[RW_OFF + 896 + lane]);
    float gate[4] = {0.f, 0.f, 0.f, 0.f};
    sgw[lane] = sg;
    __syncthreads();
#pragma unroll 8
    for (int j = 0; j < 64; ++j) {
      const float sj = sgw[j];
      const f32x4 g2 = *(const f32x4*)(g2s + j * 256 + c4);
#pragma unroll
      for (int e = 0; e < 4; ++e) gate[e] += sj * g2[e];
    }
    half4 out;
#pragma unroll
    for (int e = 0; e < 4; ++e) {
      const float b_ = (float)vb[e];
      const float v0 = b_ + ((sv0 ? (float)vm[e] : 0.f) - b_) * mu0[e];
      const float v1 = b_ + ((sv1 ? (float)vp[e] : 0.f) - b_) * mu1[e];
      float y = (o[e] - mu) * rs * lng[e] + lnb[e] + bon0 * v0 + bon1 * v1;
      out[e] = (h16)(y * gate[e]);
    }
    *(half4*)(ao + 256 + c4) = out;
  }
  {
    const half4 o0 = d_o0, o1 = d_o1, z = d_z;
    float o[4]; float ss = 0.f;
#pragma unroll
    for (int e = 0; e < 4; ++e) { o[e] = (float)o0[e] + (float)o1[e]; ss += o[e] * o[e]; }
    ss = sum16(ss);
    const float rs = 1.0f / sqrtf(ss * (1.0f / 64) + 1e-6f);
    half4 out;
#pragma unroll
    for (int e = 0; e < 4; ++e) out[e] = (h16)(o[e] * rs * dng[e] * siluf_((float)z[e]));
    *(half4*)(ao + 768 + c4) = out;
  }
}

__device__ __forceinline__ float dot8h(half8 u, half8 x, float d) {
#pragma unroll
  for (int e = 0; e < 8; ++e) d += (float)u[e] * (float)x[e];
  return d;
}
__device__ __forceinline__ void cvt8(const float* src, h16* dst, long i) {
  const f32x4 a = *(const f32x4*)(src + i * 8), b = *(const f32x4*)(src + i * 8 + 4);
  half8 o; o[0] = (h16)a[0]; o[1] = (h16)a[1]; o[2] = (h16)a[2]; o[3] = (h16)a[3]; o[4] = (h16)b[0]; o[5] = (h16)b[1]; o[6] = (h16)b[2]; o[7] = (h16)b[3];
  *(half8*)(dst + i * 8) = o;
}
__device__ __forceinline__ float sum64u(float x) {
  x = sum16(x);
  x += __builtin_bit_cast(float, __builtin_amdgcn_update_dpp(0, __builtin_bit_cast(int, x), 0x142, 0xA, 0xF, false));
  x += __builtin_bit_cast(float, __builtin_amdgcn_update_dpp(0, __builtin_bit_cast(int, x), 0x143, 0xC, 0xF, false));
  return __builtin_bit_cast(float, __builtin_amdgcn_readlane(__builtin_bit_cast(int, x), 63));
}
__device__ __forceinline__ float ferf(float x) {
  const float ax = fabsf(x);
  const float t = __frcp_rn(1.0f + 0.3275911f * ax);
  const float y = 1.0f - (((((1.061405429f * t - 1.453152027f) * t) + 1.421413741f) * t - 0.284496736f) * t + 0.254829592f) * t * __expf(-ax * ax);
  return x < 0.f ? -y : y;
}
__device__ __forceinline__ void cvt16_fp8(const float* src, unsigned char* dst, long i, float scale) {
  u32x4 o;
#pragma unroll
  for (int k = 0; k < 4; ++k) {
    const f32x4 a = *(const f32x4*)(src + i * 16 + k * 4);
    int w = __builtin_amdgcn_cvt_pk_fp8_f32(a[0] * scale, a[1] * scale, 0, false);
    w = __builtin_amdgcn_cvt_pk_fp8_f32(a[2] * scale, a[3] * scale, w, true);
    o[k] = (unsigned)w;
  }
  *(u32x4*)(dst + i * 16) = o;
}
__device__ void fin_phase(const P& p, int l) {
  float* g2s = (float*)g_smem;
  float* sgs = g2s + 64 * 256;
  const int tid = otid();
  __syncthreads();
  const f32x4* src = (const f32x4*)(p.rwg2 + (long)l * 64 * 256);
#pragma unroll
  for (int j = 0; j < 16; ++j) ((f32x4*)g2s)[tid + 256 * j] = src[tid + 256 * j];
  __syncthreads();
  for (long w = blockIdx.x; w < NT / 4; w += gridDim.x) blk_fin(w, p, l, g2s, sgs);
}
typedef unsigned u32x2 __attribute__((ext_vector_type(2)));
__device__ __forceinline__ void cvt16_fp4(const float* src, unsigned char* dst, long i, float scale) {
  u32x2 o;
#pragma unroll
  for (int k = 0; k < 2; ++k) {
    const f32x4 a = *(const f32x4*)(src + i * 16 + k * 8), b = *(const f32x4*)(src + i * 16 + k * 8 + 4);
    unsigned w = 0u;
    w = __builtin_amdgcn_cvt_scalef32_pk_fp4_f32(w, a[0] * scale, a[1] * scale, 1.0f, 0);
    w = __builtin_amdgcn_cvt_scalef32_pk_fp4_f32(w, a[2] * scale, a[3] * scale, 1.0f, 1);
    w = __builtin_amdgcn_cvt_scalef32_pk_fp4_f32(w, b[0] * scale, b[1] * scale, 1.0f, 2);
    w = __builtin_amdgcn_cvt_scalef32_pk_fp4_f32(w, b[2] * scale, b[3] * scale, 1.0f, 3);
    o[k] = w;
  }
  *(u32x2*)(dst + i * 8) = o;
}
#define PEER_USCALE 48.0f
#define PEER_VSCALE 16.0f
struct PairTab { int a[50]; int b[50]; };
__host__ __device__ constexpr PairTab make_pairs() {
  PairTab t{}; int n = 0;
  for (int a = 0; a < 16; ++a) for (int b = 0; b < 16; ++b) if ((a + 1) * (b + 1) <= 16) { t.a[n] = a; t.b[n] = b; ++n; }
  return t;
}
template <bool DRY>
__device__ void blk_peer(long w, const P& p, int l) {
  constexpr PairTab PT = make_pairs();
  const int tid_ = otid(); const int lane = tid_ & 63, wv = tid_ >> 6; const long token = w * 4 + wv;
  int* eidx = (int*)g_smem + wv * 256; float* egate = (float*)g_smem + wv * 256 + 128;
  const h16* xr = p.act + token * 1024 + lane * 16;
  const half8 x0 = *(const half8*)xr, x1 = *(const half8*)(xr + 8);
  int la = 0, lb = 0;
#pragma unroll
  for (int j = 0; j < 50; ++j) if (lane == j) { la = PT.a[j]; lb = PT.b[j]; }
  const int lc = la * 16 + lb;
  __syncthreads();
  float cs_[8]; int ce_[8];
#pragma unroll
  for (int hd = 0; hd < 8; ++hd) {
    const float* s1 = p.tks + token * 256 + hd * 32; const int* i1 = p.tki + token * 256 + hd * 32;
    const int la_ = lane < 50 ? la : 0, lb_ = lane < 50 ? lb : 0;
    cs_[hd] = s1[la_] + s1[16 + lb_]; ce_[hd] = i1[la_] * CFG_NKEYS + i1[16 + lb_];
  }
#pragma unroll
  for (int hd = 0; hd < 8; ++hd) {
    const float s = lane < 50 ? cs_[hd] : -3.0e38f;
    int rank = 0;
#pragma unroll
    for (int j = 0; j < 50; ++j) {
      const float sj = __builtin_bit_cast(float, __builtin_amdgcn_readlane(__builtin_bit_cast(int, s), j));
      rank += (sj > s) ? 1 : 0;
    }
    {
      int mk = (lane < 50 && rank < 16) ? (1 << rank) : 0;
      mk |= __builtin_amdgcn_update_dpp(0, mk, 0x128, 0xF, 0xF, true); mk |= __builtin_amdgcn_update_dpp(0, mk, 0x124, 0xF, 0xF, true);
      mk |= __builtin_amdgcn_update_dpp(0, mk, 0xB1, 0xF, 0xF, true);  mk |= __builtin_amdgcn_update_dpp(0, mk, 0x4E, 0xF, 0xF, true);
      const int mall = __builtin_amdgcn_readlane(mk, 0) | __builtin_amdgcn_readlane(mk, 16) | __builtin_amdgcn_readlane(mk, 32) | __builtin_amdgcn_readlane(mk, 48);
      const int nsel = __builtin_popcountll(__ballot(lane < 50 && rank < 16));
      if (mall != 0xFFFF || nsel != 16) {
        rank = 0;
#pragma unroll 1
        for (int j = 0; j < 50; ++j) {
          const float sj = __builtin_bit_cast(float, __builtin_amdgcn_readlane(__builtin_bit_cast(int, s), j));
          rank += (sj > s || (sj == s && j < lane)) ? 1 : 0;
        }
      }
    }
    const bool sel = lane < 50 && rank < 16;
    const float m = __builtin_bit_cast(float, __builtin_amdgcn_readlane(__builtin_bit_cast(int, s), 0));
    const float e = sel ? expf(s - m) : 0.f;
    const float sum = sum64(e);
    if (sel) { eidx[hd * 16 + rank] = ce_[hd]; egate[hd * 16 + rank] = e / sum; }
  }
  __syncthreads();
  f32x2 x2[8];
#pragma unroll
  for (int e = 0; e < 4; ++e) { x2[e][0] = (float)x0[2 * e]; x2[e][1] = (float)x0[2 * e + 1]; x2[4 + e][0] = (float)x1[2 * e]; x2[4 + e][1] = (float)x1[2 * e + 1]; }
  f32x2 acc2[8];
#pragma unroll
  for (int e = 0; e < 8; ++e) { acc2[e][0] = 0.f; acc2[e][1] = 0.f; }
  const unsigned char* u8 = (const unsigned char*)p.u16; const unsigned char* v8 = (const unsigned char*)p.v16;
#define PEER_LOAD(U, V, GT, EB)                                                                   \
  _Pragma("unroll") for (int q = 0; q < 8; ++q) {                                                 \
    const unsigned ro_ = (unsigned)eidx[(EB) + q] * 512u + (unsigned)lane * 8u; GT[q] = egate[(EB) + q];   \
    U[q] = *(const u32x2*)(u8 + ro_); V[q] = *(const u32x2*)(v8 + ro_);                           \
  }
#define PEER_COMP(U, V, GT)                                                                       \
  {                                                                                               \
    float dd_[8];                                                                                 \
    _Pragma("unroll") for (int q = 0; q < 8; ++q) {                                               \
      f32x2 d2 = {0.f, 0.f};                                                                      \
      _Pragma("unroll") for (int k = 0; k < 2; ++k) {                                             \
        d2 += __builtin_amdgcn_cvt_scalef32_pk_f32_fp4(U[q][k], 1.0f, 0) * x2[4 * k];             \
        d2 += __builtin_amdgcn_cvt_scalef32_pk_f32_fp4(U[q][k], 1.0f, 1) * x2[4 * k + 1];         \
        d2 += __builtin_amdgcn_cvt_scalef32_pk_f32_fp4(U[q][k], 1.0f, 2) * x2[4 * k + 2];         \
        d2 += __builtin_amdgcn_cvt_scalef32_pk_f32_fp4(U[q][k], 1.0f, 3) * x2[4 * k + 3];         \
      }                                                                                           \
      dd_[q] = sum64u(d2[0] + d2[1]) * (1.0f / PEER_USCALE);                                      \
    }                                                                                             \
      \
    float dv_ = dd_[7];                                                                           \
    _Pragma("unroll") for (int q = 6; q >= 0; --q) dv_ = lane == q ? dd_[q] : dv_;                \
    const float gv_ = 0.5f * dv_ * (1.0f + erff(dv_ * 0.70710678118654752f));                     \
    _Pragma("unroll") for (int q = 0; q < 8; ++q) {                                               \
      const float wgt = GT[q] * __builtin_bit_cast(float, __builtin_amdgcn_readlane(__builtin_bit_cast(int, gv_), q)) * (1.0f / PEER_VSCALE); \
      const f32x2 w2 = {wgt, wgt};                                                                \
      _Pragma("unroll") for (int k = 0; k < 2; ++k) {                                             \
        acc2[4 * k] += w2 * __builtin_amdgcn_cvt_scalef32_pk_f32_fp4(V[q][k], 1.0f, 0);           \
        acc2[4 * k + 1] += w2 * __builtin_amdgcn_cvt_scalef32_pk_f32_fp4(V[q][k], 1.0f, 1);       \
        acc2[4 * k + 2] += w2 * __builtin_amdgcn_cvt_scalef32_pk_f32_fp4(V[q][k], 1.0f, 2);       \
        acc2[4 * k + 3] += w2 * __builtin_amdgcn_cvt_scalef32_pk_f32_fp4(V[q][k], 1.0f, 3);       \
      }                                                                                           \
    }                                                                                             \
  }
  u32x2 au[8], av[8], bu[8], bv[8];
  float ag[8], bg[8];
  PEER_LOAD(au, av, ag, 0)
  for (int eb = 0; eb < 128; eb += 16) {
    PEER_LOAD(bu, bv, bg, eb + 8)
    __builtin_amdgcn_sched_barrier(0);
    PEER_COMP(au, av, ag)
    if (eb + 16 < 128) { PEER_LOAD(au, av, ag, eb + 16) }
    __builtin_amdgcn_sched_barrier(0);
    PEER_COMP(bu, bv, bg)
  }
#undef PEER_LOAD
#undef PEER_COMP
  const float* g2 = p.mod + ((long)l * NCOND + condrow(token)) * 6144 + 5120 + lane * 16;
  float* xo = p.X + token * 1024 + lane * 16;
  f32x4 xn[4]; float ssq = 0.f;
#pragma unroll
  for (int k = 0; k < 4; ++k) {
    xn[k] = *(f32x4*)(xo + 4 * k);
    const f32x4 ga = *(const f32x4*)(g2 + 4 * k);
#pragma unroll
    for (int e = 0; e < 4; ++e) { xn[k][e] += ga[e] * acc2[2 * k + (e >> 1)][e & 1]; ssq += xn[k][e] * xn[k][e]; }
  }
  if (DRY) { if (acc2[0][0] == 123456.789f) *(f32x4*)xo = xn[0]; return; }
  const float rstd = 1.0f / sqrtf(sum64u(ssq) * (1.0f / 1024) + 1e-6f);
  if (l == 0) {
    const float* m = p.mod + ((long)1 * NCOND + condrow(token)) * 6144 + lane * 16;
    const float* g = p.n1g + 1024 + lane * 16;
    half8 h0, h1;
    f32x4 gga[4], sha[4], sca[4];
#pragma unroll
    for (int k = 0; k < 4; ++k) { gga[k] = *(const f32x4*)(g + 4 * k); sha[k] = *(const f32x4*)(m + 4 * k); sca[k] = *(const f32x4*)(m + 1024 + 4 * k); }
#pragma unroll
    for (int k = 0; k < 4; ++k) {
      *(f32x4*)(xo + 4 * k) = xn[k];
      const f32x4 gg = gga[k], sh = sha[k], sc = sca[k];
#pragma unroll
      for (int e = 0; e < 4; ++e) {
        const h16 hv = (h16)((xn[k][e] * rstd * gg[e]) * (1.0f + sc[e]) + sh[e]);
        if (k < 2) h0[4 * k + e] = hv; else h1[4 * (k - 2) + e] = hv;
      }
    }
    h16* ho = p.act + token * 1024 + lane * 16;
    *(half8*)ho = h0; *(half8*)(ho + 8) = h1;
  } else {
    f32x4 fga[4];
#pragma unroll
    for (int k = 0; k < 4; ++k) fga[k] = *(const f32x4*)(p.fng + lane * 16 + 4 * k);
#pragma unroll
    for (int k = 0; k < 4; ++k) {
      const f32x4 gg = fga[k];
      f32x4 y;
#pragma unroll
      for (int e = 0; e < 4; ++e) y[e] = xn[k][e] * rstd * gg[e];
      *(f32x4*)(xo + 4 * k) = y;
    }
  }
}

__device__ void blk_attn(int type, int idx, const P& p, int l) {
  h16* Ks = (h16*)g_smem;
  h16* Vt = Ks + 64 * 72;
  float* Bt = (float*)(Vt + 64 * 72);
  const int tid = otid(), lane = tid & 63, wv = tid >> 6, ql = lane & 31, hh = lane >> 5;
  int b, hk, tb; long qtok; int qcol_off, kcol_off, vcol_off, outcol; float qscale; int ntl, ntc; long kbase_tok;
  const float *ck = nullptr, *cv = nullptr;
  int grow = 0, r0w = 0, krmin = 0;
  if (type == 0) {
    tb = idx & 3; hk = (idx >> 2) & 1; b = idx >> 3;
    const int head = hk * 2 + (wv & 1);
    kbase_tok = (long)b * CFG_SEQ; qtok = kbase_tok + tb * 64 + (wv >> 1) * 32 + ql;
    qcol_off = head * 64; kcol_off = 256 + hk * 64; vcol_off = 384 + hk * 64; outcol = head * 64; qscale = 1.0f; ntl = CFG_SEQ / 64; ntc = 0;
  } else if (type == 1) {
    tb = idx & 63; hk = (idx >> 6) & 1; b = idx >> 7;
    const int head = hk * 2 + (wv & 1);
    kbase_tok = (long)NTC + (long)b * CFG_DS; qtok = kbase_tok + tb * 64 + (wv >> 1) * 32 + ql;
    qcol_off = head * 64; kcol_off = 256 + hk * 64; vcol_off = 384 + hk * 64; outcol = head * 64; qscale = 1.0f; ntl = CFG_DS / 64; ntc = CFG_PAST / 64;
    ck = p.cgk + (((long)b * 2 + l) * 2 + hk) * CFG_PAST * 64; cv = p.cgv + (((long)b * 2 + l) * 2 + hk) * CFG_PAST * 64;
  } else if (type == 2) {
    tb = idx & 1; hk = (idx >> 1) & 3; b = idx >> 3;
    kbase_tok = (long)b * CFG_SEQ; qtok = kbase_tok + tb * 128 + wv * 32 + ql;
    qcol_off = NA_OFF + hk * 64; kcol_off = NA_OFF + 256 + hk * 64; vcol_off = NA_OFF + 512 + hk * 64; outcol = 512 + hk * 64; qscale = 0.125f; ntl = CFG_SEQ / 64; ntc = 0;
  } else {
    tb = idx & 31; hk = (idx >> 5) & 3; b = idx >> 7;
    kbase_tok = (long)NTC + (long)b * CFG_DS;
    grow = tb * 2 + (wv >> 1);
    qtok = kbase_tok + grow * 64 + (wv & 1) * 32 + ql;
    qcol_off = NA_OFF + hk * 64; kcol_off = NA_OFF + 256 + hk * 64; vcol_off = NA_OFF + 512 + hk * 64; outcol = 512 + hk * 64; qscale = 0.125f;
    r0w = grow - WR / 2; r0w = r0w < 0 ? 0 : (r0w > GROWS - WR ? GROWS - WR : r0w);
    int ra = tb * 2 - WR / 2; ra = ra < 0 ? 0 : (ra > GROWS - WR ? GROWS - WR : ra);
    int rb = tb * 2 + 1 - WR / 2; rb = rb < 0 ? 0 : (rb > GROWS - WR ? GROWS - WR : rb);
    krmin = ra; ntl = rb + WR - ra; ntc = CFG_PAST / 64;
    ck = p.cnk + (((long)b * 2 + l) * 4 + hk) * CFG_PAST * 64; cv = p.cnv + (((long)b * 2 + l) * 4 + hk) * CFG_PAST * 64;
  }
  const int nt = ntl + ntc;
  __syncthreads();
  if (type == 3) { for (int e = tid; e < 465; e += 256) Bt[e] = p.nabias[((long)l * 4 + hk) * 465 + e]; }
  half8 qf[4];
  {
    const h16* qp = p.proj + qtok * INC + qcol_off + hh * 8;
#pragma unroll
    for (int ds = 0; ds < 4; ++ds) qf[ds] = *(const half8*)(qp + ds * 16);
  }
  const int qc = (int)((qtok - kbase_tok) & 63);
  int cst = qc - 8; cst = cst < 0 ? 0 : (cst > 48 ? 48 : cst);
  f32x16 o0 = {0.f, 0.f, 0.f, 0.f, 0.f, 0.f, 0.f, 0.f, 0.f, 0.f, 0.f, 0.f, 0.f, 0.f, 0.f, 0.f};
  f32x16 o1 = o0;
  float m = -1.0e30f, lsum = 0.f;
  half8 kx0, kx1, vx0, vx1;
  const int skey0 = tid >> 3, sdc = tid & 7;
#define ATT_LOAD(TI)                                                                                       \
  {                                                                                                        \
    const int ti_ = (TI);                                                                                  \
    if (ti_ < ntc) {                                                                                       \
      const float* kk_ = ck + ((long)ti_ * 64 + skey0) * 64 + sdc * 8;                                     \
      const float* vv_ = cv + ((long)ti_ * 64 + skey0) * 64 + sdc * 8;                                     \
      f32x4 a_ = *(const f32x4*)kk_, b_ = *(const f32x4*)(kk_ + 4), c_ = *(const f32x4*)(kk_ + 2048), d_ = *(const f32x4*)(kk_ + 2052); \
      _Pragma("unroll") for (int e = 0; e < 4; ++e) { kx0[e] = (h16)a_[e]; kx0[4 + e] = (h16)b_[e]; kx1[e] = (h16)c_[e]; kx1[4 + e] = (h16)d_[e]; } \
      a_ = *(const f32x4*)vv_; b_ = *(const f32x4*)(vv_ + 4); c_ = *(const f32x4*)(vv_ + 2048); d_ = *(const f32x4*)(vv_ + 2052); \
      _Pragma("unroll") for (int e = 0; e < 4; ++e) { vx0[e] = (h16)a_[e]; vx0[4 + e] = (h16)b_[e]; vx1[e] = (h16)c_[e]; vx1[4 + e] = (h16)d_[e]; } \
    } else {                                                                                               \
      const long t0_ = kbase_tok + (long)((type == 3 ? krmin : 0) + (ti_ - ntc)) * 64;                     \
      const h16* r_ = p.proj + (t0_ + skey0) * INC + sdc * 8;                                              \
      kx0 = *(const half8*)(r_ + kcol_off); kx1 = *(const half8*)(r_ + 32 * INC + kcol_off);              \
      vx0 = *(const half8*)(r_ + vcol_off); vx1 = *(const half8*)(r_ + 32 * INC + vcol_off);              \
    }                                                                                                      \
  }
  ATT_LOAD(0)
  for (int ti = 0; ti < nt; ++ti) {
    __syncthreads();
    *(half8*)(Ks + skey0 * 72 + sdc * 8) = kx0; *(half8*)(Ks + (skey0 + 32) * 72 + sdc * 8) = kx1;
    *(half8*)(Vt + skey0 * 72 + sdc * 8) = vx0; *(half8*)(Vt + (skey0 + 32) * 72 + sdc * 8) = vx1;
    __syncthreads();
    if (ti + 1 < nt) ATT_LOAD(ti + 1)
    __builtin_amdgcn_sched_barrier(0);
    const bool local = type == 3 && ti >= ntc;
    const int kr = krmin + (ti - ntc);
    if (local && (kr < r0w || kr >= r0w + WR)) continue;
    f32x16 s0 = {0.f, 0.f, 0.f, 0.f, 0.f, 0.f, 0.f, 0.f, 0.f, 0.f, 0.f, 0.f, 0.f, 0.f, 0.f, 0.f};
    f32x16 s1 = s0;
#pragma unroll
    for (int ds = 0; ds < 4; ++ds) {
      const half8 a0 = *(const half8*)(Ks + ql * 72 + ds * 16 + hh * 8);
      const half8 a1 = *(const half8*)(Ks + (32 + ql) * 72 + ds * 16 + hh * 8);
      s0 = __builtin_amdgcn_mfma_f32_32x32x16_f16(a0, qf[ds], s0, 0, 0, 0);
      s1 = __builtin_amdgcn_mfma_f32_32x32x16_f16(a1, qf[ds], s1, 0, 0, 0);
    }
    float mx = -1.0e30f;
    if (local) {
      const float* brow = Bt + (kr - grow + 7) * 31 + 15 - qc;
#pragma unroll
      for (int i = 0; i < 16; ++i) {
        const int kc0 = (i & 3) + 8 * (i >> 2) + 4 * hh, kc1 = kc0 + 32;
        s0[i] = (kc0 >= cst && kc0 < cst + 16) ? s0[i] * 0.125f + brow[kc0] : -1.0e30f;
        s1[i] = (kc1 >= cst && kc1 < cst + 16) ? s1[i] * 0.125f + brow[kc1] : -1.0e30f;
      }
    } else if (qscale != 1.0f) {
#pragma unroll
      for (int i = 0; i < 16; ++i) { s0[i] *= qscale; s1[i] *= qscale; }
    }
#pragma unroll
    for (int i = 0; i < 16; ++i) mx = fmaxf(mx, fmaxf(s0[i], s1[i]));
    mx = fmaxf(mx, __shfl_xor(mx, 32));
    const float mn = fmaxf(m, mx);
    const float alpha = __expf(m - mn);
    m = mn; lsum *= alpha;
#pragma unroll
    for (int i = 0; i < 16; ++i) { o0[i] *= alpha; o1[i] *= alpha; }
    float ps = 0.f;
#pragma unroll
    for (int i = 0; i < 16; ++i) { s0[i] = __expf(s0[i] - mn); s1[i] = __expf(s1[i] - mn); ps += s0[i] + s1[i]; }
    lsum += ps;
    half8 pf0, pf1, pf2, pf3;
#pragma unroll
    for (int j = 0; j < 8; ++j) { pf0[j] = (h16)s0[j]; pf1[j] = (h16)s0[8 + j]; pf2[j] = (h16)s1[j]; pf3[j] = (h16)s1[8 + j]; }
#define TRD(ptr) __builtin_bit_cast(half4, __builtin_amdgcn_ds_read_tr16_b64_v4i16((__attribute__((address_space(3))) s16x4v*)(ptr)))
#define ATT_PV(KS, PF)                                                                              \
    {                                                                                               \
        \
      const h16* v0_ = Vt + (16 * (KS) + 4 * hh + ((lane & 15) >> 2)) * 72 + 16 * ((lane >> 4) & 1) + 4 * (lane & 3); \
      const half4 lo0 = TRD(v0_), hi0 = TRD(v0_ + 8 * 72);                                          \
      const half4 lo1 = TRD(v0_ + 32), hi1 = TRD(v0_ + 8 * 72 + 32);                                \
      const half8 a0_ = __builtin_shufflevector(lo0, hi0, 0, 1, 2, 3, 4, 5, 6, 7);                  \
      const half8 a1_ = __builtin_shufflevector(lo1, hi1, 0, 1, 2, 3, 4, 5, 6, 7);                  \
      o0 = __builtin_amdgcn_mfma_f32_32x32x16_f16(a0_, PF, o0, 0, 0, 0);                            \
      o1 = __builtin_amdgcn_mfma_f32_32x32x16_f16(a1_, PF, o1, 0, 0, 0);                            \
    }
    ATT_PV(0, pf0) ATT_PV(1, pf1) ATT_PV(2, pf2) ATT_PV(3, pf3)
#undef ATT_PV
#undef TRD
  }
#undef ATT_LOAD
  lsum += __shfl_xor(lsum, 32);
  const float inv = 1.0f / lsum;
  h16* op = p.act + qtok * 1024 + outcol;
#pragma unroll
  for (int g = 0; g < 4; ++g) {
    half4 a, c;
#pragma unroll
    for (int e = 0; e < 4; ++e) { a[e] = (h16)(o0[4 * g + e] * inv); c[e] = (h16)(o1[4 * g + e] * inv); }
    *(half4*)(op + 8 * g + 4 * hh) = a;
    *(half4*)(op + 32 + 8 * g + 4 * hh) = c;
  }
}
#define N_SCAN_LAT (2 * 2 * CFG_DB * 4 * 2)
#define N_SCAN_CTX (2 * 2 * CFG_BATCH * 4 * 2)
#define N_ATT1 (CFG_DB * 2 * (CFG_DS / 64))
#define N_ATT3 (CFG_DB * 4 * (CFG_DS / 128))
#define N_ATT0 (CFG_BATCH * 2 * (CFG_SEQ / 64))
#define N_ATT2 (CFG_BATCH * 4 * (CFG_SEQ / 128))
__device__ __forceinline__ void run_scan_item(int r, bool latent, const P& p, int l) {
  const int rq = r & 1; r >>= 1; const int kind = r & 1; r >>= 1; const int d = r & 1; r >>= 1; const int h = r & 3; r >>= 2;
  if (latent) __builtin_amdgcn_s_setprio(3);
  blk_scan2(kind, latent ? CFG_BATCH + r : r, h, d, rq, p, l);
  if (latent) __builtin_amdgcn_s_setprio(0);
}
__device__ void mixer_phase(const P& p, int lc, int mode = 0) {
  const int l = lc & 1;
  __shared__ long s_item;
  __shared__ unsigned s_slot;
  const long total = N_SCAN_CTX + N_ATT1 + N_ATT3 + N_ATT0 + N_ATT2;
  unsigned* lat_cnt = p.counters + 8 + lc;
  if (mode == 0) {
    __syncthreads();
    if (threadIdx.x == 0) {
      const unsigned hw = __builtin_amdgcn_s_getreg((31 << 11) | 4);
      const unsigned xcc = __builtin_amdgcn_s_getreg((3 << 11) | 20) & 0xFu;
      const unsigned key = (xcc << 8) | ((hw >> 8) & 0xFFu);
      const unsigned slot = atomicAdd(p.cucnt + lc * 4096 + key, 1u);
      s_slot = slot;
      s_item = slot == 0 ? (long)atomicAdd(lat_cnt, 1u) : (long)N_SCAN_LAT;
    }
    __syncthreads();
    const long w = s_item;
    if (w < N_SCAN_LAT) run_scan_item((int)w, true, p, l);
  }
  for (;;) {
    __syncthreads();
    if (threadIdx.x == 0) s_item = (long)atomicAdd(p.counters + lc, 1u);
    __syncthreads();
    long w = s_item;
    if (mode == 2) w += N_SCAN_CTX;
    if (w >= (mode == 1 ? (long)N_SCAN_CTX : total)) break;
    if (w < N_SCAN_CTX) {
      run_scan_item((int)w, false, p, l);
    } else {
      int a = (int)(w - N_SCAN_CTX);
      int ty;
      if (a < N_ATT1) ty = 1;
      else if ((a -= N_ATT1) < N_ATT3) ty = 3;
      else if ((a -= N_ATT3) < N_ATT0) ty = 0;
      else { a -= N_ATT0; ty = 2; }
      blk_attn(ty, a, p, l);
    }
  }
  if (mode != 2) {
    for (;;) {
      __syncthreads();
      if (threadIdx.x == 0) s_item = (long)atomicAdd(lat_cnt, 1u);
      __syncthreads();
      const long w = s_item;
      if (w >= N_SCAN_LAT) break;
      run_scan_item((int)w, true, p, l);
    }
  }
}


#define XB_TMO      128
#define XB_XCNT(j)  (256  + 64 * (j))
#define XB_XSUB(j)  (1280 + 64 * (j))
#define XB_XGEN(j)  (2304 + 64 * (j))
#define XB_TOP      3328
#define XB_TOPGEN   3392
#define XCD_BAR_WORDS 3456
#define XB_SPIN_CAP (1u << 22)
#define LAS __attribute__((address_space(3)))
__device__ __forceinline__ unsigned xb_ld(unsigned* p)              { return __hip_atomic_load(p, __ATOMIC_RELAXED, __HIP_MEMORY_SCOPE_AGENT); }
__device__ __forceinline__ unsigned xb_add(unsigned* p, unsigned v) { return __hip_atomic_fetch_add(p, v, __ATOMIC_RELAXED, __HIP_MEMORY_SCOPE_AGENT); }
__device__ __forceinline__ unsigned xb_xcc_id() { return (unsigned)__builtin_amdgcn_s_getreg((3 << 11) | 20) & 0xFu; }
#define XB_SPIN(cond, bar) do { unsigned _sp = 0; while (cond) { __builtin_amdgcn_s_sleep(1); \
    if ((++_sp & 255u) == 0u) { if (xb_ld(&(bar)[XB_TMO])) break; if (_sp > XB_SPIN_CAP) { atomicAdd(&(bar)[XB_TMO], 1u); break; } } } } while (0)
struct XcdBarrier { unsigned* bar; unsigned x; volatile LAS unsigned* st; };
__device__ __forceinline__ XcdBarrier xcd_barrier_post(unsigned* bar, volatile LAS unsigned* st) {
  XcdBarrier b; b.bar = bar; b.x = xb_xcc_id(); b.st = st;
  if (threadIdx.x == 0) (void)xb_add(&bar[XB_XCNT(b.x)], 1u);
  return b;
}
__device__ __forceinline__ void xcd_barrier_complete(unsigned* bar, unsigned x, unsigned& nloc, unsigned& nx) {
  const unsigned G = gridDim.x * gridDim.y * gridDim.z;
  unsigned sum, cnt, mine, sp = 0u;
  for (;;) {
    sum = 0u; cnt = 0u; mine = 0u;
#pragma unroll
    for (unsigned j = 0; j < 16; ++j) { const unsigned c = xb_ld(&bar[XB_XCNT(j)]); sum += c; cnt += (c > 0u) ? 1u : 0u; mine = (j == x) ? c : mine; }
    if (sum == G) break;
    __builtin_amdgcn_s_sleep(1);
    if ((++sp & 255u) == 0u) { if (xb_ld(&bar[XB_TMO])) break; if (sp > XB_SPIN_CAP) { atomicAdd(&bar[XB_TMO], 1u); break; } }
  }
  nloc = mine > 0u ? mine : 1u; nx = cnt > 0u ? cnt : 1u;
}
__device__ __forceinline__ void xcd_barrier(const XcdBarrier& b) {
  asm volatile("s_waitcnt vmcnt(0)" ::: "memory");
  __syncthreads();
  if (threadIdx.x == 0) {
    unsigned* bar = b.bar;
    __builtin_amdgcn_s_waitcnt(0);
    unsigned nloc = b.st[0], nx = b.st[1];
    if (nloc == 0u) { xcd_barrier_complete(bar, b.x, nloc, nx); b.st[0] = nloc; b.st[1] = nx; }
    const unsigned old = xb_add(&bar[XB_XSUB(b.x)], 1u);
    const unsigned gen = old / nloc;
    if (old + 1u == (gen + 1u) * nloc) {
      __builtin_amdgcn_fence(__ATOMIC_RELEASE, "agent");
      asm volatile("s_waitcnt vmcnt(0)" ::: "memory");
      const unsigned og = xb_add(&bar[XB_TOP], 1u);
      const unsigned tg = og / nx;
      if (og + 1u == (tg + 1u) * nx) xb_add(&bar[XB_TOPGEN], 1u);
      else XB_SPIN(xb_ld(&bar[XB_TOPGEN]) == tg, bar);
      __builtin_amdgcn_fence(__ATOMIC_ACQUIRE, "agent");
      xb_add(&bar[XB_XGEN(b.x)], 1u);
      asm volatile("s_waitcnt vmcnt(0)" ::: "memory");
    } else {
      XB_SPIN(xb_ld(&bar[XB_XGEN(b.x)]) == gen, bar);
      __builtin_amdgcn_fence(__ATOMIC_ACQUIRE, "agent");
      asm volatile("s_waitcnt vmcnt(0)" ::: "memory");
    }
  }
  __syncthreads();
}

#define STAGE(fn, n) for (long i_ = (long)blockIdx.x * 256 + otid(); i_ < (long)(n); i_ += (long)gridDim.x * 256) fn(i_, p, l);
#define BSTAGE(fn, n) for (long w_ = blockIdx.x; w_ < (long)(n); w_ += gridDim.x) fn(w_, p, l);
#define SYNC { XcdBarrier xb_; xb_.bar = p.xbar; xb_.x = xb_xcc_id(); xb_.st = (volatile LAS unsigned*)&xb_words; xcd_barrier(xb_); }
__global__ void __launch_bounds__(256, 2) mega(P p) {
  cg::grid_group grid = cg::this_grid();
  __shared__ uint4 xb_words;
  if (threadIdx.x == 0) xb_words = make_uint4(0u, 0u, 0u, 0u);
  __syncthreads();
  (void)xcd_barrier_post(p.xbar, (volatile LAS unsigned*)&xb_words);
#define gtid ((long)blockIdx.x * 256 + otid())
#define gstride ((long)gridDim.x * 256)
  { int l = 0;
    if (gtid < 16) p.counters[gtid] = 0u;
    for (long i_ = gtid; i_ < 4 * 4096; i_ += gstride) p.cucnt[i_] = 0u;
    for (int rep_ = 0; rep_ < REP_S0; ++rep_) {
    for (long w_ = blockIdx.x; w_ < 3200; w_ += gridDim.x) blk_convert(w_, p);
    for (long w_ = blockIdx.x; w_ < 2L * NCOND * 24; w_ += gridDim.x) blk_mod(w_, p);
    for (long i_ = gtid; i_ < 2L * 16 * CFG_NKEYS * 128 / 8; i_ += gstride) cvt8(p.pkeys, p.keys16, i_);
    }
  }
  grid.sync();
#pragma unroll 1
  for (int ph = 0; ph < 18; ++ph) {
    const int l = ph >= 9 ? 1 : 0; const int k = ph - 9 * l;
    if (k == 0 && l == 1) continue;
    switch (k) {
      case 0: { BSTAGE(blk_norm<0>, NT / 4) } break;
      case 1: gemm_phase<0>(p, l); break;
      case 2: {
        STAGE(b_prep_gqa, (long)NT * 6)
        STAGE(b_prep_cache, (long)NTC * 640)
        half8 bf0 = {0, 0, 0, 0, 0, 0, 0, 0}, bf1 = bf0; int bkey = -1;
        for (long w_ = blockIdx.x; w_ < (long)N_PREP_RW + N_PREP_DN; w_ += gridDim.x) blk_scanprep(w_, p, l, bf0, bf1, bkey);
      } break;
      case 3:
#ifdef PROBE_MIXER2
        mixer_phase(p, l + 2); SYNC
#endif
        mixer_phase(p, l); break;
      case 4: fin_phase(p, l); break;
      case 5: {
        gemm_phase<1>(p, l);
        for (long i_ = gtid; i_ < (long)NEXP * 1024 / 16; i_ += gstride) {
          cvt16_fp4(p.pu + (long)l * NEXP * 1024, (unsigned char*)p.u16, i_, PEER_USCALE);
          cvt16_fp4(p.pv + (long)l * NEXP * 1024, (unsigned char*)p.v16, i_, PEER_VSCALE);
        }
      } break;
      case 6: { BSTAGE(blk_norm<1>, NT / 4) } break;
      case 7: gemm_phase<2>(p, l); break;
      default: { BSTAGE(blk_peer<false>, NT / 4) } break;
    }
    if (ph != 17) SYNC
  }
}
#else
#define STAGE(fn, n) { _Pragma("omp parallel for schedule(dynamic, 64)") for (long i_ = 0; i_ < (long)(n); ++i_) fn(i_, p, l); }
#define SYNC
void mega(P p) {
  { int l = 0;
    STAGE(b_init, (long)NT * 1024)
    STAGE(b_mod, 2L * NCOND * 6144)
  }
  for (int l = 0; l < 2; ++l) {
    STAGE(b_norm<0>, NT)
    STAGE(b_inproj, (long)NT * INC)
    STAGE(b_prep_gqa, (long)NT * 6)
    STAGE(b_prep_cache, (long)NTC * 640)
    STAGE(b_rwaux, (long)NT * 512)
    STAGE(b_dnconv, (long)NT * 768)
    STAGE(b_dnnorm, (long)NT * 8)
    STAGE(b_rwscan, NSCAN)
    STAGE(b_dnscan, NSCAN)
    STAGE(b_attn_gqa, (long)NT * 4)
    STAGE(b_attn_na, (long)NT * 4)
    STAGE(b_rwfin, (long)NT * 4)
    STAGE(b_dnfin, (long)NT * 4)
    STAGE(b_outproj, (long)NT * 1024)
    STAGE(b_norm<1>, NT)
    STAGE(b_peerq, (long)NT * 2048)
    STAGE(b_topk1, (long)NT * 16)
    STAGE(b_topk2, (long)NT * 8)
    STAGE(b_peer_act, (long)NT * 128)
    STAGE(b_peer_out, (long)NT * 1024)
  }
  { int l = 0; STAGE(b_final, NT) }
}
#endif

static void fill_params(P& p, void* const* d_in, void* d_out, void* d_ws) {
  const float** f = (const float**)&p;
  for (int i = 0; i < 39; ++i) f[i] = (const float*)d_in[i];
  float* o = (float*)d_out;
  p.X = o; o += (long)NT * 1024;
  p.ogk = o; o += (long)CFG_BATCH * 2 * 2 * CFG_SEQ * 64;
  p.ogv = o; o += (long)CFG_BATCH * 2 * 2 * CFG_SEQ * 64;
  p.onk = o; o += (long)CFG_BATCH * 2 * 4 * CFG_SEQ * 64;
  p.onv = o; o += (long)CFG_BATCH * 2 * 4 * CFG_SEQ * 64;
  p.orw = o; o += (long)CFG_BATCH * 2 * 2 * 4 * 4096;
  p.odn = o;
  char* w = (char*)d_ws;
  auto take = [&](size_t bytes) { char* r = w; w += (bytes + 255) & ~(size_t)255; return r; };
  p.xbar = (unsigned*)take(16384);
  p.counters = (unsigned*)take(256);
  p.cucnt = (unsigned*)take(4 * 4096 * 4);
  p.mod = (float*)take(2L * NCOND * 6144 * 4);
  p.act = (h16*)take((size_t)NT * 1024 * sizeof(h16));
  p.rwaux = (h16*)take((size_t)NT * 1024 * sizeof(h16));
  p.dnp = (h16*)take((size_t)NT * 768 * sizeof(h16));
  p.proj = (h16*)take((size_t)NT * INC * sizeof(h16));
  p.wtin = (h16*)take((size_t)2 * NPAD_IN * 1024 * sizeof(h16));
  p.wtout = (h16*)take((size_t)2 * 1024 * 1024 * sizeof(h16));
  p.wtq = (h16*)take((size_t)2 * 2048 * 1024 * sizeof(h16));
  p.rwsc = (float*)take((size_t)NT * 16 * 4);
  p.dnsc = (float*)take((size_t)NT * 16 * 4);
  p.keys16 = (h16*)take((size_t)2 * 16 * CFG_NKEYS * 128 * sizeof(h16));
  char* a = (char*)p.proj;
#ifdef HOST_EMU
  p.pq = (h16*)a; a += (size_t)NT * 2048 * sizeof(h16);
#endif
  p.tks = (float*)a; a += (size_t)NT * 256 * 4;
  p.tki = (int*)a; a += (size_t)NT * 256 * 4;
  p.u16 = (h16*)a; a += (size_t)NEXP * 1024 * sizeof(h16);
  p.v16 = (h16*)a; a += (size_t)NEXP * 1024 * sizeof(h16);
  p.pidx = (int*)p.rwaux;
  p.pact = (float*)((char*)p.rwaux + (size_t)NT * 128 * 4);
}

#ifndef HOST_EMU
extern "C" void kernel_launch(void* const* d_in, const int* in_sizes, int n_in, void* d_out, int out_size, void* d_ws,
                              size_t ws_size, hipStream_t stream) {
  static int grid_blocks = 0;
  if (!grid_blocks) {
    int dev = 0, cus = 0, per_cu = 0;
    (void)hipGetDevice(&dev);
    (void)hipDeviceGetAttribute(&cus, hipDeviceAttributeMultiprocessorCount, dev);
    (void)hipOccupancyMaxActiveBlocksPerMultiprocessor(&per_cu, mega, 256, 0);
    grid_blocks = cus * per_cu;
  }
  P p;
  memset(&p, 0, sizeof(p));
  fill_params(p, d_in, d_out, d_ws);
  (void)hipMemsetAsync(p.xbar, 0, 16384, stream);
  void* args[] = {&p};
  hipError_t e = hipLaunchCooperativeKernel((void*)mega, dim3(grid_blocks), dim3(256), args, 0, stream);
  if (e != hipSuccess) fprintf(stderr, "cooperative launch failed: %s (grid %d)\n", hipGetErrorString(e), grid_blocks);
}
#endif
```

```cpp
#ifndef HOST_EMU
#include <hip/hip_runtime.h>
#include <hip/hip_cooperative_groups.h>
namespace cg = cooperative_groups;
#define HD __device__ __forceinline__
#define HDN __device__ __noinline__
typedef _Float16 h16;
#define CBAR asm volatile("" ::: "memory")
#define SMEM_BYTES 73728
__shared__ __attribute__((aligned(16))) char g_smem[SMEM_BYTES];
__device__ __forceinline__ int otid() { int t = threadIdx.x; asm volatile("" : "+v"(t)); return t; }
#define FSIN(x) __sinf(x)
#define FCOS(x) __cosf(x)
#else
#include <cmath>
#include <cstring>
#define HD static inline
#define HDN static
typedef float h16;
#define CBAR
#define FSIN(x) sinf(x)
#define FCOS(x) cosf(x)
#endif
#include <cstdio>
#include <cstring>

#ifndef CFG_BATCH
#define CFG_BATCH 32
#define CFG_SEQ 256
#define CFG_DB 8
#define CFG_DS 4096
#define CFG_PAST 512
#define CFG_NKEYS 128
#endif

#define NTC (CFG_BATCH * CFG_SEQ)
#define NTL (CFG_DB * CFG_DS)
#define NT (NTC + NTL)
#define NCOND (1 + CFG_DB)
#define GROWS (CFG_DS / 64)
#define WR (GROWS < 8 ? GROWS : 8)
#define NEXP (CFG_NKEYS * CFG_NKEYS)
#define INC 3280
#define RW_OFF 512
#define NA_OFF 1472
#define DN_OFF 2240

struct P {
  const float *xp, *xs, *c, *cgk, *cgv, *cnk, *cnv, *srw, *sdn, *cctx, *n1g, *n2g, *wmod, *bmod, *win, *wout,
      *gqn, *gkn, *rwmu, *rww0, *rww2, *rwa0, *rwa2, *rwg2, *rwkk, *rwka, *rwrk, *rwlng, *rwlnb, *nabias,
      *dnconv, *dnalog, *dndt, *dnng, *pwq, *pkeys, *pu, *pv, *fng;
  float *X, *ogk, *ogv, *onk, *onv, *orw, *odn;
  float* mod;
  h16* act;
  h16* proj;
  h16* rwaux;
  h16* dnp;
  h16* pq;
  float* tks;
  int* tki;
  int* pidx;
  float* pact;
  unsigned* counters;
  unsigned* xbar;
  unsigned* cucnt;
  h16 *keys16, *u16, *v16;
  float *rwsc, *dnsc;
  h16 *wtin, *wtout, *wtq;
};

HD float sigmoidf_(float x) { return 1.0f / (1.0f + expf(-x)); }
HD float siluf_(float x) { return x * sigmoidf_(x); }
HD float softplusf_(float x) { return fmaxf(x, 0.0f) + log1pf(expf(-fabsf(x))); }
HD int condrow(long token) { return token < NTC ? 0 : 1 + (int)((token - NTC) / CFG_DS); }
HD void seqinfo(long token, int& t, int& T, long& base) {
  if (token < NTC) { T = CFG_SEQ; t = (int)(token % CFG_SEQ); base = token - t; }
  else { long u = token - NTC; T = CFG_DS; t = (int)(u % CFG_DS); base = token - t; }
}

HD void b_init(long i, const P& p, int l) {
  p.X[i] = (i < (long)NTC * 1024) ? p.xp[i] : p.xs[i - (long)NTC * 1024];
}
HD void b_mod(long i, const P& p, int) {
  int col = (int)(i % 6144); int r = (int)((i / 6144) % NCOND); int l = (int)(i / (6144L * NCOND));
  const float* cond = r == 0 ? p.cctx : p.c + (long)(r - 1) * 1024;
  float acc = p.bmod[l * 6144 + col];
  for (int k = 0; k < 1024; ++k) acc += siluf_(cond[k]) * p.wmod[((long)l * 1024 + k) * 6144 + col];
  p.mod[i] = acc;
}
template <int WHICH>
HD void b_norm(long i, const P& p, int l) {
  const float* x = p.X + i * 1024;
  float ss = 0.f;
  for (int k = 0; k < 1024; ++k) ss += x[k] * x[k];
  float rstd = 1.0f / sqrtf(ss * (1.0f / 1024) + 1e-6f);
  const float* m = p.mod + ((long)l * NCOND + condrow(i)) * 6144 + (WHICH ? 3072 : 0);
  const float* g = (WHICH ? p.n2g : p.n1g) + l * 1024;
  for (int k = 0; k < 1024; ++k) p.act[i * 1024 + k] = (h16)((x[k] * rstd * g[k]) * (1.0f + m[1024 + k]) + m[k]);
}
HD void b_prep_gqa(long i, const P& p, int l) {
  long token = i / 6; int slot = (int)(i % 6);
  h16* x = p.proj + token * INC + slot * 64;
  float y[64]; float ss = 0.f;
#pragma unroll
  for (int d = 0; d < 64; ++d) { y[d] = (float)x[d]; ss += y[d] * y[d]; }
  float rstd = 1.0f / sqrtf(ss * (1.0f / 64) + 1e-6f);
  const float* g = (slot < 4 ? p.gqn : p.gkn) + l * 64;
#pragma unroll
  for (int d = 0; d < 64; ++d) y[d] = y[d] * rstd * g[d];
  if (token >= NTC) {
    int t = (int)((token - NTC) % CFG_DS); int row = t / 64, colp = t % 64;
#pragma unroll
    for (int j = 0; j < 32; ++j) {
      float inv = exp2f(-(float)(j % 16) * 0.83048202372184059f);
      float ang = (float)(j < 16 ? row : colp) * inv;
      float cs = FCOS(ang), sn = FSIN(ang);
      float a = y[j], b = y[j + 32];
      y[j] = a * cs - b * sn; y[j + 32] = b * cs + a * sn;
    }
  } else if (slot >= 4) {
    int b = (int)(token / CFG_SEQ), t = (int)(token % CFG_SEQ);
    float* o = p.ogk + ((((long)b * 2 + l) * 2 + (slot - 4)) * CFG_SEQ + t) * 64;
#pragma unroll
    for (int d = 0; d < 64; ++d) o[d] = y[d];
  }
  float sc = slot < 4 ? 0.125f : 1.0f;
#pragma unroll
  for (int d = 0; d < 64; ++d) x[d] = (h16)(y[d] * sc);
}
HD void b_prep_cache(long i, const P& p, int l) {
  long token = i / 640; int e = (int)(i % 640);
  int b = (int)(token / CFG_SEQ), t = (int)(token % CFG_SEQ);
  const h16* pr = p.proj + token * INC;
  if (e < 128) { int kvh = e / 64, d = e % 64; p.ogv[((((long)b * 2 + l) * 2 + kvh) * CFG_SEQ + t) * 64 + d] = (float)pr[384 + e]; }
  else if (e < 384) { int c = e - 128; int h = c / 64, d = c % 64; p.onk[((((long)b * 2 + l) * 4 + h) * CFG_SEQ + t) * 64 + d] = (float)pr[NA_OFF + 256 + c]; }
  else { int c = e - 384; int h = c / 64, d = c % 64; p.onv[((((long)b * 2 + l) * 4 + h) * CFG_SEQ + t) * 64 + d] = (float)pr[NA_OFF + 512 + c]; }
}
HD void b_rwaux(long i, const P& p, int l) {
  int col = (int)(i % 256); int d = (int)((i / 256) % 2); long token = i / 512;
  int t, T; long base; seqinfo(token, t, T, base);
  bool sv = d == 0 ? (t > 0) : (t < T - 1);
  const h16* pb = p.proj + token * INC + RW_OFF;
  const h16* ps = p.proj + (token + (d == 0 ? -1 : 1)) * INC + RW_OFF;
  const float* mu = p.rwmu + ((long)l * 2 + d) * 832;
  float accw = p.rww0[(l * 2 + d) * 256 + col], acca = p.rwa0[(l * 2 + d) * 256 + col];
  for (int j = 0; j < 32; ++j) {
    float bw = (float)pb[768 + d * 32 + j], sw = sv ? (float)ps[768 + d * 32 + j] : 0.f;
    float wl = bw + (sw - bw) * mu[768 + j];
    float ba = (float)pb[832 + d * 32 + j], sa = sv ? (float)ps[832 + d * 32 + j] : 0.f;
    float al = ba + (sa - ba) * mu[800 + j];
    accw += tanhf(wl) * p.rww2[(((long)l * 2 + d) * 32 + j) * 256 + col];
    acca += al * p.rwa2[(((long)l * 2 + d) * 32 + j) * 256 + col];
  }
  float w = -softplusf_(-accw) - 0.5f;
  p.rwaux[((token * 2 + d) * 2 + 0) * 256 + col] = (h16)expf(w);
  p.rwaux[((token * 2 + d) * 2 + 1) * 256 + col] = (h16)sigmoidf_(acca);
}
HD void b_dnconv(long i, const P& p, int l) {
  int c = (int)(i % 768); long token = i / 768;
  int t, T; long base; seqinfo(token, t, T, base);
  float acc = 0.f;
#pragma unroll
  for (int j = 0; j < 5; ++j) {
    int tt = t + j - 2;
    if (tt >= 0 && tt < T) acc += (float)p.proj[(base + tt) * INC + DN_OFF + c] * p.dnconv[((long)l * 5 + j) * 768 + c];
  }
  p.dnp[token * 768 + c] = (h16)siluf_(acc);
}
HD void b_dnnorm(long i, const P& p, int) {
  long token = i / 8; int slot = (int)(i % 8);
  h16* x = p.dnp + token * 768 + slot * 64;
  float ss = 0.f;
  for (int d = 0; d < 64; ++d) { float v = (float)x[d]; ss += v * v; }
  float rs = 1.0f / sqrtf(ss + 1e-6f) * (slot < 4 ? 0.125f : 1.0f);
  for (int d = 0; d < 64; ++d) x[d] = (h16)((float)x[d] * rs);
}

struct Softmax64 {
  float m, lsum, acc[64];
};
template <typename TK>
HD void attend_key(Softmax64& st, const float* q, const TK* k, const TK* v, float scale, float bias) {
  float s = 0.f;
#pragma unroll
  for (int d = 0; d < 64; ++d) s += q[d] * (float)k[d];
  s = s * scale + bias;
  if (s > st.m) {
    float f = expf(st.m - s);
    st.lsum *= f;
#pragma unroll
    for (int d = 0; d < 64; ++d) st.acc[d] *= f;
    st.m = s;
  }
  float pw = expf(s - st.m);
  st.lsum += pw;
#pragma unroll
  for (int d = 0; d < 64; ++d) st.acc[d] += pw * (float)v[d];
}
HD void b_attn_gqa(long i, const P& p, int l) {
  int h = (int)(i / NT); long token = i % NT; int kvh = h / 2;
  float q[64];
  const h16* qp = p.proj + token * INC + h * 64;
#pragma unroll
  for (int d = 0; d < 64; ++d) q[d] = (float)qp[d];
  Softmax64 st; st.m = -1e30f; st.lsum = 0.f;
#pragma unroll
  for (int d = 0; d < 64; ++d) st.acc[d] = 0.f;
  int t, T; long base; seqinfo(token, t, T, base);
  for (int tk = 0; tk < T; ++tk) {
    const h16* kp = p.proj + (base + tk) * INC + 256 + kvh * 64;
    attend_key<h16>(st, q, kp, kp + 128, 1.0f, 0.f);
  }
  if (token >= NTC) {
    int b = (int)((token - NTC) / CFG_DS);
    const float* ck = p.cgk + (((long)b * 2 + l) * 2 + kvh) * CFG_PAST * 64;
    const float* cv = p.cgv + (((long)b * 2 + l) * 2 + kvh) * CFG_PAST * 64;
    for (int pp = 0; pp < CFG_PAST; ++pp) attend_key<float>(st, q, ck + pp * 64, cv + pp * 64, 1.0f, 0.f);
  }
  float inv = 1.0f / st.lsum;
  h16* o = p.act + token * 1024 + h * 64;
#pragma unroll
  for (int d = 0; d < 64; ++d) o[d] = (h16)(st.acc[d] * inv);
}
HD void b_attn_na(long i, const P& p, int l) {
  int h = (int)(i / NT); long token = i % NT;
  float q[64];
  const h16* qp = p.proj + token * INC + NA_OFF + h * 64;
#pragma unroll
  for (int d = 0; d < 64; ++d) q[d] = (float)qp[d];
  Softmax64 st; st.m = -1e30f; st.lsum = 0.f;
#pragma unroll
  for (int d = 0; d < 64; ++d) st.acc[d] = 0.f;
  int t, T; long base; seqinfo(token, t, T, base);
  if (token < NTC) {
    for (int tk = 0; tk < T; ++tk) {
      const h16* kp = p.proj + (base + tk) * INC + NA_OFF + 256 + h * 64;
      attend_key<h16>(st, q, kp, kp + 256, 0.125f, 0.f);
    }
  } else {
    int r = t / 64, cq = t % 64;
    int r0 = r - WR / 2; r0 = r0 < 0 ? 0 : (r0 > GROWS - WR ? GROWS - WR : r0);
    int cs = cq - 8; cs = cs < 0 ? 0 : (cs > 48 ? 48 : cs);
    const float* bias = p.nabias + ((long)l * 4 + h) * 15 * 31;
    for (int w = 0; w < WR; ++w) {
      int kr = r0 + w;
      for (int cc = 0; cc < 16; ++cc) {
        int kc = cs + cc;
        const h16* kp = p.proj + (base + kr * 64 + kc) * INC + NA_OFF + 256 + h * 64;
        attend_key<h16>(st, q, kp, kp + 256, 0.125f, bias[(kr - r + 7) * 31 + (kc - cq + 15)]);
      }
    }
    int b = (int)((token - NTC) / CFG_DS);
    const float* ck = p.cnk + (((long)b * 2 + l) * 4 + h) * CFG_PAST * 64;
    const float* cv = p.cnv + (((long)b * 2 + l) * 4 + h) * CFG_PAST * 64;
    for (int pp = 0; pp < CFG_PAST; ++pp) attend_key<float>(st, q, ck + pp * 64, cv + pp * 64, 0.125f, 0.f);
  }
  float inv = 1.0f / st.lsum;
  h16* o = p.act + token * 1024 + 512 + h * 64;
#pragma unroll
  for (int d = 0; d < 64; ++d) o[d] = (h16)(st.acc[d] * inv);
}

HD float rw_lerp(const P& p, int l, long token, bool sv, int d, int c) {
  float b = (float)p.proj[token * INC + RW_OFF + c];
  float s = sv ? (float)p.proj[(token + (d == 0 ? -1 : 1)) * INC + RW_OFF + c] : 0.f;
  return b + (s - b) * p.rwmu[((long)l * 2 + d) * 832 + c];
}
HD void b_rwscan(long i, const P& p, int l) {
  int v = (int)(i % 64); int sb = (int)(i / 64); int h = sb % 4; int bi = sb / 4;
  bool ctx = bi < CFG_BATCH;
  int T = ctx ? CFG_SEQ : CFG_DS;
  long base = ctx ? (long)bi * CFG_SEQ : (long)NTC + (long)(bi - CFG_BATCH) * CFG_DS;
#ifndef HOST_EMU
  float* S = (float*)g_smem + threadIdx.x * 65;
#else
  float S[64];
#endif
  for (int d = 0; d < 2; ++d) {
    if (ctx) {
      for (int k = 0; k < 64; ++k) S[k] = 0.f;
    } else {
      const float* s0 = p.srw + (((((long)(bi - CFG_BATCH)) * 2 + l) * 2 + d) * 4 + h) * 4096 + v * 64;
      for (int k = 0; k < 64; ++k) S[k] = s0[k];
    }
    for (int step = 0; step < T; ++step) {
      int t = d == 0 ? step : T - 1 - step;
      long token = base + t;
      bool sv = d == 0 ? (t > 0) : (t < T - 1);
      const h16* aux = p.rwaux + (token * 2 + d) * 512;
      float ss = 0.f;
      for (int k = 0; k < 64; ++k) {
        float kv = rw_lerp(p, l, token, sv, d, 256 + h * 64 + k) * p.rwkk[l * 256 + h * 64 + k];
        ss += kv * kv;
      }
      float rs = 1.0f / sqrtf(ss + 1e-6f);
      float sa = 0.f;
      for (int k = 0; k < 64; ++k) {
        float kk = rw_lerp(p, l, token, sv, d, 256 + h * 64 + k) * p.rwkk[l * 256 + h * 64 + k] * rs;
        sa -= S[k] * kk;
      }
      float vv = rw_lerp(p, l, token, sv, d, 512 + h * 64 + v);
      float o = 0.f;
      for (int k = 0; k < 64; ++k) {
        int c = h * 64 + k;
        float kr = rw_lerp(p, l, token, sv, d, 256 + c);
        float kk = kr * p.rwkk[l * 256 + c] * rs;
        float a = (float)aux[256 + c];
        float dec = expf(-(float)aux[c]);
        float keff = kr * (1.0f + (a - 1.0f) * p.rwka[l * 256 + c]);
        float r = rw_lerp(p, l, token, sv, d, c);
        S[k] = S[k] * dec + sa * (kk * a) + vv * keff;
        o += S[k] * r;
      }
      h16* op = p.act + token * 1024 + 256 + h * 64 + v;
      if (d == 0) *op = (h16)o; else *op = (h16)((float)*op + o);
    }
    if (ctx) {
      float* so = p.orw + (((((long)bi) * 2 + l) * 2 + d) * 4 + h) * 4096 + v * 64;
      for (int k = 0; k < 64; ++k) so[k] = S[k];
    }
  }
}
HD void b_rwfin(long i, const P& p, int l) {
  long token = i / 4; int h = (int)(i % 4);
  int t, T; long base; seqinfo(token, t, T, base);
  h16* op = p.act + token * 1024 + 256 + h * 64;
  float mu = 0.f;
  for (int k = 0; k < 64; ++k) mu += (float)op[k];
  mu *= (1.0f / 64);
  float var = 0.f;
  for (int k = 0; k < 64; ++k) { float dlt = (float)op[k] - mu; var += dlt * dlt; }
  var *= (1.0f / 64);
  float rs = 1.0f / sqrtf(var + 64e-5f);
  float bon0 = 0.f, bon1 = 0.f;
  for (int d = 0; d < 2; ++d) {
    bool sv = d == 0 ? (t > 0) : (t < T - 1);
    const h16* aux = p.rwaux + (token * 2 + d) * 512;
    float s = 0.f;
    for (int k = 0; k < 64; ++k) {
      int c = h * 64 + k;
      float kr = rw_lerp(p, l, token, sv, d, 256 + c);
      float a = (float)aux[256 + c];
      float keff = kr * (1.0f + (a - 1.0f) * p.rwka[l * 256 + c]);
      s += rw_lerp(p, l, token, sv, d, c) * keff * p.rwrk[l * 256 + c];
    }
    if (d == 0) bon0 = s; else bon1 = s;
  }
  bool sv0 = t > 0, sv1 = t < T - 1;
  for (int k = 0; k < 64; ++k) {
    int c = h * 64 + k;
    float y = ((float)op[k] - mu) * rs * p.rwlng[l * 256 + c] + p.rwlnb[l * 256 + c];
    y += bon0 * rw_lerp(p, l, token, sv0, 0, 512 + c) + bon1 * rw_lerp(p, l, token, sv1, 1, 512 + c);
    float gate = 0.f;
    for (int j = 0; j < 64; ++j) gate += sigmoidf_((float)p.proj[token * INC + RW_OFF + 896 + j]) * p.rwg2[((long)l * 64 + j) * 256 + c];
    op[k] = (h16)(y * gate);
  }
}
HD void b_dnscan(long i, const P& p, int l) {
  int v = (int)(i % 64); int sb = (int)(i / 64); int h = sb % 4; int bi = sb / 4;
  bool ctx = bi < CFG_BATCH;
  int T = ctx ? CFG_SEQ : CFG_DS;
  long base = ctx ? (long)bi * CFG_SEQ : (long)NTC + (long)(bi - CFG_BATCH) * CFG_DS;
#ifndef HOST_EMU
  float* S = (float*)g_smem + threadIdx.x * 65;
#else
  float S[64];
#endif
  for (int d = 0; d < 2; ++d) {
    if (ctx) {
      for (int k = 0; k < 64; ++k) S[k] = 0.f;
    } else {
      const float* s0 = p.sdn + (((((long)(bi - CFG_BATCH)) * 2 + l) * 2 + d) * 4 + h) * 4096 + v;
      for (int k = 0; k < 64; ++k) S[k] = s0[k * 64];
    }
    float nalog = -expf(p.dnalog[(l * 2 + d) * 4 + h]);
    float dtb = p.dndt[(l * 2 + d) * 4 + h];
    for (int step = 0; step < T; ++step) {
      int t = d == 0 ? step : T - 1 - step;
      long token = base + t;
      const h16* dp = p.dnp + token * 768;
      const h16* pr = p.proj + token * INC + DN_OFF;
      float beta = sigmoidf_((float)pr[768 + d * 4 + h]);
      float g = nalog * softplusf_((float)pr[776 + d * 4 + h] + dtb);
      float a = expf(g);
      float sk = 0.f;
      for (int k = 0; k < 64; ++k) sk += (float)dp[256 + h * 64 + k] * S[k];
      float coef = beta * ((float)dp[512 + h * 64 + v] - a * sk);
      float o = 0.f;
      for (int k = 0; k < 64; ++k) {
        S[k] = a * S[k] + coef * (float)dp[256 + h * 64 + k];
        o += (float)dp[h * 64 + k] * S[k];
      }
      h16* op = p.act + token * 1024 + 768 + h * 64 + v;
      if (d == 0) *op = (h16)o; else *op = (h16)((float)*op + o);
    }
    if (ctx) {
      float* so = p.odn + (((((long)bi) * 2 + l) * 2 + d) * 4 + h) * 4096 + v;
      for (int k = 0; k < 64; ++k) so[k * 64] = S[k];
    }
  }
}
HD void b_dnfin(long i, const P& p, int l) {
  long token = i / 4; int h = (int)(i % 4);
  h16* op = p.act + token * 1024 + 768 + h * 64;
  float ss = 0.f;
  for (int k = 0; k < 64; ++k) { float o = (float)op[k]; ss += o * o; }
  float rs = 1.0f / sqrtf(ss * (1.0f / 64) + 1e-6f);
  for (int k = 0; k < 64; ++k) {
    float z = (float)p.proj[token * INC + DN_OFF + 784 + h * 64 + k];
    op[k] = (h16)((float)op[k] * rs * p.dnng[l * 64 + k] * siluf_(z));
  }
}
HD void top16_insert(float (&ts)[16], int (&ti)[16], float s, int id) {
#pragma unroll
  for (int j = 0; j < 16; ++j) {
    if (s > ts[j]) { float a = ts[j]; ts[j] = s; s = a; int b = ti[j]; ti[j] = id; id = b; }
  }
}
HD void b_topk1(long i, const P& p, int l) {
  long token = i / 16; int hp = (int)(i % 16);
  const h16* q = p.pq + token * 2048 + hp * 128;
  const float* keys = p.pkeys + ((long)l * 16 + hp) * CFG_NKEYS * 128;
  float ts[16]; int ti[16];
#pragma unroll
  for (int j = 0; j < 16; ++j) { ts[j] = -3.0e38f; ti[j] = 0; }
  for (int k = 0; k < CFG_NKEYS; ++k) {
    float s = 0.f;
    for (int d = 0; d < 128; ++d) s += (float)q[d] * keys[k * 128 + d];
    top16_insert(ts, ti, s, k);
  }
#pragma unroll
  for (int j = 0; j < 16; ++j) { p.tks[token * 256 + hp * 16 + j] = ts[j]; p.tki[token * 256 + hp * 16 + j] = ti[j]; }
}
HD void b_topk2(long i, const P& p, int l) {
  long token = i / 8; int hd = (int)(i % 8);
  const float* s1 = p.tks + token * 256 + hd * 32; const int* i1 = p.tki + token * 256 + hd * 32;
  float ts[16]; int ti[16];
#pragma unroll
  for (int j = 0; j < 16; ++j) { ts[j] = -3.0e38f; ti[j] = 0; }
  for (int a = 0; a < 16; ++a)
    for (int b = 0; b < 16; ++b) top16_insert(ts, ti, s1[a] + s1[16 + b], i1[a] * CFG_NKEYS + i1[16 + b]);
  float sum = 0.f;
#pragma unroll
  for (int j = 0; j < 16; ++j) sum += expf(ts[j] - ts[0]);
  float inv = 1.0f / sum;
#pragma unroll
  for (int j = 0; j < 16; ++j) { p.pidx[token * 128 + hd * 16 + j] = ti[j]; p.pact[token * 128 + hd * 16 + j] = expf(ts[j] - ts[0]) * inv; }
}
HD void b_peer_act(long i, const P& p, int l) {
  long token = i / 128;
  const float* u = p.pu + ((long)l * NEXP + p.pidx[i]) * 1024;
  const h16* x = p.act + token * 1024;
  float dot = 0.f;
  for (int k = 0; k < 1024; ++k) dot += (float)x[k] * u[k];
  float ge = 0.5f * dot * (1.0f + erff(dot * 0.70710678118654752f));
  p.pact[i] = p.pact[i] * ge;
}
HD void b_peer_out(long i, const P& p, int l) {
  long token = i / 1024; int col = (int)(i % 1024);
  float acc = 0.f;
  for (int e = 0; e < 128; ++e) acc += p.pact[token * 128 + e] * p.pv[((long)l * NEXP + p.pidx[token * 128 + e]) * 1024 + col];
  p.X[i] += p.mod[((long)l * NCOND + condrow(token)) * 6144 + 5120 + col] * acc;
}
HD void b_final(long i, const P& p, int) {
  float* x = p.X + i * 1024;
  float ss = 0.f;
  for (int k = 0; k < 1024; ++k) ss += x[k] * x[k];
  float rstd = 1.0f / sqrtf(ss * (1.0f / 1024) + 1e-6f);
  for (int k = 0; k < 1024; ++k) x[k] = x[k] * rstd * p.fng[k];
}
HD float gemm_elem(const h16* A, const float* B, int N, long token, int col) {
  float acc = 0.f;
  for (int k = 0; k < 1024; ++k) acc += (float)A[token * 1024 + k] * B[(long)k * N + col];
  return acc;
}
HD void b_inproj(long i, const P& p, int l) {
  long token = i / INC; int col = (int)(i % INC);
  p.proj[i] = (h16)gemm_elem(p.act, p.win + (long)l * 1024 * INC, INC, token, col);
}
HD void b_outproj(long i, const P& p, int l) {
  long token = i / 1024; int col = (int)(i % 1024);
  float acc = gemm_elem(p.act, p.wout + (long)l * 1024 * 1024, 1024, token, col);
  p.X[i] += p.mod[((long)l * NCOND + condrow(token)) * 6144 + 2048 + col] * acc;
}
HD void b_peerq(long i, const P& p, int l) {
  long token = i / 2048; int col = (int)(i % 2048);
  p.pq[i] = (h16)gemm_elem(p.act, p.pwq + (long)l * 1024 * 2048, 2048, token, col);
}

#ifndef PROBE_KMAX
#define PROBE_KMAX 16
#endif
#ifndef REP_S0
#define REP_S0 1
#endif
#ifndef REP_MISC
#define REP_MISC 1
#endif
#ifndef REP_G0
#define REP_G0 1
#endif
#ifndef REP_G2
#define REP_G2 1
#endif
#ifndef REP_SP
#define REP_SP 1
#endif
#define NSCAN ((long)(CFG_BATCH + CFG_DB) * 4 * 64)
#define NPAD_IN 3328

#ifndef HOST_EMU
typedef _Float16 half8 __attribute__((ext_vector_type(8)));
typedef _Float16 half4 __attribute__((ext_vector_type(4)));
typedef _Float16 half2v __attribute__((ext_vector_type(2)));
typedef float f32x2 __attribute__((ext_vector_type(2)));
typedef float f32x16 __attribute__((ext_vector_type(16)));
typedef float f32x4 __attribute__((ext_vector_type(4)));
typedef unsigned u32x4 __attribute__((ext_vector_type(4)));
typedef short s16x4v __attribute__((__vector_size__(4 * sizeof(short))));

template <int CTRL> __device__ __forceinline__ float dppf(float x) {
  return __builtin_bit_cast(float, __builtin_amdgcn_update_dpp(0, __builtin_bit_cast(int, x), CTRL, 0xF, 0xF, true));
}
__device__ __forceinline__ float sum16(float x) { x += dppf<0x128>(x); x += dppf<0x124>(x); x += dppf<0xB1>(x); x += dppf<0x4E>(x); return x; }
__device__ __forceinline__ float sum8(float x) { x += dppf<0xB1>(x); x += dppf<0x4E>(x); x += dppf<0x141>(x); return x; }
__device__ __forceinline__ float sum64(float x) { x = sum16(x); x += __shfl_xor(x, 16); x += __shfl_xor(x, 32); return x; }

#define CSWAP_DESC(S, ID, i, j) { const bool c_ = S[j] > S[i]; const float a_ = c_ ? S[j] : S[i]; const float b_ = c_ ? S[i] : S[j]; \
    const int ia_ = c_ ? ID[j] : ID[i]; const int ib_ = c_ ? ID[i] : ID[j]; S[i] = a_; S[j] = b_; ID[i] = ia_; ID[j] = ib_; }
__device__ __forceinline__ void bitonic_sort16_desc(float (&s)[16], int (&id)[16]) {
#pragma unroll
  for (int k = 2; k <= 16; k <<= 1) {
#pragma unroll
    for (int j = k >> 1; j > 0; j >>= 1) {
#pragma unroll
      for (int i = 0; i < 16; ++i) {
        const int l = i ^ j;
        if (l > i) {
          if ((i & k) == 0) CSWAP_DESC(s, id, i, l) else CSWAP_DESC(s, id, l, i)
        }
      }
    }
  }
}
__device__ __forceinline__ void merge_top16(float (&ts)[16], int (&ti)[16], const float (&gs)[16], const int (&gi)[16]) {
#pragma unroll
  for (int i = 0; i < 16; ++i) { if (gs[15 - i] > ts[i]) { ts[i] = gs[15 - i]; ti[i] = gi[15 - i]; } }
#pragma unroll
  for (int j = 8; j > 0; j >>= 1) {
#pragma unroll
    for (int i = 0; i < 16; ++i) { if ((i & j) == 0) CSWAP_DESC(ts, ti, i, i + j) }
  }
}
__device__ void blk_convert(long w, const P& p) {
  int l = (int)(w / 1600); int r = (int)(w % 1600);
  const float* src; h16* dst; int N, ntile;
  if (r < 832) { src = p.win + (long)l * 1024 * INC; dst = p.wtin + (long)l * NPAD_IN * 1024; N = INC; ntile = 52; }
  else if (r < 1088) { r -= 832; src = p.wout + (long)l * 1024 * 1024; dst = p.wtout + (long)l * 1024 * 1024; N = 1024; ntile = 16; }
  else { r -= 1088; src = p.pwq + (long)l * 1024 * 2048; dst = p.wtq + (long)l * 2048 * 1024; N = 2048; ntile = 32; }
  int kt = r / ntile, nt = r % ntile;
  int k0 = kt * 64, n0 = nt * 64;
  h16* tile = (h16*)g_smem;
  const int tid_ = otid(); int c = tid_ & 63, r4 = tid_ >> 6;
  __syncthreads();
#pragma unroll
  for (int j = 0; j < 16; ++j) {
    int rr = r4 + 4 * j;
    float v = (n0 + c < N) ? src[(long)(k0 + rr) * N + n0 + c] : 0.f;
    tile[rr * 66 + c] = (h16)v;
  }
  __syncthreads();
#pragma unroll
  for (int j = 0; j < 16; ++j) {
    int rr = r4 + 4 * j;
    dst[(long)(n0 + rr) * 1024 + k0 + c] = tile[c * 66 + rr];
  }
}

template <int EPI>
__device__ void gemm_phase(const P& p, int l, int kmax = 16) {
  constexpr int NTILES = EPI == 0 ? (NPAD_IN / 128) : (EPI == 1 ? 8 : 16);
  constexpr int NT8 = (NTILES + 7) / 8;
  const long nw = EPI == 0 ? (long)(NT / 128) * NTILES : (long)(NT / 128) * 8 * NT8;
#define TILE_OF(W, MT, NTV) { const int x_ = (int)((W) & 7); const int j_ = (int)((W) >> 3);                        \
    if (EPI == 0) { if (j_ < 960) { MT = j_ / 3; NTV = x_ + 8 * (j_ - 3 * MT); } else { NTV = 24 + (x_ >> 2); MT = 80 * (x_ & 3) + j_ - 960; } } \
    else { NTV = x_ + 8 * (j_ % NT8); MT = j_ / NT8; } }
  const h16* A = p.act;
  const h16* Bt = EPI == 0 ? p.wtin + (long)l * NPAD_IN * 1024 : (EPI == 1 ? p.wtout + (long)l * 1024 * 1024 : p.wtq + (long)l * 2048 * 1024);
  const int tid = otid(), lane = tid & 63, wv = tid >> 6, wm = wv >> 1, wn = wv & 1;
  h16* As = (h16*)g_smem;
  h16* Bs = As + 2 * 128 * 72;
  const int lrow = tid >> 3, lch = tid & 7;
  long w = blockIdx.x; int mt = 0, nt = 0;
  for (;;) { if (w >= nw) return; TILE_OF(w, mt, nt) if (nt < NTILES) break; w += gridDim.x; }
  int m0 = mt * 128, n0 = nt * 128;
  const h16* Ag = A + (long)(m0 + lrow) * 1024 + lch * 8;
  const h16* Bg = Bt + (long)(n0 + lrow) * 1024 + lch * 8;
  u32x4 ra0, ra1, ra2, ra3, rb0, rb1, rb2, rb3;
  u32x4 sa0, sa1, sa2, sa3, sb0, sb1, sb2, sb3;
  const f32x16 zero16 = {0.f, 0.f, 0.f, 0.f, 0.f, 0.f, 0.f, 0.f, 0.f, 0.f, 0.f, 0.f, 0.f, 0.f, 0.f, 0.f};
  f32x16 acc00, acc01, acc10, acc11;
#define GLD0(K0) \
  ra0 = *(const u32x4*)(Ag + (K0)); ra1 = *(const u32x4*)(Ag + 32 * 1024 + (K0)); ra2 = *(const u32x4*)(Ag + 64 * 1024 + (K0)); ra3 = *(const u32x4*)(Ag + 96 * 1024 + (K0)); \
  rb0 = *(const u32x4*)(Bg + (K0)); rb1 = *(const u32x4*)(Bg + 32 * 1024 + (K0)); rb2 = *(const u32x4*)(Bg + 64 * 1024 + (K0)); rb3 = *(const u32x4*)(Bg + 96 * 1024 + (K0));
#define GLD1(K0) \
  sa0 = *(const u32x4*)(Ag + (K0)); sa1 = *(const u32x4*)(Ag + 32 * 1024 + (K0)); sa2 = *(const u32x4*)(Ag + 64 * 1024 + (K0)); sa3 = *(const u32x4*)(Ag + 96 * 1024 + (K0)); \
  sb0 = *(const u32x4*)(Bg + (K0)); sb1 = *(const u32x4*)(Bg + 32 * 1024 + (K0)); sb2 = *(const u32x4*)(Bg + 64 * 1024 + (K0)); sb3 = *(const u32x4*)(Bg + 96 * 1024 + (K0));
#define LST0(AW, BW) \
  *(u32x4*)((AW) + (lrow) * 72 + lch * 8) = ra0; *(u32x4*)((AW) + (lrow + 32) * 72 + lch * 8) = ra1; *(u32x4*)((AW) + (lrow + 64) * 72 + lch * 8) = ra2; *(u32x4*)((AW) + (lrow + 96) * 72 + lch * 8) = ra3; \
  *(u32x4*)((BW) + (lrow) * 72 + lch * 8) = rb0; *(u32x4*)((BW) + (lrow + 32) * 72 + lch * 8) = rb1; *(u32x4*)((BW) + (lrow + 64) * 72 + lch * 8) = rb2; *(u32x4*)((BW) + (lrow + 96) * 72 + lch * 8) = rb3;
#define LST1(AW, BW) \
  *(u32x4*)((AW) + (lrow) * 72 + lch * 8) = sa0; *(u32x4*)((AW) + (lrow + 32) * 72 + lch * 8) = sa1; *(u32x4*)((AW) + (lrow + 64) * 72 + lch * 8) = sa2; *(u32x4*)((AW) + (lrow + 96) * 72 + lch * 8) = sa3; \
  *(u32x4*)((BW) + (lrow) * 72 + lch * 8) = sb0; *(u32x4*)((BW) + (lrow + 32) * 72 + lch * 8) = sb1; *(u32x4*)((BW) + (lrow + 64) * 72 + lch * 8) = sb2; *(u32x4*)((BW) + (lrow + 96) * 72 + lch * 8) = sb3;
#define GCOMP(BUF)                                                                                   \
  {                                                                                                  \
    const h16* Ab = As + (BUF) * 128 * 72 + (wm * 64 + (lane & 31)) * 72 + (lane >> 5) * 8;          \
    const h16* Bb = Bs + (BUF) * 128 * 72 + (wn * 64 + (lane & 31)) * 72 + (lane >> 5) * 8;          \
    _Pragma("unroll") for (int s = 0; s < 4; ++s) {                                                  \
      half8 a0 = *(const half8*)(Ab + s * 16), a1 = *(const half8*)(Ab + 32 * 72 + s * 16);          \
      half8 b0 = *(const half8*)(Bb + s * 16), b1 = *(const half8*)(Bb + 32 * 72 + s * 16);          \
      acc00 = __builtin_amdgcn_mfma_f32_32x32x16_f16(a0, b0, acc00, 0, 0, 0);                        \
      acc01 = __builtin_amdgcn_mfma_f32_32x32x16_f16(a0, b1, acc01, 0, 0, 0);                        \
      acc10 = __builtin_amdgcn_mfma_f32_32x32x16_f16(a1, b0, acc10, 0, 0, 0);                        \
      acc11 = __builtin_amdgcn_mfma_f32_32x32x16_f16(a1, b1, acc11, 0, 0, 0);                        \
    }                                                                                                \
  }
  GLD0(0)
  GLD1(64)
  for (;;) {
  acc00 = zero16; acc01 = zero16; acc10 = zero16; acc11 = zero16;
  __builtin_amdgcn_sched_barrier(0);
  __syncthreads();
  LST0(As, Bs)
  GLD0(128)
  __builtin_amdgcn_sched_barrier(0);
  __syncthreads();
  __builtin_amdgcn_s_setprio(2);
  for (int kt = 0; kt < kmax; kt += 2) {
    GCOMP(0)
    __builtin_amdgcn_sched_barrier(0);
    LST1(As + 128 * 72, Bs + 128 * 72)
    if (kt + 3 < 16) { GLD1((kt + 3) * 64) }
    __builtin_amdgcn_sched_barrier(0);
    __syncthreads();
    GCOMP(1)
    __builtin_amdgcn_sched_barrier(0);
    if (kt + 2 < 16) { LST0(As, Bs) }
    if (kt + 4 < 16) { GLD0((kt + 4) * 64) }
    __builtin_amdgcn_sched_barrier(0);
    __syncthreads();
  }
  __builtin_amdgcn_s_setprio(0);
  const int cm0 = m0, cn0 = n0, cnt = nt;
  long w2 = w + gridDim.x; int mt2 = 0, nt2 = 0; bool has_next = false;
  for (;;) { if (w2 >= nw) break; TILE_OF(w2, mt2, nt2) if (nt2 < NTILES) { has_next = true; break; } w2 += gridDim.x; }
  if (has_next) {
    m0 = mt2 * 128; n0 = nt2 * 128; nt = nt2;
    Ag = A + (long)(m0 + lrow) * 1024 + lch * 8; Bg = Bt + (long)(n0 + lrow) * 1024 + lch * 8;
  }
  __builtin_amdgcn_sched_barrier(0);
#define GEMM_EPI(ACC, I, J)                                                                         \
  _Pragma("unroll") for (int r = 0; r < 16; ++r) {                                                   \
    const long row = cm0 + wm * 64 + (I) * 32 + (r & 3) + 8 * (r >> 2) + 4 * (lane >> 5);             \
    const int col = cn0 + wn * 64 + (J) * 32 + (lane & 31);                                            \
    const float v = ACC[r];                                                                          \
    if (EPI == 0) { if (col < INC) p.proj[row * INC + col] = (h16)v; }                                \
    else if (EPI == 1) { p.X[row * 1024 + col] += p.mod[((long)l * NCOND + condrow(row)) * 6144 + 2048 + col] * v; } \
    else { p.pq[row * 2048 + col] = (h16)v; }                                                         \
  }
  if (EPI == 0) {
    h16* Ct = (h16*)g_smem;
#define CST(ACC, I, J) _Pragma("unroll") for (int r = 0; r < 16; ++r) Ct[(wm * 64 + (I) * 32 + (r & 3) + 8 * (r >> 2) + 4 * (lane >> 5)) * 136 + wn * 64 + (J) * 32 + (lane & 31)] = (h16)ACC[r];
    CST(acc00, 0, 0) CST(acc01, 0, 1) CST(acc10, 1, 0) CST(acc11, 1, 1)
#undef CST
    __syncthreads();
#pragma unroll
    for (int j = 0; j < 8; ++j) {
      const int idx = tid + 256 * j; const int rr = idx >> 4, cc = idx & 15;
      if (cn0 + cc * 8 < INC) *(u32x4*)(p.proj + (long)(cm0 + rr) * INC + cn0 + cc * 8) = *(const u32x4*)(Ct + rr * 136 + cc * 8);
    }
  } else if (EPI == 1) {
#define EPI1(ACC, I, J)                                                                              \
    {                                                                                                \
      float xv_[16], mv_[16];                                                                        \
      const int col = cn0 + wn * 64 + (J) * 32 + (lane & 31);                                         \
      _Pragma("unroll") for (int r = 0; r < 16; ++r) {                                               \
        const long row = cm0 + wm * 64 + (I) * 32 + (r & 3) + 8 * (r >> 2) + 4 * (lane >> 5);         \
        xv_[r] = p.X[row * 1024 + col]; mv_[r] = p.mod[((long)l * NCOND + condrow(row)) * 6144 + 2048 + col]; \
      }                                                                                              \
      _Pragma("unroll") for (int r = 0; r < 16; ++r) {                                               \
        const long row = cm0 + wm * 64 + (I) * 32 + (r & 3) + 8 * (r >> 2) + 4 * (lane >> 5);         \
        p.X[row * 1024 + col] = xv_[r] + mv_[r] * ACC[r];                                            \
      }                                                                                              \
    }
    EPI1(acc00, 0, 0) EPI1(acc01, 0, 1) EPI1(acc10, 1, 0) EPI1(acc11, 1, 1)
#undef EPI1
  } else {
    h16* Q = (h16*)g_smem;
    h16* Kk = Q + 128 * 136;
    const h16* kg = p.keys16 + ((long)l * 16 + cnt) * CFG_NKEYS * 128;
#define QST(ACC, I, J) _Pragma("unroll") for (int r = 0; r < 16; ++r) Q[(wm * 64 + (I) * 32 + (r & 3) + 8 * (r >> 2) + 4 * (lane >> 5)) * 136 + wn * 64 + (J) * 32 + (lane & 31)] = (h16)ACC[r];
    QST(acc00, 0, 0) QST(acc01, 0, 1) QST(acc10, 1, 0) QST(acc11, 1, 1)
#undef QST
#pragma unroll
    for (int j = 0; j < 8; ++j) {
      const int idx = tid + 256 * j; const int kr = idx >> 4, kc = idx & 15;
      *(u32x4*)(Kk + kr * 136 + kc * 8) = *(const u32x4*)(kg + kr * 128 + kc * 8);
    }
    __syncthreads();
    f32x16 z = {0.f, 0.f, 0.f, 0.f, 0.f, 0.f, 0.f, 0.f, 0.f, 0.f, 0.f, 0.f, 0.f, 0.f, 0.f, 0.f};
    f32x16 s00 = z, s01 = z, s10 = z, s11 = z;
    const h16* Qb = Q + (wm * 64 + (lane & 31)) * 136 + (lane >> 5) * 8;
    const h16* Kb = Kk + (wn * 64 + (lane & 31)) * 136 + (lane >> 5) * 8;
#pragma unroll
    for (int sidx = 0; sidx < 8; ++sidx) {
      half8 a0 = *(const half8*)(Qb + sidx * 16), a1 = *(const half8*)(Qb + 32 * 136 + sidx * 16);
      half8 b0 = *(const half8*)(Kb + sidx * 16), b1 = *(const half8*)(Kb + 32 * 136 + sidx * 16);
      s00 = __builtin_amdgcn_mfma_f32_32x32x16_f16(a0, b0, s00, 0, 0, 0);
      s01 = __builtin_amdgcn_mfma_f32_32x32x16_f16(a0, b1, s01, 0, 0, 0);
      s10 = __builtin_amdgcn_mfma_f32_32x32x16_f16(a1, b0, s10, 0, 0, 0);
      s11 = __builtin_amdgcn_mfma_f32_32x32x16_f16(a1, b1, s11, 0, 0, 0);
    }
    __syncthreads();
    float* SC = (float*)g_smem;
#define SST(ACC, I, J) _Pragma("unroll") for (int r = 0; r < 16; ++r) SC[(wm * 64 + (I) * 32 + (r & 3) + 8 * (r >> 2) + 4 * (lane >> 5)) * 129 + wn * 64 + (J) * 32 + (lane & 31)] = ACC[r];
    SST(s00, 0, 0) SST(s01, 0, 1) SST(s10, 1, 0) SST(s11, 1, 1)
#undef SST
    __syncthreads();
    const int row = tid >> 1, half = tid & 1;
    float ts[16]; int ti[16];
#pragma unroll
    for (int j = 0; j < 16; ++j) { ts[j] = -3.0e38f; ti[j] = 0; }
#pragma unroll 1
    for (int g = 0; g < 4; ++g) {
      float gs[16]; int gi[16];
#pragma unroll
      for (int j = 0; j < 16; ++j) { gs[j] = SC[row * 129 + half * 64 + g * 16 + j]; gi[j] = half * 64 + g * 16 + j; }
      bitonic_sort16_desc(gs, gi);
      merge_top16(ts, ti, gs, gi);
    }
    {
      float ps[16]; int pi[16];
#pragma unroll
      for (int j = 0; j < 16; ++j) { ps[j] = dppf<0xB1>(ts[j]); pi[j] = __builtin_amdgcn_update_dpp(0, ti[j], 0xB1, 0xF, 0xF, true); }
      merge_top16(ts, ti, ps, pi);
    }
    if (half == 0) {
      const long token = cm0 + row;
#pragma unroll
      for (int j = 0; j < 16; ++j) { p.tks[token * 256 + cnt * 16 + j] = ts[j]; p.tki[token * 256 + cnt * 16 + j] = ti[j]; }
    }
  }
#undef GEMM_EPI
  if (!has_next) break;
  GLD0(0)
  GLD1(64)
  w = w2;
  }
#undef GLD0
#undef GLD1
#undef LST0
#undef LST1
#undef GCOMP
#undef TILE_OF
}

__device__ void blk_mod(long w, const P& p) {
  float* sl = (float*)g_smem;
  const int tid = otid();
  const int cb = (int)(w % 24); const int r = (int)((w / 24) % NCOND); const int l = (int)(w / (24 * NCOND));
  const float* cond = r == 0 ? p.cctx : p.c + (long)(r - 1) * 1024;
  __syncthreads();
#pragma unroll
  for (int j = 0; j < 4; ++j) sl[tid + 256 * j] = siluf_(cond[tid + 256 * j]);
  __syncthreads();
  const int col = cb * 256 + tid;
  const float* wp = p.wmod + (long)l * 1024 * 6144 + col;
  float acc = p.bmod[l * 6144 + col];
#pragma unroll 8
  for (int k = 0; k < 1024; ++k) acc += sl[k] * wp[(long)k * 6144];
  p.mod[((long)l * NCOND + r) * 6144 + col] = acc;
}
__device__ __forceinline__ float sum64u(float x);
template <int WHICH>
__device__ void blk_norm(long w, const P& p, int l) {
  const int tid_ = otid(); const int lane = tid_ & 63; const long token = w * 4 + (tid_ >> 6);
  const float* src = (WHICH == 0 && l == 0) ? (token < NTC ? p.xp + token * 1024 : p.xs + (token - NTC) * 1024) : p.X + token * 1024;
  float4 v[4]; float ss = 0.f;
#pragma unroll
  for (int j = 0; j < 4; ++j) { v[j] = ((const float4*)src)[lane + 64 * j]; ss += v[j].x * v[j].x + v[j].y * v[j].y + v[j].z * v[j].z + v[j].w * v[j].w; }
  ss = sum64u(ss);
  const float rstd = 1.0f / sqrtf(ss * (1.0f / 1024) + 1e-6f);
  if (WHICH == 2) {
#pragma unroll
    for (int j = 0; j < 4; ++j) {
      float4 g = ((const float4*)p.fng)[lane + 64 * j];
      float4 o; o.x = v[j].x * rstd * g.x; o.y = v[j].y * rstd * g.y; o.z = v[j].z * rstd * g.z; o.w = v[j].w * rstd * g.w;
      ((float4*)(p.X + token * 1024))[lane + 64 * j] = o;
    }
    return;
  }
  const float* m = p.mod + ((long)l * NCOND + condrow(token)) * 6144 + (WHICH ? 3072 : 0);
  const float* g = (WHICH ? p.n2g : p.n1g) + l * 1024;
  float4 gga[4], sha[4], sca[4];
#pragma unroll
  for (int j = 0; j < 4; ++j) { const int c4 = lane + 64 * j; gga[j] = ((const float4*)g)[c4]; sha[j] = ((const float4*)m)[c4]; sca[j] = ((const float4*)(m + 1024))[c4]; }
#pragma unroll
  for (int j = 0; j < 4; ++j) {
    const int c4 = lane + 64 * j;
    const float4 gg = gga[j], sh = sha[j], sc = sca[j];
    half4 o;
    o[0] = (h16)((v[j].x * rstd * gg.x) * (1.0f + sc.x) + sh.x);
    o[1] = (h16)((v[j].y * rstd * gg.y) * (1.0f + sc.y) + sh.y);
    o[2] = (h16)((v[j].z * rstd * gg.z) * (1.0f + sc.z) + sh.z);
    o[3] = (h16)((v[j].w * rstd * gg.w) * (1.0f + sc.w) + sh.w);
    *(half4*)(p.act + token * 1024 + c4 * 4) = o;
    if (WHICH == 0 && l == 0) ((float4*)(p.X + token * 1024))[c4] = v[j];
  }
}


#define SC_CT 32
__device__ __forceinline__ float fsigmoid(float x) { return __frcp_rn(1.0f + __expf(-x)); }
__device__ __forceinline__ float fsilu(float x) { return x * fsigmoid(x); }
__device__ __forceinline__ float fsoftplus(float x) { return fmaxf(x, 0.0f) + __logf(1.0f + __expf(-fabsf(x))); }
__device__ __forceinline__ float ftanh(float x) { const float e = __expf(-2.0f * fabsf(x)); const float t = (1.0f - e) * __frcp_rn(1.0f + e); return x < 0.f ? -t : t; }
#define N_PREP_RW ((NT / 32) * 8)
#define N_PREP_DN ((NT / 32) * 4)
__device__ void blk_scanprep(long w, const P& p, int l, half8& bf0, half8& bf1, int& bkey) {
  h16* tw16 = (h16*)g_smem;
  h16* al16 = tw16 + 32 * 40;
  float* cbuf = (float*)(al16 + 32 * 40);
  const int tid = otid();
  const int ls = tid >> 3, part = tid & 7;
  if (w < N_PREP_RW) {
    const int d = (int)(w & 1), h = (int)((w >> 1) & 3); const long token = (w >> 3) * 32 + ls;
    int t, T; long base; seqinfo(token, t, T, base);
    const bool sv = d == 0 ? (t > 0) : (t < T - 1);
    const h16* pb = p.proj + token * INC + RW_OFF;
    const h16* ps = p.proj + (token + (d == 0 ? -1 : 1)) * INC + RW_OFF;
    const float* mu = p.rwmu + ((long)l * 2 + d) * 832;
    const int lane = tid & 63, wv = tid >> 6;
    const int mat = wv >> 1, ntile = wv & 1;
    const int c0 = h * 64 + part * 8;
    half8 rb = *(const half8*)(pb + c0), kb = *(const half8*)(pb + 256 + c0);
    half8 rs_ = rb, ks_ = kb;
    if (sv) { rs_ = *(const half8*)(ps + c0); ks_ = *(const half8*)(ps + 256 + c0); }
    if (bkey != (int)((l << 3) | (w & 7))) {
      bkey = (int)((l << 3) | (w & 7));
      const float* wsrc = (mat ? p.rwa2 : p.rww2) + ((long)l * 2 + d) * 32 * 256 + h * 64 + ntile * 32 + (lane & 31);
#pragma unroll
      for (int j = 0; j < 8; ++j) { bf0[j] = (h16)wsrc[(8 * (lane >> 5) + j) * 256]; bf1[j] = (h16)wsrc[(16 + 8 * (lane >> 5) + j) * 256]; }
    }
    __syncthreads();
#pragma unroll
    for (int e = 0; e < 4; ++e) {
      const int jj = part * 4 + e;
      float bw = (float)pb[768 + d * 32 + jj], sw = sv ? (float)ps[768 + d * 32 + jj] : 0.f;
      tw16[ls * 40 + jj] = (h16)ftanh(bw + (sw - bw) * mu[768 + jj]);
      float ba = (float)pb[832 + d * 32 + jj], sa_ = sv ? (float)ps[832 + d * 32 + jj] : 0.f;
      al16[ls * 40 + jj] = (h16)(ba + (sa_ - ba) * mu[800 + jj]);
    }
    __syncthreads();
    {
      const h16* X16 = (mat ? al16 : tw16) + (lane & 31) * 40 + 8 * (lane >> 5);
      const half8 a0 = *(const half8*)X16, a1 = *(const half8*)(X16 + 16);
      f32x16 acc = {0.f, 0.f, 0.f, 0.f, 0.f, 0.f, 0.f, 0.f, 0.f, 0.f, 0.f, 0.f, 0.f, 0.f, 0.f, 0.f};
      acc = __builtin_amdgcn_mfma_f32_32x32x16_f16(a0, bf0, acc, 0, 0, 0);
      acc = __builtin_amdgcn_mfma_f32_32x32x16_f16(a1, bf1, acc, 0, 0, 0);
      float* cb = cbuf + mat * (32 * 65) + ntile * 32 + (lane & 31);
#pragma unroll
      for (int r = 0; r < 16; ++r) cb[((r & 3) + 8 * (r >> 2) + 4 * (lane >> 5)) * 65] = acc[r];
    }
    __syncthreads();
    float accw[8], acca[8];
#pragma unroll
    for (int e = 0; e < 8; ++e) {
      accw[e] = p.rww0[(l * 2 + d) * 256 + c0 + e] + cbuf[ls * 65 + part * 8 + e];
      acca[e] = p.rwa0[(l * 2 + d) * 256 + c0 + e] + cbuf[32 * 65 + ls * 65 + part * 8 + e];
    }
    float ss = 0.f, bon = 0.f;
    half8 ewo, ago;
#pragma unroll
    for (int e = 0; e < 8; ++e) {
      const int c = c0 + e;
      float b_ = (float)rb[e], s_ = sv ? (float)rs_[e] : 0.f; const float rr = b_ + (s_ - b_) * mu[c];
      b_ = (float)kb[e]; s_ = sv ? (float)ks_[e] : 0.f; const float kr = b_ + (s_ - b_) * mu[256 + c];
      const float asg = fsigmoid(acca[e]);
      const float kkr = kr * p.rwkk[l * 256 + c];
      ss += kkr * kkr;
      const float keff = kr * (1.0f + (asg - 1.0f) * p.rwka[l * 256 + c]);
      bon += rr * keff * p.rwrk[l * 256 + c];
      ewo[e] = (h16)__expf(-fsoftplus(-accw[e]) - 0.5f);
      ago[e] = (h16)asg;
    }
    ss = sum8(ss); bon = sum8(bon);
    *(half8*)(p.rwaux + ((token * 2 + d) * 2 + 0) * 256 + c0) = ewo;
    *(half8*)(p.rwaux + ((token * 2 + d) * 2 + 1) * 256 + c0) = ago;
    if (part == 0) { float* sc = p.rwsc + ((token * 2 + d) * 4 + h) * 2; sc[0] = 1.0f / sqrtf(ss + 1e-6f); sc[1] = bon; }
  } else {
    const long w2 = w - N_PREP_RW;
    const int h = (int)(w2 & 3); const long token = (w2 >> 2) * 32 + ls;
    int t, T; long base; seqinfo(token, t, T, base);
    const int c0 = h * 64 + part * 8;
    float aq[8], ak[8], av[8];
#pragma unroll
    for (int e = 0; e < 8; ++e) { aq[e] = 0.f; ak[e] = 0.f; av[e] = 0.f; }
    half8 xq[5], xk[5], xv[5]; float tv[5];
#pragma unroll
    for (int tap = 0; tap < 5; ++tap) {
      const int tt = t + tap - 2;
      const bool ok = tt >= 0 && tt < T;
      const h16* pr = p.proj + (base + (ok ? tt : t)) * INC + DN_OFF + c0;
      xq[tap] = *(const half8*)pr; xk[tap] = *(const half8*)(pr + 256); xv[tap] = *(const half8*)(pr + 512);
      tv[tap] = ok ? 1.0f : 0.0f;
    }
    __builtin_amdgcn_sched_barrier(0);
#pragma unroll
    for (int tap = 0; tap < 5; ++tap) {
      const float* cw = p.dnconv + ((long)l * 5 + tap) * 768 + c0;
#pragma unroll
      for (int e = 0; e < 8; ++e) {
        aq[e] += (float)xq[tap][e] * (cw[e] * tv[tap]); ak[e] += (float)xk[tap][e] * (cw[256 + e] * tv[tap]); av[e] += (float)xv[tap][e] * (cw[512 + e] * tv[tap]);
      }
    }
    float ssq = 0.f, ssk = 0.f;
#pragma unroll
    for (int e = 0; e < 8; ++e) { aq[e] = fsilu(aq[e]); ak[e] = fsilu(ak[e]); av[e] = fsilu(av[e]); ssq += aq[e] * aq[e]; ssk += ak[e] * ak[e]; }
    ssq = sum8(ssq); ssk = sum8(ssk);
    const float rq = 0.125f / sqrtf(ssq + 1e-6f), rk = 1.0f / sqrtf(ssk + 1e-6f);
    half8 qo, ko, vo;
#pragma unroll
    for (int e = 0; e < 8; ++e) { qo[e] = (h16)(aq[e] * rq); ko[e] = (h16)(ak[e] * rk); vo[e] = (h16)av[e]; }
    h16* dp = p.dnp + token * 768 + c0;
    *(half8*)dp = qo; *(half8*)(dp + 256) = ko; *(half8*)(dp + 512) = vo;
    if (part < 2) {
      const int d = part;
      const h16* pr = p.proj + token * INC + DN_OFF;
      float* sc = p.dnsc + ((token * 2 + d) * 4 + h) * 2;
      sc[0] = sigmoidf_((float)pr[768 + d * 4 + h]);
      sc[1] = expf(-expf(p.dnalog[(l * 2 + d) * 4 + h]) * softplusf_((float)pr[776 + d * 4 + h] + p.dndt[(l * 2 + d) * 4 + h]));
    }
  }
}
__device__ void blk_scan2(int kind, int bi, int h, int d, int rq, const P& p, int l) {
  float* L = (float*)g_smem;
  float* LA = L; float* LW = L + 2048; float* LB = L + 4096; float* LK = L + 6144; float* LR = L + 8192; float* LV = L + 10240;
  const int tid = otid(), lane = tid & 63, wv = tid >> 6, g = lane >> 4, cl = lane & 15;
  const int i = rq * 32 + wv * 8 + g * 2, j0 = cl * 4;
  const bool ctx = bi < CFG_BATCH;
  const int T = ctx ? CFG_SEQ : CFG_DS;
  const long base = ctx ? (long)bi * CFG_SEQ : (long)NTC + (long)(bi - CFG_BATCH) * CFG_DS;
  const int ls = tid >> 3, part = tid & 7;
  f32x4 S = {0.f, 0.f, 0.f, 0.f}, S1 = {0.f, 0.f, 0.f, 0.f};
  if (!ctx) {
    const int b = bi - CFG_BATCH;
    if (kind == 0) {
      const float* s0 = p.srw + (((((long)b) * 2 + l) * 2 + d) * 4 + h) * 4096;
      S = *(const f32x4*)(s0 + i * 64 + j0); S1 = *(const f32x4*)(s0 + (i + 1) * 64 + j0);
    } else {
      const float* s0 = p.sdn + (((((long)b) * 2 + l) * 2 + d) * 4 + h) * 4096;
#pragma unroll
      for (int c = 0; c < 4; ++c) { S[c] = s0[(j0 + c) * 64 + i]; S1[c] = s0[(j0 + c) * 64 + i + 1]; }
    }
  }
  h16* obuf = (h16*)(L + 12288);
  h16* obase = (kind == 0 ? p.act + 256 + d * 512 + h * 64 : p.proj + DN_OFF + d * 256 + h * 64) + rq * 32 + (tid & 7) * 4;
  const long ostride = kind == 0 ? 1024 : INC;
#define SC_FLUSH(S0I)                                                                              \
  { const int sidx_ = (S0I) + (tid >> 3); const int t_ = d == 0 ? sidx_ : T - 1 - sidx_;             \
    *(half4*)(obase + (base + t_) * ostride) = *(const half4*)(obuf + (tid >> 3) * 32 + (tid & 7) * 4); }
  const int c0 = h * 64 + part * 8, jb = part * 8;
  float cmr[8], cmk[8], cmv[8], ckk[8], cka[8];
#pragma unroll
  for (int e = 0; e < 8; ++e) { cmr[e] = 0.f; cmk[e] = 0.f; cmv[e] = 0.f; ckk[e] = 0.f; cka[e] = 0.f; }
  if (kind == 0) {
    const float* mu = p.rwmu + ((long)l * 2 + d) * 832;
#pragma unroll
    for (int e = 0; e < 8; ++e) { cmr[e] = mu[c0 + e]; cmk[e] = mu[256 + c0 + e]; cmv[e] = mu[512 + c0 + e]; ckk[e] = p.rwkk[l * 256 + c0 + e]; cka[e] = p.rwka[l * 256 + c0 + e]; }
  }
  half8 g0, g1, g2, g3, g4, g5, g6, g7; float gf0 = 0.f, gf1 = 0.f; bool gsv = false;
  g0 = g1 = g2 = g3 = g4 = g5 = g6 = g7 = (half8){0, 0, 0, 0, 0, 0, 0, 0};
#define SC_LOADG(S0I)                                                                              \
  {                                                                                                \
    const int sidx_ = (S0I) + ls;                                                                  \
    const int t_ = d == 0 ? sidx_ : T - 1 - sidx_;                                                 \
    const long token_ = base + t_;                                                                 \
    if (kind == 0) {                                                                               \
      gsv = d == 0 ? (t_ > 0) : (t_ < T - 1);                                                      \
      const h16* pb_ = p.proj + token_ * INC + RW_OFF + c0;                                        \
      const h16* ps_ = gsv ? p.proj + (token_ + (d == 0 ? -1 : 1)) * INC + RW_OFF + c0 : pb_;      \
      g0 = *(const half8*)pb_; g1 = *(const half8*)(pb_ + 256); g2 = *(const half8*)(pb_ + 512);   \
      g3 = *(const half8*)ps_; g4 = *(const half8*)(ps_ + 256); g5 = *(const half8*)(ps_ + 512);   \
      g6 = *(const half8*)(p.rwaux + ((token_ * 2 + d) * 2 + 0) * 256 + c0);                       \
      g7 = *(const half8*)(p.rwaux + ((token_ * 2 + d) * 2 + 1) * 256 + c0);                       \
      gf0 = p.rwsc[((token_ * 2 + d) * 4 + h) * 2];                                                \
    } else {                                                                                       \
      const h16* dp_ = p.dnp + token_ * 768 + c0;                                                  \
      g0 = *(const half8*)dp_; g1 = *(const half8*)(dp_ + 256); g2 = *(const half8*)(dp_ + 512);   \
      const float* sc_ = p.dnsc + ((token_ * 2 + d) * 4 + h) * 2;                                  \
      gf0 = sc_[0]; gf1 = sc_[1];                                                                  \
    }                                                                                              \
  }
  SC_LOADG(0)
  for (int s0i = 0; s0i < T; s0i += SC_CT) {
    __syncthreads();
    if (s0i > 0) SC_FLUSH(s0i - SC_CT)
    {
      f32x4 va[2], vw[2], vb[2], vk[2], vr[2], vv_[2];
      if (kind == 0) {
#pragma unroll
        for (int e = 0; e < 8; ++e) {
          float b_ = (float)g0[e], s_ = gsv ? (float)g3[e] : 0.f; const float rr = b_ + (s_ - b_) * cmr[e];
          b_ = (float)g1[e]; s_ = gsv ? (float)g4[e] : 0.f; const float kr = b_ + (s_ - b_) * cmk[e];
          b_ = (float)g2[e]; s_ = gsv ? (float)g5[e] : 0.f; const float vl = b_ + (s_ - b_) * cmv[e];
          const float asg = (float)g7[e];
          const float kk = kr * ckk[e] * gf0;
          va[e >> 2][e & 3] = -kk; vw[e >> 2][e & 3] = __expf(-(float)g6[e]); vb[e >> 2][e & 3] = kk * asg;
          vk[e >> 2][e & 3] = kr * (1.0f + (asg - 1.0f) * cka[e]); vr[e >> 2][e & 3] = rr; vv_[e >> 2][e & 3] = vl;
        }
      } else {
        const float beta = gf0, alpha = gf1;
#pragma unroll
        for (int e = 0; e < 8; ++e) {
          const float k = (float)g1[e];
          va[e >> 2][e & 3] = k; vw[e >> 2][e & 3] = alpha; vb[e >> 2][e & 3] = -alpha * beta * k;
          vk[e >> 2][e & 3] = beta * k; vr[e >> 2][e & 3] = (float)g0[e]; vv_[e >> 2][e & 3] = (float)g2[e];
        }
      }
      const int lo_ = ls * 64 + jb;
      *(f32x4*)(LA + lo_) = va[0]; *(f32x4*)(LA + lo_ + 4) = va[1]; *(f32x4*)(LW + lo_) = vw[0]; *(f32x4*)(LW + lo_ + 4) = vw[1];
      *(f32x4*)(LB + lo_) = vb[0]; *(f32x4*)(LB + lo_ + 4) = vb[1]; *(f32x4*)(LK + lo_) = vk[0]; *(f32x4*)(LK + lo_ + 4) = vk[1];
      *(f32x4*)(LR + lo_) = vr[0]; *(f32x4*)(LR + lo_ + 4) = vr[1]; *(f32x4*)(LV + lo_) = vv_[0]; *(f32x4*)(LV + lo_ + 4) = vv_[1];
    }
    __syncthreads();
    if (s0i + SC_CT < T) SC_LOADG(s0i + SC_CT)
    __builtin_amdgcn_sched_barrier(0);
#define SC_LD(A4, W4, B4, K4, R4, VV, Q)                                                                    \
    { const int o_ = (Q) * 64; A4 = *(const f32x4*)(LA + o_ + j0); W4 = *(const f32x4*)(LW + o_ + j0); B4 = *(const f32x4*)(LB + o_ + j0); \
      K4 = *(const f32x4*)(LK + o_ + j0); R4 = *(const f32x4*)(LR + o_ + j0); VV = *(const f32x2*)(LV + o_ + i); }
#define SC_STEP(ca, cw, cb, ck, cr, cv, Q)                                                                  \
    {                                                                                                       \
      float sa = S[0] * ca[0] + S[1] * ca[1] + S[2] * ca[2] + S[3] * ca[3];                                 \
      float sb = S1[0] * ca[0] + S1[1] * ca[1] + S1[2] * ca[2] + S1[3] * ca[3];                             \
      sa = sum16(sa); sb = sum16(sb);                                                                       \
      _Pragma("unroll") for (int c = 0; c < 4; ++c) { S[c] = S[c] * cw[c] + sa * cb[c] + cv[0] * ck[c]; S1[c] = S1[c] * cw[c] + sb * cb[c] + cv[1] * ck[c]; } \
      float o = S[0] * cr[0] + S[1] * cr[1] + S[2] * cr[2] + S[3] * cr[3];                                  \
      float o1 = S1[0] * cr[0] + S1[1] * cr[1] + S1[2] * cr[2] + S1[3] * cr[3];                             \
      o = sum16(o); o1 = sum16(o1);                                                                         \
      { half2v ov; ov[0] = (h16)o; ov[1] = (h16)o1; *(half2v*)(obuf + (Q) * 32 + wv * 8 + g * 2) = ov; }   \
    }
    f32x4 a4, w4, b4, k4, r4, a5, w5, b5, k5, r5; f32x2 vv, vv5;
    SC_LD(a4, w4, b4, k4, r4, vv, 0)
#pragma unroll 4
    for (int q = 0; q < SC_CT; q += 2) {
      SC_LD(a5, w5, b5, k5, r5, vv5, q + 1)
      SC_STEP(a4, w4, b4, k4, r4, vv, q)
      SC_LD(a4, w4, b4, k4, r4, vv, q + 2)
      SC_STEP(a5, w5, b5, k5, r5, vv5, q + 1)
    }
#undef SC_LD
#undef SC_STEP
  }
  __syncthreads();
  SC_FLUSH(T - SC_CT)
#undef SC_FLUSH
  if (ctx) {
    if (kind == 0) {
      float* so = p.orw + (((((long)bi) * 2 + l) * 2 + d) * 4 + h) * 4096;
      *(f32x4*)(so + i * 64 + j0) = S; *(f32x4*)(so + (i + 1) * 64 + j0) = S1;
    } else {
      float* so = p.odn + (((((long)bi) * 2 + l) * 2 + d) * 4 + h) * 4096;
#pragma unroll
      for (int c = 0; c < 4; ++c) { so[(j0 + c) * 64 + i] = S[c]; so[(j0 + c) * 64 + i + 1] = S1[c]; }
    }
  }
}
#undef SC_LOADG
__device__ void blk_fin(long w, const P& p, int l, const float* g2s, float* sgs) {
  const int tid_ = otid(); const int lane = tid_ & 63; const long token = w * 4 + (tid_ >> 6);
  float* sgw = sgs + (tid_ >> 6) * 64;
  const int c4 = lane * 4;
  const int hd = lane >> 4;
  const h16* pr = p.proj + token * INC;
  h16* ao = p.act + token * 1024;
  int t, T; long base; seqinfo(token, t, T, base);
  const bool sv0 = t > 0, sv1 = t < T - 1;
  const float bon0 = p.rwsc[((token * 2 + 0) * 4 + hd) * 2 + 1], bon1 = p.rwsc[((token * 2 + 1) * 4 + hd) * 2 + 1];
  const half4 vb = *(const half4*)(pr + RW_OFF + 512 + c4);
  half4 vm = vb, vp = vb;
  if (sv0) vm = *(const half4*)(pr - INC + RW_OFF + 512 + c4);
  if (sv1) vp = *(const half4*)(pr + INC + RW_OFF + 512 + c4);
  const half4 d_o0 = *(const half4*)(pr + DN_OFF + c4), d_o1 = *(const half4*)(pr + DN_OFF + 256 + c4);
  const half4 d_z = *(const half4*)(pr + DN_OFF + 784 + c4);
  const f32x4 mu0 = *(const f32x4*)(p.rwmu + ((long)l * 2 + 0) * 832 + 512 + c4), mu1 = *(const f32x4*)(p.rwmu + ((long)l * 2 + 1) * 832 + 512 + c4);
  const f32x4 lng = *(const f32x4*)(p.rwlng + l * 256 + c4), lnb = *(const f32x4*)(p.rwlnb + l * 256 + c4);
  const f32x4 dng = *(const f32x4*)(p.dnng + l * 64 + (c4 & 63));
  {
    half4 o0 = *(const half4*)(ao + 256 + c4), o1 = *(const half4*)(ao + 768 + c4);
    float o[4]; float mu = 0.f;
#pragma unroll
    for (int e = 0; e < 4; ++e) { o[e] = (float)o0[e] + (float)o1[e]; mu += o[e]; }
    mu = sum16(mu) * (1.0f / 64);
    float var = 0.f;
#pragma unroll
    for (int e = 0; e < 4; ++e) { float dl = o[e] - mu; var += dl * dl; }
    var = sum16(var) * (1.0f / 64);
    const float rs = 1.0f / sqrtf(var + 64e-5f);
    const float sg = sigmoidf_((float)pr[RW_OFF + 896 + lane]);
    float gate[4] = {0.f, 0.f, 0.f, 0.f};
    sgw[lane] = sg;
    __syncthreads();
#pragma unroll 8
    for (int j = 0; j < 64; ++j) {
      const float sj = sgw[j];
      const f32x4 g2 = *(const f32x4*)(g2s + j * 256 + c4);
#pragma unroll
      for (int e = 0; e < 4; ++e) gate[e] += sj * g2[e];
    }
    half4 out;
#pragma unroll
    for (int e = 0; e < 4; ++e) {
      const float b_ = (float)vb[e];
      const float v0 = b_ + ((sv0 ? (float)vm[e] : 0.f) - b_) * mu0[e];
      const float v1 = b_ + ((sv1 ? (float)vp[e] : 0.f) - b_) * mu1[e];
      float y = (o[e] - mu) * rs * lng[e] + lnb[e] + bon0 * v0 + bon1 * v1;
      out[e] = (h16)(y * gate[e]);
    }
    *(half4*)(ao + 256 + c4) = out;
  }
  {
    const half4 o0 = d_o0, o1 = d_o1, z = d_z;
    float o[4]; float ss = 0.f;
#pragma unroll
    for (int e = 0; e < 4; ++e) { o[e] = (float)o0[e] + (float)o1[e]; ss += o[e] * o[e]; }
    ss = sum16(ss);
    const float rs = 1.0f / sqrtf(ss * (1.0f / 64) + 1e-6f);
    half4 out;
#pragma unroll
    for (int e = 0; e < 4; ++e) out[e] = (h16)(o[e] * rs * dng[e] * siluf_((float)z[e]));
    *(half4*)(ao + 768 + c4) = out;
  }
}

__device__ __forceinline__ float dot8h(half8 u, half8 x, float d) {
#pragma unroll
  for (int e = 0; e < 8; ++e) d += (float)u[e] * (float)x[e];
  return d;
}
__device__ __forceinline__ void cvt8(const float* src, h16* dst, long i) {
  const f32x4 a = *(const f32x4*)(src + i * 8), b = *(const f32x4*)(src + i * 8 + 4);
  half8 o; o[0] = (h16)a[0]; o[1] = (h16)a[1]; o[2] = (h16)a[2]; o[3] = (h16)a[3]; o[4] = (h16)b[0]; o[5] = (h16)b[1]; o[6] = (h16)b[2]; o[7] = (h16)b[3];
  *(half8*)(dst + i * 8) = o;
}
__device__ __forceinline__ float sum64u(float x) {
  x = sum16(x);
  x += __builtin_bit_cast(float, __builtin_amdgcn_update_dpp(0, __builtin_bit_cast(int, x), 0x142, 0xA, 0xF, false));
  x += __builtin_bit_cast(float, __builtin_amdgcn_update_dpp(0, __builtin_bit_cast(int, x), 0x143, 0xC, 0xF, false));
  return __builtin_bit_cast(float, __builtin_amdgcn_readlane(__builtin_bit_cast(int, x), 63));
}
__device__ __forceinline__ float ferf(float x) {
  const float ax = fabsf(x);
  const float t = __frcp_rn(1.0f + 0.3275911f * ax);
  const float y = 1.0f - (((((1.061405429f * t - 1.453152027f) * t) + 1.421413741f) * t - 0.284496736f) * t + 0.254829592f) * t * __expf(-ax * ax);
  return x < 0.f ? -y : y;
}
__device__ __forceinline__ void cvt16_fp8(const float* src, unsigned char* dst, long i, float scale) {
  u32x4 o;
#pragma unroll
  for (int k = 0; k < 4; ++k) {
    const f32x4 a = *(const f32x4*)(src + i * 16 + k * 4);
    int w = __builtin_amdgcn_cvt_pk_fp8_f32(a[0] * scale, a[1] * scale, 0, false);
    w = __builtin_amdgcn_cvt_pk_fp8_f32(a[2] * scale, a[3] * scale, w, true);
    o[k] = (unsigned)w;
  }
  *(u32x4*)(dst + i * 16) = o;
}
__device__ void fin_phase(const P& p, int l) {
  float* g2s = (float*)g_smem;
  float* sgs = g2s + 64 * 256;
  const int tid = otid();
  __syncthreads();
  const f32x4* src = (const f32x4*)(p.rwg2 + (long)l * 64 * 256);
#pragma unroll
  for (int j = 0; j < 16; ++j) ((f32x4*)g2s)[tid + 256 * j] = src[tid + 256 * j];
  __syncthreads();
  for (long w = blockIdx.x; w < NT / 4; w += gridDim.x) blk_fin(w, p, l, g2s, sgs);
}
typedef unsigned u32x2 __attribute__((ext_vector_type(2)));
__device__ __forceinline__ void cvt16_fp4(const float* src, unsigned char* dst, long i, float scale) {
  u32x2 o;
#pragma unroll
  for (int k = 0; k < 2; ++k) {
    const f32x4 a = *(const f32x4*)(src + i * 16 + k * 8), b = *(const f32x4*)(src + i * 16 + k * 8 + 4);
    unsigned w = 0u;
    w = __builtin_amdgcn_cvt_scalef32_pk_fp4_f32(w, a[0] * scale, a[1] * scale, 1.0f, 0);
    w = __builtin_amdgcn_cvt_scalef32_pk_fp4_f32(w, a[2] * scale, a[3] * scale, 1.0f, 1);
    w = __builtin_amdgcn_cvt_scalef32_pk_fp4_f32(w, b[0] * scale, b[1] * scale, 1.0f, 2);
    w = __builtin_amdgcn_cvt_scalef32_pk_fp4_f32(w, b[2] * scale, b[3] * scale, 1.0f, 3);
    o[k] = w;
  }
  *(u32x2*)(dst + i * 8) = o;
}
#define PEER_USCALE 48.0f
#define PEER_VSCALE 16.0f
struct PairTab { int a[50]; int b[50]; };
__host__ __device__ constexpr PairTab make_pairs() {
  PairTab t{}; int n = 0;
  for (int a = 0; a < 16; ++a) for (int b = 0; b < 16; ++b) if ((a + 1) * (b + 1) <= 16) { t.a[n] = a; t.b[n] = b; ++n; }
  return t;
}
template <bool DRY>
__device__ void blk_peer(long w, const P& p, int l) {
  constexpr PairTab PT = make_pairs();
  const int tid_ = otid(); const int lane = tid_ & 63, wv = tid_ >> 6; const long token = w * 4 + wv;
  int* eidx = (int*)g_smem + wv * 256; float* egate = (float*)g_smem + wv * 256 + 128;
  const h16* xr = p.act + token * 1024 + lane * 16;
  const half8 x0 = *(const half8*)xr, x1 = *(const half8*)(xr + 8);
  int la = 0, lb = 0;
#pragma unroll
  for (int j = 0; j < 50; ++j) if (lane == j) { la = PT.a[j]; lb = PT.b[j]; }
  const int lc = la * 16 + lb;
  __syncthreads();
  float cs_[8]; int ce_[8];
#pragma unroll
  for (int hd = 0; hd < 8; ++hd) {
    const float* s1 = p.tks + token * 256 + hd * 32; const int* i1 = p.tki + token * 256 + hd * 32;
    const int la_ = lane < 50 ? la : 0, lb_ = lane < 50 ? lb : 0;
    cs_[hd] = s1[la_] + s1[16 + lb_]; ce_[hd] = i1[la_] * CFG_NKEYS + i1[16 + lb_];
  }
#pragma unroll
  for (int hd = 0; hd < 8; ++hd) {
    const float s = lane < 50 ? cs_[hd] : -3.0e38f;
    int rank = 0;
#pragma unroll
    for (int j = 0; j < 50; ++j) {
      const float sj = __builtin_bit_cast(float, __builtin_amdgcn_readlane(__builtin_bit_cast(int, s), j));
      rank += (sj > s) ? 1 : 0;
    }
    {
      int mk = (lane < 50 && rank < 16) ? (1 << rank) : 0;
      mk |= __builtin_amdgcn_update_dpp(0, mk, 0x128, 0xF, 0xF, true); mk |= __builtin_amdgcn_update_dpp(0, mk, 0x124, 0xF, 0xF, true);
      mk |= __builtin_amdgcn_update_dpp(0, mk, 0xB1, 0xF, 0xF, true);  mk |= __builtin_amdgcn_update_dpp(0, mk, 0x4E, 0xF, 0xF, true);
      const int mall = __builtin_amdgcn_readlane(mk, 0) | __builtin_amdgcn_readlane(mk, 16) | __builtin_amdgcn_readlane(mk, 32) | __builtin_amdgcn_readlane(mk, 48);
      const int nsel = __builtin_popcountll(__ballot(lane < 50 && rank < 16));
      if (mall != 0xFFFF || nsel != 16) {
        rank = 0;
#pragma unroll 1
        for (int j = 0; j < 50; ++j) {
          const float sj = __builtin_bit_cast(float, __builtin_amdgcn_readlane(__builtin_bit_cast(int, s), j));
          rank += (sj > s || (sj == s && j < lane)) ? 1 : 0;
        }
      }
    }
    const bool sel = lane < 50 && rank < 16;
    const float m = __builtin_bit_cast(float, __builtin_amdgcn_readlane(__builtin_bit_cast(int, s), 0));
    const float e = sel ? expf(s - m) : 0.f;
    const float sum = sum64(e);
    if (sel) { eidx[hd * 16 + rank] = ce_[hd]; egate[hd * 16 + rank] = e / sum; }
  }
  __syncthreads();
  f32x2 x2[8];
#pragma unroll
  for (int e = 0; e < 4; ++e) { x2[e][0] = (float)x0[2 * e]; x2[e][1] = (float)x0[2 * e + 1]; x2[4 + e][0] = (float)x1[2 * e]; x2[4 + e][1] = (float)x1[2 * e + 1]; }
  f32x2 acc2[8];
#pragma unroll
  for (int e = 0; e < 8; ++e) { acc2[e][0] = 0.f; acc2[e][1] = 0.f; }
  const unsigned char* u8 = (const unsigned char*)p.u16; const unsigned char* v8 = (const unsigned char*)p.v16;
#define PEER_LOAD(U, V, GT, EB)                                                                   \
  _Pragma("unroll") for (int q = 0; q < 8; ++q) {                                                 \
    const unsigned ro_ = (unsigned)eidx[(EB) + q] * 512u + (unsigned)lane * 8u; GT[q] = egate[(EB) + q];   \
    U[q] = *(const u32x2*)(u8 + ro_); V[q] = *(const u32x2*)(v8 + ro_);                           \
  }
#define PEER_COMP(U, V, GT)                                                                       \
  {                                                                                               \
    float dd_[8];                                                                                 \
    _Pragma("unroll") for (int q = 0; q < 8; ++q) {                                               \
      f32x2 d2 = {0.f, 0.f};                                                                      \
      _Pragma("unroll") for (int k = 0; k < 2; ++k) {                                             \
        d2 += __builtin_amdgcn_cvt_scalef32_pk_f32_fp4(U[q][k], 1.0f, 0) * x2[4 * k];             \
        d2 += __builtin_amdgcn_cvt_scalef32_pk_f32_fp4(U[q][k], 1.0f, 1) * x2[4 * k + 1];         \
        d2 += __builtin_amdgcn_cvt_scalef32_pk_f32_fp4(U[q][k], 1.0f, 2) * x2[4 * k + 2];         \
        d2 += __builtin_amdgcn_cvt_scalef32_pk_f32_fp4(U[q][k], 1.0f, 3) * x2[4 * k + 3];         \
      }                                                                                           \
      dd_[q] = sum64u(d2[0] + d2[1]) * (1.0f / PEER_USCALE);                                      \
    }                                                                                             \
      \
    float dv_ = dd_[7];                                                                           \
    _Pragma("unroll") for (int q = 6; q >= 0; --q) dv_ = lane == q ? dd_[q] : dv_;                \
    const float gv_ = 0.5f * dv_ * (1.0f + erff(dv_ * 0.70710678118654752f));                     \
    _Pragma("unroll") for (int q = 0; q < 8; ++q) {                                               \
      const float wgt = GT[q] * __builtin_bit_cast(float, __builtin_amdgcn_readlane(__builtin_bit_cast(int, gv_), q)) * (1.0f / PEER_VSCALE); \
      const f32x2 w2 = {wgt, wgt};                                                                \
      _Pragma("unroll") for (int k = 0; k < 2; ++k) {                                             \
        acc2[4 * k] += w2 * __builtin_amdgcn_cvt_scalef32_pk_f32_fp4(V[q][k], 1.0f, 0);           \
        acc2[4 * k + 1] += w2 * __builtin_amdgcn_cvt_scalef32_pk_f32_fp4(V[q][k], 1.0f, 1);       \
        acc2[4 * k + 2] += w2 * __builtin_amdgcn_cvt_scalef32_pk_f32_fp4(V[q][k], 1.0f, 2);       \
        acc2[4 * k + 3] += w2 * __builtin_amdgcn_cvt_scalef32_pk_f32_fp4(V[q][k], 1.0f, 3);       \
      }                                                                                           \
    }                                                                                             \
  }
  u32x2 au[8], av[8], bu[8], bv[8];
  float ag[8], bg[8];
  PEER_LOAD(au, av, ag, 0)
  for (int eb = 0; eb < 128; eb += 16) {
    PEER_LOAD(bu, bv, bg, eb + 8)
    __builtin_amdgcn_sched_barrier(0);
    PEER_COMP(au, av, ag)
    if (eb + 16 < 128) { PEER_LOAD(au, av, ag, eb + 16) }
    __builtin_amdgcn_sched_barrier(0);
    PEER_COMP(bu, bv, bg)
  }
#undef PEER_LOAD
#undef PEER_COMP
  const float* g2 = p.mod + ((long)l * NCOND + condrow(token)) * 6144 + 5120 + lane * 16;
  float* xo = p.X + token * 1024 + lane * 16;
  f32x4 xn[4]; float ssq = 0.f;
#pragma unroll
  for (int k = 0; k < 4; ++k) {
    xn[k] = *(f32x4*)(xo + 4 * k);
    const f32x4 ga = *(const f32x4*)(g2 + 4 * k);
#pragma unroll
    for (int e = 0; e < 4; ++e) { xn[k][e] += ga[e] * acc2[2 * k + (e >> 1)][e & 1]; ssq += xn[k][e] * xn[k][e]; }
  }
  if (DRY) { if (acc2[0][0] == 123456.789f) *(f32x4*)xo = xn[0]; return; }
  const float rstd = 1.0f / sqrtf(sum64u(ssq) * (1.0f / 1024) + 1e-6f);
  if (l == 0) {
    const float* m = p.mod + ((long)1 * NCOND + condrow(token)) * 6144 + lane * 16;
    const float* g = p.n1g + 1024 + lane * 16;
    half8 h0, h1;
    f32x4 gga[4], sha[4], sca[4];
#pragma unroll
    for (int k = 0; k < 4; ++k) { gga[k] = *(const f32x4*)(g + 4 * k); sha[k] = *(const f32x4*)(m + 4 * k); sca[k] = *(const f32x4*)(m + 1024 + 4 * k); }
#pragma unroll
    for (int k = 0; k < 4; ++k) {
      *(f32x4*)(xo + 4 * k) = xn[k];
      const f32x4 gg = gga[k], sh = sha[k], sc = sca[k];
#pragma unroll
      for (int e = 0; e < 4; ++e) {
        const h16 hv = (h16)((xn[k][e] * rstd * gg[e]) * (1.0f + sc[e]) + sh[e]);
        if (k < 2) h0[4 * k + e] = hv; else h1[4 * (k - 2) + e] = hv;
      }
    }
    h16* ho = p.act + token * 1024 + lane * 16;
    *(half8*)ho = h0; *(half8*)(ho + 8) = h1;
  } else {
    f32x4 fga[4];
#pragma unroll
    for (int k = 0; k < 4; ++k) fga[k] = *(const f32x4*)(p.fng + lane * 16 + 4 * k);
#pragma unroll
    for (int k = 0; k < 4; ++k) {
      const f32x4 gg = fga[k];
      f32x4 y;
#pragma unroll
      for (int e = 0; e < 4; ++e) y[e] = xn[k][e] * rstd * gg[e];
      *(f32x4*)(xo + 4 * k) = y;
    }
  }
}

__device__ void blk_attn(int type, int idx, const P& p, int l) {
  h16* Ks = (h16*)g_smem;
  h16* Vt = Ks + 64 * 72;
  float* Bt = (float*)(Vt + 64 * 72);
  const int tid = otid(), lane = tid & 63, wv = tid >> 6, ql = lane & 31, hh = lane >> 5;
  int b, hk, tb; long qtok; int qcol_off, kcol_off, vcol_off, outcol; float qscale; int ntl, ntc; long kbase_tok;
  const float *ck = nullptr, *cv = nullptr;
  int grow = 0, r0w = 0, krmin = 0;
  if (type == 0) {
    tb = idx & 3; hk = (idx >> 2) & 1; b = idx >> 3;
    const int head = hk * 2 + (wv & 1);
    kbase_tok = (long)b * CFG_SEQ; qtok = kbase_tok + tb * 64 + (wv >> 1) * 32 + ql;
    qcol_off = head * 64; kcol_off = 256 + hk * 64; vcol_off = 384 + hk * 64; outcol = head * 64; qscale = 1.0f; ntl = CFG_SEQ / 64; ntc = 0;
  } else if (type == 1) {
    tb = idx & 63; hk = (idx >> 6) & 1; b = idx >> 7;
    const int head = hk * 2 + (wv & 1);
    kbase_tok = (long)NTC + (long)b * CFG_DS; qtok = kbase_tok + tb * 64 + (wv >> 1) * 32 + ql;
    qcol_off = head * 64; kcol_off = 256 + hk * 64; vcol_off = 384 + hk * 64; outcol = head * 64; qscale = 1.0f; ntl = CFG_DS / 64; ntc = CFG_PAST / 64;
    ck = p.cgk + (((long)b * 2 + l) * 2 + hk) * CFG_PAST * 64; cv = p.cgv + (((long)b * 2 + l) * 2 + hk) * CFG_PAST * 64;
  } else if (type == 2) {
    tb = idx & 1; hk = (idx >> 1) & 3; b = idx >> 3;
    kbase_tok = (long)b * CFG_SEQ; qtok = kbase_tok + tb * 128 + wv * 32 + ql;
    qcol_off = NA_OFF + hk * 64; kcol_off = NA_OFF + 256 + hk * 64; vcol_off = NA_OFF + 512 + hk * 64; outcol = 512 + hk * 64; qscale = 0.125f; ntl = CFG_SEQ / 64; ntc = 0;
  } else {
    tb = idx & 31; hk = (idx >> 5) & 3; b = idx >> 7;
    kbase_tok = (long)NTC + (long)b * CFG_DS;
    grow = tb * 2 + (wv >> 1);
    qtok = kbase_tok + grow * 64 + (wv & 1) * 32 + ql;
    qcol_off = NA_OFF + hk * 64; kcol_off = NA_OFF + 256 + hk * 64; vcol_off = NA_OFF + 512 + hk * 64; outcol = 512 + hk * 64; qscale = 0.125f;
    r0w = grow - WR / 2; r0w = r0w < 0 ? 0 : (r0w > GROWS - WR ? GROWS - WR : r0w);
    int ra = tb * 2 - WR / 2; ra = ra < 0 ? 0 : (ra > GROWS - WR ? GROWS - WR : ra);
    int rb = tb * 2 + 1 - WR / 2; rb = rb < 0 ? 0 : (rb > GROWS - WR ? GROWS - WR : rb);
    krmin = ra; ntl = rb + WR - ra; ntc = CFG_PAST / 64;
    ck = p.cnk + (((long)b * 2 + l) * 4 + hk) * CFG_PAST * 64; cv = p.cnv + (((long)b * 2 + l) * 4 + hk) * CFG_PAST * 64;
  }
  const int nt = ntl + ntc;
  __syncthreads();
  if (type == 3) { for (int e = tid; e < 465; e += 256) Bt[e] = p.nabias[((long)l * 4 + hk) * 465 + e]; }
  half8 qf[4];
  {
    const h16* qp = p.proj + qtok * INC + qcol_off + hh * 8;
#pragma unroll
    for (int ds = 0; ds < 4; ++ds) qf[ds] = *(const half8*)(qp + ds * 16);
  }
  const int qc = (int)((qtok - kbase_tok) & 63);
  int cst = qc - 8; cst = cst < 0 ? 0 : (cst > 48 ? 48 : cst);
  f32x16 o0 = {0.f, 0.f, 0.f, 0.f, 0.f, 0.f, 0.f, 0.f, 0.f, 0.f, 0.f, 0.f, 0.f, 0.f, 0.f, 0.f};
  f32x16 o1 = o0;
  float m = -1.0e30f, lsum = 0.f;
  half8 kx0, kx1, vx0, vx1;
  const int skey0 = tid >> 3, sdc = tid & 7;
#define ATT_LOAD(TI)                                                                                       \
  {                                                                                                        \
    const int ti_ = (TI);                                                                                  \
    if (ti_ < ntc) {                                                                                       \
      const float* kk_ = ck + ((long)ti_ * 64 + skey0) * 64 + sdc * 8;                                     \
      const float* vv_ = cv + ((long)ti_ * 64 + skey0) * 64 + sdc * 8;                                     \
      f32x4 a_ = *(const f32x4*)kk_, b_ = *(const f32x4*)(kk_ + 4), c_ = *(const f32x4*)(kk_ + 2048), d_ = *(const f32x4*)(kk_ + 2052); \
      _Pragma("unroll") for (int e = 0; e < 4; ++e) { kx0[e] = (h16)a_[e]; kx0[4 + e] = (h16)b_[e]; kx1[e] = (h16)c_[e]; kx1[4 + e] = (h16)d_[e]; } \
      a_ = *(const f32x4*)vv_; b_ = *(const f32x4*)(vv_ + 4); c_ = *(const f32x4*)(vv_ + 2048); d_ = *(const f32x4*)(vv_ + 2052); \
      _Pragma("unroll") for (int e = 0; e < 4; ++e) { vx0[e] = (h16)a_[e]; vx0[4 + e] = (h16)b_[e]; vx1[e] = (h16)c_[e]; vx1[4 + e] = (h16)d_[e]; } \
    } else {                                                                                               \
      const long t0_ = kbase_tok + (long)((type == 3 ? krmin : 0) + (ti_ - ntc)) * 64;                     \
      const h16* r_ = p.proj + (t0_ + skey0) * INC + sdc * 8;                                              \
      kx0 = *(const half8*)(r_ + kcol_off); kx1 = *(const half8*)(r_ + 32 * INC + kcol_off);              \
      vx0 = *(const half8*)(r_ + vcol_off); vx1 = *(const half8*)(r_ + 32 * INC + vcol_off);              \
    }                                                                                                      \
  }
  ATT_LOAD(0)
  for (int ti = 0; ti < nt; ++ti) {
    __syncthreads();
    *(half8*)(Ks + skey0 * 72 + sdc * 8) = kx0; *(half8*)(Ks + (skey0 + 32) * 72 + sdc * 8) = kx1;
    *(half8*)(Vt + skey0 * 72 + sdc * 8) = vx0; *(half8*)(Vt + (skey0 + 32) * 72 + sdc * 8) = vx1;
    __syncthreads();
    if (ti + 1 < nt) ATT_LOAD(ti + 1)
    __builtin_amdgcn_sched_barrier(0);
    const bool local = type == 3 && ti >= ntc;
    const int kr = krmin + (ti - ntc);
    if (local && (kr < r0w || kr >= r0w + WR)) continue;
    f32x16 s0 = {0.f, 0.f, 0.f, 0.f, 0.f, 0.f, 0.f, 0.f, 0.f, 0.f, 0.f, 0.f, 0.f, 0.f, 0.f, 0.f};
    f32x16 s1 = s0;
#pragma unroll
    for (int ds = 0; ds < 4; ++ds) {
      const half8 a0 = *(const half8*)(Ks + ql * 72 + ds * 16 + hh * 8);
      const half8 a1 = *(const half8*)(Ks + (32 + ql) * 72 + ds * 16 + hh * 8);
      s0 = __builtin_amdgcn_mfma_f32_32x32x16_f16(a0, qf[ds], s0, 0, 0, 0);
      s1 = __builtin_amdgcn_mfma_f32_32x32x16_f16(a1, qf[ds], s1, 0, 0, 0);
    }
    float mx = -1.0e30f;
    if (local) {
      const float* brow = Bt + (kr - grow + 7) * 31 + 15 - qc;
#pragma unroll
      for (int i = 0; i < 16; ++i) {
        const int kc0 = (i & 3) + 8 * (i >> 2) + 4 * hh, kc1 = kc0 + 32;
        s0[i] = (kc0 >= cst && kc0 < cst + 16) ? s0[i] * 0.125f + brow[kc0] : -1.0e30f;
        s1[i] = (kc1 >= cst && kc1 < cst + 16) ? s1[i] * 0.125f + brow[kc1] : -1.0e30f;
      }
    } else if (qscale != 1.0f) {
#pragma unroll
      for (int i = 0; i < 16; ++i) { s0[i] *= qscale; s1[i] *= qscale; }
    }
#pragma unroll
    for (int i = 0; i < 16; ++i) mx = fmaxf(mx, fmaxf(s0[i], s1[i]));
    mx = fmaxf(mx, __shfl_xor(mx, 32));
    const float mn = fmaxf(m, mx);
    const float alpha = __expf(m - mn);
    m = mn; lsum *= alpha;
#pragma unroll
    for (int i = 0; i < 16; ++i) { o0[i] *= alpha; o1[i] *= alpha; }
    float ps = 0.f;
#pragma unroll
    for (int i = 0; i < 16; ++i) { s0[i] = __expf(s0[i] - mn); s1[i] = __expf(s1[i] - mn); ps += s0[i] + s1[i]; }
    lsum += ps;
    half8 pf0, pf1, pf2, pf3;
#pragma unroll
    for (int j = 0; j < 8; ++j) { pf0[j] = (h16)s0[j]; pf1[j] = (h16)s0[8 + j]; pf2[j] = (h16)s1[j]; pf3[j] = (h16)s1[8 + j]; }
#define TRD(ptr) __builtin_bit_cast(half4, __builtin_amdgcn_ds_read_tr16_b64_v4i16((__attribute__((address_space(3))) s16x4v*)(ptr)))
#define ATT_PV(KS, PF)                                                                              \
    {                                                                                               \
        \
      const h16* v0_ = Vt + (16 * (KS) + 4 * hh + ((lane & 15) >> 2)) * 72 + 16 * ((lane >> 4) & 1) + 4 * (lane & 3); \
      const half4 lo0 = TRD(v0_), hi0 = TRD(v0_ + 8 * 72);                                          \
      const half4 lo1 = TRD(v0_ + 32), hi1 = TRD(v0_ + 8 * 72 + 32);                                \
      const half8 a0_ = __builtin_shufflevector(lo0, hi0, 0, 1, 2, 3, 4, 5, 6, 7);                  \
      const half8 a1_ = __builtin_shufflevector(lo1, hi1, 0, 1, 2, 3, 4, 5, 6, 7);                  \
      o0 = __builtin_amdgcn_mfma_f32_32x32x16_f16(a0_, PF, o0, 0, 0, 0);                            \
      o1 = __builtin_amdgcn_mfma_f32_32x32x16_f16(a1_, PF, o1, 0, 0, 0);                            \
    }
    ATT_PV(0, pf0) ATT_PV(1, pf1) ATT_PV(2, pf2) ATT_PV(3, pf3)
#undef ATT_PV
#undef TRD
  }
#undef ATT_LOAD
  lsum += __shfl_xor(lsum, 32);
  const float inv = 1.0f / lsum;
  h16* op = p.act + qtok * 1024 + outcol;
#pragma unroll
  for (int g = 0; g < 4; ++g) {
    half4 a, c;
#pragma unroll
    for (int e = 0; e < 4; ++e) { a[e] = (h16)(o0[4 * g + e] * inv); c[e] = (h16)(o1[4 * g + e] * inv); }
    *(half4*)(op + 8 * g + 4 * hh) = a;
    *(half4*)(op + 32 + 8 * g + 4 * hh) = c;
  }
}
#define N_SCAN_LAT (2 * 2 * CFG_DB * 4 * 2)
#define N_SCAN_CTX (2 * 2 * CFG_BATCH * 4 * 2)
#define N_ATT1 (CFG_DB * 2 * (CFG_DS / 64))
#define N_ATT3 (CFG_DB * 4 * (CFG_DS / 128))
#define N_ATT0 (CFG_BATCH * 2 * (CFG_SEQ / 64))
#define N_ATT2 (CFG_BATCH * 4 * (CFG_SEQ / 128))
__device__ __forceinline__ void run_scan_item(int r, bool latent, const P& p, int l) {
  const int rq = r & 1; r >>= 1; const int kind = r & 1; r >>= 1; const int d = r & 1; r >>= 1; const int h = r & 3; r >>= 2;
  if (latent) __builtin_amdgcn_s_setprio(3);
  blk_scan2(kind, latent ? CFG_BATCH + r : r, h, d, rq, p, l);
  if (latent) __builtin_amdgcn_s_setprio(0);
}
__device__ void mixer_phase(const P& p, int lc, int mode = 0) {
  const int l = lc & 1;
  __shared__ long s_item;
  __shared__ unsigned s_slot;
  const long total = N_SCAN_CTX + N_ATT1 + N_ATT3 + N_ATT0 + N_ATT2;
  unsigned* lat_cnt = p.counters + 8 + lc;
  if (mode == 0) {
    __syncthreads();
    if (threadIdx.x == 0) {
      const unsigned hw = __builtin_amdgcn_s_getreg((31 << 11) | 4);
      const unsigned xcc = __builtin_amdgcn_s_getreg((3 << 11) | 20) & 0xFu;
      const unsigned key = (xcc << 8) | ((hw >> 8) & 0xFFu);
      const unsigned slot = atomicAdd(p.cucnt + lc * 4096 + key, 1u);
      s_slot = slot;
      s_item = slot == 0 ? (long)atomicAdd(lat_cnt, 1u) : (long)N_SCAN_LAT;
    }
    __syncthreads();
    const long w = s_item;
    if (w < N_SCAN_LAT) run_scan_item((int)w, true, p, l);
  }
  for (;;) {
    __syncthreads();
    if (threadIdx.x == 0) s_item = (long)atomicAdd(p.counters + lc, 1u);
    __syncthreads();
    long w = s_item;
    if (mode == 2) w += N_SCAN_CTX;
    if (w >= (mode == 1 ? (long)N_SCAN_CTX : total)) break;
    if (w < N_SCAN_CTX) {
      run_scan_item((int)w, false, p, l);
    } else {
      int a = (int)(w - N_SCAN_CTX);
      int ty;
      if (a < N_ATT1) ty = 1;
      else if ((a -= N_ATT1) < N_ATT3) ty = 3;
      else if ((a -= N_ATT3) < N_ATT0) ty = 0;
      else { a -= N_ATT0; ty = 2; }
      blk_attn(ty, a, p, l);
    }
  }
  if (mode != 2) {
    for (;;) {
      __syncthreads();
      if (threadIdx.x == 0) s_item = (long)atomicAdd(lat_cnt, 1u);
      __syncthreads();
      const long w = s_item;
      if (w >= N_SCAN_LAT) break;
      run_scan_item((int)w, true, p, l);
    }
  }
}


#define XB_TMO      128
#define XB_XCNT(j)  (256  + 64 * (j))
#define XB_XSUB(j)  (1280 + 64 * (j))
#define XB_XGEN(j)  (2304 + 64 * (j))
#define XB_TOP      3328
#define XB_TOPGEN   3392
#define XCD_BAR_WORDS 3456
#define XB_SPIN_CAP (1u << 22)
#define LAS __attribute__((address_space(3)))
__device__ __forceinline__ unsigned xb_ld(unsigned* p)              { return __hip_atomic_load(p, __ATOMIC_RELAXED, __HIP_MEMORY_SCOPE_AGENT); }
__device__ __forceinline__ unsigned xb_add(unsigned* p, unsigned v) { return __hip_atomic_fetch_add(p, v, __ATOMIC_RELAXED, __HIP_MEMORY_SCOPE_AGENT); }
__device__ __forceinline__ unsigned xb_xcc_id() { return (unsigned)__builtin_amdgcn_s_getreg((3 << 11) | 20) & 0xFu; }
#define XB_SPIN(cond, bar) do { unsigned _sp = 0; while (cond) { __builtin_amdgcn_s_sleep(1); \
    if ((++_sp & 255u) == 0u) { if (xb_ld(&(bar)[XB_TMO])) break; if (_sp > XB_SPIN_CAP) { atomicAdd(&(bar)[XB_TMO], 1u); break; } } } } while (0)
struct XcdBarrier { unsigned* bar; unsigned x; volatile LAS unsigned* st; };
__device__ __forceinline__ XcdBarrier xcd_barrier_post(unsigned* bar, volatile LAS unsigned* st) {
  XcdBarrier b; b.bar = bar; b.x = xb_xcc_id(); b.st = st;
  if (threadIdx.x == 0) (void)xb_add(&bar[XB_XCNT(b.x)], 1u);
  return b;
}
__device__ __forceinline__ void xcd_barrier_complete(unsigned* bar, unsigned x, unsigned& nloc, unsigned& nx) {
  const unsigned G = gridDim.x * gridDim.y * gridDim.z;
  unsigned sum, cnt, mine, sp = 0u;
  for (;;) {
    sum = 0u; cnt = 0u; mine = 0u;
#pragma unroll
    for (unsigned j = 0; j < 16; ++j) { const unsigned c = xb_ld(&bar[XB_XCNT(j)]); sum += c; cnt += (c > 0u) ? 1u : 0u; mine = (j == x) ? c : mine; }
    if (sum == G) break;
    __builtin_amdgcn_s_sleep(1);
    if ((++sp & 255u) == 0u) { if (xb_ld(&bar[XB_TMO])) break; if (sp > XB_SPIN_CAP) { atomicAdd(&bar[XB_TMO], 1u); break; } }
  }
  nloc = mine > 0u ? mine : 1u; nx = cnt > 0u ? cnt : 1u;
}
__device__ __forceinline__ void xcd_barrier(const XcdBarrier& b) {
  asm volatile("s_waitcnt vmcnt(0)" ::: "memory");
  __syncthreads();
  if (threadIdx.x == 0) {
    unsigned* bar = b.bar;
    __builtin_amdgcn_s_waitcnt(0);
    unsigned nloc = b.st[0], nx = b.st[1];
    if (nloc == 0u) { xcd_barrier_complete(bar, b.x, nloc, nx); b.st[0] = nloc; b.st[1] = nx; }
    const unsigned old = xb_add(&bar[XB_XSUB(b.x)], 1u);
    const unsigned gen = old / nloc;
    if (old + 1u == (gen + 1u) * nloc) {
      __builtin_amdgcn_fence(__ATOMIC_RELEASE, "agent");
      asm volatile("s_waitcnt vmcnt(0)" ::: "memory");
      const unsigned og = xb_add(&bar[XB_TOP], 1u);
      const unsigned tg = og / nx;
      if (og + 1u == (tg + 1u) * nx) xb_add(&bar[XB_TOPGEN], 1u);
      else XB_SPIN(xb_ld(&bar[XB_TOPGEN]) == tg, bar);
      __builtin_amdgcn_fence(__ATOMIC_ACQUIRE, "agent");
      xb_add(&bar[XB_XGEN(b.x)], 1u);
      asm volatile("s_waitcnt vmcnt(0)" ::: "memory");
    } else {
      XB_SPIN(xb_ld(&bar[XB_XGEN(b.x)]) == gen, bar);
      __builtin_amdgcn_fence(__ATOMIC_ACQUIRE, "agent");
      asm volatile("s_waitcnt vmcnt(0)" ::: "memory");
    }
  }
  __syncthreads();
}

#define STAGE(fn, n) for (long i_ = (long)blockIdx.x * 256 + otid(); i_ < (long)(n); i_ += (long)gridDim.x * 256) fn(i_, p, l);
#define BSTAGE(fn, n) for (long w_ = blockIdx.x; w_ < (long)(n); w_ += gridDim.x) fn(w_, p, l);
#define SYNC { XcdBarrier xb_; xb_.bar = p.xbar; xb_.x = xb_xcc_id(); xb_.st = (volatile LAS unsigned*)&xb_words; xcd_barrier(xb_); }
__global__ void __launch_bounds__(256, 2) mega(P p) {
  cg::grid_group grid = cg::this_grid();
  __shared__ uint4 xb_words;
  if (threadIdx.x == 0) xb_words = make_uint4(0u, 0u, 0u, 0u);
  __syncthreads();
  (void)xcd_barrier_post(p.xbar, (volatile LAS unsigned*)&xb_words);
#define gtid ((long)blockIdx.x * 256 + otid())
#define gstride ((long)gridDim.x * 256)
  { int l = 0;
    if (gtid < 16) p.counters[gtid] = 0u;
    for (long i_ = gtid; i_ < 4 * 4096; i_ += gstride) p.cucnt[i_] = 0u;
    for (int rep_ = 0; rep_ < REP_S0; ++rep_) {
    for (long w_ = blockIdx.x; w_ < 3200; w_ += gridDim.x) blk_convert(w_, p);
    for (long w_ = blockIdx.x; w_ < 2L * NCOND * 24; w_ += gridDim.x) blk_mod(w_, p);
    for (long i_ = gtid; i_ < 2L * 16 * CFG_NKEYS * 128 / 8; i_ += gstride) cvt8(p.pkeys, p.keys16, i_);
    }
  }
  grid.sync();
#pragma unroll 1
  for (int ph = 0; ph < 18; ++ph) {
    const int l = ph >= 9 ? 1 : 0; const int k = ph - 9 * l;
    if (k == 0 && l == 1) continue;
    switch (k) {
      case 0: { BSTAGE(blk_norm<0>, NT / 4) } break;
      case 1: gemm_phase<0>(p, l); break;
      case 2: {
        STAGE(b_prep_gqa, (long)NT * 6)
        STAGE(b_prep_cache, (long)NTC * 640)
        half8 bf0 = {0, 0, 0, 0, 0, 0, 0, 0}, bf1 = bf0; int bkey = -1;
        for (long w_ = blockIdx.x; w_ < (long)N_PREP_RW + N_PREP_DN; w_ += gridDim.x) blk_scanprep(w_, p, l, bf0, bf1, bkey);
      } break;
      case 3:
#ifdef PROBE_MIXER2
        mixer_phase(p, l + 2); SYNC
#endif
        mixer_phase(p, l); break;
      case 4: fin_phase(p, l); break;
      case 5: {
        gemm_phase<1>(p, l);
        for (long i_ = gtid; i_ < (long)NEXP * 1024 / 16; i_ += gstride) {
          cvt16_fp4(p.pu + (long)l * NEXP * 1024, (unsigned char*)p.u16, i_, PEER_USCALE);
          cvt16_fp4(p.pv + (long)l * NEXP * 1024, (unsigned char*)p.v16, i_, PEER_VSCALE);
        }
      } break;
      case 6: { BSTAGE(blk_norm<1>, NT / 4) } break;
      case 7: gemm_phase<2>(p, l); break;
      default: { BSTAGE(blk_peer<false>, NT / 4) } break;
    }
    if (ph != 17) SYNC
  }
}
#else
#define STAGE(fn, n) { _Pragma("omp parallel for schedule(dynamic, 64)") for (long i_ = 0; i_ < (long)(n); ++i_) fn(i_, p, l); }
#define SYNC
void mega(P p) {
  { int l = 0;
    STAGE(b_init, (long)NT * 1024)
    STAGE(b_mod, 2L * NCOND * 6144)
  }
  for (int l = 0; l < 2; ++l) {
    STAGE(b_norm<0>, NT)
    STAGE(b_inproj, (long)NT * INC)
    STAGE(b_prep_gqa, (long)NT * 6)
    STAGE(b_prep_cache, (long)NTC * 640)
    STAGE(b_rwaux, (long)NT * 512)
    STAGE(b_dnconv, (long)NT * 768)
    STAGE(b_dnnorm, (long)NT * 8)
    STAGE(b_rwscan, NSCAN)
    STAGE(b_dnscan, NSCAN)
    STAGE(b_attn_gqa, (long)NT * 4)
    STAGE(b_attn_na, (long)NT * 4)
    STAGE(b_rwfin, (long)NT * 4)
    STAGE(b_dnfin, (long)NT * 4)
    STAGE(b_outproj, (long)NT * 1024)
    STAGE(b_norm<1>, NT)
    STAGE(b_peerq, (long)NT * 2048)
    STAGE(b_topk1, (long)NT * 16)
    STAGE(b_topk2, (long)NT * 8)
    STAGE(b_peer_act, (long)NT * 128)
    STAGE(b_peer_out, (long)NT * 1024)
  }
  { int l = 0; STAGE(b_final, NT) }
}
#endif

static void fill_params(P& p, void* const* d_in, void* d_out, void* d_ws) {
  const float** f = (const float**)&p;
  for (int i = 0; i < 39; ++i) f[i] = (const float*)d_in[i];
  float* o = (float*)d_out;
  p.X = o; o += (long)NT * 1024;
  p.ogk = o; o += (long)CFG_BATCH * 2 * 2 * CFG_SEQ * 64;
  p.ogv = o; o += (long)CFG_BATCH * 2 * 2 * CFG_SEQ * 64;
  p.onk = o; o += (long)CFG_BATCH * 2 * 4 * CFG_SEQ * 64;
  p.onv = o; o += (long)CFG_BATCH * 2 * 4 * CFG_SEQ * 64;
  p.orw = o; o += (long)CFG_BATCH * 2 * 2 * 4 * 4096;
  p.odn = o;
  char* w = (char*)d_ws;
  auto take = [&](size_t bytes) { char* r = w; w += (bytes + 255) & ~(size_t)255; return r; };
  p.xbar = (unsigned*)take(16384);
  p.counters = (unsigned*)take(256);
  p.cucnt = (unsigned*)take(4 * 4096 * 4);
  p.mod = (float*)take(2L * NCOND * 6144 * 4);
  p.act = (h16*)take((size_t)NT * 1024 * sizeof(h16));
  p.rwaux = (h16*)take((size_t)NT * 1024 * sizeof(h16));
  p.dnp = (h16*)take((size_t)NT * 768 * sizeof(h16));
  p.proj = (h16*)take((size_t)NT * INC * sizeof(h16));
  p.wtin = (h16*)take((size_t)2 * NPAD_IN * 1024 * sizeof(h16));
  p.wtout = (h16*)take((size_t)2 * 1024 * 1024 * sizeof(h16));
  p.wtq = (h16*)take((size_t)2 * 2048 * 1024 * sizeof(h16));
  p.rwsc = (float*)take((size_t)NT * 16 * 4);
  p.dnsc = (float*)take((size_t)NT * 16 * 4);
  p.keys16 = (h16*)take((size_t)2 * 16 * CFG_NKEYS * 128 * sizeof(h16));
  char* a = (char*)p.proj;
#ifdef HOST_EMU
  p.pq = (h16*)a; a += (size_t)NT * 2048 * sizeof(h16);
#endif
  p.tks = (float*)a; a += (size_t)NT * 256 * 4;
  p.tki = (int*)a; a += (size_t)NT * 256 * 4;
  p.u16 = (h16*)a; a += (size_t)NEXP * 1024 * sizeof(h16);
  p.v16 = (h16*)a; a += (size_t)NEXP * 1024 * sizeof(h16);
  p.pidx = (int*)p.rwaux;
  p.pact = (float*)((char*)p.rwaux + (size_t)NT * 128 * 4);
}

#ifndef HOST_EMU
extern "C" void kernel_launch(void* const* d_in, const int* in_sizes, int n_in, void* d_out, int out_size, void* d_ws,
                              size_t ws_size, hipStream_t stream) {
  static int grid_blocks = 0;
  if (!grid_blocks) {
    int dev = 0, cus = 0, per_cu = 0;
    (void)hipGetDevice(&dev);
    (void)hipDeviceGetAttribute(&cus, hipDeviceAttributeMultiprocessorCount, dev);
    (void)hipOccupancyMaxActiveBlocksPerMultiprocessor(&per_cu, mega, 256, 0);
    grid_blocks = cus * per_cu;
  }
  P p;
  memset(&p, 0, sizeof(p));
  fill_params(p, d_in, d_out, d_ws);
  (void)hipMemsetAsync(p.xbar, 0, 16384, stream);
  void* args[] = {&p};
  hipError_t e = hipLaunchCooperativeKernel((void*)mega, dim3(grid_blocks), dim3(256), args, 0, stream);
  if (e != hipSuccess) fprintf(stderr, "cooperative launch failed: %s (grid %d)\n", hipGetErrorString(e), grid_blocks);
}
#endif
```

```cpp
#ifndef HOST_EMU
#include <hip/hip_runtime.h>
#include <hip/hip_cooperative_groups.h>
namespace cg = cooperative_groups;
#define HD __device__ __forceinline__
#define HDN __device__ __noinline__
typedef _Float16 h16;
#define CBAR asm volatile("" ::: "memory")
#define SMEM_BYTES 73728
__shared__ __attribute__((aligned(16))) char g_smem[SMEM_BYTES];
__device__ __forceinline__ int otid() { int t = threadIdx.x; asm volatile("" : "+v"(t)); return t; }
#define FSIN(x) __sinf(x)
#define FCOS(x) __cosf(x)
#else
#include <cmath>
#include <cstring>
#define HD static inline
#define HDN static
typedef float h16;
#define CBAR
#define FSIN(x) sinf(x)
#define FCOS(x) cosf(x)
#endif
#include <cstdio>
#include <cstring>

#ifndef CFG_BATCH
#define CFG_BATCH 32
#define CFG_SEQ 256
#define CFG_DB 8
#define CFG_DS 4096
#define CFG_PAST 512
#define CFG_NKEYS 128
#endif

#define NTC (CFG_BATCH * CFG_SEQ)
#define NTL (CFG_DB * CFG_DS)
#define NT (NTC + NTL)
#define NCOND (1 + CFG_DB)
#define GROWS (CFG_DS / 64)
#define WR (GROWS < 8 ? GROWS : 8)
#define NEXP (CFG_NKEYS * CFG_NKEYS)
#define INC 3280
#define RW_OFF 512
#define NA_OFF 1472
#define DN_OFF 2240

struct P {
  const float *xp, *xs, *c, *cgk, *cgv, *cnk, *cnv, *srw, *sdn, *cctx, *n1g, *n2g, *wmod, *bmod, *win, *wout,
      *gqn, *gkn, *rwmu, *rww0, *rww2, *rwa0, *rwa2, *rwg2, *rwkk, *rwka, *rwrk, *rwlng, *rwlnb, *nabias,
      *dnconv, *dnalog, *dndt, *dnng, *pwq, *pkeys, *pu, *pv, *fng;
  float *X, *ogk, *ogv, *onk, *onv, *orw, *odn;
  float* mod;
  h16* act;
  h16* proj;
  h16* rwaux;
  h16* dnp;
  h16* pq;
  float* tks;
  int* tki;
  int* pidx;
  float* pact;
  unsigned* counters;
  unsigned* xbar;
  unsigned* cucnt;
  h16 *keys16, *u16, *v16;
  float *rwsc, *dnsc;
  h16 *wtin, *wtout, *wtq;
};

HD float sigmoidf_(float x) { return 1.0f / (1.0f + expf(-x)); }
HD float siluf_(float x) { return x * sigmoidf_(x); }
HD float softplusf_(float x) { return fmaxf(x, 0.0f) + log1pf(expf(-fabsf(x))); }
HD int condrow(long token) { return token < NTC ? 0 : 1 + (int)((token - NTC) / CFG_DS); }
HD void seqinfo(long token, int& t, int& T, long& base) {
  if (token < NTC) { T = CFG_SEQ; t = (int)(token % CFG_SEQ); base = token - t; }
  else { long u = token - NTC; T = CFG_DS; t = (int)(u % CFG_DS); base = token - t; }
}

HD void b_init(long i, const P& p, int l) {
  p.X[i] = (i < (long)NTC * 1024) ? p.xp[i] : p.xs[i - (long)NTC * 1024];
}
HD void b_mod(long i, const P& p, int) {
  int col = (int)(i % 6144); int r = (int)((i / 6144) % NCOND); int l = (int)(i / (6144L * NCOND));
  const float* cond = r == 0 ? p.cctx : p.c + (long)(r - 1) * 1024;
  float acc = p.bmod[l * 6144 + col];
  for (int k = 0; k < 1024; ++k) acc += siluf_(cond[k]) * p.wmod[((long)l * 1024 + k) * 6144 + col];
  p.mod[i] = acc;
}
template <int WHICH>
HD void b_norm(long i, const P& p, int l) {
  const float* x = p.X + i * 1024;
  float ss = 0.f;
  for (int k = 0; k < 1024; ++k) ss += x[k] * x[k];
  float rstd = 1.0f / sqrtf(ss * (1.0f / 1024) + 1e-6f);
  const float* m = p.mod + ((long)l * NCOND + condrow(i)) * 6144 + (WHICH ? 3072 : 0);
  const float* g = (WHICH ? p.n2g : p.n1g) + l * 1024;
  for (int k = 0; k < 1024; ++k) p.act[i * 1024 + k] = (h16)((x[k] * rstd * g[k]) * (1.0f + m[1024 + k]) + m[k]);
}
HD void b_prep_gqa(long i, const P& p, int l) {
  long token = i / 6; int slot = (int)(i % 6);
  h16* x = p.proj + token * INC + slot * 64;
  float y[64]; float ss = 0.f;
#pragma unroll
  for (int d = 0; d < 64; ++d) { y[d] = (float)x[d]; ss += y[d] * y[d]; }
  float rstd = 1.0f / sqrtf(ss * (1.0f / 64) + 1e-6f);
  const float* g = (slot < 4 ? p.gqn : p.gkn) + l * 64;
#pragma unroll
  for (int d = 0; d < 64; ++d) y[d] = y[d] * rstd * g[d];
  if (token >= NTC) {
    int t = (int)((token - NTC) % CFG_DS); int row = t / 64, colp = t % 64;
#pragma unroll
    for (int j = 0; j < 32; ++j) {
      float inv = exp2f(-(float)(j % 16) * 0.83048202372184059f);
      float ang = (float)(j < 16 ? row : colp) * inv;
      float cs = FCOS(ang), sn = FSIN(ang);
      float a = y[j], b = y[j + 32];
      y[j] = a * cs - b * sn; y[j + 32] = b * cs + a * sn;
    }
  } else if (slot >= 4) {
    int b = (int)(token / CFG_SEQ), t = (int)(token % CFG_SEQ);
    float* o = p.ogk + ((((long)b * 2 + l) * 2 + (slot - 4)) * CFG_SEQ + t) * 64;
#pragma unroll
    for (int d = 0; d < 64; ++d) o[d] = y[d];
  }
  float sc = slot < 4 ? 0.125f : 1.0f;
#pragma unroll
  for (int d = 0; d < 64; ++d) x[d] = (h16)(y[d] * sc);
}
HD void b_prep_cache(long i, const P& p, int l) {
  long token = i / 640; int e = (int)(i % 640);
  int b = (int)(token / CFG_SEQ), t = (int)(token % CFG_SEQ);
  const h16* pr = p.proj + token * INC;
  if (e < 128) { int kvh = e / 64, d = e % 64; p.ogv[((((long)b * 2 + l) * 2 + kvh) * CFG_SEQ + t) * 64 + d] = (float)pr[384 + e]; }
  else if (e < 384) { int c = e - 128; int h = c / 64, d = c % 64; p.onk[((((long)b * 2 + l) * 4 + h) * CFG_SEQ + t) * 64 + d] = (float)pr[NA_OFF + 256 + c]; }
  else { int c = e - 384; int h = c / 64, d = c % 64; p.onv[((((long)b * 2 + l) * 4 + h) * CFG_SEQ + t) * 64 + d] = (float)pr[NA_OFF + 512 + c]; }
}
HD void b_rwaux(long i, const P& p, int l) {
  int col = (int)(i % 256); int d = (int)((i / 256) % 2); long token = i / 512;
  int t, T; long base; seqinfo(token, t, T, base);
  bool sv = d == 0 ? (t > 0) : (t < T - 1);
  const h16* pb = p.proj + token * INC + RW_OFF;
  const h16* ps = p.proj + (token + (d == 0 ? -1 : 1)) * INC + RW_OFF;
  const float* mu = p.rwmu + ((long)l * 2 + d) * 832;
  float accw = p.rww0[(l * 2 + d) * 256 + col], acca = p.rwa0[(l * 2 + d) * 256 + col];
  for (int j = 0; j < 32; ++j) {
    float bw = (float)pb[768 + d * 32 + j], sw = sv ? (float)ps[768 + d * 32 + j] : 0.f;
    float wl = bw + (sw - bw) * mu[768 + j];
    float ba = (float)pb[832 + d * 32 + j], sa = sv ? (float)ps[832 + d * 32 + j] : 0.f;
    float al = ba + (sa - ba) * mu[800 + j];
    accw += tanhf(wl) * p.rww2[(((long)l * 2 + d) * 32 + j) * 256 + col];
    acca += al * p.rwa2[(((long)l * 2 + d) * 32 + j) * 256 + col];
  }
  float w = -softplusf_(-accw) - 0.5f;
  p.rwaux[((token * 2 + d) * 2 + 0) * 256 + col] = (h16)expf(w);
  p.rwaux[((token * 2 + d) * 2 + 1) * 256 + col] = (h16)sigmoidf_(acca);
}
HD void b_dnconv(long i, const P& p, int l) {
  int c = (int)(i % 768); long token = i / 768;
  int t, T; long base; seqinfo(token, t, T, base);
  float acc = 0.f;
#pragma unroll
  for (int j = 0; j < 5; ++j) {
    int tt = t + j - 2;
    if (tt >= 0 && tt < T) acc += (float)p.proj[(base + tt) * INC + DN_OFF + c] * p.dnconv[((long)l * 5 + j) * 768 + c];
  }
  p.dnp[token * 768 + c] = (h16)siluf_(acc);
}
HD void b_dnnorm(long i, const P& p, int) {
  long token = i / 8; int slot = (int)(i % 8);
  h16* x = p.dnp + token * 768 + slot * 64;
  float ss = 0.f;
  for (int d = 0; d < 64; ++d) { float v = (float)x[d]; ss += v * v; }
  float rs = 1.0f / sqrtf(ss + 1e-6f) * (slot < 4 ? 0.125f : 1.0f);
  for (int d = 0; d < 64; ++d) x[d] = (h16)((float)x[d] * rs);
}

struct Softmax64 {
  float m, lsum, acc[64];
};
template <typename TK>
HD void attend_key(Softmax64& st, const float* q, const TK* k, const TK* v, float scale, float bias) {
  float s = 0.f;
#pragma unroll
  for (int d = 0; d < 64; ++d) s += q[d] * (float)k[d];
  s = s * scale + bias;
  if (s > st.m) {
    float f = expf(st.m - s);
    st.lsum *= f;
#pragma unroll
    for (int d = 0; d < 64; ++d) st.acc[d] *= f;
    st.m = s;
  }
  float pw = expf(s - st.m);
  st.lsum += pw;
#pragma unroll
  for (int d = 0; d < 64; ++d) st.acc[d] += pw * (float)v[d];
}
HD void b_attn_gqa(long i, const P& p, int l) {
  int h = (int)(i / NT); long token = i % NT; int kvh = h / 2;
  float q[64];
  const h16* qp = p.proj + token * INC + h * 64;
#pragma unroll
  for (int d = 0; d < 64; ++d) q[d] = (float)qp[d];
  Softmax64 st; st.m = -1e30f; st.lsum = 0.f;
#pragma unroll
  for (int d = 0; d < 64; ++d) st.acc[d] = 0.f;
  int t, T; long base; seqinfo(token, t, T, base);
  for (int tk = 0; tk < T; ++tk) {
    const h16* kp = p.proj + (base + tk) * INC + 256 + kvh * 64;
    attend_key<h16>(st, q, kp, kp + 128, 1.0f, 0.f);
  }
  if (token >= NTC) {
    int b = (int)((token - NTC) / CFG_DS);
    const float* ck = p.cgk + (((long)b * 2 + l) * 2 + kvh) * CFG_PAST * 64;
    const float* cv = p.cgv + (((long)b * 2 + l) * 2 + kvh) * CFG_PAST * 64;
    for (int pp = 0; pp < CFG_PAST; ++pp) attend_key<float>(st, q, ck + pp * 64, cv + pp * 64, 1.0f, 0.f);
  }
  float inv = 1.0f / st.lsum;
  h16* o = p.act + token * 1024 + h * 64;
#pragma unroll
  for (int d = 0; d < 64; ++d) o[d] = (h16)(st.acc[d] * inv);
}
HD void b_attn_na(long i, const P& p, int l) {
  int h = (int)(i / NT); long token = i % NT;
  float q[64];
  const h16* qp = p.proj + token * INC + NA_OFF + h * 64;
#pragma unroll
  for (int d = 0; d < 64; ++d) q[d] = (float)qp[d];
  Softmax64 st; st.m = -1e30f; st.lsum = 0.f;
#pragma unroll
  for (int d = 0; d < 64; ++d) st.acc[d] = 0.f;
  int t, T; long base; seqinfo(token, t, T, base);
  if (token < NTC) {
    for (int tk = 0; tk < T; ++tk) {
      const h16* kp = p.proj + (base + tk) * INC + NA_OFF + 256 + h * 64;
      attend_key<h16>(st, q, kp, kp + 256, 0.125f, 0.f);
    }
  } else {
    int r = t / 64, cq = t % 64;
    int r0 = r - WR / 2; r0 = r0 < 0 ? 0 : (r0 > GROWS - WR ? GROWS - WR : r0);
    int cs = cq - 8; cs = cs < 0 ? 0 : (cs > 48 ? 48 : cs);
    const float* bias = p.nabias + ((long)l * 4 + h) * 15 * 31;
    for (int w = 0; w < WR; ++w) {
      int kr = r0 + w;
      for (int cc = 0; cc < 16; ++cc) {
        int kc = cs + cc;
        const h16* kp = p.proj + (base + kr * 64 + kc) * INC + NA_OFF + 256 + h * 64;
        attend_key<h16>(st, q, kp, kp + 256, 0.125f, bias[(kr - r + 7) * 31 + (kc - cq + 15)]);
      }
    }
    int b = (int)((token - NTC) / CFG_DS);
    const float* ck = p.cnk + (((long)b * 2 + l) * 4 + h) * CFG_PAST * 64;
    const float* cv = p.cnv + (((long)b * 2 + l) * 4 + h) * CFG_PAST * 64;
    for (int pp = 0; pp < CFG_PAST; ++pp) attend_key<float>(st, q, ck + pp * 64, cv + pp * 64, 0.125f, 0.f);
  }
  float inv = 1.0f / st.lsum;
  h16* o = p.act + token * 1024 + 512 + h * 64;
#pragma unroll
  for (int d = 0; d < 64; ++d) o[d] = (h16)(st.acc[d] * inv);
}

HD float rw_lerp(const P& p, int l, long token, bool sv, int d, int c) {
  float b = (float)p.proj[token * INC + RW_OFF + c];
  float s = sv ? (float)p.proj[(token + (d == 0 ? -1 : 1)) * INC + RW_OFF + c] : 0.f;
  return b + (s - b) * p.rwmu[((long)l * 2 + d) * 832 + c];
}
HD void b_rwscan(long i, const P& p, int l) {
  int v = (int)(i % 64); int sb = (int)(i / 64); int h = sb % 4; int bi = sb / 4;
  bool ctx = bi < CFG_BATCH;
  int T = ctx ? CFG_SEQ : CFG_DS;
  long base = ctx ? (long)bi * CFG_SEQ : (long)NTC + (long)(bi - CFG_BATCH) * CFG_DS;
#ifndef HOST_EMU
  float* S = (float*)g_smem + threadIdx.x * 65;
#else
  float S[64];
#endif
  for (int d = 0; d < 2; ++d) {
    if (ctx) {
      for (int k = 0; k < 64; ++k) S[k] = 0.f;
    } else {
      const float* s0 = p.srw + (((((long)(bi - CFG_BATCH)) * 2 + l) * 2 + d) * 4 + h) * 4096 + v * 64;
      for (int k = 0; k < 64; ++k) S[k] = s0[k];
    }
    for (int step = 0; step < T; ++step) {
      int t = d == 0 ? step : T - 1 - step;
      long token = base + t;
      bool sv = d == 0 ? (t > 0) : (t < T - 1);
      const h16* aux = p.rwaux + (token * 2 + d) * 512;
      float ss = 0.f;
      for (int k = 0; k < 64; ++k) {
        float kv = rw_lerp(p, l, token, sv, d, 256 + h * 64 + k) * p.rwkk[l * 256 + h * 64 + k];
        ss += kv * kv;
      }
      float rs = 1.0f / sqrtf(ss + 1e-6f);
      float sa = 0.f;
      for (int k = 0; k < 64; ++k) {
        float kk = rw_lerp(p, l, token, sv, d, 256 + h * 64 + k) * p.rwkk[l * 256 + h * 64 + k] * rs;
        sa -= S[k] * kk;
      }
      float vv = rw_lerp(p, l, token, sv, d, 512 + h * 64 + v);
      float o = 0.f;
      for (int k = 0; k < 64; ++k) {
        int c = h * 64 + k;
        float kr = rw_lerp(p, l, token, sv, d, 256 + c);
        float kk = kr * p.rwkk[l * 256 + c] * rs;
        float a = (float)aux[256 + c];
        float dec = expf(-(float)aux[c]);
        float keff = kr * (1.0f + (a - 1.0f) * p.rwka[l * 256 + c]);
        float r = rw_lerp(p, l, token, sv, d, c);
        S[k] = S[k] * dec + sa * (kk * a) + vv * keff;
        o += S[k] * r;
      }
      h16* op = p.act + token * 1024 + 256 + h * 64 + v;
      if (d == 0) *op = (h16)o; else *op = (h16)((float)*op + o);
    }
    if (ctx) {
      float* so = p.orw + (((((long)bi) * 2 + l) * 2 + d) * 4 + h) * 4096 + v * 64;
      for (int k = 0; k < 64; ++k) so[k] = S[k];
    }
  }
}
HD void b_rwfin(long i, const P& p, int l) {
  long token = i / 4; int h = (int)(i % 4);
  int t, T; long base; seqinfo(token, t, T, base);
  h16* op = p.act + token * 1024 + 256 + h * 64;
  float mu = 0.f;
  for (int k = 0; k < 64; ++k) mu += (float)op[k];
  mu *= (1.0f / 64);
  float var = 0.f;
  for (int k = 0; k < 64; ++k) { float dlt = (float)op[k] - mu; var += dlt * dlt; }
  var *= (1.0f / 64);
  float rs = 1.0f / sqrtf(var + 64e-5f);
  float bon0 = 0.f, bon1 = 0.f;
  for (int d = 0; d < 2; ++d) {
    bool sv = d == 0 ? (t > 0) : (t < T - 1);
    const h16* aux = p.rwaux + (token * 2 + d) * 512;
    float s = 0.f;
    for (int k = 0; k < 64; ++k) {
      int c = h * 64 + k;
      float kr = rw_lerp(p, l, token, sv, d, 256 + c);
      float a = (float)aux[256 + c];
      float keff = kr * (1.0f + (a - 1.0f) * p.rwka[l * 256 + c]);
      s += rw_lerp(p, l, token, sv, d, c) * keff * p.rwrk[l * 256 + c];
    }
    if (d == 0) bon0 = s; else bon1 = s;
  }
  bool sv0 = t > 0, sv1 = t < T - 1;
  for (int k = 0; k < 64; ++k) {
    int c = h * 64 + k;
    float y = ((float)op[k] - mu) * rs * p.rwlng[l * 256 + c] + p.rwlnb[l * 256 + c];
    y += bon0 * rw_lerp(p, l, token, sv0, 0, 512 + c) + bon1 * rw_lerp(p, l, token, sv1, 1, 512 + c);
    float gate = 0.f;
    for (int j = 0; j < 64; ++j) gate += sigmoidf_((float)p.proj[token * INC + RW_OFF + 896 + j]) * p.rwg2[((long)l * 64 + j) * 256 + c];
    op[k] = (h16)(y * gate);
  }
}
HD void b_dnscan(long i, const P& p, int l) {
  int v = (int)(i % 64); int sb = (int)(i / 64); int h = sb % 4; int bi = sb / 4;
  bool ctx = bi < CFG_BATCH;
  int T = ctx ? CFG_SEQ : CFG_DS;
  long base = ctx ? (long)bi * CFG_SEQ : (long)NTC + (long)(bi - CFG_BATCH) * CFG_DS;
#ifndef HOST_EMU
  float* S = (float*)g_smem + threadIdx.x * 65;
#else
  float S[64];
#endif
  for (int d = 0; d < 2; ++d) {
    if (ctx) {
      for (int k = 0; k < 64; ++k) S[k] = 0.f;
    } else {
      const float* s0 = p.sdn + (((((long)(bi - CFG_BATCH)) * 2 + l) * 2 + d) * 4 + h) * 4096 + v;
      for (int k = 0; k < 64; ++k) S[k] = s0[k * 64];
    }
    float nalog = -expf(p.dnalog[(l * 2 + d) * 4 + h]);
    float dtb = p.dndt[(l * 2 + d) * 4 + h];
    for (int step = 0; step < T; ++step) {
      int t = d == 0 ? step : T - 1 - step;
      long token = base + t;
      const h16* dp = p.dnp + token * 768;
      const h16* pr = p.proj + token * INC + DN_OFF;
      float beta = sigmoidf_((float)pr[768 + d * 4 + h]);
      float g = nalog * softplusf_((float)pr[776 + d * 4 + h] + dtb);
      float a = expf(g);
      float sk = 0.f;
      for (int k = 0; k < 64; ++k) sk += (float)dp[256 + h * 64 + k] * S[k];
      float coef = beta * ((float)dp[512 + h * 64 + v] - a * sk);
      float o = 0.f;
      for (int k = 0; k < 64; ++k) {
        S[k] = a * S[k] + coef * (float)dp[256 + h * 64 + k];
        o += (float)dp[h * 64 + k] * S[k];
      }
      h16* op = p.act + token * 1024 + 768 + h * 64 + v;
      if (d == 0) *op = (h16)o; else *op = (h16)((float)*op + o);
    }
    if (ctx) {
      float* so = p.odn + (((((long)bi) * 2 + l) * 2 + d) * 4 + h) * 4096 + v;
      for (int k = 0; k < 64; ++k) so[k * 64] = S[k];
    }
  }
}
HD void b_dnfin(long i, const P& p, int l) {
  long token = i / 4; int h = (int)(i % 4);
  h16* op = p.act + token * 1024 + 768 + h * 64;
  float ss = 0.f;
  for (int k = 0; k < 64; ++k) { float o = (float)op[k]; ss += o * o; }
  float rs = 1.0f / sqrtf(ss * (1.0f / 64) + 1e-6f);
  for (int k = 0; k < 64; ++k) {
    float z = (float)p.proj[token * INC + DN_OFF + 784 + h * 64 + k];
    op[k] = (h16)((float)op[k] * rs * p.dnng[l * 64 + k] * siluf_(z));
  }
}
HD void top16_insert(float (&ts)[16], int (&ti)[16], float s, int id) {
#pragma unroll
  for (int j = 0; j < 16; ++j) {
    if (s > ts[j]) { float a = ts[j]; ts[j] = s; s = a; int b = ti[j]; ti[j] = id; id = b; }
  }
}
HD void b_topk1(long i, const P& p, int l) {
  long token = i / 16; int hp = (int)(i % 16);
  const h16* q = p.pq + token * 2048 + hp * 128;
  const float* keys = p.pkeys + ((long)l * 16 + hp) * CFG_NKEYS * 128;
  float ts[16]; int ti[16];
#pragma unroll
  for (int j = 0; j < 16; ++j) { ts[j] = -3.0e38f; ti[j] = 0; }
  for (int k = 0; k < CFG_NKEYS; ++k) {
    float s = 0.f;
    for (int d = 0; d < 128; ++d) s += (float)q[d] * keys[k * 128 + d];
    top16_insert(ts, ti, s, k);
  }
#pragma unroll
  for (int j = 0; j < 16; ++j) { p.tks[token * 256 + hp * 16 + j] = ts[j]; p.tki[token * 256 + hp * 16 + j] = ti[j]; }
}
HD void b_topk2(long i, const P& p, int l) {
  long token = i / 8; int hd = (int)(i % 8);
  const float* s1 = p.tks + token * 256 + hd * 32; const int* i1 = p.tki + token * 256 + hd * 32;
  float ts[16]; int ti[16];
#pragma unroll
  for (int j = 0; j < 16; ++j) { ts[j] = -3.0e38f; ti[j] = 0; }
  for (int a = 0; a < 16; ++a)
    for (int b = 0; b < 16; ++b) top16_insert(ts, ti, s1[a] + s1[16 + b], i1[a] * CFG_NKEYS + i1[16 + b]);
  float sum = 0.f;
#pragma unroll
  for (int j = 0; j < 16; ++j) sum += expf(ts[j] - ts[0]);
  float inv = 1.0f / sum;
#pragma unroll
  for (int j = 0; j < 16; ++j) { p.pidx[token * 128 + hd * 16 + j] = ti[j]; p.pact[token * 128 + hd * 16 + j] = expf(ts[j] - ts[0]) * inv; }
}
HD void b_peer_act(long i, const P& p, int l) {
  long token = i / 128;
  const float* u = p.pu + ((long)l * NEXP + p.pidx[i]) * 1024;
  const h16* x = p.act + token * 1024;
  float dot = 0.f;
  for (int k = 0; k < 1024; ++k) dot += (float)x[k] * u[k];
  float ge = 0.5f * dot * (1.0f + erff(dot * 0.70710678118654752f));
  p.pact[i] = p.pact[i] * ge;
}
HD void b_peer_out(long i, const P& p, int l) {
  long token = i / 1024; int col = (int)(i % 1024);
  float acc = 0.f;
  for (int e = 0; e < 128; ++e) acc += p.pact[token * 128 + e] * p.pv[((long)l * NEXP + p.pidx[token * 128 + e]) * 1024 + col];
  p.X[i] += p.mod[((long)l * NCOND + condrow(token)) * 6144 + 5120 + col] * acc;
}
HD void b_final(long i, const P& p, int) {
  float* x = p.X + i * 1024;
  float ss = 0.f;
  for (int k = 0; k < 1024; ++k) ss += x[k] * x[k];
  float rstd = 1.0f / sqrtf(ss * (1.0f / 1024) + 1e-6f);
  for (int k = 0; k < 1024; ++k) x[k] = x[k] * rstd * p.fng[k];
}
HD float gemm_elem(const h16* A, const float* B, int N, long token, int col) {
  float acc = 0.f;
  for (int k = 0; k < 1024; ++k) acc += (float)A[token * 1024 + k] * B[(long)k * N + col];
  return acc;
}
HD void b_inproj(long i, const P& p, int l) {
  long token = i / INC; int col = (int)(i % INC);
  p.proj[i] = (h16)gemm_elem(p.act, p.win + (long)l * 1024 * INC, INC, token, col);
}
HD void b_outproj(long i, const P& p, int l) {
  long token = i / 1024; int col = (int)(i % 1024);
  float acc = gemm_elem(p.act, p.wout + (long)l * 1024 * 1024, 1024, token, col);
  p.X[i] += p.mod[((long)l * NCOND + condrow(token)) * 6144 + 2048 + col] * acc;
}
HD void b_peerq(long i, const P& p, int l) {
  long token = i / 2048; int col = (int)(i % 2048);
  p.pq[i] = (h16)gemm_elem(p.act, p.pwq + (long)l * 1024 * 2048, 2048, token, col);
}

#ifndef PROBE_KMAX
#define PROBE_KMAX 16
#endif
#ifndef REP_S0
#define REP_S0 1
#endif
#ifndef REP_MISC
#define REP_MISC 1
#endif
#ifndef REP_G0
#define REP_G0 1
#endif
#ifndef REP_G2
#define REP_G2 1
#endif
#ifndef REP_SP
#define REP_SP 1
#endif
#define NSCAN ((long)(CFG_BATCH + CFG_DB) * 4 * 64)
#define NPAD_IN 3328

#ifndef HOST_EMU
typedef _Float16 half8 __attribute__((ext_vector_type(8)));
typedef _Float16 half4 __attribute__((ext_vector_type(4)));
typedef _Float16 half2v __attribute__((ext_vector_type(2)));
typedef float f32x2 __attribute__((ext_vector_type(2)));
typedef float f32x16 __attribute__((ext_vector_type(16)));
typedef float f32x4 __attribute__((ext_vector_type(4)));
typedef unsigned u32x4 __attribute__((ext_vector_type(4)));
typedef short s16x4v __attribute__((__vector_size__(4 * sizeof(short))));

template <int CTRL> __device__ __forceinline__ float dppf(float x) {
  return __builtin_bit_cast(float, __builtin_amdgcn_update_dpp(0, __builtin_bit_cast(int, x), CTRL, 0xF, 0xF, true));
}
__device__ __forceinline__ float sum16(float x) { x += dppf<0x128>(x); x += dppf<0x124>(x); x += dppf<0xB1>(x); x += dppf<0x4E>(x); return x; }
__device__ __forceinline__ float sum8(float x) { x += dppf<0xB1>(x); x += dppf<0x4E>(x); x += dppf<0x141>(x); return x; }
__device__ __forceinline__ float sum64(float x) { x = sum16(x); x += __shfl_xor(x, 16); x += __shfl_xor(x, 32); return x; }

#define CSWAP_DESC(S, ID, i, j) { const bool c_ = S[j] > S[i]; const float a_ = c_ ? S[j] : S[i]; const float b_ = c_ ? S[i] : S[j]; \
    const int ia_ = c_ ? ID[j] : ID[i]; const int ib_ = c_ ? ID[i] : ID[j]; S[i] = a_; S[j] = b_; ID[i] = ia_; ID[j] = ib_; }
__device__ __forceinline__ void bitonic_sort16_desc(float (&s)[16], int (&id)[16]) {
#pragma unroll
  for (int k = 2; k <= 16; k <<= 1) {
#pragma unroll
    for (int j = k >> 1; j > 0; j >>= 1) {
#pragma unroll
      for (int i = 0; i < 16; ++i) {
        const int l = i ^ j;
        if (l > i) {
          if ((i & k) == 0) CSWAP_DESC(s, id, i, l) else CSWAP_DESC(s, id, l, i)
        }
      }
    }
  }
}
__device__ __forceinline__ void merge_top16(float (&ts)[16], int (&ti)[16], const float (&gs)[16], const int (&gi)[16]) {
#pragma unroll
  for (int i = 0; i < 16; ++i) { if (gs[15 - i] > ts[i]) { ts[i] = gs[15 - i]; ti[i] = gi[15 - i]; } }
#pragma unroll
  for (int j = 8; j > 0; j >>= 1) {
#pragma unroll
    for (int i = 0; i < 16; ++i) { if ((i & j) == 0) CSWAP_DESC(ts, ti, i, i + j) }
  }
}
__device__ void blk_convert(long w, const P& p) {
  int l = (int)(w / 1600); int r = (int)(w % 1600);
  const float* src; h16* dst; int N, ntile;
  if (r < 832) { src = p.win + (long)l * 1024 * INC; dst = p.wtin + (long)l * NPAD_IN * 1024; N = INC; ntile = 52; }
  else if (r < 1088) { r -= 832; src = p.wout + (long)l * 1024 * 1024; dst = p.wtout + (long)l * 1024 * 1024; N = 1024; ntile = 16; }
  else { r -= 1088; src = p.pwq + (long)l * 1024 * 2048; dst = p.wtq + (long)l * 2048 * 1024; N = 2048; ntile = 32; }
  int kt = r / ntile, nt = r % ntile;
  int k0 = kt * 64, n0 = nt * 64;
  h16* tile = (h16*)g_smem;
  const int tid_ = otid(); int c = tid_ & 63, r4 = tid_ >> 6;
  __syncthreads();
#pragma unroll
  for (int j = 0; j < 16; ++j) {
    int rr = r4 + 4 * j;
    float v = (n0 + c < N) ? src[(long)(k0 + rr) * N + n0 + c] : 0.f;
    tile[rr * 66 + c] = (h16)v;
  }
  __syncthreads();
#pragma unroll
  for (int j = 0; j < 16; ++j) {
    int rr = r4 + 4 * j;
    dst[(long)(n0 + rr) * 1024 + k0 + c] = tile[c * 66 + rr];
  }
}

template <int EPI>
__device__ void gemm_phase(const P& p, int l, int kmax = 16) {
  constexpr int NTILES = EPI == 0 ? (NPAD_IN / 128) : (EPI == 1 ? 8 : 16);
  constexpr int NT8 = (NTILES + 7) / 8;
  const long nw = EPI == 0 ? (long)(NT / 128) * NTILES : (long)(NT / 128) * 8 * NT8;
#define TILE_OF(W, MT, NTV) { const int x_ = (int)((W) & 7); const int j_ = (int)((W) >> 3);                        \
    if (EPI == 0) { if (j_ < 960) { MT = j_ / 3; NTV = x_ + 8 * (j_ - 3 * MT); } else { NTV = 24 + (x_ >> 2); MT = 80 * (x_ & 3) + j_ - 960; } } \
    else { NTV = x_ + 8 * (j_ % NT8); MT = j_ / NT8; } }
  const h16* A = p.act;
  const h16* Bt = EPI == 0 ? p.wtin + (long)l * NPAD_IN * 1024 : (EPI == 1 ? p.wtout + (long)l * 1024 * 1024 : p.wtq + (long)l * 2048 * 1024);
  const int tid = otid(), lane = tid & 63, wv = tid >> 6, wm = wv >> 1, wn = wv & 1;
  h16* As = (h16*)g_smem;
  h16* Bs = As + 2 * 128 * 72;
  const int lrow = tid >> 3, lch = tid & 7;
  long w = blockIdx.x; int mt = 0, nt = 0;
  for (;;) { if (w >= nw) return; TILE_OF(w, mt, nt) if (nt < NTILES) break; w += gridDim.x; }
  int m0 = mt * 128, n0 = nt * 128;
  const h16* Ag = A + (long)(m0 + lrow) * 1024 + lch * 8;
  const h16* Bg = Bt + (long)(n0 + lrow) * 1024 + lch * 8;
  u32x4 ra0, ra1, ra2, ra3, rb0, rb1, rb2, rb3;
  u32x4 sa0, sa1, sa2, sa3, sb0, sb1, sb2, sb3;
  const f32x16 zero16 = {0.f, 0.f, 0.f, 0.f, 0.f, 0.f, 0.f, 0.f, 0.f, 0.f, 0.f, 0.f, 0.f, 0.f, 0.f, 0.f};
  f32x16 acc00, acc01, acc10, acc11;
#define GLD0(K0) \
  ra0 = *(const u32x4*)(Ag + (K0)); ra1 = *(const u32x4*)(Ag + 32 * 1024 + (K0)); ra2 = *(const u32x4*)(Ag + 64 * 1024 + (K0)); ra3 = *(const u32x4*)(Ag + 96 * 1024 + (K0)); \
  rb0 = *(const u32x4*)(Bg + (K0)); rb1 = *(const u32x4*)(Bg + 32 * 1024 + (K0)); rb2 = *(const u32x4*)(Bg + 64 * 1024 + (K0)); rb3 = *(const u32x4*)(Bg + 96 * 1024 + (K0));
#define GLD1(K0) \
  sa0 = *(const u32x4*)(Ag + (K0)); sa1 = *(const u32x4*)(Ag + 32 * 1024 + (K0)); sa2 = *(const u32x4*)(Ag + 64 * 1024 + (K0)); sa3 = *(const u32x4*)(Ag + 96 * 1024 + (K0)); \
  sb0 = *(const u32x4*)(Bg + (K0)); sb1 = *(const u32x4*)(Bg + 32 * 1024 + (K0)); sb2 = *(const u32x4*)(Bg + 64 * 1024 + (K0)); sb3 = *(const u32x4*)(Bg + 96 * 1024 + (K0));
#define LST0(AW, BW) \
  *(u32x4*)((AW) + (lrow) * 72 + lch * 8) = ra0; *(u32x4*)((AW) + (lrow + 32) * 72 + lch * 8) = ra1; *(u32x4*)((AW) + (lrow + 64) * 72 + lch * 8) = ra2; *(u32x4*)((AW) + (lrow + 96) * 72 + lch * 8) = ra3; \
  *(u32x4*)((BW) + (lrow) * 72 + lch * 8) = rb0; *(u32x4*)((BW) + (lrow + 32) * 72 + lch * 8) = rb1; *(u32x4*)((BW) + (lrow + 64) * 72 + lch * 8) = rb2; *(u32x4*)((BW) + (lrow + 96) * 72 + lch * 8) = rb3;
#define LST1(AW, BW) \
  *(u32x4*)((AW) + (lrow) * 72 + lch * 8) = sa0; *(u32x4*)((AW) + (lrow + 32) * 72 + lch * 8) = sa1; *(u32x4*)((AW) + (lrow + 64) * 72 + lch * 8) = sa2; *(u32x4*)((AW) + (lrow + 96) * 72 + lch * 8) = sa3; \
  *(u32x4*)((BW) + (lrow) * 72 + lch * 8) = sb0; *(u32x4*)((BW) + (lrow + 32) * 72 + lch * 8) = sb1; *(u32x4*)((BW) + (lrow + 64) * 72 + lch * 8) = sb2; *(u32x4*)((BW) + (lrow + 96) * 72 + lch * 8) = sb3;
#define GCOMP(BUF)                                                                                   \
  {                                                                                                  \
    const h16* Ab = As + (BUF) * 128 * 72 + (wm * 64 + (lane & 31)) * 72 + (lane >> 5) * 8;          \
    const h16* Bb = Bs + (BUF) * 128 * 72 + (wn * 64 + (lane & 31)) * 72 + (lane >> 5) * 8;          \
    _Pragma("unroll") for (int s = 0; s < 4; ++s) {                                                  \
      half8 a0 = *(const half8*)(Ab + s * 16), a1 = *(const half8*)(Ab + 32 * 72 + s * 16);          \
      half8 b0 = *(const half8*)(Bb + s * 16), b1 = *(const half8*)(Bb + 32 * 72 + s * 16);          \
      acc00 = __builtin_amdgcn_mfma_f32_32x32x16_f16(a0, b0, acc00, 0, 0, 0);                        \
      acc01 = __builtin_amdgcn_mfma_f32_32x32x16_f16(a0, b1, acc01, 0, 0, 0);                        \
      acc10 = __builtin_amdgcn_mfma_f32_32x32x16_f16(a1, b0, acc10, 0, 0, 0);                        \
      acc11 = __builtin_amdgcn_mfma_f32_32x32x16_f16(a1, b1, acc11, 0, 0, 0);                        \
    }                                                                                                \
  }
  GLD0(0)
  GLD1(64)
  for (;;) {
  acc00 = zero16; acc01 = zero16; acc10 = zero16; acc11 = zero16;
  __builtin_amdgcn_sched_barrier(0);
  __syncthreads();
  LST0(As, Bs)
  GLD0(128)
  __builtin_amdgcn_sched_barrier(0);
  __syncthreads();
  __builtin_amdgcn_s_setprio(2);
  for (int kt = 0; kt < kmax; kt += 2) {
    GCOMP(0)
    __builtin_amdgcn_sched_barrier(0);
    LST1(As + 128 * 72, Bs + 128 * 72)
    if (kt + 3 < 16) { GLD1((kt + 3) * 64) }
    __builtin_amdgcn_sched_barrier(0);
    __syncthreads();
    GCOMP(1)
    __builtin_amdgcn_sched_barrier(0);
    if (kt + 2 < 16) { LST0(As, Bs) }
    if (kt + 4 < 16) { GLD0((kt + 4) * 64) }
    __builtin_amdgcn_sched_barrier(0);
    __syncthreads();
  }
  __builtin_amdgcn_s_setprio(0);
  const int cm0 = m0, cn0 = n0, cnt = nt;
  long w2 = w + gridDim.x; int mt2 = 0, nt2 = 0; bool has_next = false;
  for (;;) { if (w2 >= nw) break; TILE_OF(w2, mt2, nt2) if (nt2 < NTILES) { has_next = true; break; } w2 += gridDim.x; }
  if (has_next) {
    m0 = mt2 * 128; n0 = nt2 * 128; nt = nt2;
    Ag = A + (long)(m0 + lrow) * 1024 + lch * 8; Bg = Bt + (long)(n0 + lrow) * 1024 + lch * 8;
  }
  __builtin_amdgcn_sched_barrier(0);
#define GEMM_EPI(ACC, I, J)                                                                         \
  _Pragma("unroll") for (int r = 0; r < 16; ++r) {                                                   \
    const long row = cm0 + wm * 64 + (I) * 32 + (r & 3) + 8 * (r >> 2) + 4 * (lane >> 5);             \
    const int col = cn0 + wn * 64 + (J) * 32 + (lane & 31);                                            \
    const float v = ACC[r];                                                                          \
    if (EPI == 0) { if (col < INC) p.proj[row * INC + col] = (h16)v; }                                \
    else if (EPI == 1) { p.X[row * 1024 + col] += p.mod[((long)l * NCOND + condrow(row)) * 6144 + 2048 + col] * v; } \
    else { p.pq[row * 2048 + col] = (h16)v; }                                                         \
  }
  if (EPI == 0) {
    h16* Ct = (h16*)g_smem;
#define CST(ACC, I, J) _Pragma("unroll") for (int r = 0; r < 16; ++r) Ct[(wm * 64 + (I) * 32 + (r & 3) + 8 * (r >> 2) + 4 * (lane >> 5)) * 136 + wn * 64 + (J) * 32 + (lane & 31)] = (h16)ACC[r];
    CST(acc00, 0, 0) CST(acc01, 0, 1) CST(acc10, 1, 0) CST(acc11, 1, 1)
#undef CST
    __syncthreads();
#pragma unroll
    for (int j = 0; j < 8; ++j) {
      const int idx = tid + 256 * j; const int rr = idx >> 4, cc = idx & 15;
      if (cn0 + cc * 8 < INC) *(u32x4*)(p.proj + (long)(cm0 + rr) * INC + cn0 + cc * 8) = *(const u32x4*)(Ct + rr * 136 + cc * 8);
    }
  } else if (EPI == 1) {
#define EPI1(ACC, I, J)                                                                              \
    {                                                                                                \
      float xv_[16], mv_[16];                                                                        \
      const int col = cn0 + wn * 64 + (J) * 32 + (lane & 31);                                         \
      _Pragma("unroll") for (int r = 0; r < 16; ++r) {                                               \
        const long row = cm0 + wm * 64 + (I) * 32 + (r & 3) + 8 * (r >> 2) + 4 * (lane >> 5);         \
        xv_[r] = p.X[row * 1024 + col]; mv_[r] = p.mod[((long)l * NCOND + condrow(row)) * 6144 + 2048 + col]; \
      }                                                                                              \
      _Pragma("unroll") for (int r = 0; r < 16; ++r) {                                               \
        const long row = cm0 + wm * 64 + (I) * 32 + (r & 3) + 8 * (r >> 2) + 4 * (lane >> 5);         \
        p.X[row * 1024 + col] = xv_[r] + mv_[r] * ACC[r];                                            \
      }                                                                                              \
    }
    EPI1(acc00, 0, 0) EPI1(acc01, 0, 1) EPI1(acc10, 1, 0) EPI1(acc11, 1, 1)
#undef EPI1
  } else {
    h16* Q = (h16*)g_smem;
    h16* Kk = Q + 128 * 136;
    const h16* kg = p.keys16 + ((long)l * 16 + cnt) * CFG_NKEYS * 128;
#define QST(ACC, I, J) _Pragma("unroll") for (int r = 0; r < 16; ++r) Q[(wm * 64 + (I) * 32 + (r & 3) + 8 * (r >> 2) + 4 * (lane >> 5)) * 136 + wn * 64 + (J) * 32 + (lane & 31)] = (h16)ACC[r];
    QST(acc00, 0, 0) QST(acc01, 0, 1) QST(acc10, 1, 0) QST(acc11, 1, 1)
#undef QST
#pragma unroll
    for (int j = 0; j < 8; ++j) {
      const int idx = tid + 256 * j; const int kr = idx >> 4, kc = idx & 15;
      *(u32x4*)(Kk + kr * 136 + kc * 8) = *(const u32x4*)(kg + kr * 128 + kc * 8);
    }
    __syncthreads();
    f32x16 z = {0.f, 0.f, 0.f, 0.f, 0.f, 0.f, 0.f, 0.f, 0.f, 0.f, 0.f, 0.f, 0.f, 0.f, 0.f, 0.f};
    f32x16 s00 = z, s01 = z, s10 = z, s11 = z;
    const h16* Qb = Q + (wm * 64 + (lane & 31)) * 136 + (lane >> 5) * 8;
    const h16* Kb = Kk + (wn * 64 + (lane & 31)) * 136 + (lane >> 5) * 8;
#pragma unroll
    for (int sidx = 0; sidx < 8; ++sidx) {
      half8 a0 = *(const half8*)(Qb + sidx * 16), a1 = *(const half8*)(Qb + 32 * 136 + sidx * 16);
      half8 b0 = *(const half8*)(Kb + sidx * 16), b1 = *(const half8*)(Kb + 32 * 136 + sidx * 16);
      s00 = __builtin_amdgcn_mfma_f32_32x32x16_f16(a0, b0, s00, 0, 0, 0);
      s01 = __builtin_amdgcn_mfma_f32_32x32x16_f16(a0, b1, s01, 0, 0, 0);
      s10 = __builtin_amdgcn_mfma_f32_32x32x16_f16(a1, b0, s10, 0, 0, 0);
      s11 = __builtin_amdgcn_mfma_f32_32x32x16_f16(a1, b1, s11, 0, 0, 0);
    }
    __syncthreads();
    float* SC = (float*)g_smem;
#define SST(ACC, I, J) _Pragma("unroll") for (int r = 0; r < 16; ++r) SC[(wm * 64 + (I) * 32 + (r & 3) + 8 * (r >> 2) + 4 * (lane >> 5)) * 129 + wn * 64 + (J) * 32 + (lane & 31)] = ACC[r];
    SST(s00, 0, 0) SST(s01, 0, 1) SST(s10, 1, 0) SST(s11, 1, 1)
#undef SST
    __syncthreads();
    const int row = tid >> 1, half = tid & 1;
    float ts[16]; int ti[16];
#pragma unroll
    for (int j = 0; j < 16; ++j) { ts[j] = -3.0e38f; ti[j] = 0; }
#pragma unroll 1
    for (int g = 0; g < 4; ++g) {
      float gs[16]; int gi[16];
#pragma unroll
      for (int j = 0; j < 16; ++j) { gs[j] = SC[row * 129 + half * 64 + g * 16 + j]; gi[j] = half * 64 + g * 16 + j; }
      bitonic_sort16_desc(gs, gi);
      merge_top16(ts, ti, gs, gi);
    }
    {
      float ps[16]; int pi[16];
#pragma unroll
      for (int j = 0; j < 16; ++j) { ps[j] = dppf<0xB1>(ts[j]); pi[j] = __builtin_amdgcn_update_dpp(0, ti[j], 0xB1, 0xF, 0xF, true); }
      merge_top16(ts, ti, ps, pi);
    }
    if (half == 0) {
      const long token = cm0 + row;
#pragma unroll
      for (int j = 0; j < 16; ++j) { p.tks[token * 256 + cnt * 16 + j] = ts[j]; p.tki[token * 256 + cnt * 16 + j] = ti[j]; }
    }
  }
#undef GEMM_EPI
  if (!has_next) break;
  GLD0(0)
  GLD1(64)
  w = w2;
  }
#undef GLD0
#undef GLD1
#undef LST0
#undef LST1
#undef GCOMP
#undef TILE_OF
}

__device__ void blk_mod(long w, const P& p) {
  float* sl = (float*)g_smem;
  const int tid = otid();
  const int cb = (int)(w % 24); const int r = (int)((w / 24) % NCOND); const int l = (int)(w / (24 * NCOND));
  const float* cond = r == 0 ? p.cctx : p.c + (long)(r - 1) * 1024;
  __syncthreads();
#pragma unroll
  for (int j = 0; j < 4; ++j) sl[tid + 256 * j] = siluf_(cond[tid + 256 * j]);
  __syncthreads();
  const int col = cb * 256 + tid;
  const float* wp = p.wmod + (long)l * 1024 * 6144 + col;
  float acc = p.bmod[l * 6144 + col];
#pragma unroll 8
  for (int k = 0; k < 1024; ++k) acc += sl[k] * wp[(long)k * 6144];
  p.mod[((long)l * NCOND + r) * 6144 + col] = acc;
}
__device__ __forceinline__ float sum64u(float x);
template <int WHICH>
__device__ void blk_norm(long w, const P& p, int l) {
  const int tid_ = otid(); const int lane = tid_ & 63; const long token = w * 4 + (tid_ >> 6);
  const float* src = (WHICH == 0 && l == 0) ? (token < NTC ? p.xp + token * 1024 : p.xs + (token - NTC) * 1024) : p.X + token * 1024;
  float4 v[4]; float ss = 0.f;
#pragma unroll
  for (int j = 0; j < 4; ++j) { v[j] = ((const float4*)src)[lane + 64 * j]; ss += v[j].x * v[j].x + v[j].y * v[j].y + v[j].z * v[j].z + v[j].w * v[j].w; }
  ss = sum64u(ss);
  const float rstd = 1.0f / sqrtf(ss * (1.0f / 1024) + 1e-6f);
  if (WHICH == 2) {
#pragma unroll
    for (int j = 0; j < 4; ++j) {
      float4 g = ((const float4*)p.fng)[lane + 64 * j];
      float4 o; o.x = v[j].x * rstd * g.x; o.y = v[j].y * rstd * g.y; o.z = v[j].z * rstd * g.z; o.w = v[j].w * rstd * g.w;
      ((float4*)(p.X + token * 1024))[lane + 64 * j] = o;
    }
    return;
  }
  const float* m = p.mod + ((long)l * NCOND + condrow(token)) * 6144 + (WHICH ? 3072 : 0);
  const float* g = (WHICH ? p.n2g : p.n1g) + l * 1024;
  float4 gga[4], sha[4], sca[4];
#pragma unroll
  for (int j = 0; j < 4; ++j) { const int c4 = lane + 64 * j; gga[j] = ((const float4*)g)[c4]; sha[j] = ((const float4*)m)[c4]; sca[j] = ((const float4*)(m + 1024))[c4]; }
#pragma unroll
  for (int j = 0; j < 4; ++j) {
    const int c4 = lane + 64 * j;
    const float4 gg = gga[j], sh = sha[j], sc = sca[j];
    half4 o;
    o[0] = (h16)((v[j].x * rstd * gg.x) * (1.0f + sc.x) + sh.x);
    o[1] = (h16)((v[j].y * rstd * gg.y) * (1.0f + sc.y) + sh.y);
    o[2] = (h16)((v[j].z * rstd * gg.z) * (1.0f + sc.z) + sh.z);
    o[3] = (h16)((v[j].w * rstd * gg.w) * (1.0f + sc.w) + sh.w);
    *(half4*)(p.act + token * 1024 + c4 * 4) = o;
    if (WHICH == 0 && l == 0) ((float4*)(p.X + token * 1024))[c4] = v[j];
  }
}


#define SC_CT 32
__device__ __forceinline__ float fsigmoid(float x) { return __frcp_rn(1.0f + __expf(-x)); }
__device__ __forceinline__ float fsilu(float x) { return x * fsigmoid(x); }
__device__ __forceinline__ float fsoftplus(float x) { return fmaxf(x, 0.0f) + __logf(1.0f + __expf(-fabsf(x))); }
__device__ __forceinline__ float ftanh(float x) { const float e = __expf(-2.0f * fabsf(x)); const float t = (1.0f - e) * __frcp_rn(1.0f + e); return x < 0.f ? -t : t; }
#define N_PREP_RW ((NT / 32) * 8)
#define N_PREP_DN ((NT / 32) * 4)
__device__ void blk_scanprep(long w, const P& p, int l, half8& bf0, half8& bf1, int& bkey) {
  h16* tw16 = (h16*)g_smem;
  h16* al16 = tw16 + 32 * 40;
  float* cbuf = (float*)(al16 + 32 * 40);
  const int tid = otid();
  const int ls = tid >> 3, part = tid & 7;
  if (w < N_PREP_RW) {
    const int d = (int)(w & 1), h = (int)((w >> 1) & 3); const long token = (w >> 3) * 32 + ls;
    int t, T; long base; seqinfo(token, t, T, base);
    const bool sv = d == 0 ? (t > 0) : (t < T - 1);
    const h16* pb = p.proj + token * INC + RW_OFF;
    const h16* ps = p.proj + (token + (d == 0 ? -1 : 1)) * INC + RW_OFF;
    const float* mu = p.rwmu + ((long)l * 2 + d) * 832;
    const int lane = tid & 63, wv = tid >> 6;
    const int mat = wv >> 1, ntile = wv & 1;
    const int c0 = h * 64 + part * 8;
    half8 rb = *(const half8*)(pb + c0), kb = *(const half8*)(pb + 256 + c0);
    half8 rs_ = rb, ks_ = kb;
    if (sv) { rs_ = *(const half8*)(ps + c0); ks_ = *(const half8*)(ps + 256 + c0); }
    if (bkey != (int)((l << 3) | (w & 7))) {
      bkey = (int)((l << 3) | (w & 7));
      const float* wsrc = (mat ? p.rwa2 : p.rww2) + ((long)l * 2 + d) * 32 * 256 + h * 64 + ntile * 32 + (lane & 31);
#pragma unroll
      for (int j = 0; j < 8; ++j) { bf0[j] = (h16)wsrc[(8 * (lane >> 5) + j) * 256]; bf1[j] = (h16)wsrc[(16 + 8 * (lane >> 5) + j) * 256]; }
    }
    __syncthreads();
#pragma unroll
    for (int e = 0; e < 4; ++e) {
      const int jj = part * 4 + e;
      float bw = (float)pb[768 + d * 32 + jj], sw = sv ? (float)ps[768 + d * 32 + jj] : 0.f;
      tw16[ls * 40 + jj] = (h16)ftanh(bw + (sw - bw) * mu[768 + jj]);
      float ba = (float)pb[832 + d * 32 + jj], sa_ = sv ? (float)ps[832 + d * 32 + jj] : 0.f;
      al16[ls * 40 + jj] = (h16)(ba + (sa_ - ba) * mu[800 + jj]);
    }
    __syncthreads();
    {
      const h16* X16 = (mat ? al16 : tw16) + (lane & 31) * 40 + 8 * (lane >> 5);
      const half8 a0 = *(const half8*)X16, a1 = *(const half8*)(X16 + 16);
      f32x16 acc = {0.f, 0.f, 0.f, 0.f, 0.f, 0.f, 0.f, 0.f, 0.f, 0.f, 0.f, 0.f, 0.f, 0.f, 0.f, 0.f};
      acc = __builtin_amdgcn_mfma_f32_32x32x16_f16(a0, bf0, acc, 0, 0, 0);
      acc = __builtin_amdgcn_mfma_f32_32x32x16_f16(a1, bf1, acc, 0, 0, 0);
      float* cb = cbuf + mat * (32 * 65) + ntile * 32 + (lane & 31);
#pragma unroll
      for (int r = 0; r < 16; ++r) cb[((r & 3) + 8 * (r >> 2) + 4 * (lane >> 5)) * 65] = acc[r];
    }
    __syncthreads();
    float accw[8], acca[8];
#pragma unroll
    for (int e = 0; e < 8; ++e) {
      accw[e] = p.rww0[(l * 2 + d) * 256 + c0 + e] + cbuf[ls * 65 + part * 8 + e];
      acca[e] = p.rwa0[(l * 2 + d) * 256 + c0 + e] + cbuf[32 * 65 + ls * 65 + part * 8 + e];
    }
    float ss = 0.f, bon = 0.f;
    half8 ewo, ago;
#pragma unroll
    for (int e = 0; e < 8; ++e) {
      const int c = c0 + e;
      float b_ = (float)rb[e], s_ = sv ? (float)rs_[e] : 0.f; const float rr = b_ + (s_ - b_) * mu[c];
      b_ = (float)kb[e]; s_ = sv ? (float)ks_[e] : 0.f; const float kr = b_ + (s_ - b_) * mu[256 + c];
      const float asg = fsigmoid(acca[e]);
      const float kkr = kr * p.rwkk[l * 256 + c];
      ss += kkr * kkr;
      const float keff = kr * (1.0f + (asg - 1.0f) * p.rwka[l * 256 + c]);
      bon += rr * keff * p.rwrk[l * 256 + c];
      ewo[e] = (h16)__expf(-fsoftplus(-accw[e]) - 0.5f);
      ago[e] = (h16)asg;
    }
    ss = sum8(ss); bon = sum8(bon);
    *(half8*)(p.rwaux + ((token * 2 + d) * 2 + 0) * 256 + c0) = ewo;
    *(half8*)(p.rwaux + ((token * 2 + d) * 2 + 1) * 256 + c0) = ago;
    if (part == 0) { float* sc = p.rwsc + ((token * 2 + d) * 4 + h) * 2; sc[0] = 1.0f / sqrtf(ss + 1e-6f); sc[1] = bon; }
  } else {
    const long w2 = w - N_PREP_RW;
    const int h = (int)(w2 & 3); const long token = (w2 >> 2) * 32 + ls;
    int t, T; long base; seqinfo(token, t, T, base);
    const int c0 = h * 64 + part * 8;
    float aq[8], ak[8], av[8];
#pragma unroll
    for (int e = 0; e < 8; ++e) { aq[e] = 0.f; ak[e] = 0.f; av[e] = 0.f; }
    half8 xq[5], xk[5], xv[5]; float tv[5];
#pragma unroll
    for (int tap = 0; tap < 5; ++tap) {
      const int tt = t + tap - 2;
      const bool ok = tt >= 0 && tt < T;
      const h16* pr = p.proj + (base + (ok ? tt : t)) * INC + DN_OFF + c0;
      xq[tap] = *(const half8*)pr; xk[tap] = *(const half8*)(pr + 256); xv[tap] = *(const half8*)(pr + 512);
      tv[tap] = ok ? 1.0f : 0.0f;
    }
    __builtin_amdgcn_sched_barrier(0);
#pragma unroll
    for (int tap = 0; tap < 5; ++tap) {
      const float* cw = p.dnconv + ((long)l * 5 + tap) * 768 + c0;
#pragma unroll
      for (int e = 0; e < 8; ++e) {
        aq[e] += (float)xq[tap][e] * (cw[e] * tv[tap]); ak[e] += (float)xk[tap][e] * (cw[256 + e] * tv[tap]); av[e] += (float)xv[tap][e] * (cw[512 + e] * tv[tap]);
      }
    }
    float ssq = 0.f, ssk = 0.f;
#pragma unroll
    for (int e = 0; e < 8; ++e) { aq[e] = fsilu(aq[e]); ak[e] = fsilu(ak[e]); av[e] = fsilu(av[e]); ssq += aq[e] * aq[e]; ssk += ak[e] * ak[e]; }
    ssq = sum8(ssq); ssk = sum8(ssk);
    const float rq = 0.125f / sqrtf(ssq + 1e-6f), rk = 1.0f / sqrtf(ssk + 1e-6f);
    half8 qo, ko, vo;
#pragma unroll
    for (int e = 0; e < 8; ++e) { qo[e] = (h16)(aq[e] * rq); ko[e] = (h16)(ak[e] * rk); vo[e] = (h16)av[e]; }
    h16* dp = p.dnp + token * 768 + c0;
    *(half8*)dp = qo; *(half8*)(dp + 256) = ko; *(half8*)(dp + 512) = vo;
    if (part < 2) {
      const int d = part;
      const h16* pr = p.proj + token * INC + DN_OFF;
      float* sc = p.dnsc + ((token * 2 + d) * 4 + h) * 2;
      sc[0] = sigmoidf_((float)pr[768 + d * 4 + h]);
      sc[1] = expf(-expf(p.dnalog[(l * 2 + d) * 4 + h]) * softplusf_((float)pr[776 + d * 4 + h] + p.dndt[(l * 2 + d) * 4 + h]));
    }
  }
}
__device__ void blk_scan2(int kind, int bi, int h, int d, int rq, const P& p, int l) {
  float* L = (float*)g_smem;
  float* LA = L; float* LW = L + 2048; float* LB = L + 4096; float* LK = L + 6144; float* LR = L + 8192; float* LV = L + 10240;
  const int tid = otid(), lane = tid & 63, wv = tid >> 6, g = lane >> 4, cl = lane & 15;
  const int i = rq * 32 + wv * 8 + g * 2, j0 = cl * 4;
  const bool ctx = bi < CFG_BATCH;
  const int T = ctx ? CFG_SEQ : CFG_DS;
  const long base = ctx ? (long)bi * CFG_SEQ : (long)NTC + (long)(bi - CFG_BATCH) * CFG_DS;
  const int ls = tid >> 3, part = tid & 7;
  f32x4 S = {0.f, 0.f, 0.f, 0.f}, S1 = {0.f, 0.f, 0.f, 0.f};
  if (!ctx) {
    const int b = bi - CFG_BATCH;
    if (kind == 0) {
      const float* s0 = p.srw + (((((long)b) * 2 + l) * 2 + d) * 4 + h) * 4096;
      S = *(const f32x4*)(s0 + i * 64 + j0); S1 = *(const f32x4*)(s0 + (i + 1) * 64 + j0);
    } else {
      const float* s0 = p.sdn + (((((long)b) * 2 + l) * 2 + d) * 4 + h) * 4096;
#pragma unroll
      for (int c = 0; c < 4; ++c) { S[c] = s0[(j0 + c) * 64 + i]; S1[c] = s0[(j0 + c) * 64 + i + 1]; }
    }
  }
  h16* obuf = (h16*)(L + 12288);
  h16* obase = (kind == 0 ? p.act + 256 + d * 512 + h * 64 : p.proj + DN_OFF + d * 256 + h * 64) + rq * 32 + (tid & 7) * 4;
  const long ostride = kind == 0 ? 1024 : INC;
#define SC_FLUSH(S0I)                                                                              \
  { const int sidx_ = (S0I) + (tid >> 3); const int t_ = d == 0 ? sidx_ : T - 1 - sidx_;             \
    *(half4*)(obase + (base + t_) * ostride) = *(const half4*)(obuf + (tid >> 3) * 32 + (tid & 7) * 4); }
  const int c0 = h * 64 + part * 8, jb = part * 8;
  float cmr[8], cmk[8], cmv[8], ckk[8], cka[8];
#pragma unroll
  for (int e = 0; e < 8; ++e) { cmr[e] = 0.f; cmk[e] = 0.f; cmv[e] = 0.f; ckk[e] = 0.f; cka[e] = 0.f; }
  if (kind == 0) {
    const float* mu = p.rwmu + ((long)l * 2 + d) * 832;
#pragma unroll
    for (int e = 0; e < 8; ++e) { cmr[e] = mu[c0 + e]; cmk[e] = mu[256 + c0 + e]; cmv[e] = mu[512 + c0 + e]; ckk[e] = p.rwkk[l * 256 + c0 + e]; cka[e] = p.rwka[l * 256 + c0 + e]; }
  }
  half8 g0, g1, g2, g3, g4, g5, g6, g7; float gf0 = 0.f, gf1 = 0.f; bool gsv = false;
  g0 = g1 = g2 = g3 = g4 = g5 = g6 = g7 = (half8){0, 0, 0, 0, 0, 0, 0, 0};
#define SC_LOADG(S0I)                                                                              \
  {                                                                                                \
    const int sidx_ = (S0I) + ls;                                                                  \
    const int t_ = d == 0 ? sidx_ : T - 1 - sidx_;                                                 \
    const long token_ = base + t_;                                                                 \
    if (kind == 0) {                                                                               \
      gsv = d == 0 ? (t_ > 0) : (t_ < T - 1);                                                      \
      const h16* pb_ = p.proj + token_ * INC + RW_OFF + c0;                                        \
      const h16* ps_ = gsv ? p.proj + (token_ + (d == 0 ? -1 : 1)) * INC + RW_OFF + c0 : pb_;      \
      g0 = *(const half8*)pb_; g1 = *(const half8*)(pb_ + 256); g2 = *(const half8*)(pb_ + 512);   \
      g3 = *(const half8*)ps_; g4 = *(const half8*)(ps_ + 256); g5 = *(const half8*)(ps_ + 512);   \
      g6 = *(const half8*)(p.rwaux + ((token_ * 2 + d) * 2 + 0) * 256 + c0);                       \
      g7 = *(const half8*)(p.rwaux + ((token_ * 2 + d) * 2 + 1) * 256 + c0);                       \
      gf0 = p.rwsc[((token_ * 2 + d) * 4 + h) * 2];                                                \
    } else {                                                                                       \
      const h16* dp_ = p.dnp + token_ * 768 + c0;                                                  \
      g0 = *(const half8*)dp_; g1 = *(const half8*)(dp_ + 256); g2 = *(const half8*)(dp_ + 512);   \
      const float* sc_ = p.dnsc + ((token_ * 2 + d) * 4 + h) * 2;                                  \
      gf0 = sc_[0]; gf1 = sc_[1];                                                                  \
    }                                                                                              \
  }
  SC_LOADG(0)
  for (int s0i = 0; s0i < T; s0i += SC_CT) {
    __syncthreads();
    if (s0i > 0) SC_FLUSH(s0i - SC_CT)
    {
      f32x4 va[2], vw[2], vb[2], vk[2], vr[2], vv_[2];
      if (kind == 0) {
#pragma unroll
        for (int e = 0; e < 8; ++e) {
          float b_ = (float)g0[e], s_ = gsv ? (float)g3[e] : 0.f; const float rr = b_ + (s_ - b_) * cmr[e];
          b_ = (float)g1[e]; s_ = gsv ? (float)g4[e] : 0.f; const float kr = b_ + (s_ - b_) * cmk[e];
          b_ = (float)g2[e]; s_ = gsv ? (float)g5[e] : 0.f; const float vl = b_ + (s_ - b_) * cmv[e];
          const float asg = (float)g7[e];
          const float kk = kr * ckk[e] * gf0;
          va[e >> 2][e & 3] = -kk; vw[e >> 2][e & 3] = __expf(-(float)g6[e]); vb[e >> 2][e & 3] = kk * asg;
          vk[e >> 2][e & 3] = kr * (1.0f + (asg - 1.0f) * cka[e]); vr[e >> 2][e & 3] = rr; vv_[e >> 2][e & 3] = vl;
        }
      } else {
        const float beta = gf0, alpha = gf1;
#pragma unroll
        for (int e = 0; e < 8; ++e) {
          const float k = (float)g1[e];
          va[e >> 2][e & 3] = k; vw[e >> 2][e & 3] = alpha; vb[e >> 2][e & 3] = -alpha * beta * k;
          vk[e >> 2][e & 3] = beta * k; vr[e >> 2][e & 3] = (float)g0[e]; vv_[e >> 2][e & 3] = (float)g2[e];
        }
      }
      const int lo_ = ls * 64 + jb;
      *(f32x4*)(LA + lo_) = va[0]; *(f32x4*)(LA + lo_ + 4) = va[1]; *(f32x4*)(LW + lo_) = vw[0]; *(f32x4*)(LW + lo_ + 4) = vw[1];
      *(f32x4*)(LB + lo_) = vb[0]; *(f32x4*)(LB + lo_ + 4) = vb[1]; *(f32x4*)(LK + lo_) = vk[0]; *(f32x4*)(LK + lo_ + 4) = vk[1];
      *(f32x4*)(LR + lo_) = vr[0]; *(f32x4*)(LR + lo_ + 4) = vr[1]; *(f32x4*)(LV + lo_) = vv_[0]; *(f32x4*)(LV + lo_ + 4) = vv_[1];
    }
    __syncthreads();
    if (s0i + SC_CT < T) SC_LOADG(s0i + SC_CT)
    __builtin_amdgcn_sched_barrier(0);
#define SC_LD(A4, W4, B4, K4, R4, VV, Q)                                                                    \
    { const int o_ = (Q) * 64; A4 = *(const f32x4*)(LA + o_ + j0); W4 = *(const f32x4*)(LW + o_ + j0); B4 = *(const f32x4*)(LB + o_ + j0); \
      K4 = *(const f32x4*)(LK + o_ + j0); R4 = *(const f32x4*)(LR + o_ + j0); VV = *(const f32x2*)(LV + o_ + i); }
#define SC_STEP(ca, cw, cb, ck, cr, cv, Q)                                                                  \
    {                                                                                                       \
      float sa = S[0] * ca[0] + S[1] * ca[1] + S[2] * ca[2] + S[3] * ca[3];                                 \
      float sb = S1[0] * ca[0] + S1[1] * ca[1] + S1[2] * ca[2] + S1[3] * ca[3];                             \
      sa = sum16(sa); sb = sum16(sb);                                                                       \
      _Pragma("unroll") for (int c = 0; c < 4; ++c) { S[c] = S[c] * cw[c] + sa * cb[c] + cv[0] * ck[c]; S1[c] = S1[c] * cw[c] + sb * cb[c] + cv[1] * ck[c]; } \
      float o = S[0] * cr[0] + S[1] * cr[1] + S[2] * cr[2] + S[3] * cr[3];                                  \
      float o1 = S1[0] * cr[0] + S1[1] * cr[1] + S1[2] * cr[2] + S1[3] * cr[3];                             \
      o = sum16(o); o1 = sum16(o1);                                                                         \
      { half2v ov; ov[0] = (h16)o; ov[1] = (h16)o1; *(half2v*)(obuf + (Q) * 32 + wv * 8 + g * 2) = ov; }   \
    }
    f32x4 a4, w4, b4, k4, r4, a5, w5, b5, k5, r5; f32x2 vv, vv5;
    SC_LD(a4, w4, b4, k4, r4, vv, 0)
#pragma unroll 8
    for (int q = 0; q < SC_CT; q += 2) {
      SC_LD(a5, w5, b5, k5, r5, vv5, q + 1)
      SC_STEP(a4, w4, b4, k4, r4, vv, q)
      SC_LD(a4, w4, b4, k4, r4, vv, q + 2)
      SC_STEP(a5, w5, b5, k5, r5, vv5, q + 1)
    }
#undef SC_LD
#undef SC_STEP
  }
  __syncthreads();
  SC_FLUSH(T - SC_CT)
#undef SC_FLUSH
  if (ctx) {
    if (kind == 0) {
      float* so = p.orw + (((((long)bi) * 2 + l) * 2 + d) * 4 + h) * 4096;
      *(f32x4*)(so + i * 64 + j0) = S; *(f32x4*)(so + (i + 1) * 64 + j0) = S1;
    } else {
      float* so = p.odn + (((((long)bi) * 2 + l) * 2 + d) * 4 + h) * 4096;
#pragma unroll
      for (int c = 0; c < 4; ++c) { so[(j0 + c) * 64 + i] = S[c]; so[(j0 + c) * 64 + i + 1] = S1[c]; }
    }
  }
}
#undef SC_LOADG
__device__ void blk_fin(long w, const P& p, int l, const float* g2s, float* sgs) {
  const int tid_ = otid(); const int lane = tid_ & 63; const long token = w * 4 + (tid_ >> 6);
  float* sgw = sgs + (tid_ >> 6) * 64;
  const int c4 = lane * 4;
  const int hd = lane >> 4;
  const h16* pr = p.proj + token * INC;
  h16* ao = p.act + token * 1024;
  int t, T; long base; seqinfo(token, t, T, base);
  const bool sv0 = t > 0, sv1 = t < T - 1;
  const float bon0 = p.rwsc[((token * 2 + 0) * 4 + hd) * 2 + 1], bon1 = p.rwsc[((token * 2 + 1) * 4 + hd) * 2 + 1];
  const half4 vb = *(const half4*)(pr + RW_OFF + 512 + c4);
  half4 vm = vb, vp = vb;
  if (sv0) vm = *(const half4*)(pr - INC + RW_OFF + 512 + c4);
  if (sv1) vp = *(const half4*)(pr + INC + RW_OFF + 512 + c4);
  const half4 d_o0 = *(const half4*)(pr + DN_OFF + c4), d_o1 = *(const half4*)(pr + DN_OFF + 256 + c4);
  const half4 d_z = *(const half4*)(pr + DN_OFF + 784 + c4);
  const f32x4 mu0 = *(const f32x4*)(p.rwmu + ((long)l * 2 + 0) * 832 + 512 + c4), mu1 = *(const f32x4*)(p.rwmu + ((long)l * 2 + 1) * 832 + 512 + c4);
  const f32x4 lng = *(const f32x4*)(p.rwlng + l * 256 + c4), lnb = *(const f32x4*)(p.rwlnb + l * 256 + c4);
  const f32x4 dng = *(const f32x4*)(p.dnng + l * 64 + (c4 & 63));
  {
    half4 o0 = *(const half4*)(ao + 256 + c4), o1 = *(const half4*)(ao + 768 + c4);
    float o[4]; float mu = 0.f;
#pragma unroll
    for (int e = 0; e < 4; ++e) { o[e] = (float)o0[e] + (float)o1[e]; mu += o[e]; }
    mu = sum16(mu) * (1.0f / 64);
    float var = 0.f;
#pragma unroll
    for (int e = 0; e < 4; ++e) { float dl = o[e] - mu; var += dl * dl; }
    var = sum16(var) * (1.0f / 64);
    const float rs = 1.0f / sqrtf(var + 64e-5f);
    const float sg = sigmoidf_((float)pr[RW_OFF + 896 + lane]);
    float gate[4] = {0.f, 0.f, 0.f, 0.f};
    sgw[lane] = sg;
    __syncthreads();
#pragma unroll 8
    for (int j = 0; j < 64; ++j) {
      const float sj = sgw[j];
      const f32x4 g2 = *(const f32x4*)(g2s + j * 256 + c4);
#pragma unroll
      for (int e = 0; e < 4; ++e) gate[e] += sj * g2[e];
    }
    half4 out;
#pragma unroll
    for (int e = 0; e < 4; ++e) {
      const float b_ = (float)vb[e];
      const float v0 = b_ + ((sv0 ? (float)vm[e] : 0.f) - b_) * mu0[e];
      const float v1 = b_ + ((sv1 ? (float)vp[e] : 0.f) - b_) * mu1[e];
      float y = (o[e] - mu) * rs * lng[e] + lnb[e] + bon0 * v0 + bon1 * v1;
      out[e] = (h16)(y * gate[e]);
    }
    *(half4*)(ao + 256 + c4) = out;
  }
  {
    const half4 o0 = d_o0, o1 = d_o1, z = d_z;
    float o[4]; float ss = 0.f;
#pragma unroll
    for (int e = 0; e < 4; ++e) { o[e] = (float)o0[e] + (float)o1[e]; ss += o[e] * o[e]; }
    ss = sum16(ss);
    const float rs = 1.0f / sqrtf(ss * (1.0f / 64) + 1e-6f);
    half4 out;
#pragma unroll
    for (int e = 0; e < 4; ++e) out[e] = (h16)(o[e] * rs * dng[e] * siluf_((float)z[e]));
    *(half4*)(ao + 768 + c4) = out;
  }
}

__device__ __forceinline__ float dot8h(half8 u, half8 x, float d) {
#pragma unroll
  for (int e = 0; e < 8; ++e) d += (float)u[e] * (float)x[e];
  return d;
}
__device__ __forceinline__ void cvt8(const float* src, h16* dst, long i) {
  const f32x4 a = *(const f32x4*)(src + i * 8), b = *(const f32x4*)(src + i * 8 + 4);
  half8 o; o[0] = (h16)a[0]; o[1] = (h16)a[1]; o[2] = (h16)a[2]; o[3] = (h16)a[3]; o[4] = (h16)b[0]; o[5] = (h16)b[1]; o[6] = (h16)b[2]; o[7] = (h16)b[3];
  *(half8*)(dst + i * 8) = o;
}
__device__ __forceinline__ float sum64u(float x) {
  x = sum16(x);
  x += __builtin_bit_cast(float, __builtin_amdgcn_update_dpp(0, __builtin_bit_cast(int, x), 0x142, 0xA, 0xF, false));
  x += __builtin_bit_cast(float, __builtin_amdgcn_update_dpp(0, __builtin_bit_cast(int, x), 0x143, 0xC, 0xF, false));
  return __builtin_bit_cast(float, __builtin_amdgcn_readlane(__builtin_bit_cast(int, x), 63));
}
__device__ __forceinline__ float ferf(float x) {
  const float ax = fabsf(x);
  const float t = __frcp_rn(1.0f + 0.3275911f * ax);
  const float y = 1.0f - (((((1.061405429f * t - 1.453152027f) * t) + 1.421413741f) * t - 0.284496736f) * t + 0.254829592f) * t * __expf(-ax * ax);
  return x < 0.f ? -y : y;
}
__device__ __forceinline__ void cvt16_fp8(const float* src, unsigned char* dst, long i, float scale) {
  u32x4 o;
#pragma unroll
  for (int k = 0; k < 4; ++k) {
    const f32x4 a = *(const f32x4*)(src + i * 16 + k * 4);
    int w = __builtin_amdgcn_cvt_pk_fp8_f32(a[0] * scale, a[1] * scale, 0, false);
    w = __builtin_amdgcn_cvt_pk_fp8_f32(a[2] * scale, a[3] * scale, w, true);
    o[k] = (unsigned)w;
  }
  *(u32x4*)(dst + i * 16) = o;
}
__device__ void fin_phase(const P& p, int l) {
  float* g2s = (float*)g_smem;
  float* sgs = g2s + 64 * 256;
  const int tid = otid();
  __syncthreads();
  const f32x4* src = (const f32x4*)(p.rwg2 + (long)l * 64 * 256);
#pragma unroll
  for (int j = 0; j < 16; ++j) ((f32x4*)g2s)[tid + 256 * j] = src[tid + 256 * j];
  __syncthreads();
  for (long w = blockIdx.x; w < NT / 4; w += gridDim.x) blk_fin(w, p, l, g2s, sgs);
}
typedef unsigned u32x2 __attribute__((ext_vector_type(2)));
__device__ __forceinline__ void cvt16_fp4(const float* src, unsigned char* dst, long i, float scale) {
  u32x2 o;
#pragma unroll
  for (int k = 0; k < 2; ++k) {
    const f32x4 a = *(const f32x4*)(src + i * 16 + k * 8), b = *(const f32x4*)(src + i * 16 + k * 8 + 4);
    unsigned w = 0u;
    w = __builtin_amdgcn_cvt_scalef32_pk_fp4_f32(w, a[0] * scale, a[1] * scale, 1.0f, 0);
    w = __builtin_amdgcn_cvt_scalef32_pk_fp4_f32(w, a[2] * scale, a[3] * scale, 1.0f, 1);
    w = __builtin_amdgcn_cvt_scalef32_pk_fp4_f32(w, b[0] * scale, b[1] * scale, 1.0f, 2);
    w = __builtin_amdgcn_cvt_scalef32_pk_fp4_f32(w, b[2] * scale, b[3] * scale, 1.0f, 3);
    o[k] = w;
  }
  *(u32x2*)(dst + i * 8) = o;
}
#define PEER_USCALE 48.0f
#define PEER_VSCALE 16.0f
struct PairTab { int a[50]; int b[50]; };
__host__ __device__ constexpr PairTab make_pairs() {
  PairTab t{}; int n = 0;
  for (int a = 0; a < 16; ++a) for (int b = 0; b < 16; ++b) if ((a + 1) * (b + 1) <= 16) { t.a[n] = a; t.b[n] = b; ++n; }
  return t;
}
template <bool DRY>
__device__ void blk_peer(long w, const P& p, int l) {
  constexpr PairTab PT = make_pairs();
  const int tid_ = otid(); const int lane = tid_ & 63, wv = tid_ >> 6; const long token = w * 4 + wv;
  int* eidx = (int*)g_smem + wv * 256; float* egate = (float*)g_smem + wv * 256 + 128;
  const h16* xr = p.act + token * 1024 + lane * 16;
  const half8 x0 = *(const half8*)xr, x1 = *(const half8*)(xr + 8);
  int la = 0, lb = 0;
#pragma unroll
  for (int j = 0; j < 50; ++j) if (lane == j) { la = PT.a[j]; lb = PT.b[j]; }
  const int lc = la * 16 + lb;
  __syncthreads();
  float cs_[8]; int ce_[8];
#pragma unroll
  for (int hd = 0; hd < 8; ++hd) {
    const float* s1 = p.tks + token * 256 + hd * 32; const int* i1 = p.tki + token * 256 + hd * 32;
    const int la_ = lane < 50 ? la : 0, lb_ = lane < 50 ? lb : 0;
    cs_[hd] = s1[la_] + s1[16 + lb_]; ce_[hd] = i1[la_] * CFG_NKEYS + i1[16 + lb_];
  }
#pragma unroll
  for (int hd = 0; hd < 8; ++hd) {
    const float s = lane < 50 ? cs_[hd] : -3.0e38f;
    int rank = 0;
#pragma unroll
    for (int j = 0; j < 50; ++j) {
      const float sj = __builtin_bit_cast(float, __builtin_amdgcn_readlane(__builtin_bit_cast(int, s), j));
      rank += (sj > s) ? 1 : 0;
    }
    {
      int mk = (lane < 50 && rank < 16) ? (1 << rank) : 0;
      mk |= __builtin_amdgcn_update_dpp(0, mk, 0x128, 0xF, 0xF, true); mk |= __builtin_amdgcn_update_dpp(0, mk, 0x124, 0xF, 0xF, true);
      mk |= __builtin_amdgcn_update_dpp(0, mk, 0xB1, 0xF, 0xF, true);  mk |= __builtin_amdgcn_update_dpp(0, mk, 0x4E, 0xF, 0xF, true);
      const int mall = __builtin_amdgcn_readlane(mk, 0) | __builtin_amdgcn_readlane(mk, 16) | __builtin_amdgcn_readlane(mk, 32) | __builtin_amdgcn_readlane(mk, 48);
      const int nsel = __builtin_popcountll(__ballot(lane < 50 && rank < 16));
      if (mall != 0xFFFF || nsel != 16) {
        rank = 0;
#pragma unroll 1
        for (int j = 0; j < 50; ++j) {
          const float sj = __builtin_bit_cast(float, __builtin_amdgcn_readlane(__builtin_bit_cast(int, s), j));
          rank += (sj > s || (sj == s && j < lane)) ? 1 : 0;
        }
      }
    }
    const bool sel = lane < 50 && rank < 16;
    const float m = __builtin_bit_cast(float, __builtin_amdgcn_readlane(__builtin_bit_cast(int, s), 0));
    const float e = sel ? expf(s - m) : 0.f;
    const float sum = sum64(e);
    if (sel) { eidx[hd * 16 + rank] = ce_[hd]; egate[hd * 16 + rank] = e / sum; }
  }
  __syncthreads();
  f32x2 x2[8];
#pragma unroll
  for (int e = 0; e < 4; ++e) { x2[e][0] = (float)x0[2 * e]; x2[e][1] = (float)x0[2 * e + 1]; x2[4 + e][0] = (float)x1[2 * e]; x2[4 + e][1] = (float)x1[2 * e + 1]; }
  f32x2 acc2[8];
#pragma unroll
  for (int e = 0; e < 8; ++e) { acc2[e][0] = 0.f; acc2[e][1] = 0.f; }
  const unsigned char* u8 = (const unsigned char*)p.u16; const unsigned char* v8 = (const unsigned char*)p.v16;
#define PEER_LOAD(U, V, GT, EB)                                                                   \
  _Pragma("unroll") for (int q = 0; q < 8; ++q) {                                                 \
    const unsigned ro_ = (unsigned)eidx[(EB) + q] * 512u + (unsigned)lane * 8u; GT[q] = egate[(EB) + q];   \
    U[q] = *(const u32x2*)(u8 + ro_); V[q] = *(const u32x2*)(v8 + ro_);                           \
  }
#define PEER_COMP(U, V, GT)                                                                       \
  {                                                                                               \
    float dd_[8];                                                                                 \
    _Pragma("unroll") for (int q = 0; q < 8; ++q) {                                               \
      f32x2 d2 = {0.f, 0.f};                                                                      \
      _Pragma("unroll") for (int k = 0; k < 2; ++k) {                                             \
        d2 += __builtin_amdgcn_cvt_scalef32_pk_f32_fp4(U[q][k], 1.0f, 0) * x2[4 * k];             \
        d2 += __builtin_amdgcn_cvt_scalef32_pk_f32_fp4(U[q][k], 1.0f, 1) * x2[4 * k + 1];         \
        d2 += __builtin_amdgcn_cvt_scalef32_pk_f32_fp4(U[q][k], 1.0f, 2) * x2[4 * k + 2];         \
        d2 += __builtin_amdgcn_cvt_scalef32_pk_f32_fp4(U[q][k], 1.0f, 3) * x2[4 * k + 3];         \
      }                                                                                           \
      dd_[q] = sum64u(d2[0] + d2[1]) * (1.0f / PEER_USCALE);                                      \
    }                                                                                             \
      \
    float dv_ = dd_[7];                                                                           \
    _Pragma("unroll") for (int q = 6; q >= 0; --q) dv_ = lane == q ? dd_[q] : dv_;                \
    const float gv_ = 0.5f * dv_ * (1.0f + erff(dv_ * 0.70710678118654752f));                     \
    _Pragma("unroll") for (int q = 0; q < 8; ++q) {                                               \
      const float wgt = GT[q] * __builtin_bit_cast(float, __builtin_amdgcn_readlane(__builtin_bit_cast(int, gv_), q)) * (1.0f / PEER_VSCALE); \
      const f32x2 w2 = {wgt, wgt};                                                                \
      _Pragma("unroll") for (int k = 0; k < 2; ++k) {                                             \
        acc2[4 * k] += w2 * __builtin_amdgcn_cvt_scalef32_pk_f32_fp4(V[q][k], 1.0f, 0);           \
        acc2[4 * k + 1] += w2 * __builtin_amdgcn_cvt_scalef32_pk_f32_fp4(V[q][k], 1.0f, 1);       \
        acc2[4 * k + 2] += w2 * __builtin_amdgcn_cvt_scalef32_pk_f32_fp4(V[q][k], 1.0f, 2);       \
        acc2[4 * k + 3] += w2 * __builtin_amdgcn_cvt_scalef32_pk_f32_fp4(V[q][k], 1.0f, 3);       \
      }                                                                                           \
    }                                                                                             \
  }
  u32x2 au[8], av[8], bu[8], bv[8];
  float ag[8], bg[8];
  PEER_LOAD(au, av, ag, 0)
  for (int eb = 0; eb < 128; eb += 16) {
    PEER_LOAD(bu, bv, bg, eb + 8)
    __builtin_amdgcn_sched_barrier(0);
    PEER_COMP(au, av, ag)
    if (eb + 16 < 128) { PEER_LOAD(au, av, ag, eb + 16) }
    __builtin_amdgcn_sched_barrier(0);
    PEER_COMP(bu, bv, bg)
  }
#undef PEER_LOAD
#undef PEER_COMP
  const float* g2 = p.mod + ((long)l * NCOND + condrow(token)) * 6144 + 5120 + lane * 16;
  float* xo = p.X + token * 1024 + lane * 16;
  f32x4 xn[4]; float ssq = 0.f;
#pragma unroll
  for (int k = 0; k < 4; ++k) {
    xn[k] = *(f32x4*)(xo + 4 * k);
    const f32x4 ga = *(const f32x4*)(g2 + 4 * k);
#pragma unroll
    for (int e = 0; e < 4; ++e) { xn[k][e] += ga[e] * acc2[2 * k + (e >> 1)][e & 1]; ssq += xn[k][e] * xn[k][e]; }
  }
  if (DRY) { if (acc2[0][0] == 123456.789f) *(f32x4*)xo = xn[0]; return; }
  const float rstd = 1.0f / sqrtf(sum64u(ssq) * (1.0f / 1024) + 1e-6f);
  if (l == 0) {
    const float* m = p.mod + ((long)1 * NCOND + condrow(token)) * 6144 + lane * 16;
    const float* g = p.n1g + 1024 + lane * 16;
    half8 h0, h1;
    f32x4 gga[4], sha[4], sca[4];
#pragma unroll
    for (int k = 0; k < 4; ++k) { gga[k] = *(const f32x4*)(g + 4 * k); sha[k] = *(const f32x4*)(m + 4 * k); sca[k] = *(const f32x4*)(m + 1024 + 4 * k); }
#pragma unroll
    for (int k = 0; k < 4; ++k) {
      *(f32x4*)(xo + 4 * k) = xn[k];
      const f32x4 gg = gga[k], sh = sha[k], sc = sca[k];
#pragma unroll
      for (int e = 0; e < 4; ++e) {
        const h16 hv = (h16)((xn[k][e] * rstd * gg[e]) * (1.0f + sc[e]) + sh[e]);
        if (k < 2) h0[4 * k + e] = hv; else h1[4 * (k - 2) + e] = hv;
      }
    }
    h16* ho = p.act + token * 1024 + lane * 16;
    *(half8*)ho = h0; *(half8*)(ho + 8) = h1;
  } else {
    f32x4 fga[4];
#pragma unroll
    for (int k = 0; k < 4; ++k) fga[k] = *(const f32x4*)(p.fng + lane * 16 + 4 * k);
#pragma unroll
    for (int k = 0; k < 4; ++k) {
      const f32x4 gg = fga[k];
      f32x4 y;
#pragma unroll
      for (int e = 0; e < 4; ++e) y[e] = xn[k][e] * rstd * gg[e];
      *(f32x4*)(xo + 4 * k) = y;
    }
  }
}

__device__ void blk_attn(int type, int idx, const P& p, int l) {
  h16* Ks = (h16*)g_smem;
  h16* Vt = Ks + 64 * 72;
  float* Bt = (float*)(Vt + 64 * 72);
  const int tid = otid(), lane = tid & 63, wv = tid >> 6, ql = lane & 31, hh = lane >> 5;
  int b, hk, tb; long qtok; int qcol_off, kcol_off, vcol_off, outcol; float qscale; int ntl, ntc; long kbase_tok;
  const float *ck = nullptr, *cv = nullptr;
  int grow = 0, r0w = 0, krmin = 0;
  if (type == 0) {
    tb = idx & 3; hk = (idx >> 2) & 1; b = idx >> 3;
    const int head = hk * 2 + (wv & 1);
    kbase_tok = (long)b * CFG_SEQ; qtok = kbase_tok + tb * 64 + (wv >> 1) * 32 + ql;
    qcol_off = head * 64; kcol_off = 256 + hk * 64; vcol_off = 384 + hk * 64; outcol = head * 64; qscale = 1.0f; ntl = CFG_SEQ / 64; ntc = 0;
  } else if (type == 1) {
    tb = idx & 63; hk = (idx >> 6) & 1; b = idx >> 7;
    const int head = hk * 2 + (wv & 1);
    kbase_tok = (long)NTC + (long)b * CFG_DS; qtok = kbase_tok + tb * 64 + (wv >> 1) * 32 + ql;
    qcol_off = head * 64; kcol_off = 256 + hk * 64; vcol_off = 384 + hk * 64; outcol = head * 64; qscale = 1.0f; ntl = CFG_DS / 64; ntc = CFG_PAST / 64;
    ck = p.cgk + (((long)b * 2 + l) * 2 + hk) * CFG_PAST * 64; cv = p.cgv + (((long)b * 2 + l) * 2 + hk) * CFG_PAST * 64;
  } else if (type == 2) {
    tb = idx & 1; hk = (idx >> 1) & 3; b = idx >> 3;
    kbase_tok = (long)b * CFG_SEQ; qtok = kbase_tok + tb * 128 + wv * 32 + ql;
    qcol_off = NA_OFF + hk * 64; kcol_off = NA_OFF + 256 + hk * 64; vcol_off = NA_OFF + 512 + hk * 64; outcol = 512 + hk * 64; qscale = 0.125f; ntl = CFG_SEQ / 64; ntc = 0;
  } else {
    tb = idx & 31; hk = (idx >> 5) & 3; b = idx >> 7;
    kbase_tok = (long)NTC + (long)b * CFG_DS;
    grow = tb * 2 + (wv >> 1);
    qtok = kbase_tok + grow * 64 + (wv & 1) * 32 + ql;
    qcol_off = NA_OFF + hk * 64; kcol_off = NA_OFF + 256 + hk * 64; vcol_off = NA_OFF + 512 + hk * 64; outcol = 512 + hk * 64; qscale = 0.125f;
    r0w = grow - WR / 2; r0w = r0w < 0 ? 0 : (r0w > GROWS - WR ? GROWS - WR : r0w);
    int ra = tb * 2 - WR / 2; ra = ra < 0 ? 0 : (ra > GROWS - WR ? GROWS - WR : ra);
    int rb = tb * 2 + 1 - WR / 2; rb = rb < 0 ? 0 : (rb > GROWS - WR ? GROWS - WR : rb);
    krmin = ra; ntl = rb + WR - ra; ntc = CFG_PAST / 64;
    ck = p.cnk + (((long)b * 2 + l) * 4 + hk) * CFG_PAST * 64; cv = p.cnv + (((long)b * 2 + l) * 4 + hk) * CFG_PAST * 64;
  }
  const int nt = ntl + ntc;
  __syncthreads();
  if (type == 3) { for (int e = tid; e < 465; e += 256) Bt[e] = p.nabias[((long)l * 4 + hk) * 465 + e]; }
  half8 qf[4];
  {
    const h16* qp = p.proj + qtok * INC + qcol_off + hh * 8;
#pragma unroll
    for (int ds = 0; ds < 4; ++ds) qf[ds] = *(const half8*)(qp + ds * 16);
  }
  const int qc = (int)((qtok - kbase_tok) & 63);
  int cst = qc - 8; cst = cst < 0 ? 0 : (cst > 48 ? 48 : cst);
  f32x16 o0 = {0.f, 0.f, 0.f, 0.f, 0.f, 0.f, 0.f, 0.f, 0.f, 0.f, 0.f, 0.f, 0.f, 0.f, 0.f, 0.f};
  f32x16 o1 = o0;
  float m = -1.0e30f, lsum = 0.f;
  half8 kx0, kx1, vx0, vx1;
  const int skey0 = tid >> 3, sdc = tid & 7;
#define ATT_LOAD(TI)                                                                                       \
  {                                                                                                        \
    const int ti_ = (TI);                                                                                  \
    if (ti_ < ntc) {                                                                                       \
      const float* kk_ = ck + ((long)ti_ * 64 + skey0) * 64 + sdc * 8;                                     \
      const float* vv_ = cv + ((long)ti_ * 64 + skey0) * 64 + sdc * 8;                                     \
      f32x4 a_ = *(const f32x4*)kk_, b_ = *(const f32x4*)(kk_ + 4), c_ = *(const f32x4*)(kk_ + 2048), d_ = *(const f32x4*)(kk_ + 2052); \
      _Pragma("unroll") for (int e = 0; e < 4; ++e) { kx0[e] = (h16)a_[e]; kx0[4 + e] = (h16)b_[e]; kx1[e] = (h16)c_[e]; kx1[4 + e] = (h16)d_[e]; } \
      a_ = *(const f32x4*)vv_; b_ = *(const f32x4*)(vv_ + 4); c_ = *(const f32x4*)(vv_ + 2048); d_ = *(const f32x4*)(vv_ + 2052); \
      _Pragma("unroll") for (int e = 0; e < 4; ++e) { vx0[e] = (h16)a_[e]; vx0[4 + e] = (h16)b_[e]; vx1[e] = (h16)c_[e]; vx1[4 + e] = (h16)d_[e]; } \
    } else {                                                                                               \
      const long t0_ = kbase_tok + (long)((type == 3 ? krmin : 0) + (ti_ - ntc)) * 64;                     \
      const h16* r_ = p.proj + (t0_ + skey0) * INC + sdc * 8;                                              \
      kx0 = *(const half8*)(r_ + kcol_off); kx1 = *(const half8*)(r_ + 32 * INC + kcol_off);              \
      vx0 = *(const half8*)(r_ + vcol_off); vx1 = *(const half8*)(r_ + 32 * INC + vcol_off);              \
    }                                                                                                      \
  }
  ATT_LOAD(0)
  for (int ti = 0; ti < nt; ++ti) {
    __syncthreads();
    *(half8*)(Ks + skey0 * 72 + sdc * 8) = kx0; *(half8*)(Ks + (skey0 + 32) * 72 + sdc * 8) = kx1;
    *(half8*)(Vt + skey0 * 72 + sdc * 8) = vx0; *(half8*)(Vt + (skey0 + 32) * 72 + sdc * 8) = vx1;
    __syncthreads();
    if (ti + 1 < nt) ATT_LOAD(ti + 1)
    __builtin_amdgcn_sched_barrier(0);
    const bool local = type == 3 && ti >= ntc;
    const int kr = krmin + (ti - ntc);
    if (local && (kr < r0w || kr >= r0w + WR)) continue;
    f32x16 s0 = {0.f, 0.f, 0.f, 0.f, 0.f, 0.f, 0.f, 0.f, 0.f, 0.f, 0.f, 0.f, 0.f, 0.f, 0.f, 0.f};
    f32x16 s1 = s0;
#pragma unroll
    for (int ds = 0; ds < 4; ++ds) {
      const half8 a0 = *(const half8*)(Ks + ql * 72 + ds * 16 + hh * 8);
      const half8 a1 = *(const half8*)(Ks + (32 + ql) * 72 + ds * 16 + hh * 8);
      s0 = __builtin_amdgcn_mfma_f32_32x32x16_f16(a0, qf[ds], s0, 0, 0, 0);
      s1 = __builtin_amdgcn_mfma_f32_32x32x16_f16(a1, qf[ds], s1, 0, 0, 0);
    }
    float mx = -1.0e30f;
    if (local) {
      const float* brow = Bt + (kr - grow + 7) * 31 + 15 - qc;
#pragma unroll
      for (int i = 0; i < 16; ++i) {
        const int kc0 = (i & 3) + 8 * (i >> 2) + 4 * hh, kc1 = kc0 + 32;
        s0[i] = (kc0 >= cst && kc0 < cst + 16) ? s0[i] * 0.125f + brow[kc0] : -1.0e30f;
        s1[i] = (kc1 >= cst && kc1 < cst + 16) ? s1[i] * 0.125f + brow[kc1] : -1.0e30f;
      }
    } else if (qscale != 1.0f) {
#pragma unroll
      for (int i = 0; i < 16; ++i) { s0[i] *= qscale; s1[i] *= qscale; }
    }
#pragma unroll
    for (int i = 0; i < 16; ++i) mx = fmaxf(mx, fmaxf(s0[i], s1[i]));
    mx = fmaxf(mx, __shfl_xor(mx, 32));
    const float mn = fmaxf(m, mx);
    const float alpha = __expf(m - mn);
    m = mn; lsum *= alpha;
#pragma unroll
    for (int i = 0; i < 16; ++i) { o0[i] *= alpha; o1[i] *= alpha; }
    float ps = 0.f;
#pragma unroll
    for (int i = 0; i < 16; ++i) { s0[i] = __expf(s0[i] - mn); s1[i] = __expf(s1[i] - mn); ps += s0[i] + s1[i]; }
    lsum += ps;
    half8 pf0, pf1, pf2, pf3;
#pragma unroll
    for (int j = 0; j < 8; ++j) { pf0[j] = (h16)s0[j]; pf1[j] = (h16)s0[8 + j]; pf2[j] = (h16)s1[j]; pf3[j] = (h16)s1[8 + j]; }
#define TRD(ptr) __builtin_bit_cast(half4, __builtin_amdgcn_ds_read_tr16_b64_v4i16((__attribute__((address_space(3))) s16x4v*)(ptr)))
#define ATT_PV(KS, PF)                                                                              \
    {                                                                                               \
        \
      const h16* v0_ = Vt + (16 * (KS) + 4 * hh + ((lane & 15) >> 2)) * 72 + 16 * ((lane >> 4) & 1) + 4 * (lane & 3); \
      const half4 lo0 = TRD(v0_), hi0 = TRD(v0_ + 8 * 72);                                          \
      const half4 lo1 = TRD(v0_ + 32), hi1 = TRD(v0_ + 8 * 72 + 32);                                \
      const half8 a0_ = __builtin_shufflevector(lo0, hi0, 0, 1, 2, 3, 4, 5, 6, 7);                  \
      const half8 a1_ = __builtin_shufflevector(lo1, hi1, 0, 1, 2, 3, 4, 5, 6, 7);                  \
      o0 = __builtin_amdgcn_mfma_f32_32x32x16_f16(a0_, PF, o0, 0, 0, 0);                            \
      o1 = __builtin_amdgcn_mfma_f32_32x32x16_f16(a1_, PF, o1, 0, 0, 0);                            \
    }
    ATT_PV(0, pf0) ATT_PV(1, pf1) ATT_PV(2, pf2) ATT_PV(3, pf3)
#undef ATT_PV
#undef TRD
  }
#undef ATT_LOAD
  lsum += __shfl_xor(lsum, 32);
  const float inv = 1.0f / lsum;
  h16* op = p.act + qtok * 1024 + outcol;
#pragma unroll
  for (int g = 0; g < 4; ++g) {
    half4 a, c;
#pragma unroll
    for (int e = 0; e < 4; ++e) { a[e] = (h16)(o0[4 * g + e] * inv); c[e] = (h16)(o1[4 * g + e] * inv); }
    *(half4*)(op + 8 * g + 4 * hh) = a;
    *(half4*)(op + 32 + 8 * g + 4 * hh) = c;
  }
}
#define N_SCAN_LAT (2 * 2 * CFG_DB * 4 * 2)
#define N_SCAN_CTX (2 * 2 * CFG_BATCH * 4 * 2)
#define N_ATT1 (CFG_DB * 2 * (CFG_DS / 64))
#define N_ATT3 (CFG_DB * 4 * (CFG_DS / 128))
#define N_ATT0 (CFG_BATCH * 2 * (CFG_SEQ / 64))
#define N_ATT2 (CFG_BATCH * 4 * (CFG_SEQ / 128))
__device__ __forceinline__ void run_scan_item(int r, bool latent, const P& p, int l) {
  const int rq = r & 1; r >>= 1; const int kind = r & 1; r >>= 1; const int d = r & 1; r >>= 1; const int h = r & 3; r >>= 2;
  if (latent) __builtin_amdgcn_s_setprio(3);
  blk_scan2(kind, latent ? CFG_BATCH + r : r, h, d, rq, p, l);
  if (latent) __builtin_amdgcn_s_setprio(0);
}
__device__ void mixer_phase(const P& p, int lc, int mode = 0) {
  const int l = lc & 1;
  __shared__ long s_item;
  __shared__ unsigned s_slot;
  const long total = N_SCAN_CTX + N_ATT1 + N_ATT3 + N_ATT0 + N_ATT2;
  unsigned* lat_cnt = p.counters + 8 + lc;
  if (mode == 0) {
    __syncthreads();
    if (threadIdx.x == 0) {
      const unsigned hw = __builtin_amdgcn_s_getreg((31 << 11) | 4);
      const unsigned xcc = __builtin_amdgcn_s_getreg((3 << 11) | 20) & 0xFu;
      const unsigned key = (xcc << 8) | ((hw >> 8) & 0xFFu);
      const unsigned slot = atomicAdd(p.cucnt + lc * 4096 + key, 1u);
      s_slot = slot;
      s_item = slot == 0 ? (long)atomicAdd(lat_cnt, 1u) : (long)N_SCAN_LAT;
    }
    __syncthreads();
    const long w = s_item;
    if (w < N_SCAN_LAT) run_scan_item((int)w, true, p, l);
  }
  for (;;) {
    __syncthreads();
    if (threadIdx.x == 0) s_item = (long)atomicAdd(p.counters + lc, 1u);
    __syncthreads();
    long w = s_item;
    if (mode == 2) w += N_SCAN_CTX;
    if (w >= (mode == 1 ? (long)N_SCAN_CTX : total)) break;
    if (w < N_SCAN_CTX) {
      run_scan_item((int)w, false, p, l);
    } else {
      int a = (int)(w - N_SCAN_CTX);
      int ty;
      if (a < N_ATT1) ty = 1;
      else if ((a -= N_ATT1) < N_ATT3) ty = 3;
      else if ((a -= N_ATT3) < N_ATT0) ty = 0;
      else { a -= N_ATT0; ty = 2; }
      blk_attn(ty, a, p, l);
    }
  }
  if (mode != 2) {
    for (;;) {
      __syncthreads();
      if (threadIdx.x == 0) s_item = (long)atomicAdd(lat_cnt, 1u);
      __syncthreads();
      const long w = s_item;
      if (w >= N_SCAN_LAT) break;
      run_scan_item((int)w, true, p, l);
    }
  }
}


#define XB_TMO      128
#define XB_XCNT(j)  (256  + 64 * (j))
#define XB_XSUB(j)  (1280 + 64 * (j))
#define XB_XGEN(j)  (2304 + 64 * (j))
#define XB_TOP      3328
#define XB_TOPGEN   3392
#define XCD_BAR_WORDS 3456
#define XB_SPIN_CAP (1u << 22)
#define LAS __attribute__((address_space(3)))
__device__ __forceinline__ unsigned xb_ld(unsigned* p)              { return __hip_atomic_load(p, __ATOMIC_RELAXED, __HIP_MEMORY_SCOPE_AGENT); }
__device__ __forceinline__ unsigned xb_add(unsigned* p, unsigned v) { return __hip_atomic_fetch_add(p, v, __ATOMIC_RELAXED, __HIP_MEMORY_SCOPE_AGENT); }
__device__ __forceinline__ unsigned xb_xcc_id() { return (unsigned)__builtin_amdgcn_s_getreg((3 << 11) | 20) & 0xFu; }
#define XB_SPIN(cond, bar) do { unsigned _sp = 0; while (cond) { __builtin_amdgcn_s_sleep(1); \
    if ((++_sp & 255u) == 0u) { if (xb_ld(&(bar)[XB_TMO])) break; if (_sp > XB_SPIN_CAP) { atomicAdd(&(bar)[XB_TMO], 1u); break; } } } } while (0)
struct XcdBarrier { unsigned* bar; unsigned x; volatile LAS unsigned* st; };
__device__ __forceinline__ XcdBarrier xcd_barrier_post(unsigned* bar, volatile LAS unsigned* st) {
  XcdBarrier b; b.bar = bar; b.x = xb_xcc_id(); b.st = st;
  if (threadIdx.x == 0) (void)xb_add(&bar[XB_XCNT(b.x)], 1u);
  return b;
}
__device__ __forceinline__ void xcd_barrier_complete(unsigned* bar, unsigned x, unsigned& nloc, unsigned& nx) {
  const unsigned G = gridDim.x * gridDim.y * gridDim.z;
  unsigned sum, cnt, mine, sp = 0u;
  for (;;) {
    sum = 0u; cnt = 0u; mine = 0u;
#pragma unroll
    for (unsigned j = 0; j < 16; ++j) { const unsigned c = xb_ld(&bar[XB_XCNT(j)]); sum += c; cnt += (c > 0u) ? 1u : 0u; mine = (j == x) ? c : mine; }
    if (sum == G) break;
    __builtin_amdgcn_s_sleep(1);
    if ((++sp & 255u) == 0u) { if (xb_ld(&bar[XB_TMO])) break; if (sp > XB_SPIN_CAP) { atomicAdd(&bar[XB_TMO], 1u); break; } }
  }
  nloc = mine > 0u ? mine : 1u; nx = cnt > 0u ? cnt : 1u;
}
__device__ __forceinline__ void xcd_barrier(const XcdBarrier& b) {
  asm volatile("s_waitcnt vmcnt(0)" ::: "memory");
  __syncthreads();
  if (threadIdx.x == 0) {
    unsigned* bar = b.bar;
    __builtin_amdgcn_s_waitcnt(0);
    unsigned nloc = b.st[0], nx = b.st[1];
    if (nloc == 0u) { xcd_barrier_complete(bar, b.x, nloc, nx); b.st[0] = nloc; b.st[1] = nx; }
    const unsigned old = xb_add(&bar[XB_XSUB(b.x)], 1u);
    const unsigned gen = old / nloc;
    if (old + 1u == (gen + 1u) * nloc) {
      __builtin_amdgcn_fence(__ATOMIC_RELEASE, "agent");
      asm volatile("s_waitcnt vmcnt(0)" ::: "memory");
      const unsigned og = xb_add(&bar[XB_TOP], 1u);
      const unsigned tg = og / nx;
      if (og + 1u == (tg + 1u) * nx) xb_add(&bar[XB_TOPGEN], 1u);
      else XB_SPIN(xb_ld(&bar[XB_TOPGEN]) == tg, bar);
      __builtin_amdgcn_fence(__ATOMIC_ACQUIRE, "agent");
      xb_add(&bar[XB_XGEN(b.x)], 1u);
      asm volatile("s_waitcnt vmcnt(0)" ::: "memory");
    } else {
      XB_SPIN(xb_ld(&bar[XB_XGEN(b.x)]) == gen, bar);
      __builtin_amdgcn_fence(__ATOMIC_ACQUIRE, "agent");
      asm volatile("s_waitcnt vmcnt(0)" ::: "memory");
    }
  }
  __syncthreads();
}

#define STAGE(fn, n) for (long i_ = (long)blockIdx.x * 256 + otid(); i_ < (long)(n); i_ += (long)gridDim.x * 256) fn(i_, p, l);
#define BSTAGE(fn, n) for (long w_ = blockIdx.x; w_ < (long)(n); w_ += gridDim.x) fn(w_, p, l);
#define SYNC { XcdBarrier xb_; xb_.bar = p.xbar; xb_.x = xb_xcc_id(); xb_.st = (volatile LAS unsigned*)&xb_words; xcd_barrier(xb_); }
__global__ void __launch_bounds__(256, 2) mega(P p) {
  cg::grid_group grid = cg::this_grid();
  __shared__ uint4 xb_words;
  if (threadIdx.x == 0) xb_words = make_uint4(0u, 0u, 0u, 0u);
  __syncthreads();
  (void)xcd_barrier_post(p.xbar, (volatile LAS unsigned*)&xb_words);
#define gtid ((long)blockIdx.x * 256 + otid())
#define gstride ((long)gridDim.x * 256)
  { int l = 0;
    if (gtid < 16) p.counters[gtid] = 0u;
    for (long i_ = gtid; i_ < 4 * 4096; i_ += gstride) p.cucnt[i_] = 0u;
    for (int rep_ = 0; rep_ < REP_S0; ++rep_) {
    for (long w_ = blockIdx.x; w_ < 3200; w_ += gridDim.x) blk_convert(w_, p);
    for (long w_ = blockIdx.x; w_ < 2L * NCOND * 24; w_ += gridDim.x) blk_mod(w_, p);
    for (long i_ = gtid; i_ < 2L * 16 * CFG_NKEYS * 128 / 8; i_ += gstride) cvt8(p.pkeys, p.keys16, i_);
    }
  }
  grid.sync();
#pragma unroll 1
  for (int ph = 0; ph < 18; ++ph) {
    const int l = ph >= 9 ? 1 : 0; const int k = ph - 9 * l;
    if (k == 0 && l == 1) continue;
    switch (k) {
      case 0: { BSTAGE(blk_norm<0>, NT / 4) } break;
      case 1: gemm_phase<0>(p, l); break;
      case 2: {
        STAGE(b_prep_gqa, (long)NT * 6)
        STAGE(b_prep_cache, (long)NTC * 640)
        half8 bf0 = {0, 0, 0, 0, 0, 0, 0, 0}, bf1 = bf0; int bkey = -1;
        for (long w_ = blockIdx.x; w_ < (long)N_PREP_RW + N_PREP_DN; w_ += gridDim.x) blk_scanprep(w_, p, l, bf0, bf1, bkey);
      } break;
      case 3:
#ifdef PROBE_MIXER2
        mixer_phase(p, l + 2); SYNC
#endif
        mixer_phase(p, l); break;
      case 4: fin_phase(p, l); break;
      case 5: {
        gemm_phase<1>(p, l);
        for (long i_ = gtid; i_ < (long)NEXP * 1024 / 16; i_ += gstride) {
          cvt16_fp4(p.pu + (long)l * NEXP * 1024, (unsigned char*)p.u16, i_, PEER_USCALE);
          cvt16_fp4(p.pv + (long)l * NEXP * 1024, (unsigned char*)p.v16, i_, PEER_VSCALE);
        }
      } break;
      case 6: { BSTAGE(blk_norm<1>, NT / 4) } break;
      case 7: gemm_phase<2>(p, l); break;
      default: { BSTAGE(blk_peer<false>, NT / 4) } break;
    }
    if (ph != 17) SYNC
  }
}
#else
#define STAGE(fn, n) { _Pragma("omp parallel for schedule(dynamic, 64)") for (long i_ = 0; i_ < (long)(n); ++i_) fn(i_, p, l); }
#define SYNC
void mega(P p) {
  { int l = 0;
    STAGE(b_init, (long)NT * 1024)
    STAGE(b_mod, 2L * NCOND * 6144)
  }
  for (int l = 0; l < 2; ++l) {
    STAGE(b_norm<0>, NT)
    STAGE(b_inproj, (long)NT * INC)
    STAGE(b_prep_gqa, (long)NT * 6)
    STAGE(b_prep_cache, (long)NTC * 640)
    STAGE(b_rwaux, (long)NT * 512)
    STAGE(b_dnconv, (long)NT * 768)
    STAGE(b_dnnorm, (long)NT * 8)
    STAGE(b_rwscan, NSCAN)
    STAGE(b_dnscan, NSCAN)
    STAGE(b_attn_gqa, (long)NT * 4)
    STAGE(b_attn_na, (long)NT * 4)
    STAGE(b_rwfin, (long)NT * 4)
    STAGE(b_dnfin, (long)NT * 4)
    STAGE(b_outproj, (long)NT * 1024)
    STAGE(b_norm<1>, NT)
    STAGE(b_peerq, (long)NT * 2048)
    STAGE(b_topk1, (long)NT * 16)
    STAGE(b_topk2, (long)NT * 8)
    STAGE(b_peer_act, (long)NT * 128)
    STAGE(b_peer_out, (long)NT * 1024)
  }
  { int l = 0; STAGE(b_final, NT) }
}
#endif

static void fill_params(P& p, void* const* d_in, void* d_out, void* d_ws) {
  const float** f = (const float**)&p;
  for (int i = 0; i < 39; ++i) f[i] = (const float*)d_in[i];
  float* o = (float*)d_out;
  p.X = o; o += (long)NT * 1024;
  p.ogk = o; o += (long)CFG_BATCH * 2 * 2 * CFG_SEQ * 64;
  p.ogv = o; o += (long)CFG_BATCH * 2 * 2 * CFG_SEQ * 64;
  p.onk = o; o += (long)CFG_BATCH * 2 * 4 * CFG_SEQ * 64;
  p.onv = o; o += (long)CFG_BATCH * 2 * 4 * CFG_SEQ * 64;
  p.orw = o; o += (long)CFG_BATCH * 2 * 2 * 4 * 4096;
  p.odn = o;
  char* w = (char*)d_ws;
  auto take = [&](size_t bytes) { char* r = w; w += (bytes + 255) & ~(size_t)255; return r; };
  p.xbar = (unsigned*)take(16384);
  p.counters = (unsigned*)take(256);
  p.cucnt = (unsigned*)take(4 * 4096 * 4);
  p.mod = (float*)take(2L * NCOND * 6144 * 4);
  p.act = (h16*)take((size_t)NT * 1024 * sizeof(h16));
  p.rwaux = (h16*)take((size_t)NT * 1024 * sizeof(h16));
  p.dnp = (h16*)take((size_t)NT * 768 * sizeof(h16));
  p.proj = (h16*)take((size_t)NT * INC * sizeof(h16));
  p.wtin = (h16*)take((size_t)2 * NPAD_IN * 1024 * sizeof(h16));
  p.wtout = (h16*)take((size_t)2 * 1024 * 1024 * sizeof(h16));
  p.wtq = (h16*)take((size_t)2 * 2048 * 1024 * sizeof(h16));
  p.rwsc = (float*)take((size_t)NT * 16 * 4);
  p.dnsc = (float*)take((size_t)NT * 16 * 4);
  p.keys16 = (h16*)take((size_t)2 * 16 * CFG_NKEYS * 128 * sizeof(h16));
  char* a = (char*)p.proj;
#ifdef HOST_EMU
  p.pq = (h16*)a; a += (size_t)NT * 2048 * sizeof(h16);
#endif
  p.tks = (float*)a; a += (size_t)NT * 256 * 4;
  p.tki = (int*)a; a += (size_t)NT * 256 * 4;
  p.u16 = (h16*)a; a += (size_t)NEXP * 1024 * sizeof(h16);
  p.v16 = (h16*)a; a += (size_t)NEXP * 1024 * sizeof(h16);
  p.pidx = (int*)p.rwaux;
  p.pact = (float*)((char*)p.rwaux + (size_t)NT * 128 * 4);
}

#ifndef HOST_EMU
extern "C" void kernel_launch(void* const* d_in, const int* in_sizes, int n_in, void* d_out, int out_size, void* d_ws,
                              size_t ws_size, hipStream_t stream) {
  static int grid_blocks = 0;
  if (!grid_blocks) {
    int dev = 0, cus = 0, per_cu = 0;
    (void)hipGetDevice(&dev);
    (void)hipDeviceGetAttribute(&cus, hipDeviceAttributeMultiprocessorCount, dev);
    (void)hipOccupancyMaxActiveBlocksPerMultiprocessor(&per_cu, mega, 256, 0);
    grid_blocks = cus * per_cu;
  }
  P p;
  memset(&p, 0, sizeof(p));
  fill_params(p, d_in, d_out, d_ws);
  (void)hipMemsetAsync(p.xbar, 0, 16384, stream);
  void* args[] = {&p};
  hipError_t e = hipLaunchCooperativeKernel((void*)mega, dim3(grid_blocks), dim3(256), args, 0, stream);
  if (e != hipSuccess) fprintf(stderr, "cooperative launch failed: %s (grid %d)\n", hipGetErrorString(e), grid_blocks);
}
#endif
```
